# Optimizing an MI355X kernel written in HIP

```python
import jax, jax.numpy as jnp
from jax import lax
import numpy as np

D_MODEL = 1024
BATCH = 4
SEQ = 4096
DEPTH = 1

GRID_W = 64
CTX_LEN = 256
POOL_WINDOWS = (2, 4, 8, 16)
POOL_GROUPS = len(POOL_WINDOWS)
POOL_GROUP_DIM = 128
POOL_WIDTH = POOL_GROUPS * POOL_GROUP_DIM
HG_HEADS = 4
HG_KEY_DIM = 128
HG_VAL_DIM = 128
HG_QK_WIDTH = HG_HEADS * HG_KEY_DIM
HG_V_WIDTH = HG_HEADS * HG_VAL_DIM
HG_CHUNK = 16
N_BRANCH = 2
IN_WIDTH = POOL_WIDTH + 3 * HG_QK_WIDTH + 2 * HG_V_WIDTH + N_BRANCH * D_MODEL
PEER_HEADS = 8
PEER_NKEYS = 128
PEER_EXPERTS = PEER_NKEYS * PEER_NKEYS
PEER_KEY_HALF = 128
PEER_TOPK = 16
PEER_BLOCK = 128
N_MOD = 6
EPS = 1e-6

kernel_name = 'hybrid_pool_hgrn2_peer_dit_block'


def rms_norm(x, g):
    xf = x.astype(jnp.float32)
    y = xf * lax.rsqrt(jnp.mean(xf * xf, axis=-1, keepdims=True) + EPS)
    return (y * g.astype(jnp.float32)).astype(x.dtype)


def modulate(x, g, shift, scale):
    return rms_norm(x, g) * (1 + scale) + shift


def split_proj(h, w_in):
    z = h @ w_in
    idx = list(np.cumsum([POOL_WIDTH, HG_QK_WIDTH, HG_V_WIDTH, HG_QK_WIDTH, HG_QK_WIDTH, HG_V_WIDTH, D_MODEL]))
    return jnp.split(z, idx, axis=-1)


def box_sum(x, w, axis):
    n = x.shape[axis]
    cs = jnp.cumsum(x.astype(jnp.float32), axis=axis)
    pad = [(0, 0)] * x.ndim
    pad[axis] = (1, 0)
    cs = jnp.pad(cs, pad)
    t = jnp.arange(n)
    lo = jnp.clip(t - w // 2, 0, n)
    hi = jnp.clip(t - w // 2 + w, 0, n)
    s = jnp.take(cs, hi, axis=axis) - jnp.take(cs, lo, axis=axis)
    return s, (hi - lo).astype(jnp.float32)


def pool_branch(p, pool_w, pool_scale, on_grid):
    B, L, _ = p.shape
    outs = []
    for g, win in enumerate(POOL_WINDOWS):
        pg = p[..., g * POOL_GROUP_DIM:(g + 1) * POOL_GROUP_DIM]
        if on_grid:
            rows = L // GRID_W
            s, cr = box_sum(pg.reshape(B, rows, GRID_W, POOL_GROUP_DIM), win, 1)
            s, cc = box_sum(s, win, 2)
            mean = (s / (cr[:, None] * cc[None, :])[None, :, :, None]).reshape(B, L, POOL_GROUP_DIM)
        else:
            s, cnt = box_sum(pg, win, 1)
            mean = s / cnt[None, :, None]
        outs.append((mean.astype(p.dtype) - pg) @ pool_w[g])
    return jnp.concatenate(outs, axis=-1) * pool_scale


def chunk_scan(q, k, v, log_f, s0):
    B, L, H, _ = q.shape
    n = L // HG_CHUNK
    r = lambda t: t.reshape(B, n, HG_CHUNK, H, t.shape[-1]).astype(jnp.float32)
    qc, kc, vc, gc = r(q), r(k), r(v), r(log_f)
    b = jnp.cumsum(gc, axis=2)
    mask = jnp.tril(jnp.ones((HG_CHUNK, HG_CHUNK), bool))
    diff = b[:, :, :, None] - b[:, :, None, :]
    decay = jnp.exp(jnp.where(mask[:, :, None, None], diff, -jnp.inf))
    attn = jnp.einsum('bntshk,bnthk,bnshk->bntsh', decay, qc, kc)
    o_intra = jnp.einsum('bntsh,bnshv->bnthv', attn, vc)
    b_last = b[:, :, -1]
    k_dec = kc * jnp.exp(b_last[:, :, None] - b)
    u = jnp.einsum('bnshk,bnshv->bnhkv', k_dec, vc)
    a = jnp.exp(b_last)

    def step(S, inp):
        a_n, u_n = inp
        return a_n[..., None] * S + u_n, S

    s_final, s_prev = lax.scan(step, s0, (jnp.moveaxis(a, 1, 0), jnp.moveaxis(u, 1, 0)))
    s_prev = jnp.moveaxis(s_prev, 0, 1)
    o_inter = jnp.einsum('bnthk,bnhkv->bnthv', qc * jnp.exp(b), s_prev)
    return (o_intra + o_inter).reshape(B, L, H, -1), s_final


def hgrn2_direction(q, i, f_raw, lb, s0, reverse):
    f = lb + (1 - lb) * jax.nn.sigmoid(f_raw.astype(jnp.float32))
    log_f = jnp.log(f)
    k = 1 - f
    if reverse:
        q, k, i, log_f = (jnp.flip(t, axis=1) for t in (q, k, i, log_f))
    o, s = chunk_scan(q, k, i, log_f, s0)
    if reverse:
        o = jnp.flip(o, axis=1)
    return o, s


def hgrn2_branch(parts, lb, norm_g, init_states):
    heads = lambda t: t.reshape(t.shape[0], t.shape[1], HG_HEADS, -1)
    q, i, f_fwd, f_bwd, og = (heads(t) for t in parts[1:6])
    B, L = q.shape[0], q.shape[1]
    if init_states is None:
        zero = jnp.zeros((B, HG_HEADS, HG_KEY_DIM, HG_VAL_DIM), jnp.float32)
        init_states = (zero, zero)
    lb = lb.reshape(2, HG_HEADS, HG_KEY_DIM)
    o_f, s_f = hgrn2_direction(q, i, f_fwd, lb[0], init_states[0], False)
    o_b, s_b = hgrn2_direction(q, i, f_bwd, lb[1], init_states[1], True)
    o = rms_norm(o_f + o_b, norm_g) * jax.nn.silu(og.astype(jnp.float32))
    return o.reshape(B, L, HG_V_WIDTH).astype(parts[0].dtype), (s_f, s_b)


def merge_branches(parts, y_pool, y_hg, w_a, w_b, w_o):
    g_pool, g_hg = parts[6], parts[7]
    m = jax.nn.sigmoid(g_pool) * (y_pool @ w_a) + jax.nn.sigmoid(g_hg) * (y_hg @ w_b)
    return m @ w_o


def peer_ffn(h, w_q, sub_keys, u, v):
    B, L, D = h.shape
    blocks = h.reshape(-1, PEER_BLOCK, D)

    def block(hb):
        T = hb.shape[0]
        q = (hb @ w_q).reshape(T, PEER_HEADS, 2, PEER_KEY_HALF)
        s = jnp.einsum('thpc,hpnc->thpn', q, sub_keys).astype(jnp.float32)
        v1, i1 = lax.top_k(s[:, :, 0], PEER_TOPK)
        v2, i2 = lax.top_k(s[:, :, 1], PEER_TOPK)
        cand = (v1[..., :, None] + v2[..., None, :]).reshape(T, PEER_HEADS, PEER_TOPK * PEER_TOPK)
        cidx = (i1[..., :, None] * PEER_NKEYS + i2[..., None, :]).reshape(T, PEER_HEADS, PEER_TOPK * PEER_TOPK)
        top_s, pos = lax.top_k(cand, PEER_TOPK)
        eidx = jnp.take_along_axis(cidx, pos, axis=-1)
        gate = jax.nn.softmax(top_s, axis=-1)
        act = jax.nn.gelu(jnp.einsum('td,thkd->thk', hb, u[eidx]).astype(jnp.float32), approximate=False)
        return jnp.einsum('thk,thkd->td', (gate * act).astype(hb.dtype), v[eidx])

    return lax.map(block, blocks).reshape(B, L, D)


def setup_inputs(seed: int = 0) -> dict:
    key = jax.random.key(seed)
    ks = jax.random.split(key, 24)
    nrm = lambda k, shape, s: jax.random.normal(k, shape, jnp.float32) * s
    D = D_MODEL
    return {
        'x': nrm(ks[0], (BATCH, SEQ, D), 1.0),
        'c': nrm(ks[1], (BATCH, D), 1.0),
        'ctx': nrm(ks[2], (BATCH, CTX_LEN, D), 1.0),
        'c_ctx': nrm(ks[3], (D,), 1.0),
        'w_mod': nrm(ks[4], (DEPTH, D, N_MOD * D), 0.5 * D ** -0.5),
        'b_mod': nrm(ks[5], (DEPTH, N_MOD * D), 0.01),
        'norm1_g': 1.0 + nrm(ks[6], (DEPTH, D), 0.01),
        'norm2_g': 1.0 + nrm(ks[7], (DEPTH, D), 0.01),
        'w_in': nrm(ks[8], (DEPTH, D, IN_WIDTH), D ** -0.5),
        'pool_w': nrm(ks[9], (DEPTH, POOL_GROUPS, POOL_GROUP_DIM, POOL_GROUP_DIM), POOL_GROUP_DIM ** -0.5),
        'pool_scale': 1.0 + nrm(ks[10], (DEPTH, POOL_WIDTH), 0.01),
        'hg_lb_logits': nrm(ks[11], (2, DEPTH + 1, HG_QK_WIDTH), 0.1),
        'hg_norm_g': 1.0 + nrm(ks[12], (DEPTH, HG_VAL_DIM), 0.01),
        'w_a': nrm(ks[13], (DEPTH, POOL_WIDTH, D), POOL_WIDTH ** -0.5),
        'w_b': nrm(ks[14], (DEPTH, HG_V_WIDTH, D), HG_V_WIDTH ** -0.5),
        'w_o': nrm(ks[15], (DEPTH, D, D), D ** -0.5),
        'peer_wq': nrm(ks[16], (DEPTH, D, PEER_HEADS * 2 * PEER_KEY_HALF), D ** -0.5),
        'peer_keys': nrm(ks[17], (DEPTH, PEER_HEADS, 2, PEER_NKEYS, PEER_KEY_HALF), PEER_KEY_HALF ** -0.5),
        'peer_u': nrm(ks[18], (DEPTH, PEER_EXPERTS, D), D ** -0.5),
        'peer_v': nrm(ks[19], (DEPTH, PEER_EXPERTS, D), PEER_HEADS ** -0.5),
        'final_g': 1.0 + nrm(ks[20], (D,), 0.01),
    }


def reference(x, c, ctx, c_ctx, w_mod, b_mod, norm1_g, norm2_g, w_in, pool_w, pool_scale,
              hg_lb_logits, hg_norm_g, w_a, w_b, w_o, peer_wq, peer_keys, peer_u, peer_v, final_g):
    hs = ctx
    lbs = jnp.cumsum(jax.nn.softmax(hg_lb_logits.astype(jnp.float32), axis=1), axis=1)
    for l in range(DEPTH):
        last = l == DEPTH - 1
        mod = (jax.nn.silu(c) @ w_mod[l] + b_mod[l])[:, None, :]
        mod_c = (jax.nn.silu(c_ctx) @ w_mod[l] + b_mod[l])[None, None, :]
        sh1, sc1, g1, sh2, sc2, g2 = jnp.split(mod, N_MOD, axis=-1)
        csh1, csc1, cg1, csh2, csc2, cg2 = jnp.split(mod_c, N_MOD, axis=-1)
        lb = lbs[:, l]

        pc = split_proj(modulate(hs, norm1_g[l], csh1, csc1), w_in[l])
        pl = split_proj(modulate(x, norm1_g[l], sh1, sc1), w_in[l])
        yc_hg, ctx_states = hgrn2_branch(pc, lb, hg_norm_g[l], None)
        yl_hg, _ = hgrn2_branch(pl, lb, hg_norm_g[l], ctx_states)
        yl_pool = pool_branch(pl[0], pool_w[l], pool_scale[l], True)
        x = x + g1 * merge_branches(pl, yl_pool, yl_hg, w_a[l], w_b[l], w_o[l])

        x = x + g2 * peer_ffn(modulate(x, norm2_g[l], sh2, sc2), peer_wq[l], peer_keys[l], peer_u[l], peer_v[l])

        if not last:
            yc_pool = pool_branch(pc[0], pool_w[l], pool_scale[l], False)
            hs = hs + cg1 * merge_branches(pc, yc_pool, yc_hg, w_a[l], w_b[l], w_o[l])
            hs = hs + cg2 * peer_ffn(modulate(hs, norm2_g[l], csh2, csc2), peer_wq[l], peer_keys[l], peer_u[l], peer_v[l])
    return rms_norm(x, final_g)
```

```cpp
#define ONE_LAUNCH 1
#include <hip/hip_runtime.h>
#include <cstdio>
#include <cstdint>

#ifndef ONE_LAUNCH
#define ONE_LAUNCH 1
#endif

namespace pg8 {
#define PG8_LAS __attribute__((address_space(3)))
typedef unsigned short bf16_t;
typedef short bf16x8 __attribute__((ext_vector_type(8)));
typedef float f32x4 __attribute__((ext_vector_type(4)));
typedef float f32x2 __attribute__((ext_vector_type(2)));
typedef unsigned u32x4 __attribute__((ext_vector_type(4)));
typedef unsigned u32x2 __attribute__((ext_vector_type(2)));
constexpr int BM = 256, BK = 64, HALF = 128, HTB = HALF * BK * 2, STAGE_BYTES = 8 * HTB, NXCD = 8, WGM = 8;

__host__ __device__ __forceinline__ int lds_byte(int r, int c) { const int st = (r >> 4) * 2 + (c >> 5), rr = r & 15, cc = c & 31, ob = rr * 64 + cc * 2; return st * 1024 + (ob ^ (((ob >> 9) & 1) << 5)); }
__host__ __device__ __forceinline__ void stage_rc(int b, int& R, int& C) { const int st = b / 1024, sb = b % 1024, swz = sb ^ (((sb >> 9) & 1) << 5); R = (st >> 1) * 16 + swz / 64; C = (st & 1) * 32 + (swz % 64) / 2; }
__host__ __device__ __forceinline__ int perm32(int rho) { const int n = rho >> 4, i = rho & 15; return 8 * (i >> 2) + 4 * n + (i & 3); }

struct Unit { int pm, pn, seg; };

__host__ __device__ __forceinline__ void tile_of(int wgid, int nM, int nN, int& pm, int& pn) {
    const int nwg = nM * nN;
    { const int q = nwg / NXCD, r = nwg % NXCD, xcd = wgid % NXCD, off = wgid / NXCD; wgid = (xcd < r ? xcd * (q + 1) : r * (q + 1) + (xcd - r) * q) + off; }
    const int nig = WGM * nN, gid = wgid / nig, fm = gid * WGM, gsz = (nM - fm) < WGM ? (nM - fm) : WGM;
    pm = fm + ((wgid % nig) % gsz); pn = (wgid % nig) / gsz;
}

typedef __bf16 bf16x2_t __attribute__((ext_vector_type(2)));
__device__ __forceinline__ unsigned cvt_pk_bf16(float lo, float hi) { bf16x2_t v; v.x = (__bf16)lo; v.y = (__bf16)hi; return __builtin_bit_cast(unsigned, v); }

template <class Epi, class Sched, bool ALIGN_EPI = false, bool SP2 = false>
__device__ __forceinline__ void gemm_phase(PG8_LAS unsigned char* lds, const int K, const Sched& S, const Epi& E) {
    const int tid = threadIdx.x, wid = __builtin_amdgcn_readfirstlane(tid >> 6), lane = tid & 63, wr = wid >> 2, wc = wid & 3, fr = lane & 15, fq = lane >> 4;
    const int nt = K / BK;
    unsigned voffA[2], voffB[2];
#pragma unroll
    for (int i = 0; i < 2; ++i) { int R, C; stage_rc(tid * 16 + i * 8192, R, C); const int Rb = Epi::PERM ? ((R & ~31) + perm32(R & 31)) : R;
        voffA[i] = (unsigned)(R * K + C) * 2u; voffB[i] = (unsigned)(Rb * K + C) * 2u; }
    const size_t kstep = (size_t)(BK * 2);
    const size_t hstep = (size_t)HALF * K * 2;
    const unsigned ldsw = (unsigned)wid * 1024u;
    const int aoff = lds_byte(wr * 64 + fr, fq * 8), boff = lds_byte(wc * 32 + fr, fq * 8);
#define PG8_SA(b, h) (((b) * 2 + (h)) * HTB)
#define PG8_SB(b, h) ((4 + (b) * 2 + (h)) * HTB)
#define PG8_STAGE(bufoff, gbase, voff) do { _Pragma("unroll") for (int _i = 0; _i < 2; ++_i) \
        __builtin_amdgcn_global_load_lds((const unsigned*)((const char*)(gbase) + (voff)[_i]), (PG8_LAS unsigned*)(lds + (bufoff) + ldsw + _i * 8192), 16, 0, 0); } while (0)
#define PG8_LDA(dst, b, h) do { _Pragma("unroll") for (int m = 0; m < 4; ++m) _Pragma("unroll") for (int k = 0; k < 2; ++k) dst[m][k] = *(const PG8_LAS bf16x8*)(lds + PG8_SA(b, h) + aoff + m * 2048 + k * 1024); } while (0)
#define PG8_LDB(dst, b, h) do { _Pragma("unroll") for (int n = 0; n < 2; ++n) _Pragma("unroll") for (int k = 0; k < 2; ++k) dst[n][k] = *(const PG8_LAS bf16x8*)(lds + PG8_SB(b, h) + boff + n * 2048 + k * 1024); } while (0)
#define PG8_MMA(ai, bj, At, Bt) do { __builtin_amdgcn_s_setprio(1); _Pragma("unroll") for (int m = 0; m < 4; ++m) _Pragma("unroll") for (int n = 0; n < 2; ++n) _Pragma("unroll") for (int k = 0; k < 2; ++k) \
        acc[ai][bj][m][n] = __builtin_amdgcn_mfma_f32_16x16x32_bf16(Bt[n][k], At[m][k], acc[ai][bj][m][n], 0, 0, 0); __builtin_amdgcn_s_setprio(0); } while (0)
#define PG8_WAIT_V(n) asm volatile("s_waitcnt vmcnt(" #n ")" ::: "memory")
#define PG8_WAIT_L(n) asm volatile("s_waitcnt lgkmcnt(" #n ")" ::: "memory")
#define PG8_BAR __builtin_amdgcn_s_barrier()
#define PG8_SCHED __builtin_amdgcn_sched_barrier(0)
    Unit cur, nxt; int ui = 0;
    if (!S.next(0, cur)) return;
    f32x4 acc[2][2][4][2];
#pragma unroll
    for (int a = 0; a < 2; ++a)
#pragma unroll
        for (int b = 0; b < 2; ++b)
#pragma unroll
            for (int m = 0; m < 4; ++m)
#pragma unroll
                for (int n = 0; n < 2; ++n) acc[a][b][m][n] = (f32x4){0.f, 0.f, 0.f, 0.f};
    bf16x8 At[4][2], B0[2][2], B1[2][2];
    const char* cA = S.A(cur); const char* cB = S.B(cur);
    if constexpr (SP2) {
        PG8_STAGE(PG8_SB(0, 0), cB, voffB); PG8_STAGE(PG8_SB(0, 1), cB + hstep, voffB); PG8_STAGE(PG8_SA(0, 0), cA, voffA); PG8_STAGE(PG8_SA(0, 1), cA + hstep, voffA);
        if (wr == 1) PG8_BAR;
        PG8_WAIT_V(2); PG8_BAR;
        PG8_STAGE(PG8_SB(1, 0), cB + kstep, voffB); PG8_STAGE(PG8_SA(1, 0), cA + kstep, voffA); PG8_STAGE(PG8_SB(1, 1), cB + hstep + kstep, voffB);
        PG8_WAIT_V(6); PG8_BAR;
    } else {
        PG8_STAGE(PG8_SB(0, 0), cB, voffB); PG8_STAGE(PG8_SA(0, 0), cA, voffA); PG8_STAGE(PG8_SB(0, 1), cB + hstep, voffB); PG8_STAGE(PG8_SA(0, 1), cA + hstep, voffA);
        if (wr == 1) PG8_BAR;
        PG8_WAIT_V(4); PG8_BAR;
        PG8_STAGE(PG8_SB(1, 0), cB + kstep, voffB); PG8_STAGE(PG8_SA(1, 0), cA + kstep, voffA); PG8_STAGE(PG8_SB(1, 1), cB + hstep + kstep, voffB);
        PG8_WAIT_V(6); PG8_BAR;
    }
    for (;;) {
        const bool has_next = S.next(ui + 1, nxt);
        const char* nA = has_next ? S.A(nxt) : cA; const char* nB = has_next ? S.B(nxt) : cB;
        for (int t = 0; t < nt; t += 2) {
            const bool last = (t == nt - 2);
            const char* a1 = cA + (size_t)(t + 1) * kstep;
            const char* a2 = last ? nA : cA + (size_t)(t + 2) * kstep; const char* b2 = last ? nB : cB + (size_t)(t + 2) * kstep;
            const char* a3 = a2 + kstep; const char* b3 = b2 + kstep;
            if constexpr (SP2) {
            PG8_LDB(B0, 0, 0); PG8_LDB(B1, 0, 1); PG8_SCHED; PG8_LDA(At, 0, 0); PG8_STAGE(PG8_SA(1, 1), a1 + hstep, voffA);
            PG8_WAIT_V(8); PG8_WAIT_L(0); PG8_BAR; PG8_MMA(0, 0, At, B0); PG8_MMA(0, 1, At, B1); PG8_BAR; PG8_SCHED;
            PG8_LDA(At, 0, 1); PG8_STAGE(PG8_SB(0, 0), b2, voffB); PG8_STAGE(PG8_SB(0, 1), b2 + hstep, voffB); PG8_STAGE(PG8_SA(0, 0), a2, voffA);
            PG8_WAIT_V(8); PG8_WAIT_L(0); PG8_BAR; PG8_MMA(1, 0, At, B0); PG8_MMA(1, 1, At, B1); PG8_BAR; PG8_SCHED;
            PG8_LDB(B0, 1, 0); PG8_LDB(B1, 1, 1); PG8_SCHED; PG8_LDA(At, 1, 0); PG8_STAGE(PG8_SA(0, 1), a2 + hstep, voffA);
            PG8_WAIT_V(8); PG8_WAIT_L(0); PG8_BAR; PG8_MMA(0, 0, At, B0); PG8_MMA(0, 1, At, B1); PG8_BAR; PG8_SCHED;
            PG8_LDA(At, 1, 1); PG8_STAGE(PG8_SB(1, 0), b3, voffB); PG8_STAGE(PG8_SB(1, 1), b3 + hstep, voffB); PG8_STAGE(PG8_SA(1, 0), a3, voffA);
            PG8_WAIT_V(8); PG8_WAIT_L(0); PG8_BAR; PG8_MMA(1, 0, At, B0); PG8_MMA(1, 1, At, B1); PG8_BAR; PG8_SCHED;
            } else {
            PG8_LDB(B0, 0, 0); PG8_SCHED; PG8_LDA(At, 0, 0); PG8_STAGE(PG8_SA(1, 1), a1 + hstep, voffA);
            PG8_WAIT_L(8); PG8_BAR; PG8_WAIT_L(0); PG8_MMA(0, 0, At, B0); PG8_BAR; PG8_SCHED;
            PG8_LDB(B1, 0, 1); PG8_STAGE(PG8_SB(0, 0), b2, voffB);
            PG8_BAR; PG8_WAIT_L(0); PG8_MMA(0, 1, At, B1); PG8_BAR;
            PG8_LDA(At, 0, 1); PG8_STAGE(PG8_SA(0, 0), a2, voffA);
            PG8_BAR; PG8_WAIT_L(0); PG8_MMA(1, 0, At, B0); PG8_BAR; PG8_SCHED;
            PG8_STAGE(PG8_SB(0, 1), b2 + hstep, voffB);
            PG8_WAIT_V(6); PG8_BAR; PG8_MMA(1, 1, At, B1); PG8_BAR;
            PG8_LDB(B0, 1, 0); PG8_SCHED; PG8_LDA(At, 1, 0); PG8_STAGE(PG8_SA(0, 1), a2 + hstep, voffA);
            PG8_WAIT_L(8); PG8_BAR; PG8_WAIT_L(0); PG8_MMA(0, 0, At, B0); PG8_BAR; PG8_SCHED;
            PG8_LDB(B1, 1, 1); PG8_STAGE(PG8_SB(1, 0), b3, voffB);
            PG8_BAR; PG8_WAIT_L(0); PG8_MMA(0, 1, At, B1); PG8_BAR;
            PG8_LDA(At, 1, 1); PG8_STAGE(PG8_SA(1, 0), a3, voffA);
            PG8_BAR; PG8_WAIT_L(0); PG8_MMA(1, 0, At, B0); PG8_BAR; PG8_SCHED;
            PG8_STAGE(PG8_SB(1, 1), b3 + hstep, voffB);
            PG8_WAIT_V(6); PG8_BAR; PG8_MMA(1, 1, At, B1); PG8_BAR;
            }
        }
        if constexpr (ALIGN_EPI) { if (wr == 0) PG8_BAR; }
        E(acc, cur, wr, wc, fr, fq);
        if (!has_next) break;
        if (!S.keep(cur)) {
#pragma unroll
        for (int a = 0; a < 2; ++a)
#pragma unroll
            for (int b = 0; b < 2; ++b)
#pragma unroll
                for (int m = 0; m < 4; ++m)
#pragma unroll
                    for (int n = 0; n < 2; ++n) acc[a][b][m][n] = (f32x4){0.f, 0.f, 0.f, 0.f};
        }
        cur = nxt; cA = nA; cB = nB; ++ui;
        if constexpr (ALIGN_EPI) { if (wr == 1) PG8_BAR; }
    }
    PG8_WAIT_V(0);
    if constexpr (!ALIGN_EPI) { if (wr == 0) PG8_BAR; }
    PG8_BAR;
#undef PG8_SA
#undef PG8_SB
#undef PG8_STAGE
#undef PG8_LDA
#undef PG8_LDB
#undef PG8_MMA
#undef PG8_WAIT_V
#undef PG8_WAIT_L
#undef PG8_BAR
#undef PG8_SCHED
}
}

constexpr int D = 1024, NB = 4, SEQ = 4096, CTXL = 256;
constexpr int ML = NB * SEQ;
constexpr int MC = NB * CTXL;
constexpr int MH = ML + MC;
constexpr int INW = 5120;
constexpr int ZC_W = 1536;
constexpr int NEXP = 16384, NHEAD_P = 8, TOPK = 16;
constexpr float EPS = 1e-6f;
constexpr int NWAVES = 8, NTHREADS = 512;
constexpr int SEGT = 512, NSEG = SEQ / SEGT;
constexpr int CHT = 32;
constexpr int NSCAN_L = NB * 4 * 2 * NSEG;
constexpr int NSCAN = NSCAN_L + NB * 4 * 2;

constexpr size_t MiB = 1u << 20;
constexpr size_t WS_CTL = 0, CTL_ZERO_BYTES = 64 * 1024;
constexpr size_t WS_MOD = 1 * MiB;
constexpr size_t WS_LBT = WS_MOD + 128 * 1024;
constexpr size_t WS_ASEG = WS_LBT + 8 * 1024;
constexpr size_t WS_SU = WS_ASEG + 160 * 1024;
constexpr size_t WS_SV = WS_SU + 64 * 1024;
constexpr size_t WS_WIN = 2 * MiB;
constexpr size_t WS_WA = 12 * MiB, WS_WB = 13 * MiB, WS_WO = 14 * MiB, WS_WQ = 16 * MiB;
constexpr size_t WS_POOLW = 20 * MiB;
constexpr size_t WS_KEYS = WS_POOLW + 128 * 1024;
constexpr size_t WS_ZC = 21 * MiB;
constexpr size_t WS_Z = 24 * MiB;
constexpr size_t WS_QB = 24 * MiB;
constexpr size_t WS_EIDX = 88 * MiB;
constexpr size_t WS_GATE = 96 * MiB;
constexpr size_t WS_U8 = 112 * MiB, WS_V8 = 128 * MiB;
constexpr size_t WS_H = 184 * MiB;
constexpr size_t WS_YHG = 184 * MiB, WS_YPOOL = 200 * MiB;
constexpr size_t WS_USEG = 218 * MiB;
constexpr size_t WS_M = 218 * MiB;
constexpr size_t WS_END = 252 * MiB;
static_assert(WS_Z + (size_t)ML * INW * 2 <= WS_H && WS_H + (size_t)MH * D * 2 <= WS_USEG && WS_USEG + (size_t)NSCAN * 128 * 128 * 4 <= WS_END && WS_M + (size_t)ML * D * 2 <= WS_END, "ws map");
static_assert(WS_QB + (size_t)ML * 2048 * 2 <= WS_EIDX && WS_V8 + (size_t)NEXP * D <= WS_H, "ws map 2");
constexpr size_t OUT_OLOC = 0, OUT_QSEG = 32 * MiB;
constexpr int CW_BAR = 1024;

constexpr int LDS_BYTES = 163840;
constexpr int MISC_OFF = LDS_BYTES - 256;

#define GAS __attribute__((address_space(1)))
#define LAS __attribute__((address_space(3)))
typedef unsigned short bf16;
typedef unsigned v4u __attribute__((ext_vector_type(4)));
typedef unsigned v2u __attribute__((ext_vector_type(2)));
typedef float f32x4 __attribute__((ext_vector_type(4)));
typedef float f32x2 __attribute__((ext_vector_type(2)));
typedef short bf16x8 __attribute__((ext_vector_type(8)));
typedef short s16x4 __attribute__((ext_vector_type(4)));
#define LDS_WAIT() asm volatile("s_waitcnt lgkmcnt(0)" ::: "memory")
#define VM_WAIT() asm volatile("s_waitcnt vmcnt(0)" ::: "memory")
__device__ __forceinline__ unsigned f2bf(float f) { unsigned u = __builtin_bit_cast(unsigned, f); return (u + 0x7fffu + ((u >> 16) & 1u)) >> 16; }
__device__ __forceinline__ unsigned pk2(float lo, float hi) { return pg8::cvt_pk_bf16(lo, hi); }
__device__ __forceinline__ float bflo(unsigned w) { return __builtin_bit_cast(float, w << 16); }
__device__ __forceinline__ float bfhi(unsigned w) { return __builtin_bit_cast(float, w & 0xffff0000u); }
__device__ __forceinline__ float fast_exp(float x) { return __builtin_amdgcn_exp2f(x * 1.4426950408889634f); }
__device__ __forceinline__ float fast_rcp(float x) { return __builtin_amdgcn_rcpf(x); }
__device__ __forceinline__ float sigmoidf_(float x) { x = fminf(fmaxf(x, -30.f), 30.f); return fast_rcp(1.f + fast_exp(-x)); }
__device__ __forceinline__ float wave_sum(float v) {
#pragma unroll
    for (int o = 1; o < 64; o <<= 1) v += __shfl_xor(v, o);
    return v;
}
__device__ __forceinline__ float wave_max(float v) {
#pragma unroll
    for (int o = 1; o < 64; o <<= 1) v = fmaxf(v, __shfl_xor(v, o));
    return v;
}

#define XB_TMO      128
#define XB_XCNT(j)  (256  + 64 * (j))
#define XB_XSUB(j)  (1280 + 64 * (j))
#define XB_XGEN(j)  (2304 + 64 * (j))
#define XB_TOP      3328
#define XB_TOPGEN   3392
#define XCD_BAR_WORDS 3456
#define XB_SPIN_CAP (1u << 18)
__device__ __forceinline__ unsigned xb_ld(unsigned* p)              { return __hip_atomic_load(p, __ATOMIC_RELAXED, __HIP_MEMORY_SCOPE_AGENT); }
__device__ __forceinline__ unsigned xb_add(unsigned* p, unsigned v) { return __hip_atomic_fetch_add(p, v, __ATOMIC_RELAXED, __HIP_MEMORY_SCOPE_AGENT); }
__device__ __forceinline__ unsigned xb_xcc_id() { return (unsigned)__builtin_amdgcn_s_getreg((3 << 11) | 20) & 0xFu; }
#define XB_SPIN(cond, bar) do { unsigned _sp = 0; while (cond) { __builtin_amdgcn_s_sleep(1); \
    if ((++_sp & 255u) == 0u) { if (xb_ld(&(bar)[XB_TMO])) break; if (_sp > XB_SPIN_CAP) { atomicAdd(&(bar)[XB_TMO], 1u); break; } } } } while (0)
struct XcdBarrier { unsigned* bar; unsigned x; volatile LAS unsigned* st; };
__device__ __forceinline__ XcdBarrier xcd_barrier_post(unsigned* bar, volatile LAS unsigned* st) {
    XcdBarrier b; b.bar = bar; b.x = xb_xcc_id(); b.st = st;
    if (threadIdx.x == 0) (void)xb_add(&bar[XB_XCNT(b.x)], 1u);
    return b;
}
__device__ __forceinline__ void xcd_barrier_complete(unsigned* bar, unsigned x, unsigned& nloc, unsigned& nx) {
    const unsigned G = gridDim.x * gridDim.y * gridDim.z;
    unsigned sum, cnt, mine, sp = 0u;
    for (;;) {
        sum = 0u; cnt = 0u; mine = 0u;
#pragma unroll
        for (unsigned j = 0; j < 16; ++j) { const unsigned c = xb_ld(&bar[XB_XCNT(j)]); sum += c; cnt += (c > 0u) ? 1u : 0u; mine = (j == x) ? c : mine; }
        if (sum == G) break;
        __builtin_amdgcn_s_sleep(1);
        if ((++sp & 255u) == 0u) { if (xb_ld(&bar[XB_TMO])) break; if (sp > XB_SPIN_CAP) { atomicAdd(&bar[XB_TMO], 1u); break; } }
    }
    nloc = mine > 0u ? mine : 1u; nx = cnt > 0u ? cnt : 1u;
}
__device__ __forceinline__ void xcd_barrier(const XcdBarrier& b) {
    asm volatile("s_waitcnt vmcnt(0)" ::: "memory");
    __syncthreads();
    if (threadIdx.x == 0) {
        unsigned* bar = b.bar;
        __builtin_amdgcn_s_waitcnt(0);
        unsigned nloc = b.st[0], nx = b.st[1];
        if (nloc == 0u) { xcd_barrier_complete(bar, b.x, nloc, nx); b.st[0] = nloc; b.st[1] = nx; }
        const unsigned old = xb_add(&bar[XB_XSUB(b.x)], 1u);
        const unsigned gen = old / nloc;
        if (old + 1u == (gen + 1u) * nloc) {
            __builtin_amdgcn_fence(__ATOMIC_RELEASE, "agent");
            asm volatile("s_waitcnt vmcnt(0)" ::: "memory");
            const unsigned og = xb_add(&bar[XB_TOP], 1u);
            const unsigned tg = og / nx;
            if (og + 1u == (tg + 1u) * nx) xb_add(&bar[XB_TOPGEN], 1u);
            else XB_SPIN(xb_ld(&bar[XB_TOPGEN]) == tg, bar);
            __builtin_amdgcn_fence(__ATOMIC_ACQUIRE, "agent");
            xb_add(&bar[XB_XGEN(b.x)], 1u);
            asm volatile("s_waitcnt vmcnt(0)" ::: "memory");
        } else {
            XB_SPIN(xb_ld(&bar[XB_XGEN(b.x)]) == gen, bar);
            __builtin_amdgcn_fence(__ATOMIC_ACQUIRE, "agent");
            asm volatile("s_waitcnt vmcnt(0)" ::: "memory");
        }
    }
    __syncthreads();
}

struct Args { const float* in[21]; float* out; unsigned char* ws; int ph_lo, ph_hi; };

struct Frame {
    LAS unsigned char* lds; int tid, lane, wave, G, bid;
    const float *x, *c, *ctx, *c_ctx, *w_mod, *b_mod, *n1g, *n2g, *w_in, *pool_w, *pool_scale, *lb_logits, *hg_norm_g, *w_a, *w_b, *w_o, *wq, *keys, *pu, *pv, *final_g;
    float* out; unsigned char* ws;
};

__device__ __forceinline__ void p0_transpose_item(const float* W, int K, int N, bf16* WT, LAS float* scr, int item, int lane) {
    const int nblk = N / 32, kb = item / nblk, nb = item % nblk, k0 = 64 * kb, n0 = 32 * nb;
#pragma unroll 8
    for (int i = 0; i < 32; ++i) { const int kk = 2 * i + (lane >> 5); scr[kk * 33 + (lane & 31)] = W[(size_t)(k0 + kk) * N + n0 + (lane & 31)]; }
    LDS_WAIT(); asm volatile("" ::: "memory");
    const int c = lane & 7;
#pragma unroll
    for (int j = 0; j < 4; ++j) { const int n = (lane >> 3) + 8 * j; const LAS float* s = scr + (8 * c) * 33 + n;
        v4u o; o.x = pk2(s[0 * 33], s[1 * 33]); o.y = pk2(s[2 * 33], s[3 * 33]); o.z = pk2(s[4 * 33], s[5 * 33]); o.w = pk2(s[6 * 33], s[7 * 33]);
        *(GAS v4u*)(WT + (size_t)(n0 + n) * K + k0 + 8 * c) = o; }
    LDS_WAIT(); asm volatile("" ::: "memory");
}

__device__ __forceinline__ void p0_prologue(Frame& F) {
    float* mod = (float*)(F.ws + WS_MOD);
    if (F.bid < 192) {
        LAS float* sl = (LAS float*)(F.lds + 81920);
        LAS float* red = (LAS float*)(F.lds + 81920 + 20480);
        for (int i = F.tid; i < 5 * 1024; i += NTHREADS) { const float cv = (i < 4096) ? F.c[i] : F.c_ctx[i - 4096]; sl[i] = cv * sigmoidf_(cv); }
        __syncthreads();
        const int col = F.tid & 31, kg = F.tid >> 5, col0 = 32 * F.bid;
        float a0 = 0.f, a1 = 0.f, a2 = 0.f, a3 = 0.f, a4 = 0.f;
        const float* wp = F.w_mod + (size_t)(kg * 64) * 6144 + col0 + col;
#pragma unroll 8
        for (int r = 0; r < 64; ++r) { const float w = wp[(size_t)r * 6144]; const int k = kg * 64 + r;
            a0 += w * sl[k]; a1 += w * sl[1024 + k]; a2 += w * sl[2048 + k]; a3 += w * sl[3072 + k]; a4 += w * sl[4096 + k]; }
        red[(kg * 5 + 0) * 32 + col] = a0; red[(kg * 5 + 1) * 32 + col] = a1; red[(kg * 5 + 2) * 32 + col] = a2; red[(kg * 5 + 3) * 32 + col] = a3; red[(kg * 5 + 4) * 32 + col] = a4;
        __syncthreads();
        if (F.tid < 160) { const int v = F.tid >> 5, cc = F.tid & 31; float s = 0.f;
#pragma unroll
            for (int g = 0; g < 16; ++g) s += red[(g * 5 + v) * 32 + cc];
            mod[v * 6144 + col0 + cc] = s + F.b_mod[col0 + cc]; }
        __syncthreads();
    }
    LAS float* scr = (LAS float*)(F.lds + F.wave * 8448);
    const int gw = F.bid * NWAVES + F.wave, NGW = F.G * NWAVES;
    constexpr int I_IN = (D / 64) * (INW / 32), I_A = (512 / 64) * (D / 32), I_O = (D / 64) * (D / 32), I_Q = (D / 64) * (2048 / 32), I_P = (128 / 64) * (128 / 32);
    constexpr int NITEMS = I_IN + 2 * I_A + I_O + I_Q + 4 * I_P;
    for (int it = gw; it < NITEMS; it += NGW) {
        int r = it;
        if (r < I_IN) { p0_transpose_item(F.w_in, D, INW, (bf16*)(F.ws + WS_WIN), scr, r, F.lane); continue; } r -= I_IN;
        if (r < I_A) { p0_transpose_item(F.w_a, 512, D, (bf16*)(F.ws + WS_WA), scr, r, F.lane); continue; } r -= I_A;
        if (r < I_A) { p0_transpose_item(F.w_b, 512, D, (bf16*)(F.ws + WS_WB), scr, r, F.lane); continue; } r -= I_A;
        if (r < I_O) { p0_transpose_item(F.w_o, D, D, (bf16*)(F.ws + WS_WO), scr, r, F.lane); continue; } r -= I_O;
        if (r < I_Q) { p0_transpose_item(F.wq, D, 2048, (bf16*)(F.ws + WS_WQ), scr, r, F.lane); continue; } r -= I_Q;
        { const int g = r / I_P; p0_transpose_item(F.pool_w + (size_t)g * 128 * 128, 128, 128, (bf16*)(F.ws + WS_POOLW) + (size_t)g * 128 * 128, scr, r % I_P, F.lane); }
    }
    { bf16* kb = (bf16*)(F.ws + WS_KEYS); const int gt = F.bid * NTHREADS + F.tid, NT = F.G * NTHREADS;
      for (int i = gt; i < 16 * 128 * 128 / 4; i += NT) { const f32x4 v = ((const GAS f32x4*)F.keys)[i]; v2u o; o.x = pk2(v.x, v.y); o.y = pk2(v.z, v.w); ((GAS v2u*)kb)[i] = o; }
      float* lbt = (float*)(F.ws + WS_LBT);
      if (gt < 1024) { const int dir = gt >> 9, cc = gt & 511; const float l0 = F.lb_logits[(dir * 2 + 0) * 512 + cc], l1 = F.lb_logits[(dir * 2 + 1) * 512 + cc];
          lbt[gt] = 1.f / (1.f + expf(l1 - l0)); } }
}

__device__ __forceinline__ void modulate_row(const float* xrow, bf16* orow, const float* g, const float* shift, const float* scale, int lane) {
    const GAS f32x4* xr = (const GAS f32x4*)xrow + lane;
    f32x4 v[4]; float s2 = 0.f;
#pragma unroll
    for (int j = 0; j < 4; ++j) { v[j] = xr[64 * j]; s2 += (v[j].x * v[j].x + v[j].y * v[j].y) + (v[j].z * v[j].z + v[j].w * v[j].w); }
    const float rstd = 1.f / sqrtf(wave_sum(s2) * (1.f / D) + EPS);
    GAS v2u* o8 = (GAS v2u*)orow + lane;
#pragma unroll
    for (int j = 0; j < 4; ++j) {
        const f32x4 gg = ((const GAS f32x4*)g)[lane + 64 * j], sh = ((const GAS f32x4*)shift)[lane + 64 * j], sc = ((const GAS f32x4*)scale)[lane + 64 * j];
        const f32x4 y = (v[j] * rstd) * gg * (sc + 1.0f) + sh;
        v2u o; o.x = pk2(y.x, y.y); o.y = pk2(y.z, y.w); o8[64 * j] = o; }
}
__device__ __forceinline__ void p1_modulate(Frame& F) {
    const float* mod = (const float*)(F.ws + WS_MOD); bf16* H = (bf16*)(F.ws + WS_H);
    const int gw = F.bid * NWAVES + F.wave, NGW = F.G * NWAVES;
    for (int m = gw; m < MH; m += NGW) {
        const int v = (m < ML) ? (m >> 12) : 4;
        const float* xr = (m < ML) ? F.x + (size_t)m * D : F.ctx + (size_t)(m - ML) * D;
        modulate_row(xr, H + (size_t)m * D, F.n1g, mod + v * 6144 + 0, mod + v * 6144 + 1024, F.lane);
    }
}

using pg8::Unit;
struct SchedPlain {
    const char* Ab; const char* Bb; int nM, nN, K, G, c;
    __device__ __forceinline__ bool next(int i, Unit& u) const { const int L = i * G + c; if (L >= nM * nN) return false; pg8::tile_of(L, nM, nN, u.pm, u.pn); u.seg = 0; return true; }
    __device__ __forceinline__ const char* A(const Unit& u) const { return Ab + (size_t)u.pm * 256 * K * 2; }
    __device__ __forceinline__ const char* B(const Unit& u) const { return Bb + (size_t)u.pn * 256 * K * 2; }
    __device__ __forceinline__ bool keep(const Unit&) const { return false; }
};
struct SchedIn {
    const char* Ab; const char* Bb; int G, c;
    __device__ __forceinline__ bool next(int i, Unit& u) const { const int L = i * G + c; u.seg = 0;
        if (L < 1280) { pg8::tile_of(L, 64, 20, u.pm, u.pn); return true; }
        if (L < 1304) { const int l = L - 1280; u.pm = 64 + (l & 3); u.pn = 4 + (l >> 2); return true; }
        return false; }
    __device__ __forceinline__ const char* A(const Unit& u) const { return Ab + (size_t)u.pm * 256 * D * 2; }
    __device__ __forceinline__ const char* B(const Unit& u) const { return Bb + (size_t)u.pn * 256 * D * 2; }
    __device__ __forceinline__ bool keep(const Unit&) const { return false; }
};
struct SchedMerge {
    const char *A0, *A1, *B0, *B1; int G, c;
    __device__ __forceinline__ bool next(int i, Unit& u) const { const int tile = (i >> 1) * G + c; if (tile >= 256) return false; pg8::tile_of(tile, 64, 4, u.pm, u.pn); u.seg = i & 1; return true; }
    __device__ __forceinline__ const char* A(const Unit& u) const { return (u.seg ? A1 : A0) + (size_t)u.pm * 256 * 512 * 2; }
    __device__ __forceinline__ const char* B(const Unit& u) const { return (u.seg ? B1 : B0) + (size_t)u.pn * 256 * 512 * 2; }
    __device__ __forceinline__ bool keep(const Unit& u) const { return u.seg == 0; }
};

struct EpiZ {
    static constexpr bool PERM = true;
    bf16* Z; bf16* ZC;
    __device__ __forceinline__ void operator()(pg8::f32x4 (&acc)[2][2][4][2], const Unit& u, int wr, int wc, int fr, int fq) const {
        int row0 = u.pm * 256 + wr * 64 + fr, col0 = u.pn * 256 + wc * 32 + 8 * fq, ldc = INW; bf16* base = Z;
        if (u.pm >= 64) { base = ZC; row0 -= ML; col0 -= 1024; ldc = ZC_W; }
        const bool sg = u.pn >= 12;
#pragma unroll
        for (int ai = 0; ai < 2; ++ai)
#pragma unroll
            for (int m = 0; m < 4; ++m) { bf16* rowp = base + (size_t)(row0 + ai * 128 + m * 16) * ldc + col0;
#pragma unroll
                for (int bj = 0; bj < 2; ++bj) { pg8::f32x4 v0 = acc[ai][bj][m][0], v1 = acc[ai][bj][m][1];
                    if (sg) {
#pragma unroll
                        for (int j = 0; j < 4; ++j) { v0[j] = sigmoidf_(v0[j]); v1[j] = sigmoidf_(v1[j]); } }
                    v4u w; w.x = pk2(v0[0], v0[1]); w.y = pk2(v0[2], v0[3]); w.z = pk2(v1[0], v1[1]); w.w = pk2(v1[2], v1[3]);
                    *(GAS v4u*)(rowp + bj * 128) = w; } }
    }
};
struct EpiPlain {
    static constexpr bool PERM = true;
    bf16* O; int ldc;
    __device__ __forceinline__ void operator()(pg8::f32x4 (&acc)[2][2][4][2], const Unit& u, int wr, int wc, int fr, int fq) const {
        const int row0 = u.pm * 256 + wr * 64 + fr, col0 = u.pn * 256 + wc * 32 + 8 * fq;
#pragma unroll
        for (int ai = 0; ai < 2; ++ai)
#pragma unroll
            for (int m = 0; m < 4; ++m) { bf16* rowp = O + (size_t)(row0 + ai * 128 + m * 16) * ldc + col0;
#pragma unroll
                for (int bj = 0; bj < 2; ++bj) { const pg8::f32x4 v0 = acc[ai][bj][m][0], v1 = acc[ai][bj][m][1];
                    v4u w; w.x = pk2(v0[0], v0[1]); w.y = pk2(v0[2], v0[3]); w.z = pk2(v1[0], v1[1]); w.w = pk2(v1[2], v1[3]);
                    *(GAS v4u*)(rowp + bj * 128) = w; } }
    }
};
struct EpiMerge {
    static constexpr bool PERM = true;
    const bf16* Z; bf16* Mo;
    __device__ __forceinline__ void operator()(pg8::f32x4 (&acc)[2][2][4][2], const Unit& u, int wr, int wc, int fr, int fq) const {
        const int row0 = u.pm * 256 + wr * 64 + fr, col0 = u.pn * 256 + wc * 32 + 8 * fq;
#pragma unroll
        for (int ai = 0; ai < 2; ++ai)
#pragma unroll
            for (int m = 0; m < 4; ++m) { const size_t r = (size_t)(row0 + ai * 128 + m * 16);
#pragma unroll
                for (int bj = 0; bj < 2; ++bj) { const int c = col0 + bj * 128;
                    const v4u gh = *(const GAS v4u*)(Z + r * INW + 4096 + c);
                    float h[8] = {bflo(gh.x), bfhi(gh.x), bflo(gh.y), bfhi(gh.y), bflo(gh.z), bfhi(gh.z), bflo(gh.w), bfhi(gh.w)};
                    if (u.seg == 0) {
                        const v4u gp = *(const GAS v4u*)(Z + r * INW + 3072 + c);
                        float p[8] = {bflo(gp.x), bfhi(gp.x), bflo(gp.y), bfhi(gp.y), bflo(gp.z), bfhi(gp.z), bflo(gp.w), bfhi(gp.w)};
#pragma unroll
                        for (int j = 0; j < 4; ++j) { acc[ai][bj][m][0][j] *= p[j] * fast_rcp(h[j]); acc[ai][bj][m][1][j] *= p[4 + j] * fast_rcp(h[4 + j]); }
                    } else {
                        pg8::f32x4 v0 = acc[ai][bj][m][0], v1 = acc[ai][bj][m][1];
#pragma unroll
                        for (int j = 0; j < 4; ++j) { v0[j] *= h[j]; v1[j] *= h[4 + j]; }
                        v4u w; w.x = pk2(v0[0], v0[1]); w.y = pk2(v0[2], v0[3]); w.z = pk2(v1[0], v1[1]); w.w = pk2(v1[2], v1[3]);
                        *(GAS v4u*)(Mo + r * D + c) = w; } } }
    }
};
struct EpiRes {
    static constexpr bool PERM = false;
    const float* X; const float* mod; float* O;
    __device__ __forceinline__ void operator()(pg8::f32x4 (&acc)[2][2][4][2], const Unit& u, int wr, int wc, int fr, int fq) const {
        const int row0 = u.pm * 256 + wr * 64 + fr, col0 = u.pn * 256 + wc * 32 + 4 * fq;
        const float* g1 = mod + (size_t)(u.pm >> 4) * 6144 + 2048;
        pg8::f32x4 gv[2][2];
#pragma unroll
        for (int bj = 0; bj < 2; ++bj)
#pragma unroll
            for (int n = 0; n < 2; ++n) gv[bj][n] = *(const GAS pg8::f32x4*)(g1 + col0 + bj * 128 + n * 16);
#pragma unroll
        for (int ai = 0; ai < 2; ++ai)
#pragma unroll
            for (int m = 0; m < 4; ++m) { const size_t off = (size_t)(row0 + ai * 128 + m * 16) * D + col0;
#pragma unroll
                for (int bj = 0; bj < 2; ++bj)
#pragma unroll
                    for (int n = 0; n < 2; ++n) { const pg8::f32x4 xv = *(const GAS pg8::f32x4*)(X + off + bj * 128 + n * 16);
                        *(GAS pg8::f32x4*)(O + off + bj * 128 + n * 16) = xv + gv[bj][n] * acc[ai][bj][m][n]; }
                asm volatile("" ::: "memory"); }
    }
};

__device__ __forceinline__ unsigned off_b(unsigned row, unsigned ch) { return 256u * row + 16u * (ch ^ (((row & 3) << 2) | ((row >> 2) & 3))); }
__device__ __forceinline__ unsigned row_addr16(unsigned lane, unsigned rb, unsigned s) { return off_b((lane & 15) + 16 * rb, 4 * s + (lane >> 4)); }
__device__ __forceinline__ unsigned tr_addr16(unsigned lane, unsigned c, unsigned t) { const unsigned g = lane >> 4, q = (lane & 15) >> 2, p = lane & 3; return off_b(8 * g + 4 * t + q, 2 * c + (p >> 1)) + 8 * (p & 1); }
__device__ __forceinline__ bf16x8 tr_frag(LAS unsigned char* tile, unsigned lane, unsigned c) {
    const s16x4 lo = __builtin_amdgcn_ds_read_tr16_b64_v4i16((LAS s16x4*)(tile + tr_addr16(lane, c, 0)));
    const s16x4 hi = __builtin_amdgcn_ds_read_tr16_b64_v4i16((LAS s16x4*)(tile + tr_addr16(lane, c, 1)));
    return __builtin_shufflevector(lo, hi, 0, 1, 2, 3, 4, 5, 6, 7);
}
#define MFMA16(a, b, c) __builtin_amdgcn_mfma_f32_16x16x32_bf16((a), (b), (c), 0, 0, 0)

constexpr int SC_QT = 0, SC_KT = 8192, SC_KD = 16384, SC_VT = 24576, SC_ATT = 32768, SC_EL = 35328, SC_WT = 35840;

__device__ __forceinline__ void scan_unit(Frame& F, int u) {
    const int tid = F.tid, lane = F.lane, w = F.wave, q = lane >> 4;
    const bool isctx = u >= NSCAN_L;
    int b, h, dir, rowbase, nch; const bf16* src; int ld, cq, ci, cf;
    if (!isctx) { const int j = u & 7; dir = (u >> 3) & 1; h = (u >> 4) & 3; b = u >> 6; const int tb = dir ? 7 - j : j;
        rowbase = b * SEQ + tb * SEGT; nch = SEGT / CHT; src = (const bf16*)(F.ws + WS_Z); ld = INW; cq = 512 + h * 128; ci = 1024 + h * 128; cf = (dir ? 2048 : 1536) + h * 128; }
    else { const int v = u - NSCAN_L; dir = v & 1; h = (v >> 1) & 3; b = v >> 3;
        rowbase = b * CTXL; nch = CTXL / CHT; src = (const bf16*)(F.ws + WS_ZC); ld = ZC_W; ci = h * 128; cq = ci; cf = (dir ? 1024 : 512) + h * 128; }
    const int t = tid >> 4, k8 = tid & 15;
    const int pl = dir ? 3 - q : q;
    const float* lbt = (const float*)(F.ws + WS_LBT) + dir * 512 + h * 128 + 8 * k8;
    float lb[8], ecum[8];
#pragma unroll
    for (int i = 0; i < 8; ++i) { lb[i] = lbt[i]; ecum[i] = 1.f; }
    f32x4 S[8];
#pragma unroll
    for (int i = 0; i < 8; ++i) S[i] = (f32x4){0.f, 0.f, 0.f, 0.f};
    LAS unsigned char* L = F.lds;
    bf16* qseg = (bf16*)((unsigned char*)F.out + OUT_QSEG) + (size_t)dir * ML * 512;
    bf16* oloc = (bf16*)((unsigned char*)F.out + OUT_OLOC);
    v4u qv, vv, fv;
    { const int tc = dir ? nch - 1 : 0; const bf16* rp = src + (size_t)(rowbase + tc * CHT + t) * ld + 8 * k8;
      qv = *(const GAS v4u*)(rp + cq); vv = *(const GAS v4u*)(rp + ci); fv = *(const GAS v4u*)(rp + cf); }
    for (int pc = 0; pc < nch; ++pc) {
        const int tc = dir ? nch - 1 - pc : pc;
        const v4u q0 = qv, v0 = vv, f0 = fv;
        if (pc + 1 < nch) { const int tn = dir ? tc - 1 : tc + 1; const bf16* rp = src + (size_t)(rowbase + tn * CHT + t) * ld + 8 * k8;
            qv = *(const GAS v4u*)(rp + cq); vv = *(const GAS v4u*)(rp + ci); fv = *(const GAS v4u*)(rp + cf); }
        float fr_[8] = {bflo(f0.x), bfhi(f0.x), bflo(f0.y), bfhi(f0.y), bflo(f0.z), bfhi(f0.z), bflo(f0.w), bfhi(f0.w)};
        float e[8], kk[8];
#pragma unroll
        for (int i = 0; i < 8; ++i) { const float s = sigmoidf_(fr_[i]); const float om = 1.f - lb[i]; e[i] = lb[i] + om * s; kk[i] = om * (1.f - s); }
        { const int s1 = dir ? lane + 16 : lane - 16, s2 = dir ? lane + 32 : lane - 32;
#pragma unroll
          for (int i = 0; i < 8; ++i) { const float o = __shfl(e[i], s1 & 63); e[i] = (pl >= 1) ? e[i] * o : e[i]; }
#pragma unroll
          for (int i = 0; i < 8; ++i) { const float o = __shfl(e[i], s2 & 63); e[i] = (pl >= 2) ? e[i] * o : e[i]; } }
        if (pl == 3) { LAS f32x4* wt = (LAS f32x4*)(L + SC_WT + (w * 128 + 8 * k8) * 4); wt[0] = (f32x4){e[0], e[1], e[2], e[3]}; wt[1] = (f32x4){e[4], e[5], e[6], e[7]}; }
        __syncthreads();
        float etot[8];
        { float pre[8];
#pragma unroll
          for (int i = 0; i < 8; ++i) { pre[i] = 1.f; etot[i] = 1.f; }
#pragma unroll
          for (int ww = 0; ww < 8; ++ww) { const LAS f32x4* wt = (const LAS f32x4*)(L + SC_WT + (ww * 128 + 8 * k8) * 4); const f32x4 a = wt[0], c = wt[1];
              const float x[8] = {a.x, a.y, a.z, a.w, c.x, c.y, c.z, c.w};
              const bool before = dir ? (ww > w) : (ww < w);
#pragma unroll
              for (int i = 0; i < 8; ++i) { etot[i] *= x[i]; pre[i] = before ? pre[i] * x[i] : pre[i]; } }
#pragma unroll
          for (int i = 0; i < 8; ++i) e[i] *= pre[i]; }
        {
            const float qf[8] = {bflo(q0.x), bfhi(q0.x), bflo(q0.y), bfhi(q0.y), bflo(q0.z), bfhi(q0.z), bflo(q0.w), bfhi(q0.w)};
            float qt[8], kt[8], kd[8];
#pragma unroll
            for (int i = 0; i < 8; ++i) { qt[i] = qf[i] * e[i]; kt[i] = kk[i] * fast_rcp(e[i]); kd[i] = kt[i] * etot[i]; }
            const unsigned ob = off_b((unsigned)t, (unsigned)k8);
            v4u o; o.x = pk2(qt[0], qt[1]); o.y = pk2(qt[2], qt[3]); o.z = pk2(qt[4], qt[5]); o.w = pk2(qt[6], qt[7]); *(LAS v4u*)(L + SC_QT + ob) = o;
            o.x = pk2(kt[0], kt[1]); o.y = pk2(kt[2], kt[3]); o.z = pk2(kt[4], kt[5]); o.w = pk2(kt[6], kt[7]); *(LAS v4u*)(L + SC_KT + ob) = o;
            o.x = pk2(kd[0], kd[1]); o.y = pk2(kd[2], kd[3]); o.z = pk2(kd[4], kd[5]); o.w = pk2(kd[6], kd[7]); *(LAS v4u*)(L + SC_KD + ob) = o;
            *(LAS v4u*)(L + SC_VT + ob) = v0;
            if (!isctx) { o.x = pk2(qt[0] * ecum[0], qt[1] * ecum[1]); o.y = pk2(qt[2] * ecum[2], qt[3] * ecum[3]); o.z = pk2(qt[4] * ecum[4], qt[5] * ecum[5]); o.w = pk2(qt[6] * ecum[6], qt[7] * ecum[7]);
                *(GAS v4u*)(qseg + (size_t)(rowbase + tc * CHT + t) * 512 + h * 128 + 8 * k8) = o; }
            if (t == 0) { LAS f32x4* el = (LAS f32x4*)(L + SC_EL + 32 * k8); el[0] = (f32x4){etot[0], etot[1], etot[2], etot[3]}; el[1] = (f32x4){etot[4], etot[5], etot[6], etot[7]}; }
#pragma unroll
            for (int i = 0; i < 8; ++i) ecum[i] *= etot[i];
        }
        __syncthreads();
        if (w < 4 && !isctx) {
            const int tt = dir ? (w >> 1) : ((w + 1) >> 1), st = dir ? ((w + 1) >> 1) : (w >> 1);
            const int tz = dir ? 1 : 0, sz = dir ? 0 : 1;
            f32x4 a = (f32x4){0.f, 0.f, 0.f, 0.f};
            if (w < 3) {
#pragma unroll
                for (int s = 0; s < 4; ++s) { const bf16x8 A = *(const LAS bf16x8*)(L + SC_QT + row_addr16(lane, tt, s)); const bf16x8 B = *(const LAS bf16x8*)(L + SC_KT + row_addr16(lane, st, s)); a = MFMA16(A, B, a); }
            }
            const int tr = (w < 3 ? tt : tz) * 16 + 4 * q, sc = (w < 3 ? st : sz) * 16 + (lane & 15);
#pragma unroll
            for (int j = 0; j < 4; ++j) { const int ti = tr + j; const bool ok = (w < 3) && (dir ? (sc >= ti) : (sc <= ti));
                *(LAS unsigned short*)(L + SC_ATT + ti * 80 + sc * 2) = (unsigned short)f2bf(ok ? a[j] : 0.f); }
        }
        __syncthreads();
        {
            const bf16x8 Bv = tr_frag(L + SC_VT, lane, w);
            if (!isctx) {
#pragma unroll 1
                for (int tt = 0; tt < 2; ++tt) {
                    f32x4 o = (f32x4){0.f, 0.f, 0.f, 0.f};
                    const unsigned row = 16 * tt + (lane & 15);
#pragma unroll
                    for (int s = 0; s < 4; ++s) {
                        const v2u alo = *(const LAS v2u*)(L + SC_QT + off_b(row, 4 * s + (q >> 1)) + 8 * (q & 1));
                        const v2u ahi = *(const LAS v2u*)(L + SC_QT + off_b(row, 4 * s + 2 + (q >> 1)) + 8 * (q & 1));
                        const v4u av = (v4u){alo.x, alo.y, ahi.x, ahi.y};
                        v4u bv; bv.x = pk2(S[2 * s][0], S[2 * s][1]); bv.y = pk2(S[2 * s][2], S[2 * s][3]); bv.z = pk2(S[2 * s + 1][0], S[2 * s + 1][1]); bv.w = pk2(S[2 * s + 1][2], S[2 * s + 1][3]);
                        o = MFMA16(__builtin_bit_cast(bf16x8, av), __builtin_bit_cast(bf16x8, bv), o);
                    }
                    const bf16x8 At = *(const LAS bf16x8*)(L + SC_ATT + row * 80 + 16 * q);
                    o = MFMA16(At, Bv, o);
                    const int ttg = (rowbase + tc * CHT + 16 * tt) >> 4;
                    v2u ov; ov.x = pk2(o[0], o[1]); ov.y = pk2(o[2], o[3]);
                    *(GAS v2u*)(oloc + ((((size_t)(dir * 1024 + ttg) * 4 + h) * 8 + w) * 64 + lane) * 4) = ov;
                }
            }
#pragma unroll
            for (int kt = 0; kt < 8; ++kt) {
                const bf16x8 A = tr_frag(L + SC_KD, lane, kt);
                const f32x4 a4 = *(const LAS f32x4*)(L + SC_EL + (16 * kt + 4 * q) * 4);
                S[kt] = MFMA16(A, Bv, S[kt] * a4);
            }
        }
    }
    { float* us = (float*)(F.ws + WS_USEG) + (size_t)u * 128 * 128 + (4 * q) * 128 + 16 * w + (lane & 15);
#pragma unroll
      for (int kt = 0; kt < 8; ++kt) {
#pragma unroll
          for (int j = 0; j < 4; ++j) us[j * 128] = S[kt][j];
          us += 16 * 128; asm volatile("" : "+v"(us)); }
      if (t == 0) { float* as = (float*)(F.ws + WS_ASEG) + (size_t)u * 128 + 8 * k8;
#pragma unroll
          for (int i = 0; i < 8; ++i) as[i] = ecum[i]; } }
    __syncthreads();
}

constexpr int PL_V = 0, PL_VSTR = 132, PL_D = 34816, PL_DSTR = 272;
__device__ __forceinline__ void pool_unit(Frame& F, int u) {
    const int b = u >> 6, r = u & 63, tid = F.tid, lane = F.lane, w = F.wave, q = lane >> 4;
    const int c = tid >> 3, ch16 = tid & 7;
    const bf16* Z = (const bf16*)(F.ws + WS_Z); bf16* YP = (bf16*)(F.ws + WS_YPOOL);
    LAS unsigned char* L = F.lds;
#pragma unroll 1
    for (int g = 0; g < 4; ++g) {
        const int half = 1 << g;
        const int r_lo = max(0, r - half), r_hi = min(63, r + half - 1), c_lo = max(0, c - half), c_hi = min(63, c + half - 1);
        float vs[16], pc[16];
#pragma unroll
        for (int i = 0; i < 16; ++i) { vs[i] = 0.f; pc[i] = 0.f; }
        for (int rr = r_lo; rr <= r_hi; ++rr) {
            const bf16* p = Z + (size_t)(b * SEQ + rr * 64 + c) * INW + g * 128 + 16 * ch16;
            const v4u a = *(const GAS v4u*)p, d = *(const GAS v4u*)(p + 8);
            const float x[16] = {bflo(a.x), bfhi(a.x), bflo(a.y), bfhi(a.y), bflo(a.z), bfhi(a.z), bflo(a.w), bfhi(a.w), bflo(d.x), bfhi(d.x), bflo(d.y), bfhi(d.y), bflo(d.z), bfhi(d.z), bflo(d.w), bfhi(d.w)};
#pragma unroll
            for (int i = 0; i < 16; ++i) { vs[i] += x[i]; pc[i] = (rr == r) ? x[i] : pc[i]; }
        }
        { LAS f32x4* vp = (LAS f32x4*)(L + PL_V + (c * PL_VSTR + 16 * ch16) * 4);
#pragma unroll
          for (int i = 0; i < 4; ++i) vp[i] = (f32x4){vs[4 * i], vs[4 * i + 1], vs[4 * i + 2], vs[4 * i + 3]}; }
        __syncthreads();
        float hs[16];
#pragma unroll
        for (int i = 0; i < 16; ++i) hs[i] = 0.f;
        for (int cc = c_lo; cc <= c_hi; ++cc) { const LAS f32x4* vp = (const LAS f32x4*)(L + PL_V + (cc * PL_VSTR + 16 * ch16) * 4);
#pragma unroll
            for (int i = 0; i < 4; ++i) { const f32x4 x = vp[i]; hs[4 * i] += x.x; hs[4 * i + 1] += x.y; hs[4 * i + 2] += x.z; hs[4 * i + 3] += x.w; } }
        { const float inv = 1.f / (float)((r_hi - r_lo + 1) * (c_hi - c_lo + 1));
          v4u o0, o1;
          o0.x = pk2(hs[0] * inv - pc[0], hs[1] * inv - pc[1]); o0.y = pk2(hs[2] * inv - pc[2], hs[3] * inv - pc[3]); o0.z = pk2(hs[4] * inv - pc[4], hs[5] * inv - pc[5]); o0.w = pk2(hs[6] * inv - pc[6], hs[7] * inv - pc[7]);
          o1.x = pk2(hs[8] * inv - pc[8], hs[9] * inv - pc[9]); o1.y = pk2(hs[10] * inv - pc[10], hs[11] * inv - pc[11]); o1.z = pk2(hs[12] * inv - pc[12], hs[13] * inv - pc[13]); o1.w = pk2(hs[14] * inv - pc[14], hs[15] * inv - pc[15]);
          LAS v4u* dp = (LAS v4u*)(L + PL_D + c * PL_DSTR + 32 * ch16); dp[0] = o0; dp[1] = o1; }
        __syncthreads();
        { const int tt = w >> 1; const bf16* wt = (const bf16*)(F.ws + WS_POOLW) + (size_t)g * 128 * 128;
          bf16x8 Bd[4];
#pragma unroll
          for (int s = 0; s < 4; ++s) Bd[s] = *(const LAS bf16x8*)(L + PL_D + (16 * tt + (lane & 15)) * PL_DSTR + (32 * s + 8 * q) * 2);
#pragma unroll
          for (int ni = 0; ni < 4; ++ni) { const int nt = 4 * (w & 1) + ni; f32x4 a = (f32x4){0.f, 0.f, 0.f, 0.f};
#pragma unroll
              for (int s = 0; s < 4; ++s) { const bf16x8 A = *(const GAS bf16x8*)(wt + (size_t)(16 * nt + (lane & 15)) * 128 + 32 * s + 8 * q); a = MFMA16(A, Bd[s], a); }
              const f32x4 sc = *(const GAS f32x4*)(F.pool_scale + g * 128 + 16 * nt + 4 * q);
              v2u o; o.x = pk2(a[0] * sc.x, a[1] * sc.y); o.y = pk2(a[2] * sc.z, a[3] * sc.w);
              *(GAS v2u*)(YP + (size_t)(b * SEQ + r * 64 + 16 * tt + (lane & 15)) * 512 + g * 128 + 16 * nt + 4 * q) = o; } }
    }
    __syncthreads();
}

constexpr int FX_SF = 0, FX_SB = 32768, FX_SCR = 65536, FX_SCRSTR = 132;
__device__ __forceinline__ void fix_fold(Frame& F, int b, int h, int dir, int nfold, int soff) {
    const int tid = F.tid, kr = tid >> 4, ch = tid & 15;
    const float* US = (const float*)(F.ws + WS_USEG); const float* AS = (const float*)(F.ws + WS_ASEG);
    float s[4][8];
    { const int uc = NSCAN_L + (b * 4 + h) * 2 + dir;
#pragma unroll
      for (int rr = 0; rr < 4; ++rr) { const float* p = US + ((size_t)uc * 128 + kr + 32 * rr) * 128 + 8 * ch; const f32x4 a = *(const GAS f32x4*)p, c = *(const GAS f32x4*)(p + 4);
          s[rr][0] = a.x; s[rr][1] = a.y; s[rr][2] = a.z; s[rr][3] = a.w; s[rr][4] = c.x; s[rr][5] = c.y; s[rr][6] = c.z; s[rr][7] = c.w; } }
    for (int j = 0; j < nfold; ++j) { const int u = ((b * 4 + h) * 2 + dir) * 8 + j;
#pragma unroll
        for (int rr = 0; rr < 4; ++rr) { const int k = kr + 32 * rr; const float* p = US + ((size_t)u * 128 + k) * 128 + 8 * ch; const f32x4 a = *(const GAS f32x4*)p, c = *(const GAS f32x4*)(p + 4);
            const float al = AS[u * 128 + k];
            s[rr][0] = al * s[rr][0] + a.x; s[rr][1] = al * s[rr][1] + a.y; s[rr][2] = al * s[rr][2] + a.z; s[rr][3] = al * s[rr][3] + a.w;
            s[rr][4] = al * s[rr][4] + c.x; s[rr][5] = al * s[rr][5] + c.y; s[rr][6] = al * s[rr][6] + c.z; s[rr][7] = al * s[rr][7] + c.w; } }
#pragma unroll
    for (int rr = 0; rr < 4; ++rr) { v4u o; o.x = pk2(s[rr][0], s[rr][1]); o.y = pk2(s[rr][2], s[rr][3]); o.z = pk2(s[rr][4], s[rr][5]); o.w = pk2(s[rr][6], s[rr][7]);
        *(LAS v4u*)(F.lds + soff + rr * 8192 + off_b((unsigned)kr, (unsigned)ch)) = o; }
}
__device__ __forceinline__ void fix_unit(Frame& F, int u) {
    const int tb = u & 7, h = (u >> 3) & 3, b = u >> 5, lane = F.lane, w = F.wave, q = lane >> 4;
    LAS unsigned char* L = F.lds;
    fix_fold(F, b, h, 0, tb, FX_SF);
    fix_fold(F, b, h, 1, 7 - tb, FX_SB);
    __syncthreads();
    const bf16* Z = (const bf16*)(F.ws + WS_Z); bf16* YH = (bf16*)(F.ws + WS_YHG);
    const bf16* qseg = (const bf16*)((const unsigned char*)F.out + OUT_QSEG); const bf16* oloc = (const bf16*)((const unsigned char*)F.out + OUT_OLOC);
    LAS float* scr = (LAS float*)(L + FX_SCR + w * (16 * FX_SCRSTR * 4));
    const int row0 = b * SEQ + tb * SEGT;
#pragma unroll 1
    for (int ti = 0; ti < 4; ++ti) {
        const int tt = 4 * w + ti, rowt = row0 + 16 * tt;
        f32x4 acc[8];
#pragma unroll
        for (int c = 0; c < 8; ++c) acc[c] = (f32x4){0.f, 0.f, 0.f, 0.f};
#pragma unroll
        for (int dir = 0; dir < 2; ++dir) {
            bf16x8 A[4];
#pragma unroll
            for (int s = 0; s < 4; ++s) A[s] = *(const GAS bf16x8*)(qseg + ((size_t)dir * ML + rowt + (lane & 15)) * 512 + h * 128 + 32 * s + 8 * q);
#pragma unroll
            for (int s = 0; s < 4; ++s)
#pragma unroll
                for (int c = 0; c < 8; ++c) { const bf16x8 B = tr_frag(L + (dir ? FX_SB : FX_SF) + s * 8192, lane, c); acc[c] = MFMA16(A[s], B, acc[c]); }
#pragma unroll
            for (int c = 0; c < 8; ++c) { const v2u ov = *(const GAS v2u*)(oloc + ((((size_t)(dir * 1024 + (rowt >> 4)) * 4 + h) * 8 + c) * 64 + lane) * 4);
                acc[c][0] += bflo(ov.x); acc[c][1] += bfhi(ov.x); acc[c][2] += bflo(ov.y); acc[c][3] += bfhi(ov.y); }
        }
        float ss[4];
#pragma unroll
        for (int j = 0; j < 4; ++j) { float s = 0.f;
#pragma unroll
            for (int c = 0; c < 8; ++c) s += acc[c][j] * acc[c][j];
            s += __shfl_xor(s, 1); s += __shfl_xor(s, 2); s += __shfl_xor(s, 4); s += __shfl_xor(s, 8);
            ss[j] = 1.f / sqrtf(s * (1.f / 128.f) + EPS); }
#pragma unroll
        for (int c = 0; c < 8; ++c)
#pragma unroll
            for (int j = 0; j < 4; ++j) scr[(4 * q + j) * FX_SCRSTR + 16 * c + (lane & 15)] = acc[c][j] * ss[j];
        LDS_WAIT();
        { const int tl = lane >> 2, v0 = 32 * (lane & 3); const size_t row = (size_t)(rowt + tl);
          const bf16* og = Z + row * INW + 2560 + h * 128 + v0; bf16* yo = YH + row * 512 + h * 128 + v0;
#pragma unroll
          for (int i = 0; i < 4; ++i) {
              const f32x4 a = *(const LAS f32x4*)(scr + tl * FX_SCRSTR + v0 + 8 * i), c2 = *(const LAS f32x4*)(scr + tl * FX_SCRSTR + v0 + 8 * i + 4);
              const v4u g = *(const GAS v4u*)(og + 8 * i);
              const f32x4 n0 = *(const GAS f32x4*)(F.hg_norm_g + v0 + 8 * i), n1 = *(const GAS f32x4*)(F.hg_norm_g + v0 + 8 * i + 4);
              const float gg[8] = {bflo(g.x), bfhi(g.x), bflo(g.y), bfhi(g.y), bflo(g.z), bfhi(g.z), bflo(g.w), bfhi(g.w)};
              const float yv[8] = {a.x * n0.x, a.y * n0.y, a.z * n0.z, a.w * n0.w, c2.x * n1.x, c2.y * n1.y, c2.z * n1.z, c2.w * n1.w};
              float o[8];
#pragma unroll
              for (int e = 0; e < 8; ++e) o[e] = yv[e] * gg[e] * sigmoidf_(gg[e]);
              v4u ov; ov.x = pk2(o[0], o[1]); ov.y = pk2(o[2], o[3]); ov.z = pk2(o[4], o[5]); ov.w = pk2(o[6], o[7]);
              *(GAS v4u*)(yo + 8 * i) = ov; } }
        LDS_WAIT();
    }
    __syncthreads();
}

__device__ __forceinline__ void fp8_rows(const float* src, unsigned char* dst, float* inv_scale, int gw, int NGW, int lane) {
    for (int r = gw; r < NEXP; r += NGW) {
        const GAS f32x4* p = (const GAS f32x4*)(src + (size_t)r * D + 16 * lane);
        const f32x4 a = p[0], b = p[1], c = p[2], d = p[3];
        float m = fmaxf(fmaxf(fmaxf(fabsf(a.x), fabsf(a.y)), fmaxf(fabsf(a.z), fabsf(a.w))), fmaxf(fmaxf(fabsf(b.x), fabsf(b.y)), fmaxf(fabsf(b.z), fabsf(b.w))));
        m = fmaxf(m, fmaxf(fmaxf(fmaxf(fabsf(c.x), fabsf(c.y)), fmaxf(fabsf(c.z), fabsf(c.w))), fmaxf(fmaxf(fabsf(d.x), fabsf(d.y)), fmaxf(fabsf(d.z), fabsf(d.w)))));
        m = wave_max(m);
        const float sc = (m > 0.f) ? 224.f / m : 1.f;
        v4u o; int w;
        w = __builtin_amdgcn_cvt_pk_fp8_f32(a.x * sc, a.y * sc, 0, false); w = __builtin_amdgcn_cvt_pk_fp8_f32(a.z * sc, a.w * sc, w, true); o.x = (unsigned)w;
        w = __builtin_amdgcn_cvt_pk_fp8_f32(b.x * sc, b.y * sc, 0, false); w = __builtin_amdgcn_cvt_pk_fp8_f32(b.z * sc, b.w * sc, w, true); o.y = (unsigned)w;
        w = __builtin_amdgcn_cvt_pk_fp8_f32(c.x * sc, c.y * sc, 0, false); w = __builtin_amdgcn_cvt_pk_fp8_f32(c.z * sc, c.w * sc, w, true); o.z = (unsigned)w;
        w = __builtin_amdgcn_cvt_pk_fp8_f32(d.x * sc, d.y * sc, 0, false); w = __builtin_amdgcn_cvt_pk_fp8_f32(d.z * sc, d.w * sc, w, true); o.w = (unsigned)w;
        *(GAS v4u*)(dst + (size_t)r * D + 16 * lane) = o;
        if (lane == 0) inv_scale[r] = (m > 0.f) ? m * (1.f / 224.f) : 1.f;
    }
}

constexpr int TK_S = 0, TK_SSTR = 132, TK_L = 135168;
__device__ __forceinline__ void topk_unit(Frame& F, int u) {
    const int tid = F.tid, lane = F.lane, w = F.wave, q = lane >> 4, tok0 = 64 * u;
    const bf16* Qb = (const bf16*)(F.ws + WS_QB); const bf16* KB = (const bf16*)(F.ws + WS_KEYS);
    int* eidx = (int*)(F.ws + WS_EIDX); float* gate = (float*)(F.ws + WS_GATE);
    LAS unsigned char* L = F.lds;
#pragma unroll 1
    for (int r = 0; r < 4; ++r) {
#ifdef DBG_NAIVE_S
        for (int o = tid; o < 256 * 128; o += NTHREADS) { const int row = o >> 7, key = o & 127, hpl2 = row >> 6, tt = row & 63, hp2 = 4 * r + hpl2; float sacc = 0.f;
            for (int cc = 0; cc < 128; ++cc) sacc += bflo((unsigned)Qb[(size_t)(tok0 + tt) * 2048 + hp2 * 128 + cc]) * bflo((unsigned)KB[(size_t)(hp2 * 128 + key) * 128 + cc]);
            ((LAS float*)(L + TK_S))[row * TK_SSTR + key] = sacc; }
        if (0)
#endif
        { const int hpl = w >> 1, hp = 4 * r + hpl;
          bf16x8 Aq[2][4];
#pragma unroll
          for (int t2 = 0; t2 < 2; ++t2)
#pragma unroll
              for (int s = 0; s < 4; ++s) Aq[t2][s] = *(const GAS bf16x8*)(Qb + (size_t)(tok0 + 16 * (2 * (w & 1) + t2) + (lane & 15)) * 2048 + hp * 128 + 32 * s + 8 * q);
#pragma unroll 2
          for (int kt = 0; kt < 8; ++kt) {
              bf16x8 Bk[4];
#pragma unroll
              for (int s = 0; s < 4; ++s) Bk[s] = *(const GAS bf16x8*)(KB + (size_t)(hp * 128 + 16 * kt + (lane & 15)) * 128 + 32 * s + 8 * q);
#pragma unroll
              for (int t2 = 0; t2 < 2; ++t2) { f32x4 a = (f32x4){0.f, 0.f, 0.f, 0.f};
#pragma unroll
                  for (int s = 0; s < 4; ++s) a = MFMA16(Aq[t2][s], Bk[s], a);
                  LAS float* sp = (LAS float*)(L + TK_S) + (hpl * 64 + 16 * (2 * (w & 1) + t2) + 4 * q) * TK_SSTR + 16 * kt + (lane & 15);
#pragma unroll
                  for (int j = 0; j < 4; ++j) sp[j * TK_SSTR] = a[j]; } } }
        __syncthreads();
#ifdef DBG_NAIVE_SEL
        {
            LAS float* Sg = (LAS float*)(L + TK_S); LAS float* NV = (LAS float*)(L + TK_L); LAS unsigned short* NI = (LAS unsigned short*)(L + TK_L + 16384);
            for (int o = tid; o < 256 * 128; o += NTHREADS) { const int row = o >> 7, i = o & 127; const float si = Sg[row * TK_SSTR + i]; int rank = 0;
                for (int j = 0; j < 128; ++j) { const float sj = Sg[row * TK_SSTR + j]; rank += (sj > si || (sj == si && j < i)) ? 1 : 0; }
                if (rank < 16) { NV[row * 16 + rank] = si; NI[row * 16 + rank] = (unsigned short)i; } }
            __syncthreads();
            for (int o = tid; o < 128 * 256; o += NTHREADS) { const int th = o >> 8, cnd = o & 255, hl = th >> 6, t = th & 63, r0 = (2 * hl) * 64 + t, r1 = r0 + 64, ia = cnd >> 4, ib = cnd & 15;
                const float sc_ = NV[r0 * 16 + ia] + NV[r1 * 16 + ib]; int rank = 0;
                for (int j = 0; j < 256; ++j) { const float sj = NV[r0 * 16 + (j >> 4)] + NV[r1 * 16 + (j & 15)]; rank += (sj > sc_ || (sj == sc_ && j < cnd)) ? 1 : 0; }
                if (rank < 16) { const size_t ob = (size_t)(tok0 + t) * 128 + (2 * r + hl) * 16 + rank; eidx[ob] = (int)NI[r0 * 16 + ia] * 128 + (int)NI[r1 * 16 + ib]; gate[ob] = sc_; } }
            __syncthreads();
            if (tid < 128) { const int hl = tid >> 6, t = tid & 63; const size_t ob = (size_t)(tok0 + t) * 128 + (2 * r + hl) * 16; float mx = -3e38f, sum = 0.f, ex[16];
                for (int k = 0; k < 16; ++k) mx = fmaxf(mx, gate[ob + k]);
                for (int k = 0; k < 16; ++k) { ex[k] = expf(gate[ob + k] - mx); sum += ex[k]; }
                for (int k = 0; k < 16; ++k) gate[ob + k] = ex[k] / sum; }
            __syncthreads();
        }
        if (0)
#endif
        if (tid < 256) {
            float a[16];
#pragma unroll
            for (int j = 0; j < 16; ++j) a[j] = -3.0e38f;
            const LAS f32x4* sp = (const LAS f32x4*)((LAS float*)(L + TK_S) + tid * TK_SSTR);
#pragma unroll 2
            for (int i = 0; i < 32; ++i) { const f32x4 v = sp[i]; const float ve[4] = {v.x, v.y, v.z, v.w};
#pragma unroll
                for (int e = 0; e < 4; ++e) { const float x = __builtin_bit_cast(float, (__builtin_bit_cast(unsigned, ve[e]) & ~127u) | (unsigned)(4 * i + e));
#pragma unroll
                    for (int j = 15; j >= 1; --j) a[j] = __builtin_amdgcn_fmed3f(a[j - 1], a[j], x);
                    a[0] = fmaxf(a[0], x); } }
            LAS v4u* tp = (LAS v4u*)(L + TK_L + tid * 64);
#pragma unroll
            for (int i = 0; i < 4; ++i) tp[i] = (v4u){__builtin_bit_cast(unsigned, a[4 * i]), __builtin_bit_cast(unsigned, a[4 * i + 1]), __builtin_bit_cast(unsigned, a[4 * i + 2]), __builtin_bit_cast(unsigned, a[4 * i + 3])};
        }
        __syncthreads();
#ifdef DBG_NAIVE_SEL
        if (0)
#endif
        if (tid < 128) {
            const int hl = tid >> 6, t = tid & 63, r0 = (2 * hl) * 64 + t, r1 = r0 + 64;
            const LAS unsigned* t0 = (const LAS unsigned*)(L + TK_L + r0 * 64); const LAS unsigned* t1 = (const LAS unsigned*)(L + TK_L + r1 * 64);
            float v1[16], v2[16];
#pragma unroll
            for (int i = 0; i < 4; ++i) { const v4u x = ((const LAS v4u*)t0)[i], y = ((const LAS v4u*)t1)[i];
                v1[4 * i] = __builtin_bit_cast(float, x.x & ~127u); v1[4 * i + 1] = __builtin_bit_cast(float, x.y & ~127u); v1[4 * i + 2] = __builtin_bit_cast(float, x.z & ~127u); v1[4 * i + 3] = __builtin_bit_cast(float, x.w & ~127u);
                v2[4 * i] = __builtin_bit_cast(float, y.x & ~127u); v2[4 * i + 1] = __builtin_bit_cast(float, y.y & ~127u); v2[4 * i + 2] = __builtin_bit_cast(float, y.z & ~127u); v2[4 * i + 3] = __builtin_bit_cast(float, y.w & ~127u); }
            float c[16];
#pragma unroll
            for (int j = 0; j < 16; ++j) c[j] = -3.0e38f;
#pragma unroll
            for (int ia = 0; ia < 16; ++ia)
#pragma unroll
                for (int ib = 0; ib < 16; ++ib) if ((ia + 1) * (ib + 1) <= 16) {
                    const float x = __builtin_bit_cast(float, (__builtin_bit_cast(unsigned, v1[ia] + v2[ib]) & ~255u) | (unsigned)(ia * 16 + ib));
#pragma unroll
                    for (int j = 15; j >= 1; --j) c[j] = __builtin_amdgcn_fmed3f(c[j - 1], c[j], x);
                    c[0] = fmaxf(c[0], x); }
            float ex[16], sum = 0.f; const float mx = __builtin_bit_cast(float, __builtin_bit_cast(unsigned, c[0]) & ~255u);
#pragma unroll
            for (int k = 0; k < 16; ++k) { ex[k] = fast_exp(__builtin_bit_cast(float, __builtin_bit_cast(unsigned, c[k]) & ~255u) - mx); sum += ex[k]; }
            const float inv = 1.f / sum; const int h = 2 * r + hl; const size_t ob = (size_t)(tok0 + t) * 128 + h * 16;
#pragma unroll
            for (int k = 0; k < 16; ++k) { const unsigned code = __builtin_bit_cast(unsigned, c[k]) & 255u;
                const unsigned i1 = t0[code >> 4] & 127u, i2 = t1[code & 15u] & 127u;
                eidx[ob + k] = (int)(i1 * 128u + i2); gate[ob + k] = ex[k] * inv; }
        }
    }
    __syncthreads();
}

__device__ __forceinline__ void cvt16(const v4u r, float (&o)[16]) {
#pragma unroll
    for (int d = 0; d < 4; ++d) { const f32x2 lo = __builtin_amdgcn_cvt_pk_f32_fp8((int)r[d], false), hi = __builtin_amdgcn_cvt_pk_f32_fp8((int)r[d], true);
        o[4 * d] = lo.x; o[4 * d + 1] = lo.y; o[4 * d + 2] = hi.x; o[4 * d + 3] = hi.y; }
}
__device__ __forceinline__ void p10_experts(Frame& F) {
    const int lane = F.lane, gw = F.bid * NWAVES + F.wave, NGW = F.G * NWAVES;
    const bf16* H2 = (const bf16*)(F.ws + WS_H); const unsigned char* U8 = F.ws + WS_U8; const unsigned char* V8 = F.ws + WS_V8;
    const float* su = (const float*)(F.ws + WS_SU); const float* sv = (const float*)(F.ws + WS_SV);
    const int* eidx = (const int*)(F.ws + WS_EIDX); const float* gate = (const float*)(F.ws + WS_GATE); const float* mod = (const float*)(F.ws + WS_MOD);
    const int myi = ((lane >> 5) & 1) * 8 + ((lane >> 4) & 1) * 4 + ((lane >> 3) & 1) * 2 + ((lane >> 2) & 1);
    for (int tok = gw; tok < ML; tok += NGW) {
        float hf[16];
        { const v4u a = *(const GAS v4u*)(H2 + (size_t)tok * D + 16 * lane), b = *(const GAS v4u*)(H2 + (size_t)tok * D + 16 * lane + 8);
          hf[0] = bflo(a.x); hf[1] = bfhi(a.x); hf[2] = bflo(a.y); hf[3] = bfhi(a.y); hf[4] = bflo(a.z); hf[5] = bfhi(a.z); hf[6] = bflo(a.w); hf[7] = bfhi(a.w);
          hf[8] = bflo(b.x); hf[9] = bfhi(b.x); hf[10] = bflo(b.y); hf[11] = bfhi(b.y); hf[12] = bflo(b.z); hf[13] = bfhi(b.z); hf[14] = bflo(b.w); hf[15] = bfhi(b.w); }
        const int e0 = eidx[(size_t)tok * 128 + lane], e1 = eidx[(size_t)tok * 128 + 64 + lane];
        const float g0 = gate[(size_t)tok * 128 + lane], g1 = gate[(size_t)tok * 128 + 64 + lane];
        float acc[16];
#pragma unroll
        for (int i = 0; i < 16; ++i) acc[i] = 0.f;
#pragma unroll 1
        for (int bt = 0; bt < 8; ++bt) {
            const int ev = (bt < 4) ? e0 : e1; const float gv = (bt < 4) ? g0 : g1; const int jb = (16 * bt) & 63;
            float p[16];
#pragma unroll
            for (int i = 0; i < 16; ++i) { const int e = __builtin_amdgcn_readlane(ev, jb + i);
                float x[16];
#ifdef DBG_F32EXP
                { const GAS f32x4* rp = (const GAS f32x4*)(F.pu + (size_t)e * D + 16 * lane);
#pragma unroll
                  for (int d4 = 0; d4 < 4; ++d4) { const f32x4 t4 = rp[d4]; x[4 * d4] = t4.x; x[4 * d4 + 1] = t4.y; x[4 * d4 + 2] = t4.z; x[4 * d4 + 3] = t4.w; } }
#else
                { const v4u row = *(const GAS v4u*)(U8 + (size_t)e * D + 16 * lane); cvt16(row, x); }
#endif
                float s = 0.f;
#pragma unroll
                for (int k = 0; k < 16; ++k) s += x[k] * hf[k];
                p[i] = s; }
#pragma unroll
            for (int i = 0; i < 8; ++i) { const bool hi = (lane & 32) != 0; const float keep = hi ? p[i + 8] : p[i], send = hi ? p[i] : p[i + 8]; p[i] = keep + __shfl_xor(send, 32); }
#pragma unroll
            for (int i = 0; i < 4; ++i) { const bool hi = (lane & 16) != 0; const float keep = hi ? p[i + 4] : p[i], send = hi ? p[i] : p[i + 4]; p[i] = keep + __shfl_xor(send, 16); }
#pragma unroll
            for (int i = 0; i < 2; ++i) { const bool hi = (lane & 8) != 0; const float keep = hi ? p[i + 2] : p[i], send = hi ? p[i] : p[i + 2]; p[i] = keep + __shfl_xor(send, 8); }
            { const bool hi = (lane & 4) != 0; const float keep = hi ? p[1] : p[0], send = hi ? p[0] : p[1]; p[0] = keep + __shfl_xor(send, 4); }
            p[0] += __shfl_xor(p[0], 2); p[0] += __shfl_xor(p[0], 1);
            const int ej = __shfl(ev, jb + myi); const float gj = __shfl(gv, jb + myi);
#ifdef DBG_F32EXP
            const float z = p[0];
            const float wl = gj * (0.5f * z * (1.f + erff(z * 0.70710678118f)));
#else
            const float z = p[0] * su[ej];
            const float wl = gj * (0.5f * z * (1.f + erff(z * 0.70710678118f))) * sv[ej];
#endif
#pragma unroll
            for (int i = 0; i < 16; ++i) { const int e = __builtin_amdgcn_readlane(ev, jb + i);
                const int src = ((i >> 3) & 1) * 32 + ((i >> 2) & 1) * 16 + ((i >> 1) & 1) * 8 + (i & 1) * 4;
                const float wi = __builtin_bit_cast(float, __builtin_amdgcn_readlane(__builtin_bit_cast(int, wl), src));
                float x[16];
#ifdef DBG_F32EXP
                { const GAS f32x4* rp = (const GAS f32x4*)(F.pv + (size_t)e * D + 16 * lane);
#pragma unroll
                  for (int d4 = 0; d4 < 4; ++d4) { const f32x4 t4 = rp[d4]; x[4 * d4] = t4.x; x[4 * d4 + 1] = t4.y; x[4 * d4 + 2] = t4.z; x[4 * d4 + 3] = t4.w; } }
#else
                { const v4u row = *(const GAS v4u*)(V8 + (size_t)e * D + 16 * lane); cvt16(row, x); }
#endif
#pragma unroll
                for (int k = 0; k < 16; ++k) acc[k] += wi * x[k]; }
        }
        { float* orow = F.out + (size_t)tok * D + 16 * lane; const float* g2 = mod + (size_t)(tok >> 12) * 6144 + 5 * 1024 + 16 * lane; const float* fg = F.final_g + 16 * lane;
          f32x4 xv[4]; float s2 = 0.f;
#pragma unroll
          for (int i = 0; i < 4; ++i) { const f32x4 x1 = ((const GAS f32x4*)orow)[i], gg = ((const GAS f32x4*)g2)[i];
#ifdef DBG_NOPEER
              xv[i] = x1 + 0.f * gg * (f32x4){acc[4 * i], acc[4 * i + 1], acc[4 * i + 2], acc[4 * i + 3]};
#else
              xv[i] = x1 + gg * (f32x4){acc[4 * i], acc[4 * i + 1], acc[4 * i + 2], acc[4 * i + 3]};
#endif
              s2 += (xv[i].x * xv[i].x + xv[i].y * xv[i].y) + (xv[i].z * xv[i].z + xv[i].w * xv[i].w); }
          const float rstd = 1.f / sqrtf(wave_sum(s2) * (1.f / D) + EPS);
#pragma unroll
          for (int i = 0; i < 4; ++i) ((GAS f32x4*)orow)[i] = xv[i] * rstd * ((const GAS f32x4*)fg)[i]; }
    }
}

#ifndef TAP
#define TAP 0
#endif
constexpr int N_PHASES = TAP ? 12 : 11;
__global__ void __launch_bounds__(NTHREADS, 2) fwd_kernel(Args args) {
    extern __shared__ __attribute__((aligned(16))) unsigned char lds[];
    Frame F;
    F.lds = (LAS unsigned char*)lds;
    F.tid = threadIdx.x; F.lane = F.tid & 63; F.wave = __builtin_amdgcn_readfirstlane(F.tid >> 6); F.G = gridDim.x; F.bid = blockIdx.x;
    F.x = args.in[0]; F.c = args.in[1]; F.ctx = args.in[2]; F.c_ctx = args.in[3]; F.w_mod = args.in[4]; F.b_mod = args.in[5]; F.n1g = args.in[6]; F.n2g = args.in[7];
    F.w_in = args.in[8]; F.pool_w = args.in[9]; F.pool_scale = args.in[10]; F.lb_logits = args.in[11]; F.hg_norm_g = args.in[12]; F.w_a = args.in[13]; F.w_b = args.in[14];
    F.w_o = args.in[15]; F.wq = args.in[16]; F.keys = args.in[17]; F.pu = args.in[18]; F.pv = args.in[19]; F.final_g = args.in[20];
    F.out = args.out; F.ws = args.ws;
    volatile LAS unsigned* MISC = (volatile LAS unsigned*)(F.lds + MISC_OFF);
    if (F.tid < 64) MISC[F.tid] = 0u;
    __syncthreads();
    unsigned* barw = (unsigned*)(F.ws + WS_CTL) + CW_BAR;
    XcdBarrier bar; bar.bar = barw; bar.x = 0; bar.st = nullptr;
    if (ONE_LAUNCH) bar = xcd_barrier_post(barw, MISC + 8);
    const int lo = args.ph_lo, hi = args.ph_hi;
#ifndef PH_MASK
#define PH_MASK 0x7ff
#endif
#define IN(k) (((PH_MASK >> (k)) & 1) && lo <= (k) && (k) < hi)
#define SEAM(k) do { if (IN(k) && IN((k) + 1)) xcd_barrier(bar); } while (0)

    if (IN(0)) { p0_prologue(F); } SEAM(0);
    if (IN(1)) { p1_modulate(F); } SEAM(1);
    if (IN(2)) {
        SchedIn S{(const char*)(F.ws + WS_H), (const char*)(F.ws + WS_WIN), F.G, F.bid};
        EpiZ E{(bf16*)(F.ws + WS_Z), (bf16*)(F.ws + WS_ZC)};
        pg8::gemm_phase<EpiZ, SchedIn, true, true>(F.lds, D, S, E);
    } SEAM(2);
    if (IN(3)) {
#ifndef NO_SCAN
        for (int u = F.bid; u < NSCAN; u += F.G) scan_unit(F, u);
#endif
#ifndef NO_POOL
        for (int u = F.bid; u < NB * 64; u += F.G) pool_unit(F, u);
#endif
    } SEAM(3);
    if (IN(4)) { for (int u = F.bid; u < NB * 4 * NSEG; u += F.G) fix_unit(F, u); } SEAM(4);
    if (IN(5)) {
        SchedMerge S{(const char*)(F.ws + WS_YPOOL), (const char*)(F.ws + WS_YHG), (const char*)(F.ws + WS_WA), (const char*)(F.ws + WS_WB), F.G, F.bid};
        EpiMerge E{(const bf16*)(F.ws + WS_Z), (bf16*)(F.ws + WS_M)};
        pg8::gemm_phase<EpiMerge, SchedMerge, true, true>(F.lds, 512, S, E);
    } SEAM(5);
    if (IN(6)) {
        SchedPlain S{(const char*)(F.ws + WS_M), (const char*)(F.ws + WS_WO), 64, 4, D, F.G, F.bid};
        EpiRes E{F.x, (const float*)(F.ws + WS_MOD), F.out};
        pg8::gemm_phase<EpiRes, SchedPlain, true, true>(F.lds, D, S, E);
    } SEAM(6);
    if (IN(7)) {
        const float* mod = (const float*)(F.ws + WS_MOD); bf16* H2 = (bf16*)(F.ws + WS_H);
        const int gw = F.bid * NWAVES + F.wave, NGW = F.G * NWAVES;
        for (int m = gw; m < ML; m += NGW) { const int v = m >> 12; modulate_row(F.out + (size_t)m * D, H2 + (size_t)m * D, F.n2g, mod + v * 6144 + 3 * 1024, mod + v * 6144 + 4 * 1024, F.lane); }
        fp8_rows(F.pu, F.ws + WS_U8, (float*)(F.ws + WS_SU), gw, NGW, F.lane);
        fp8_rows(F.pv, F.ws + WS_V8, (float*)(F.ws + WS_SV), gw, NGW, F.lane);
    } SEAM(7);
    if (IN(8)) {
        SchedPlain S{(const char*)(F.ws + WS_H), (const char*)(F.ws + WS_WQ), 64, 8, D, F.G, F.bid};
        EpiPlain E{(bf16*)(F.ws + WS_QB), 2048};
        pg8::gemm_phase<EpiPlain, SchedPlain, true, true>(F.lds, D, S, E);
    } SEAM(8);
    if (IN(9)) { for (int u = F.bid; u < ML / 64; u += F.G) topk_unit(F, u); } SEAM(9);
    if (IN(10)) { p10_experts(F); }
#if TAP
    if (lo <= 11 && 11 < hi) {
        const bf16* Z = (const bf16*)(F.ws + WS_Z); const bf16* ZC = (const bf16*)(F.ws + WS_ZC); const bf16* YP = (const bf16*)(F.ws + WS_YPOOL); const bf16* YH = (const bf16*)(F.ws + WS_YHG);
        const bf16* Hh = (const bf16*)(F.ws + WS_H); const float* modp = (const float*)(F.ws + WS_MOD);
        for (size_t i = (size_t)F.bid * NTHREADS + F.tid; i < (size_t)ML * D; i += (size_t)F.G * NTHREADS) { const size_t row = i >> 10; const int c = (int)(i & 1023); float v = 0.f;
            if (TAP == 1) { v = __builtin_bit_cast(float, (unsigned)Hh[row * D + c] << 16) + __builtin_bit_cast(float, (unsigned)Hh[(size_t)(ML + (row & 1023)) * D + c] << 16) + modp[(row % 5) * 6144 + c * 6 % 6144]; }
            if (TAP == 2) { for (int k = 0; k < 5; ++k) v += __builtin_bit_cast(float, (unsigned)Z[row * INW + k * 1024 + c] << 16); v += __builtin_bit_cast(float, (unsigned)ZC[(row & 1023) * ZC_W + c] << 16) + __builtin_bit_cast(float, (unsigned)ZC[(row & 1023) * ZC_W + 512 + c] << 16); }
            if (TAP == 3) { v = (c < 512) ? __builtin_bit_cast(float, (unsigned)YP[row * 512 + c] << 16) : ((const float*)(F.ws + WS_USEG))[(row * 512 + (c - 512)) % ((size_t)NSCAN * 16384)]; }
            if (TAP == 4) { v = (c < 512) ? __builtin_bit_cast(float, (unsigned)YP[row * 512 + c] << 16) : __builtin_bit_cast(float, (unsigned)YH[row * 512 + c - 512] << 16); }
            if (TAP == 5) { const unsigned wd = ((const unsigned*)F.out)[i]; v = __builtin_bit_cast(float, wd << 16) + __builtin_bit_cast(float, wd & 0xffff0000u) + ((const float*)(F.ws + WS_ASEG))[i % (NSCAN * 128)]; }
            if (TAP == 6) { const unsigned wd = ((const unsigned*)F.out)[i]; v = (i < (size_t)ML * D / 2) ? __builtin_bit_cast(float, wd << 16) + __builtin_bit_cast(float, wd & 0xffff0000u) : 0.f; }
            if (TAP == 7) { const unsigned wd = ((const unsigned*)F.out)[i]; v = (i >= (size_t)ML * D / 2) ? __builtin_bit_cast(float, wd << 16) + __builtin_bit_cast(float, wd & 0xffff0000u) : 0.f; }
            if (!(fabsf(v) < 3.0e38f)) v = 7777.f;
            F.out[i] = v; }
    }
#endif
#undef IN
#undef SEAM
}

extern "C" void kernel_launch(void* const* d_in, const int* in_sizes, int n_in, void* d_out, int out_size, void* d_ws, size_t ws_size, hipStream_t stream) {
    static int grid = 0;
    if (grid == 0) {
        if (n_in != 21 || out_size != ML * D || ws_size < WS_END) { fprintf(stderr, "kernel_launch: unexpected problem (n_in %d, out %d, ws %zu)\n", n_in, out_size, ws_size); grid = -1; return; }
        int dev = 0, cus = 0;
        if (hipGetDevice(&dev) != hipSuccess || hipDeviceGetAttribute(&cus, hipDeviceAttributeMultiprocessorCount, dev) != hipSuccess) { grid = -1; return; }
        if (hipFuncSetAttribute((const void*)fwd_kernel, hipFuncAttributeMaxDynamicSharedMemorySize, LDS_BYTES) != hipSuccess) { fprintf(stderr, "kernel_launch: hipFuncSetAttribute failed\n"); grid = -1; return; }
        int per_cu = 0;
        if (hipOccupancyMaxActiveBlocksPerMultiprocessor(&per_cu, (const void*)fwd_kernel, NTHREADS, LDS_BYTES) != hipSuccess || per_cu < 1) fprintf(stderr, "kernel_launch: occupancy query says %d\n", per_cu);
        (void)hipGetLastError();
        grid = cus;
    }
    if (grid < 0) return;
    (void)hipMemsetAsync((char*)d_ws + WS_CTL, 0, CTL_ZERO_BYTES, stream);
    Args a{};
    for (int i = 0; i < 21; ++i) a.in[i] = (const float*)d_in[i];
    a.out = (float*)d_out; a.ws = (unsigned char*)d_ws;
#if ONE_LAUNCH
    a.ph_lo = 0; a.ph_hi = N_PHASES;
    hipLaunchKernelGGL(fwd_kernel, dim3(grid), dim3(NTHREADS), LDS_BYTES, stream, a);
#else
    for (int p = 0; p < N_PHASES; ++p) { a.ph_lo = p; a.ph_hi = p + 1; hipLaunchKernelGGL(fwd_kernel, dim3(grid), dim3(NTHREADS), LDS_BYTES, stream, a); }
#endif
}
```

```cpp
#define ONE_LAUNCH 1
#include <hip/hip_runtime.h>
#include <cstdio>
#include <cstdint>

#ifndef ONE_LAUNCH
#define ONE_LAUNCH 1
#endif

namespace pg8 {
#define PG8_LAS __attribute__((address_space(3)))
typedef unsigned short bf16_t;
typedef short bf16x8 __attribute__((ext_vector_type(8)));
typedef float f32x4 __attribute__((ext_vector_type(4)));
typedef float f32x2 __attribute__((ext_vector_type(2)));
typedef unsigned u32x4 __attribute__((ext_vector_type(4)));
typedef unsigned u32x2 __attribute__((ext_vector_type(2)));
constexpr int BM = 256, BK = 64, HALF = 128, HTB = HALF * BK * 2, STAGE_BYTES = 8 * HTB, NXCD = 8, WGM = 8;

__host__ __device__ __forceinline__ int lds_byte(int r, int c) { const int st = (r >> 4) * 2 + (c >> 5), rr = r & 15, cc = c & 31, ob = rr * 64 + cc * 2; return st * 1024 + (ob ^ (((ob >> 9) & 1) << 5)); }
__host__ __device__ __forceinline__ void stage_rc(int b, int& R, int& C) { const int st = b / 1024, sb = b % 1024, swz = sb ^ (((sb >> 9) & 1) << 5); R = (st >> 1) * 16 + swz / 64; C = (st & 1) * 32 + (swz % 64) / 2; }
__host__ __device__ __forceinline__ int perm32(int rho) { const int n = rho >> 4, i = rho & 15; return 8 * (i >> 2) + 4 * n + (i & 3); }

struct Unit { int pm, pn, seg; };

__host__ __device__ __forceinline__ void tile_of(int wgid, int nM, int nN, int& pm, int& pn) {
    const int nwg = nM * nN;
    { const int q = nwg / NXCD, r = nwg % NXCD, xcd = wgid % NXCD, off = wgid / NXCD; wgid = (xcd < r ? xcd * (q + 1) : r * (q + 1) + (xcd - r) * q) + off; }
    const int nig = WGM * nN, gid = wgid / nig, fm = gid * WGM, gsz = (nM - fm) < WGM ? (nM - fm) : WGM;
    pm = fm + ((wgid % nig) % gsz); pn = (wgid % nig) / gsz;
}

typedef __bf16 bf16x2_t __attribute__((ext_vector_type(2)));
__device__ __forceinline__ unsigned cvt_pk_bf16(float lo, float hi) { bf16x2_t v; v.x = (__bf16)lo; v.y = (__bf16)hi; return __builtin_bit_cast(unsigned, v); }

template <class Epi, class Sched, bool ALIGN_EPI = false, bool SP2 = false>
__device__ __forceinline__ void gemm_phase(PG8_LAS unsigned char* lds, const int K, const Sched& S, const Epi& E) {
    const int tid = threadIdx.x, wid = __builtin_amdgcn_readfirstlane(tid >> 6), lane = tid & 63, wr = wid >> 2, wc = wid & 3, fr = lane & 15, fq = lane >> 4;
    const int nt = K / BK;
    unsigned voffA[2], voffB[2];
#pragma unroll
    for (int i = 0; i < 2; ++i) { int R, C; stage_rc(tid * 16 + i * 8192, R, C); const int Rb = Epi::PERM ? ((R & ~31) + perm32(R & 31)) : R;
        voffA[i] = (unsigned)(R * K + C) * 2u; voffB[i] = (unsigned)(Rb * K + C) * 2u; }
    const size_t kstep = (size_t)(BK * 2);
    const size_t hstep = (size_t)HALF * K * 2;
    const unsigned ldsw = (unsigned)wid * 1024u;
    const int aoff = lds_byte(wr * 64 + fr, fq * 8), boff = lds_byte(wc * 32 + fr, fq * 8);
#define PG8_SA(b, h) (((b) * 2 + (h)) * HTB)
#define PG8_SB(b, h) ((4 + (b) * 2 + (h)) * HTB)
#define PG8_STAGE(bufoff, gbase, voff) do { _Pragma("unroll") for (int _i = 0; _i < 2; ++_i) \
        __builtin_amdgcn_global_load_lds((const unsigned*)((const char*)(gbase) + (voff)[_i]), (PG8_LAS unsigned*)(lds + (bufoff) + ldsw + _i * 8192), 16, 0, 0); } while (0)
#define PG8_LDA(dst, b, h) do { _Pragma("unroll") for (int m = 0; m < 4; ++m) _Pragma("unroll") for (int k = 0; k < 2; ++k) dst[m][k] = *(const PG8_LAS bf16x8*)(lds + PG8_SA(b, h) + aoff + m * 2048 + k * 1024); } while (0)
#define PG8_LDB(dst, b, h) do { _Pragma("unroll") for (int n = 0; n < 2; ++n) _Pragma("unroll") for (int k = 0; k < 2; ++k) dst[n][k] = *(const PG8_LAS bf16x8*)(lds + PG8_SB(b, h) + boff + n * 2048 + k * 1024); } while (0)
#define PG8_MMA(ai, bj, At, Bt) do { __builtin_amdgcn_s_setprio(1); _Pragma("unroll") for (int m = 0; m < 4; ++m) _Pragma("unroll") for (int n = 0; n < 2; ++n) _Pragma("unroll") for (int k = 0; k < 2; ++k) \
        acc[ai][bj][m][n] = __builtin_amdgcn_mfma_f32_16x16x32_bf16(Bt[n][k], At[m][k], acc[ai][bj][m][n], 0, 0, 0); __builtin_amdgcn_s_setprio(0); } while (0)
#define PG8_WAIT_V(n) asm volatile("s_waitcnt vmcnt(" #n ")" ::: "memory")
#define PG8_WAIT_L(n) asm volatile("s_waitcnt lgkmcnt(" #n ")" ::: "memory")
#define PG8_BAR __builtin_amdgcn_s_barrier()
#define PG8_SCHED __builtin_amdgcn_sched_barrier(0)
    Unit cur, nxt; int ui = 0;
    if (!S.next(0, cur)) return;
    f32x4 acc[2][2][4][2];
#pragma unroll
    for (int a = 0; a < 2; ++a)
#pragma unroll
        for (int b = 0; b < 2; ++b)
#pragma unroll
            for (int m = 0; m < 4; ++m)
#pragma unroll
                for (int n = 0; n < 2; ++n) acc[a][b][m][n] = (f32x4){0.f, 0.f, 0.f, 0.f};
    bf16x8 At[4][2], B0[2][2], B1[2][2];
    const char* cA = S.A(cur); const char* cB = S.B(cur);
    if constexpr (SP2) {
        PG8_STAGE(PG8_SB(0, 0), cB, voffB); PG8_STAGE(PG8_SB(0, 1), cB + hstep, voffB); PG8_STAGE(PG8_SA(0, 0), cA, voffA); PG8_STAGE(PG8_SA(0, 1), cA + hstep, voffA);
        if (wr == 1) PG8_BAR;
        PG8_WAIT_V(2); PG8_BAR;
        PG8_STAGE(PG8_SB(1, 0), cB + kstep, voffB); PG8_STAGE(PG8_SA(1, 0), cA + kstep, voffA); PG8_STAGE(PG8_SB(1, 1), cB + hstep + kstep, voffB);
        PG8_WAIT_V(6); PG8_BAR;
    } else {
        PG8_STAGE(PG8_SB(0, 0), cB, voffB); PG8_STAGE(PG8_SA(0, 0), cA, voffA); PG8_STAGE(PG8_SB(0, 1), cB + hstep, voffB); PG8_STAGE(PG8_SA(0, 1), cA + hstep, voffA);
        if (wr == 1) PG8_BAR;
        PG8_WAIT_V(4); PG8_BAR;
        PG8_STAGE(PG8_SB(1, 0), cB + kstep, voffB); PG8_STAGE(PG8_SA(1, 0), cA + kstep, voffA); PG8_STAGE(PG8_SB(1, 1), cB + hstep + kstep, voffB);
        PG8_WAIT_V(6); PG8_BAR;
    }
    for (;;) {
        const bool has_next = S.next(ui + 1, nxt);
        const char* nA = has_next ? S.A(nxt) : cA; const char* nB = has_next ? S.B(nxt) : cB;
        for (int t = 0; t < nt; t += 2) {
            const bool last = (t == nt - 2);
            const char* a1 = cA + (size_t)(t + 1) * kstep;
            const char* a2 = last ? nA : cA + (size_t)(t + 2) * kstep; const char* b2 = last ? nB : cB + (size_t)(t + 2) * kstep;
            const char* a3 = a2 + kstep; const char* b3 = b2 + kstep;
            if constexpr (SP2) {
            PG8_LDB(B0, 0, 0); PG8_LDB(B1, 0, 1); PG8_SCHED; PG8_LDA(At, 0, 0); PG8_STAGE(PG8_SA(1, 1), a1 + hstep, voffA);
            PG8_WAIT_V(8); PG8_WAIT_L(0); PG8_BAR; PG8_MMA(0, 0, At, B0); PG8_MMA(0, 1, At, B1); PG8_BAR; PG8_SCHED;
            PG8_LDA(At, 0, 1); PG8_STAGE(PG8_SB(0, 0), b2, voffB); PG8_STAGE(PG8_SB(0, 1), b2 + hstep, voffB); PG8_STAGE(PG8_SA(0, 0), a2, voffA);
            PG8_WAIT_V(8); PG8_WAIT_L(0); PG8_BAR; PG8_MMA(1, 0, At, B0); PG8_MMA(1, 1, At, B1); PG8_BAR; PG8_SCHED;
            PG8_LDB(B0, 1, 0); PG8_LDB(B1, 1, 1); PG8_SCHED; PG8_LDA(At, 1, 0); PG8_STAGE(PG8_SA(0, 1), a2 + hstep, voffA);
            PG8_WAIT_V(8); PG8_WAIT_L(0); PG8_BAR; PG8_MMA(0, 0, At, B0); PG8_MMA(0, 1, At, B1); PG8_BAR; PG8_SCHED;
            PG8_LDA(At, 1, 1); PG8_STAGE(PG8_SB(1, 0), b3, voffB); PG8_STAGE(PG8_SB(1, 1), b3 + hstep, voffB); PG8_STAGE(PG8_SA(1, 0), a3, voffA);
            PG8_WAIT_V(8); PG8_WAIT_L(0); PG8_BAR; PG8_MMA(1, 0, At, B0); PG8_MMA(1, 1, At, B1); PG8_BAR; PG8_SCHED;
            } else {
            PG8_LDB(B0, 0, 0); PG8_SCHED; PG8_LDA(At, 0, 0); PG8_STAGE(PG8_SA(1, 1), a1 + hstep, voffA);
            PG8_WAIT_L(8); PG8_BAR; PG8_WAIT_L(0); PG8_MMA(0, 0, At, B0); PG8_BAR; PG8_SCHED;
            PG8_LDB(B1, 0, 1); PG8_STAGE(PG8_SB(0, 0), b2, voffB);
            PG8_BAR; PG8_WAIT_L(0); PG8_MMA(0, 1, At, B1); PG8_BAR;
            PG8_LDA(At, 0, 1); PG8_STAGE(PG8_SA(0, 0), a2, voffA);
            PG8_BAR; PG8_WAIT_L(0); PG8_MMA(1, 0, At, B0); PG8_BAR; PG8_SCHED;
            PG8_STAGE(PG8_SB(0, 1), b2 + hstep, voffB);
            PG8_WAIT_V(6); PG8_BAR; PG8_MMA(1, 1, At, B1); PG8_BAR;
            PG8_LDB(B0, 1, 0); PG8_SCHED; PG8_LDA(At, 1, 0); PG8_STAGE(PG8_SA(0, 1), a2 + hstep, voffA);
            PG8_WAIT_L(8); PG8_BAR; PG8_WAIT_L(0); PG8_MMA(0, 0, At, B0); PG8_BAR; PG8_SCHED;
            PG8_LDB(B1, 1, 1); PG8_STAGE(PG8_SB(1, 0), b3, voffB);
            PG8_BAR; PG8_WAIT_L(0); PG8_MMA(0, 1, At, B1); PG8_BAR;
            PG8_LDA(At, 1, 1); PG8_STAGE(PG8_SA(1, 0), a3, voffA);
            PG8_BAR; PG8_WAIT_L(0); PG8_MMA(1, 0, At, B0); PG8_BAR; PG8_SCHED;
            PG8_STAGE(PG8_SB(1, 1), b3 + hstep, voffB);
            PG8_WAIT_V(6); PG8_BAR; PG8_MMA(1, 1, At, B1); PG8_BAR;
            }
        }
        if constexpr (ALIGN_EPI) { if (wr == 0) PG8_BAR; }
        E(acc, cur, wr, wc, fr, fq);
        if (!has_next) break;
        if (!S.keep(cur)) {
#pragma unroll
        for (int a = 0; a < 2; ++a)
#pragma unroll
            for (int b = 0; b < 2; ++b)
#pragma unroll
                for (int m = 0; m < 4; ++m)
#pragma unroll
                    for (int n = 0; n < 2; ++n) acc[a][b][m][n] = (f32x4){0.f, 0.f, 0.f, 0.f};
        }
        cur = nxt; cA = nA; cB = nB; ++ui;
        if constexpr (ALIGN_EPI) { if (wr == 1) PG8_BAR; }
    }
    PG8_WAIT_V(0);
    if constexpr (!ALIGN_EPI) { if (wr == 0) PG8_BAR; }
    PG8_BAR;
#undef PG8_SA
#undef PG8_SB
#undef PG8_STAGE
#undef PG8_LDA
#undef PG8_LDB
#undef PG8_MMA
#undef PG8_WAIT_V
#undef PG8_WAIT_L
#undef PG8_BAR
#undef PG8_SCHED
}
}

constexpr int D = 1024, NB = 4, SEQ = 4096, CTXL = 256;
constexpr int ML = NB * SEQ;
constexpr int MC = NB * CTXL;
constexpr int MH = ML + MC;
constexpr int INW = 5120;
constexpr int ZC_W = 1536;
constexpr int NEXP = 16384, NHEAD_P = 8, TOPK = 16;
constexpr float EPS = 1e-6f;
constexpr int NWAVES = 8, NTHREADS = 512;
constexpr int SEGT = 512, NSEG = SEQ / SEGT;
constexpr int CHT = 32;
constexpr int NSCAN_L = NB * 4 * 2 * NSEG;
constexpr int NSCAN = NSCAN_L + NB * 4 * 2;

constexpr size_t MiB = 1u << 20;
constexpr size_t WS_CTL = 0, CTL_ZERO_BYTES = 64 * 1024;
constexpr size_t WS_MOD = 1 * MiB;
constexpr size_t WS_LBT = WS_MOD + 128 * 1024;
constexpr size_t WS_ASEG = WS_LBT + 8 * 1024;
constexpr size_t WS_SU = WS_ASEG + 160 * 1024;
constexpr size_t WS_SV = WS_SU + 64 * 1024;
constexpr size_t WS_WIN = 2 * MiB;
constexpr size_t WS_WA = 12 * MiB, WS_WB = 13 * MiB, WS_WO = 14 * MiB, WS_WQ = 16 * MiB;
constexpr size_t WS_POOLW = 20 * MiB;
constexpr size_t WS_KEYS = WS_POOLW + 128 * 1024;
constexpr size_t WS_ZC = 21 * MiB;
constexpr size_t WS_Z = 24 * MiB;
constexpr size_t WS_QB = 24 * MiB;
constexpr size_t WS_EIDX = 88 * MiB;
constexpr size_t WS_GATE = 96 * MiB;
constexpr size_t WS_U8 = 112 * MiB, WS_V8 = 128 * MiB;
constexpr size_t WS_PART = 24 * MiB;
constexpr size_t WS_WGT = 104 * MiB;
constexpr size_t WS_H8 = 144 * MiB;
constexpr size_t WS_SH = 160 * MiB;
constexpr size_t WS_SSQ = 21 * MiB;
constexpr size_t WS_H = 184 * MiB;
constexpr size_t WS_YHG = 184 * MiB, WS_YPOOL = 200 * MiB;
constexpr size_t WS_USEG = 218 * MiB;
constexpr size_t WS_M = 218 * MiB;
constexpr size_t WS_END = 252 * MiB;
static_assert(WS_Z + (size_t)ML * INW * 2 <= WS_H && WS_H + (size_t)MH * D * 2 <= WS_USEG && WS_USEG + (size_t)NSCAN * 128 * 128 * 4 <= WS_END && WS_M + (size_t)ML * D * 2 <= WS_END, "ws map");
static_assert(WS_QB + (size_t)ML * 2048 * 2 <= WS_EIDX && WS_V8 + (size_t)NEXP * D <= WS_H, "ws map 2");
constexpr size_t OUT_OLOC = 0, OUT_QSEG = 32 * MiB;
constexpr int CW_BAR = 1024;

constexpr int LDS_BYTES = 163840;
constexpr int MISC_OFF = LDS_BYTES - 256;

#define GAS __attribute__((address_space(1)))
#define LAS __attribute__((address_space(3)))
typedef unsigned short bf16;
typedef unsigned v4u __attribute__((ext_vector_type(4)));
typedef unsigned v2u __attribute__((ext_vector_type(2)));
typedef float f32x4 __attribute__((ext_vector_type(4)));
typedef float f32x2 __attribute__((ext_vector_type(2)));
typedef short bf16x8 __attribute__((ext_vector_type(8)));
typedef short s16x4 __attribute__((ext_vector_type(4)));
#define LDS_WAIT() asm volatile("s_waitcnt lgkmcnt(0)" ::: "memory")
#define VM_WAIT() asm volatile("s_waitcnt vmcnt(0)" ::: "memory")
#define LBAR() do { asm volatile("s_waitcnt lgkmcnt(0)" ::: "memory"); __builtin_amdgcn_s_barrier(); asm volatile("" ::: "memory"); } while (0)
__device__ __forceinline__ unsigned f2bf(float f) { unsigned u = __builtin_bit_cast(unsigned, f); return (u + 0x7fffu + ((u >> 16) & 1u)) >> 16; }
__device__ __forceinline__ unsigned pk2(float lo, float hi) { return pg8::cvt_pk_bf16(lo, hi); }
__device__ __forceinline__ float bflo(unsigned w) { return __builtin_bit_cast(float, w << 16); }
__device__ __forceinline__ float bfhi(unsigned w) { return __builtin_bit_cast(float, w & 0xffff0000u); }
__device__ __forceinline__ float fast_exp(float x) { return __builtin_amdgcn_exp2f(x * 1.4426950408889634f); }
__device__ __forceinline__ float fast_rcp(float x) { return __builtin_amdgcn_rcpf(x); }
__device__ __forceinline__ float sigmoidf_(float x) { x = fminf(fmaxf(x, -30.f), 30.f); return fast_rcp(1.f + fast_exp(-x)); }
__device__ __forceinline__ float wave_sum(float v) {
#pragma unroll
    for (int o = 1; o < 64; o <<= 1) v += __shfl_xor(v, o);
    return v;
}
__device__ __forceinline__ float wave_max(float v) {
#pragma unroll
    for (int o = 1; o < 64; o <<= 1) v = fmaxf(v, __shfl_xor(v, o));
    return v;
}

#define XB_TMO      128
#define XB_XCNT(j)  (256  + 64 * (j))
#define XB_XSUB(j)  (1280 + 64 * (j))
#define XB_XGEN(j)  (2304 + 64 * (j))
#define XB_TOP      3328
#define XB_TOPGEN   3392
#define XCD_BAR_WORDS 3456
#define XB_SPIN_CAP (1u << 18)
__device__ __forceinline__ unsigned xb_ld(unsigned* p)              { return __hip_atomic_load(p, __ATOMIC_RELAXED, __HIP_MEMORY_SCOPE_AGENT); }
__device__ __forceinline__ unsigned xb_add(unsigned* p, unsigned v) { return __hip_atomic_fetch_add(p, v, __ATOMIC_RELAXED, __HIP_MEMORY_SCOPE_AGENT); }
__device__ __forceinline__ unsigned xb_xcc_id() { return (unsigned)__builtin_amdgcn_s_getreg((3 << 11) | 20) & 0xFu; }
#define XB_SPIN(cond, bar) do { unsigned _sp = 0; while (cond) { __builtin_amdgcn_s_sleep(1); \
    if ((++_sp & 255u) == 0u) { if (xb_ld(&(bar)[XB_TMO])) break; if (_sp > XB_SPIN_CAP) { atomicAdd(&(bar)[XB_TMO], 1u); break; } } } } while (0)
struct XcdBarrier { unsigned* bar; unsigned x; volatile LAS unsigned* st; };
__device__ __forceinline__ XcdBarrier xcd_barrier_post(unsigned* bar, volatile LAS unsigned* st) {
    XcdBarrier b; b.bar = bar; b.x = xb_xcc_id(); b.st = st;
    if (threadIdx.x == 0) st[2] = xb_add(&bar[XB_XCNT(b.x)], 1u);
    return b;
}
__device__ __forceinline__ void xcd_barrier_complete(unsigned* bar, unsigned x, unsigned& nloc, unsigned& nx) {
    const unsigned G = gridDim.x * gridDim.y * gridDim.z;
    unsigned sum, cnt, mine, sp = 0u;
    for (;;) {
        sum = 0u; cnt = 0u; mine = 0u;
#pragma unroll
        for (unsigned j = 0; j < 16; ++j) { const unsigned c = xb_ld(&bar[XB_XCNT(j)]); sum += c; cnt += (c > 0u) ? 1u : 0u; mine = (j == x) ? c : mine; }
        if (sum == G) break;
        __builtin_amdgcn_s_sleep(1);
        if ((++sp & 255u) == 0u) { if (xb_ld(&bar[XB_TMO])) break; if (sp > XB_SPIN_CAP) { atomicAdd(&bar[XB_TMO], 1u); break; } }
    }
    nloc = mine > 0u ? mine : 1u; nx = cnt > 0u ? cnt : 1u;
}
__device__ __forceinline__ void xcd_barrier(const XcdBarrier& b) {
    asm volatile("s_waitcnt vmcnt(0)" ::: "memory");
    __syncthreads();
    if (threadIdx.x == 0) {
        unsigned* bar = b.bar;
        __builtin_amdgcn_s_waitcnt(0);
        unsigned nloc = b.st[0], nx = b.st[1];
        if (nloc == 0u) { xcd_barrier_complete(bar, b.x, nloc, nx); b.st[0] = nloc; b.st[1] = nx; }
        const unsigned old = xb_add(&bar[XB_XSUB(b.x)], 1u);
        const unsigned gen = old / nloc;
        if (old + 1u == (gen + 1u) * nloc) {
            __builtin_amdgcn_fence(__ATOMIC_RELEASE, "agent");
            asm volatile("s_waitcnt vmcnt(0)" ::: "memory");
            const unsigned og = xb_add(&bar[XB_TOP], 1u);
            const unsigned tg = og / nx;
            if (og + 1u == (tg + 1u) * nx) xb_add(&bar[XB_TOPGEN], 1u);
            else XB_SPIN(xb_ld(&bar[XB_TOPGEN]) == tg, bar);
            __builtin_amdgcn_fence(__ATOMIC_ACQUIRE, "agent");
            xb_add(&bar[XB_XGEN(b.x)], 1u);
            asm volatile("s_waitcnt vmcnt(0)" ::: "memory");
        } else {
            XB_SPIN(xb_ld(&bar[XB_XGEN(b.x)]) == gen, bar);
            __builtin_amdgcn_fence(__ATOMIC_ACQUIRE, "agent");
            asm volatile("s_waitcnt vmcnt(0)" ::: "memory");
        }
    }
    __syncthreads();
}

struct Args { const float* in[21]; float* out; unsigned char* ws; int ph_lo, ph_hi; };

struct Frame {
    LAS unsigned char* lds; int tid, lane, wave, G, bid;
    const float *x, *c, *ctx, *c_ctx, *w_mod, *b_mod, *n1g, *n2g, *w_in, *pool_w, *pool_scale, *lb_logits, *hg_norm_g, *w_a, *w_b, *w_o, *wq, *keys, *pu, *pv, *final_g;
    float* out; unsigned char* ws;
};

__device__ __forceinline__ void p0_transpose_item(const float* W, int K, int N, bf16* WT, LAS float* scr, int item, int lane) {
    const int nblk = N / 32, kb = item / nblk, nb = item % nblk, k0 = 64 * kb, n0 = 32 * nb;
#pragma unroll 8
    for (int i = 0; i < 32; ++i) { const int kk = 2 * i + (lane >> 5); scr[kk * 33 + (lane & 31)] = W[(size_t)(k0 + kk) * N + n0 + (lane & 31)]; }
    LDS_WAIT(); asm volatile("" ::: "memory");
    const int c = lane & 7;
#pragma unroll
    for (int j = 0; j < 4; ++j) { const int n = (lane >> 3) + 8 * j; const LAS float* s = scr + (8 * c) * 33 + n;
        v4u o; o.x = pk2(s[0 * 33], s[1 * 33]); o.y = pk2(s[2 * 33], s[3 * 33]); o.z = pk2(s[4 * 33], s[5 * 33]); o.w = pk2(s[6 * 33], s[7 * 33]);
        *(GAS v4u*)(WT + (size_t)(n0 + n) * K + k0 + 8 * c) = o; }
    LDS_WAIT(); asm volatile("" ::: "memory");
}

__device__ __forceinline__ void p0_prologue(Frame& F) {
    float* mod = (float*)(F.ws + WS_MOD);
    if (F.bid < 192) {
        LAS float* sl = (LAS float*)(F.lds + 81920);
        LAS float* red = (LAS float*)(F.lds + 81920 + 20480);
        for (int i = F.tid; i < 5 * 1024; i += NTHREADS) { const float cv = (i < 4096) ? F.c[i] : F.c_ctx[i - 4096]; sl[i] = cv * sigmoidf_(cv); }
        __syncthreads();
        const int col = F.tid & 31, kg = F.tid >> 5, col0 = 32 * F.bid;
        float a0 = 0.f, a1 = 0.f, a2 = 0.f, a3 = 0.f, a4 = 0.f;
        const float* wp = F.w_mod + (size_t)(kg * 64) * 6144 + col0 + col;
#pragma unroll 8
        for (int r = 0; r < 64; ++r) { const float w = wp[(size_t)r * 6144]; const int k = kg * 64 + r;
            a0 += w * sl[k]; a1 += w * sl[1024 + k]; a2 += w * sl[2048 + k]; a3 += w * sl[3072 + k]; a4 += w * sl[4096 + k]; }
        red[(kg * 5 + 0) * 32 + col] = a0; red[(kg * 5 + 1) * 32 + col] = a1; red[(kg * 5 + 2) * 32 + col] = a2; red[(kg * 5 + 3) * 32 + col] = a3; red[(kg * 5 + 4) * 32 + col] = a4;
        __syncthreads();
        if (F.tid < 160) { const int v = F.tid >> 5, cc = F.tid & 31; float s = 0.f;
#pragma unroll
            for (int g = 0; g < 16; ++g) s += red[(g * 5 + v) * 32 + cc];
            mod[v * 6144 + col0 + cc] = s + F.b_mod[col0 + cc]; }
        __syncthreads();
    }
    LAS float* scr = (LAS float*)(F.lds + F.wave * 8448);
    const int gw = F.bid * NWAVES + F.wave, NGW = F.G * NWAVES;
    constexpr int I_IN = (D / 64) * (INW / 32), I_A = (512 / 64) * (D / 32), I_O = (D / 64) * (D / 32), I_Q = (D / 64) * (2048 / 32), I_P = (128 / 64) * (128 / 32);
    constexpr int NITEMS = I_IN + 2 * I_A + I_O + I_Q + 4 * I_P;
    for (int it = gw; it < NITEMS; it += NGW) {
        int r = it;
        if (r < I_IN) { p0_transpose_item(F.w_in, D, INW, (bf16*)(F.ws + WS_WIN), scr, r, F.lane); continue; } r -= I_IN;
        if (r < I_A) { p0_transpose_item(F.w_a, 512, D, (bf16*)(F.ws + WS_WA), scr, r, F.lane); continue; } r -= I_A;
        if (r < I_A) { p0_transpose_item(F.w_b, 512, D, (bf16*)(F.ws + WS_WB), scr, r, F.lane); continue; } r -= I_A;
        if (r < I_O) { p0_transpose_item(F.w_o, D, D, (bf16*)(F.ws + WS_WO), scr, r, F.lane); continue; } r -= I_O;
        if (r < I_Q) { p0_transpose_item(F.wq, D, 2048, (bf16*)(F.ws + WS_WQ), scr, r, F.lane); continue; } r -= I_Q;
        { const int g = r / I_P; p0_transpose_item(F.pool_w + (size_t)g * 128 * 128, 128, 128, (bf16*)(F.ws + WS_POOLW) + (size_t)g * 128 * 128, scr, r % I_P, F.lane); }
    }
    { bf16* kb = (bf16*)(F.ws + WS_KEYS); const int gt = F.bid * NTHREADS + F.tid, NT = F.G * NTHREADS;
      for (int i = gt; i < 16 * 128 * 128 / 4; i += NT) { const f32x4 v = ((const GAS f32x4*)F.keys)[i]; v2u o; o.x = pk2(v.x, v.y); o.y = pk2(v.z, v.w); ((GAS v2u*)kb)[i] = o; }
      float* lbt = (float*)(F.ws + WS_LBT);
      if (gt < 1024) { const int dir = gt >> 9, cc = gt & 511; const float l0 = F.lb_logits[(dir * 2 + 0) * 512 + cc], l1 = F.lb_logits[(dir * 2 + 1) * 512 + cc];
          lbt[gt] = 1.f / (1.f + expf(l1 - l0)); } }
}

__device__ __forceinline__ void modulate_row(const float* xrow, bf16* orow, const float* g, const float* shift, const float* scale, int lane) {
    const GAS f32x4* xr = (const GAS f32x4*)xrow + lane;
    f32x4 v[4]; float s2 = 0.f;
#pragma unroll
    for (int j = 0; j < 4; ++j) { v[j] = xr[64 * j]; s2 += (v[j].x * v[j].x + v[j].y * v[j].y) + (v[j].z * v[j].z + v[j].w * v[j].w); }
    const float rstd = 1.f / sqrtf(wave_sum(s2) * (1.f / D) + EPS);
    GAS v2u* o8 = (GAS v2u*)orow + lane;
#pragma unroll
    for (int j = 0; j < 4; ++j) {
        const f32x4 gg = ((const GAS f32x4*)g)[lane + 64 * j], sh = ((const GAS f32x4*)shift)[lane + 64 * j], sc = ((const GAS f32x4*)scale)[lane + 64 * j];
        const f32x4 y = (v[j] * rstd) * gg * (sc + 1.0f) + sh;
        v2u o; o.x = pk2(y.x, y.y); o.y = pk2(y.z, y.w); o8[64 * j] = o; }
}
__device__ __forceinline__ void p1_modulate(Frame& F) {
    const float* mod = (const float*)(F.ws + WS_MOD); bf16* H = (bf16*)(F.ws + WS_H);
    const int gw = F.bid * NWAVES + F.wave, NGW = F.G * NWAVES;
    for (int m = gw; m < MH; m += NGW) {
        const int v = (m < ML) ? (m >> 12) : 4;
        const float* xr = (m < ML) ? F.x + (size_t)m * D : F.ctx + (size_t)(m - ML) * D;
        modulate_row(xr, H + (size_t)m * D, F.n1g, mod + v * 6144 + 0, mod + v * 6144 + 1024, F.lane);
    }
}

using pg8::Unit;
struct SchedPlain {
    const char* Ab; const char* Bb; int nM, nN, K, G, c;
    __device__ __forceinline__ bool next(int i, Unit& u) const { const int L = i * G + c; if (L >= nM * nN) return false; pg8::tile_of(L, nM, nN, u.pm, u.pn); u.seg = 0; return true; }
    __device__ __forceinline__ const char* A(const Unit& u) const { return Ab + (size_t)u.pm * 256 * K * 2; }
    __device__ __forceinline__ const char* B(const Unit& u) const { return Bb + (size_t)u.pn * 256 * K * 2; }
    __device__ __forceinline__ bool keep(const Unit&) const { return false; }
};
struct SchedIn {
    const char* Ab; const char* Bb; int G, c;
    __device__ __forceinline__ bool next(int i, Unit& u) const { const int L = i * G + c; u.seg = 0;
        if (L < 1280) { pg8::tile_of(L, 64, 20, u.pm, u.pn); return true; }
        if (L < 1304) { const int l = L - 1280; u.pm = 64 + (l & 3); u.pn = 4 + (l >> 2); return true; }
        return false; }
    __device__ __forceinline__ const char* A(const Unit& u) const { return Ab + (size_t)u.pm * 256 * D * 2; }
    __device__ __forceinline__ const char* B(const Unit& u) const { return Bb + (size_t)u.pn * 256 * D * 2; }
    __device__ __forceinline__ bool keep(const Unit&) const { return false; }
};
struct SchedMerge {
    const char *A0, *A1, *B0, *B1; int G, c;
    __device__ __forceinline__ bool next(int i, Unit& u) const { const int tile = (i >> 1) * G + c; if (tile >= 256) return false; pg8::tile_of(tile, 64, 4, u.pm, u.pn); u.seg = i & 1; return true; }
    __device__ __forceinline__ const char* A(const Unit& u) const { return (u.seg ? A1 : A0) + (size_t)u.pm * 256 * 512 * 2; }
    __device__ __forceinline__ const char* B(const Unit& u) const { return (u.seg ? B1 : B0) + (size_t)u.pn * 256 * 512 * 2; }
    __device__ __forceinline__ bool keep(const Unit& u) const { return u.seg == 0; }
};

struct EpiZ {
    static constexpr bool PERM = true;
    bf16* Z; bf16* ZC;
    __device__ __forceinline__ void operator()(pg8::f32x4 (&acc)[2][2][4][2], const Unit& u, int wr, int wc, int fr, int fq) const {
        int row0 = u.pm * 256 + wr * 64 + fr, col0 = u.pn * 256 + wc * 32 + 8 * fq, ldc = INW; bf16* base = Z;
        if (u.pm >= 64) { base = ZC; row0 -= ML; col0 -= 1024; ldc = ZC_W; }
        const bool sg = u.pn >= 12;
#pragma unroll
        for (int ai = 0; ai < 2; ++ai)
#pragma unroll
            for (int m = 0; m < 4; ++m) { bf16* rowp = base + (size_t)(row0 + ai * 128 + m * 16) * ldc + col0;
#pragma unroll
                for (int bj = 0; bj < 2; ++bj) { pg8::f32x4 v0 = acc[ai][bj][m][0], v1 = acc[ai][bj][m][1];
                    if (sg) {
#pragma unroll
                        for (int j = 0; j < 4; ++j) { v0[j] = sigmoidf_(v0[j]); v1[j] = sigmoidf_(v1[j]); } }
                    v4u w; w.x = pk2(v0[0], v0[1]); w.y = pk2(v0[2], v0[3]); w.z = pk2(v1[0], v1[1]); w.w = pk2(v1[2], v1[3]);
                    *(GAS v4u*)(rowp + bj * 128) = w; } }
    }
};
struct EpiPlain {
    static constexpr bool PERM = true;
    bf16* O; int ldc;
    __device__ __forceinline__ void operator()(pg8::f32x4 (&acc)[2][2][4][2], const Unit& u, int wr, int wc, int fr, int fq) const {
        const int row0 = u.pm * 256 + wr * 64 + fr, col0 = u.pn * 256 + wc * 32 + 8 * fq;
#pragma unroll
        for (int ai = 0; ai < 2; ++ai)
#pragma unroll
            for (int m = 0; m < 4; ++m) { bf16* rowp = O + (size_t)(row0 + ai * 128 + m * 16) * ldc + col0;
#pragma unroll
                for (int bj = 0; bj < 2; ++bj) { const pg8::f32x4 v0 = acc[ai][bj][m][0], v1 = acc[ai][bj][m][1];
                    v4u w; w.x = pk2(v0[0], v0[1]); w.y = pk2(v0[2], v0[3]); w.z = pk2(v1[0], v1[1]); w.w = pk2(v1[2], v1[3]);
                    *(GAS v4u*)(rowp + bj * 128) = w; } }
    }
};
struct EpiMerge {
    static constexpr bool PERM = true;
    const bf16* Z; bf16* Mo;
    __device__ __forceinline__ void operator()(pg8::f32x4 (&acc)[2][2][4][2], const Unit& u, int wr, int wc, int fr, int fq) const {
        const int row0 = u.pm * 256 + wr * 64 + fr, col0 = u.pn * 256 + wc * 32 + 8 * fq;
#pragma unroll
        for (int ai = 0; ai < 2; ++ai)
#pragma unroll
            for (int m = 0; m < 4; ++m) { const size_t r = (size_t)(row0 + ai * 128 + m * 16);
#pragma unroll
                for (int bj = 0; bj < 2; ++bj) { const int c = col0 + bj * 128;
                    const v4u gh = *(const GAS v4u*)(Z + r * INW + 4096 + c);
                    float h[8] = {bflo(gh.x), bfhi(gh.x), bflo(gh.y), bfhi(gh.y), bflo(gh.z), bfhi(gh.z), bflo(gh.w), bfhi(gh.w)};
                    if (u.seg == 0) {
                        const v4u gp = *(const GAS v4u*)(Z + r * INW + 3072 + c);
                        float p[8] = {bflo(gp.x), bfhi(gp.x), bflo(gp.y), bfhi(gp.y), bflo(gp.z), bfhi(gp.z), bflo(gp.w), bfhi(gp.w)};
#pragma unroll
                        for (int j = 0; j < 4; ++j) { acc[ai][bj][m][0][j] *= p[j] * fast_rcp(h[j]); acc[ai][bj][m][1][j] *= p[4 + j] * fast_rcp(h[4 + j]); }
                    } else {
                        pg8::f32x4 v0 = acc[ai][bj][m][0], v1 = acc[ai][bj][m][1];
#pragma unroll
                        for (int j = 0; j < 4; ++j) { v0[j] *= h[j]; v1[j] *= h[4 + j]; }
                        v4u w; w.x = pk2(v0[0], v0[1]); w.y = pk2(v0[2], v0[3]); w.z = pk2(v1[0], v1[1]); w.w = pk2(v1[2], v1[3]);
                        *(GAS v4u*)(Mo + r * D + c) = w; } } }
    }
};
struct EpiRes {
    static constexpr bool PERM = false;
    const float* X; const float* mod; float* O;
    __device__ __forceinline__ void operator()(pg8::f32x4 (&acc)[2][2][4][2], const Unit& u, int wr, int wc, int fr, int fq) const {
        const int row0 = u.pm * 256 + wr * 64 + fr, col0 = u.pn * 256 + wc * 32 + 4 * fq;
        const float* g1 = mod + (size_t)(u.pm >> 4) * 6144 + 2048;
        pg8::f32x4 gv[2][2];
#pragma unroll
        for (int bj = 0; bj < 2; ++bj)
#pragma unroll
            for (int n = 0; n < 2; ++n) gv[bj][n] = *(const GAS pg8::f32x4*)(g1 + col0 + bj * 128 + n * 16);
#pragma unroll
        for (int ai = 0; ai < 2; ++ai)
#pragma unroll
            for (int m = 0; m < 4; ++m) { const size_t off = (size_t)(row0 + ai * 128 + m * 16) * D + col0;
#pragma unroll
                for (int bj = 0; bj < 2; ++bj)
#pragma unroll
                    for (int n = 0; n < 2; ++n) { const pg8::f32x4 xv = *(const GAS pg8::f32x4*)(X + off + bj * 128 + n * 16);
                        *(GAS pg8::f32x4*)(O + off + bj * 128 + n * 16) = xv + gv[bj][n] * acc[ai][bj][m][n]; }
                asm volatile("" ::: "memory"); }
    }
};

__device__ __forceinline__ unsigned off_b(unsigned row, unsigned ch) { return 256u * row + 16u * (ch ^ (((row & 3) << 2) | ((row >> 2) & 3))); }
__device__ __forceinline__ unsigned row_addr16(unsigned lane, unsigned rb, unsigned s) { return off_b((lane & 15) + 16 * rb, 4 * s + (lane >> 4)); }
__device__ __forceinline__ unsigned tr_addr16(unsigned lane, unsigned c, unsigned t) { const unsigned g = lane >> 4, q = (lane & 15) >> 2, p = lane & 3; return off_b(8 * g + 4 * t + q, 2 * c + (p >> 1)) + 8 * (p & 1); }
__device__ __forceinline__ bf16x8 tr_frag(LAS unsigned char* tile, unsigned lane, unsigned c) {
    const s16x4 lo = __builtin_amdgcn_ds_read_tr16_b64_v4i16((LAS s16x4*)(tile + tr_addr16(lane, c, 0)));
    const s16x4 hi = __builtin_amdgcn_ds_read_tr16_b64_v4i16((LAS s16x4*)(tile + tr_addr16(lane, c, 1)));
    return __builtin_shufflevector(lo, hi, 0, 1, 2, 3, 4, 5, 6, 7);
}
#define MFMA16(a, b, c) __builtin_amdgcn_mfma_f32_16x16x32_bf16((a), (b), (c), 0, 0, 0)

constexpr int SC_QT = 0, SC_KT = 8192, SC_KD = 16384, SC_VT = 24576, SC_ATT = 32768, SC_EL = 35328, SC_WT = 35840;

__device__ __forceinline__ void scan_unit(Frame& F, int u) {
    const int tid = F.tid, lane = F.lane, w = F.wave, q = lane >> 4;
    const bool isctx = u >= NSCAN_L;
    int b, h, dir, rowbase, nch; const bf16* src; int ld, cq, ci, cf;
    if (!isctx) { const int j = u & 7; dir = (u >> 3) & 1; h = (u >> 4) & 3; b = u >> 6; const int tb = dir ? 7 - j : j;
        rowbase = b * SEQ + tb * SEGT; nch = SEGT / CHT; src = (const bf16*)(F.ws + WS_Z); ld = INW; cq = 512 + h * 128; ci = 1024 + h * 128; cf = (dir ? 2048 : 1536) + h * 128; }
    else { const int v = u - NSCAN_L; dir = v & 1; h = (v >> 1) & 3; b = v >> 3;
        rowbase = b * CTXL; nch = CTXL / CHT; src = (const bf16*)(F.ws + WS_ZC); ld = ZC_W; ci = h * 128; cq = ci; cf = (dir ? 1024 : 512) + h * 128; }
    const int t = tid >> 4, k8 = tid & 15;
    const int pl = dir ? 3 - q : q;
    const float* lbt = (const float*)(F.ws + WS_LBT) + dir * 512 + h * 128 + 8 * k8;
    float lb[8], ecum[8];
#pragma unroll
    for (int i = 0; i < 8; ++i) { lb[i] = lbt[i]; ecum[i] = 1.f; }
    f32x4 S[8];
#pragma unroll
    for (int i = 0; i < 8; ++i) S[i] = (f32x4){0.f, 0.f, 0.f, 0.f};
    LAS unsigned char* L = F.lds;
    bf16* qseg = (bf16*)((unsigned char*)F.out + OUT_QSEG) + (size_t)dir * ML * 512;
    bf16* oloc = (bf16*)((unsigned char*)F.out + OUT_OLOC);
    v4u qv, vv, fv;
    { const int tc = dir ? nch - 1 : 0; const bf16* rp = src + (size_t)(rowbase + tc * CHT + t) * ld + 8 * k8;
      qv = *(const GAS v4u*)(rp + cq); vv = *(const GAS v4u*)(rp + ci); fv = *(const GAS v4u*)(rp + cf); }
    for (int pc = 0; pc < nch; ++pc) {
        const int tc = dir ? nch - 1 - pc : pc;
        const v4u q0 = qv, v0 = vv, f0 = fv;
        if (pc + 1 < nch) { const int tn = dir ? tc - 1 : tc + 1; const bf16* rp = src + (size_t)(rowbase + tn * CHT + t) * ld + 8 * k8;
            qv = *(const GAS v4u*)(rp + cq); vv = *(const GAS v4u*)(rp + ci); fv = *(const GAS v4u*)(rp + cf); }
        float fr_[8] = {bflo(f0.x), bfhi(f0.x), bflo(f0.y), bfhi(f0.y), bflo(f0.z), bfhi(f0.z), bflo(f0.w), bfhi(f0.w)};
        float e[8], kk[8];
#pragma unroll
        for (int i = 0; i < 8; ++i) { const float s = sigmoidf_(fr_[i]); const float om = 1.f - lb[i]; e[i] = lb[i] + om * s; kk[i] = om * (1.f - s); }
        { const int s1 = dir ? lane + 16 : lane - 16, s2 = dir ? lane + 32 : lane - 32;
#pragma unroll
          for (int i = 0; i < 8; ++i) { const float o = __shfl(e[i], s1 & 63); e[i] = (pl >= 1) ? e[i] * o : e[i]; }
#pragma unroll
          for (int i = 0; i < 8; ++i) { const float o = __shfl(e[i], s2 & 63); e[i] = (pl >= 2) ? e[i] * o : e[i]; } }
        if (pl == 3) { LAS f32x4* wt = (LAS f32x4*)(L + SC_WT + (w * 128 + 8 * k8) * 4); wt[0] = (f32x4){e[0], e[1], e[2], e[3]}; wt[1] = (f32x4){e[4], e[5], e[6], e[7]}; }
        LBAR();
        float etot[8];
        { float pre[8];
#pragma unroll
          for (int i = 0; i < 8; ++i) { pre[i] = 1.f; etot[i] = 1.f; }
#pragma unroll
          for (int ww = 0; ww < 8; ++ww) { const LAS f32x4* wt = (const LAS f32x4*)(L + SC_WT + (ww * 128 + 8 * k8) * 4); const f32x4 a = wt[0], c = wt[1];
              const float x[8] = {a.x, a.y, a.z, a.w, c.x, c.y, c.z, c.w};
              const bool before = dir ? (ww > w) : (ww < w);
#pragma unroll
              for (int i = 0; i < 8; ++i) { etot[i] *= x[i]; pre[i] = before ? pre[i] * x[i] : pre[i]; } }
#pragma unroll
          for (int i = 0; i < 8; ++i) e[i] *= pre[i]; }
        {
            const float qf[8] = {bflo(q0.x), bfhi(q0.x), bflo(q0.y), bfhi(q0.y), bflo(q0.z), bfhi(q0.z), bflo(q0.w), bfhi(q0.w)};
            float qt[8], kt[8], kd[8];
#pragma unroll
            for (int i = 0; i < 8; ++i) { qt[i] = qf[i] * e[i]; kt[i] = kk[i] * fast_rcp(e[i]); kd[i] = kt[i] * etot[i]; }
            const unsigned ob = off_b((unsigned)t, (unsigned)k8);
            v4u o; o.x = pk2(qt[0], qt[1]); o.y = pk2(qt[2], qt[3]); o.z = pk2(qt[4], qt[5]); o.w = pk2(qt[6], qt[7]); *(LAS v4u*)(L + SC_QT + ob) = o;
            o.x = pk2(kt[0], kt[1]); o.y = pk2(kt[2], kt[3]); o.z = pk2(kt[4], kt[5]); o.w = pk2(kt[6], kt[7]); *(LAS v4u*)(L + SC_KT + ob) = o;
            o.x = pk2(kd[0], kd[1]); o.y = pk2(kd[2], kd[3]); o.z = pk2(kd[4], kd[5]); o.w = pk2(kd[6], kd[7]); *(LAS v4u*)(L + SC_KD + ob) = o;
            *(LAS v4u*)(L + SC_VT + ob) = v0;
            if (!isctx) { o.x = pk2(qt[0] * ecum[0], qt[1] * ecum[1]); o.y = pk2(qt[2] * ecum[2], qt[3] * ecum[3]); o.z = pk2(qt[4] * ecum[4], qt[5] * ecum[5]); o.w = pk2(qt[6] * ecum[6], qt[7] * ecum[7]);
                *(GAS v4u*)(qseg + (size_t)(rowbase + tc * CHT + t) * 512 + h * 128 + 8 * k8) = o; }
            if (t == 0) { LAS f32x4* el = (LAS f32x4*)(L + SC_EL + 32 * k8); el[0] = (f32x4){etot[0], etot[1], etot[2], etot[3]}; el[1] = (f32x4){etot[4], etot[5], etot[6], etot[7]}; }
#pragma unroll
            for (int i = 0; i < 8; ++i) ecum[i] *= etot[i];
        }
        LBAR();
        if (w < 4 && !isctx) {
            const int tt = dir ? (w >> 1) : ((w + 1) >> 1), st = dir ? ((w + 1) >> 1) : (w >> 1);
            const int tz = dir ? 1 : 0, sz = dir ? 0 : 1;
            f32x4 a = (f32x4){0.f, 0.f, 0.f, 0.f};
            if (w < 3) {
#pragma unroll
                for (int s = 0; s < 4; ++s) { const bf16x8 A = *(const LAS bf16x8*)(L + SC_QT + row_addr16(lane, tt, s)); const bf16x8 B = *(const LAS bf16x8*)(L + SC_KT + row_addr16(lane, st, s)); a = MFMA16(A, B, a); }
            }
            const int tr = (w < 3 ? tt : tz) * 16 + 4 * q, sc = (w < 3 ? st : sz) * 16 + (lane & 15);
#pragma unroll
            for (int j = 0; j < 4; ++j) { const int ti = tr + j; const bool ok = (w < 3) && (dir ? (sc >= ti) : (sc <= ti));
                *(LAS unsigned short*)(L + SC_ATT + ti * 80 + sc * 2) = (unsigned short)f2bf(ok ? a[j] : 0.f); }
        }
        LBAR();
        {
            const bf16x8 Bv = tr_frag(L + SC_VT, lane, w);
            if (!isctx) {
#pragma unroll 1
                for (int tt = 0; tt < 2; ++tt) {
                    f32x4 o = (f32x4){0.f, 0.f, 0.f, 0.f};
                    const unsigned row = 16 * tt + (lane & 15);
#pragma unroll
                    for (int s = 0; s < 4; ++s) {
                        const v2u alo = *(const LAS v2u*)(L + SC_QT + off_b(row, 4 * s + (q >> 1)) + 8 * (q & 1));
                        const v2u ahi = *(const LAS v2u*)(L + SC_QT + off_b(row, 4 * s + 2 + (q >> 1)) + 8 * (q & 1));
                        const v4u av = (v4u){alo.x, alo.y, ahi.x, ahi.y};
                        v4u bv; bv.x = pk2(S[2 * s][0], S[2 * s][1]); bv.y = pk2(S[2 * s][2], S[2 * s][3]); bv.z = pk2(S[2 * s + 1][0], S[2 * s + 1][1]); bv.w = pk2(S[2 * s + 1][2], S[2 * s + 1][3]);
                        o = MFMA16(__builtin_bit_cast(bf16x8, av), __builtin_bit_cast(bf16x8, bv), o);
                    }
                    const bf16x8 At = *(const LAS bf16x8*)(L + SC_ATT + row * 80 + 16 * q);
                    o = MFMA16(At, Bv, o);
                    const int ttg = (rowbase + tc * CHT + 16 * tt) >> 4;
                    v2u ov; ov.x = pk2(o[0], o[1]); ov.y = pk2(o[2], o[3]);
                    *(GAS v2u*)(oloc + ((((size_t)(dir * 1024 + ttg) * 4 + h) * 8 + w) * 64 + lane) * 4) = ov;
                }
            }
#pragma unroll
            for (int kt = 0; kt < 8; ++kt) {
                const bf16x8 A = tr_frag(L + SC_KD, lane, kt);
                const f32x4 a4 = *(const LAS f32x4*)(L + SC_EL + (16 * kt + 4 * q) * 4);
                S[kt] = MFMA16(A, Bv, S[kt] * a4);
            }
        }
    }
    { float* us = (float*)(F.ws + WS_USEG) + (size_t)u * 128 * 128 + (4 * q) * 128 + 16 * w + (lane & 15);
#pragma unroll
      for (int kt = 0; kt < 8; ++kt) {
#pragma unroll
          for (int j = 0; j < 4; ++j) us[j * 128] = S[kt][j];
          us += 16 * 128; asm volatile("" : "+v"(us)); }
      if (t == 0) { float* as = (float*)(F.ws + WS_ASEG) + (size_t)u * 128 + 8 * k8;
#pragma unroll
          for (int i = 0; i < 8; ++i) as[i] = ecum[i]; } }
    __syncthreads();
}

constexpr int PL_V = 0, PL_VSTR = 132, PL_D = 34816, PL_DSTR = 272;
__device__ __forceinline__ void pool_unit(Frame& F, int u) {
    const int b = u >> 6, r = u & 63, tid = F.tid, lane = F.lane, w = F.wave, q = lane >> 4;
    const int c = tid >> 3, ch16 = tid & 7;
    const bf16* Z = (const bf16*)(F.ws + WS_Z); bf16* YP = (bf16*)(F.ws + WS_YPOOL);
    LAS unsigned char* L = F.lds;
#pragma unroll 1
    for (int g = 0; g < 4; ++g) {
        const int half = 1 << g;
        const int r_lo = max(0, r - half), r_hi = min(63, r + half - 1), c_lo = max(0, c - half), c_hi = min(63, c + half - 1);
        float vs[16], pc[16];
#pragma unroll
        for (int i = 0; i < 16; ++i) { vs[i] = 0.f; pc[i] = 0.f; }
        for (int rr = r_lo; rr <= r_hi; ++rr) {
            const bf16* p = Z + (size_t)(b * SEQ + rr * 64 + c) * INW + g * 128 + 16 * ch16;
            const v4u a = *(const GAS v4u*)p, d = *(const GAS v4u*)(p + 8);
            const float x[16] = {bflo(a.x), bfhi(a.x), bflo(a.y), bfhi(a.y), bflo(a.z), bfhi(a.z), bflo(a.w), bfhi(a.w), bflo(d.x), bfhi(d.x), bflo(d.y), bfhi(d.y), bflo(d.z), bfhi(d.z), bflo(d.w), bfhi(d.w)};
#pragma unroll
            for (int i = 0; i < 16; ++i) { vs[i] += x[i]; pc[i] = (rr == r) ? x[i] : pc[i]; }
        }
        { LAS f32x4* vp = (LAS f32x4*)(L + PL_V + (c * PL_VSTR + 16 * ch16) * 4);
#pragma unroll
          for (int i = 0; i < 4; ++i) vp[i] = (f32x4){vs[4 * i], vs[4 * i + 1], vs[4 * i + 2], vs[4 * i + 3]}; }
        LBAR();
        float hs[16];
#pragma unroll
        for (int i = 0; i < 16; ++i) hs[i] = 0.f;
        for (int cc = c_lo; cc <= c_hi; ++cc) { const LAS f32x4* vp = (const LAS f32x4*)(L + PL_V + (cc * PL_VSTR + 16 * ch16) * 4);
#pragma unroll
            for (int i = 0; i < 4; ++i) { const f32x4 x = vp[i]; hs[4 * i] += x.x; hs[4 * i + 1] += x.y; hs[4 * i + 2] += x.z; hs[4 * i + 3] += x.w; } }
        { const float inv = 1.f / (float)((r_hi - r_lo + 1) * (c_hi - c_lo + 1));
          v4u o0, o1;
          o0.x = pk2(hs[0] * inv - pc[0], hs[1] * inv - pc[1]); o0.y = pk2(hs[2] * inv - pc[2], hs[3] * inv - pc[3]); o0.z = pk2(hs[4] * inv - pc[4], hs[5] * inv - pc[5]); o0.w = pk2(hs[6] * inv - pc[6], hs[7] * inv - pc[7]);
          o1.x = pk2(hs[8] * inv - pc[8], hs[9] * inv - pc[9]); o1.y = pk2(hs[10] * inv - pc[10], hs[11] * inv - pc[11]); o1.z = pk2(hs[12] * inv - pc[12], hs[13] * inv - pc[13]); o1.w = pk2(hs[14] * inv - pc[14], hs[15] * inv - pc[15]);
          LAS v4u* dp = (LAS v4u*)(L + PL_D + c * PL_DSTR + 32 * ch16); dp[0] = o0; dp[1] = o1; }
        LBAR();
        { const int tt = w >> 1; const bf16* wt = (const bf16*)(F.ws + WS_POOLW) + (size_t)g * 128 * 128;
          bf16x8 Bd[4];
#pragma unroll
          for (int s = 0; s < 4; ++s) Bd[s] = *(const LAS bf16x8*)(L + PL_D + (16 * tt + (lane & 15)) * PL_DSTR + (32 * s + 8 * q) * 2);
#pragma unroll
          for (int ni = 0; ni < 4; ++ni) { const int nt = 4 * (w & 1) + ni; f32x4 a = (f32x4){0.f, 0.f, 0.f, 0.f};
#pragma unroll
              for (int s = 0; s < 4; ++s) { const bf16x8 A = *(const GAS bf16x8*)(wt + (size_t)(16 * nt + (lane & 15)) * 128 + 32 * s + 8 * q); a = MFMA16(A, Bd[s], a); }
              const f32x4 sc = *(const GAS f32x4*)(F.pool_scale + g * 128 + 16 * nt + 4 * q);
              v2u o; o.x = pk2(a[0] * sc.x, a[1] * sc.y); o.y = pk2(a[2] * sc.z, a[3] * sc.w);
              *(GAS v2u*)(YP + (size_t)(b * SEQ + r * 64 + 16 * tt + (lane & 15)) * 512 + g * 128 + 16 * nt + 4 * q) = o; } }
    }
    __syncthreads();
}

constexpr int FX_SF = 0, FX_SB = 32768, FX_SCR = 65536, FX_SCRSTR = 132;
__device__ __forceinline__ void fix_fold(Frame& F, int b, int h, int dir, int nfold, int soff) {
    const int tid = F.tid, kr = tid >> 4, ch = tid & 15;
    const float* US = (const float*)(F.ws + WS_USEG); const float* AS = (const float*)(F.ws + WS_ASEG);
    float s[4][8];
    { const int uc = NSCAN_L + (b * 4 + h) * 2 + dir;
#pragma unroll
      for (int rr = 0; rr < 4; ++rr) { const float* p = US + ((size_t)uc * 128 + kr + 32 * rr) * 128 + 8 * ch; const f32x4 a = *(const GAS f32x4*)p, c = *(const GAS f32x4*)(p + 4);
          s[rr][0] = a.x; s[rr][1] = a.y; s[rr][2] = a.z; s[rr][3] = a.w; s[rr][4] = c.x; s[rr][5] = c.y; s[rr][6] = c.z; s[rr][7] = c.w; } }
    for (int j = 0; j < nfold; ++j) { const int u = ((b * 4 + h) * 2 + dir) * 8 + j;
#pragma unroll
        for (int rr = 0; rr < 4; ++rr) { const int k = kr + 32 * rr; const float* p = US + ((size_t)u * 128 + k) * 128 + 8 * ch; const f32x4 a = *(const GAS f32x4*)p, c = *(const GAS f32x4*)(p + 4);
            const float al = AS[u * 128 + k];
            s[rr][0] = al * s[rr][0] + a.x; s[rr][1] = al * s[rr][1] + a.y; s[rr][2] = al * s[rr][2] + a.z; s[rr][3] = al * s[rr][3] + a.w;
            s[rr][4] = al * s[rr][4] + c.x; s[rr][5] = al * s[rr][5] + c.y; s[rr][6] = al * s[rr][6] + c.z; s[rr][7] = al * s[rr][7] + c.w; } }
#pragma unroll
    for (int rr = 0; rr < 4; ++rr) { v4u o; o.x = pk2(s[rr][0], s[rr][1]); o.y = pk2(s[rr][2], s[rr][3]); o.z = pk2(s[rr][4], s[rr][5]); o.w = pk2(s[rr][6], s[rr][7]);
        *(LAS v4u*)(F.lds + soff + rr * 8192 + off_b((unsigned)kr, (unsigned)ch)) = o; }
}
__device__ __forceinline__ void fix_unit(Frame& F, int u) {
    const int tb = u & 7, h = (u >> 3) & 3, b = u >> 5, lane = F.lane, w = F.wave, q = lane >> 4;
    LAS unsigned char* L = F.lds;
    fix_fold(F, b, h, 0, tb, FX_SF);
    fix_fold(F, b, h, 1, 7 - tb, FX_SB);
    __syncthreads();
    const bf16* Z = (const bf16*)(F.ws + WS_Z); bf16* YH = (bf16*)(F.ws + WS_YHG);
    const bf16* qseg = (const bf16*)((const unsigned char*)F.out + OUT_QSEG); const bf16* oloc = (const bf16*)((const unsigned char*)F.out + OUT_OLOC);
    LAS float* scr = (LAS float*)(L + FX_SCR + w * (16 * FX_SCRSTR * 4));
    const int row0 = b * SEQ + tb * SEGT;
#pragma unroll 1
    for (int ti = 0; ti < 4; ++ti) {
        const int tt = 4 * w + ti, rowt = row0 + 16 * tt;
        f32x4 acc[8];
#pragma unroll
        for (int c = 0; c < 8; ++c) acc[c] = (f32x4){0.f, 0.f, 0.f, 0.f};
#pragma unroll
        for (int dir = 0; dir < 2; ++dir) {
            bf16x8 A[4];
#pragma unroll
            for (int s = 0; s < 4; ++s) A[s] = *(const GAS bf16x8*)(qseg + ((size_t)dir * ML + rowt + (lane & 15)) * 512 + h * 128 + 32 * s + 8 * q);
#pragma unroll
            for (int s = 0; s < 4; ++s)
#pragma unroll
                for (int c = 0; c < 8; ++c) { const bf16x8 B = tr_frag(L + (dir ? FX_SB : FX_SF) + s * 8192, lane, c); acc[c] = MFMA16(A[s], B, acc[c]); }
#pragma unroll
            for (int c = 0; c < 8; ++c) { const v2u ov = *(const GAS v2u*)(oloc + ((((size_t)(dir * 1024 + (rowt >> 4)) * 4 + h) * 8 + c) * 64 + lane) * 4);
                acc[c][0] += bflo(ov.x); acc[c][1] += bfhi(ov.x); acc[c][2] += bflo(ov.y); acc[c][3] += bfhi(ov.y); }
        }
        float ss[4];
#pragma unroll
        for (int j = 0; j < 4; ++j) { float s = 0.f;
#pragma unroll
            for (int c = 0; c < 8; ++c) s += acc[c][j] * acc[c][j];
            s += __shfl_xor(s, 1); s += __shfl_xor(s, 2); s += __shfl_xor(s, 4); s += __shfl_xor(s, 8);
            ss[j] = 1.f / sqrtf(s * (1.f / 128.f) + EPS); }
#pragma unroll
        for (int c = 0; c < 8; ++c)
#pragma unroll
            for (int j = 0; j < 4; ++j) scr[(4 * q + j) * FX_SCRSTR + 16 * c + (lane & 15)] = acc[c][j] * ss[j];
        LDS_WAIT();
        { const int tl = lane >> 2, v0 = 32 * (lane & 3); const size_t row = (size_t)(rowt + tl);
          const bf16* og = Z + row * INW + 2560 + h * 128 + v0; bf16* yo = YH + row * 512 + h * 128 + v0;
#pragma unroll
          for (int i = 0; i < 4; ++i) {
              const f32x4 a = *(const LAS f32x4*)(scr + tl * FX_SCRSTR + v0 + 8 * i), c2 = *(const LAS f32x4*)(scr + tl * FX_SCRSTR + v0 + 8 * i + 4);
              const v4u g = *(const GAS v4u*)(og + 8 * i);
              const f32x4 n0 = *(const GAS f32x4*)(F.hg_norm_g + v0 + 8 * i), n1 = *(const GAS f32x4*)(F.hg_norm_g + v0 + 8 * i + 4);
              const float gg[8] = {bflo(g.x), bfhi(g.x), bflo(g.y), bfhi(g.y), bflo(g.z), bfhi(g.z), bflo(g.w), bfhi(g.w)};
              const float yv[8] = {a.x * n0.x, a.y * n0.y, a.z * n0.z, a.w * n0.w, c2.x * n1.x, c2.y * n1.y, c2.z * n1.z, c2.w * n1.w};
              float o[8];
#pragma unroll
              for (int e = 0; e < 8; ++e) o[e] = yv[e] * gg[e] * sigmoidf_(gg[e]);
              v4u ov; ov.x = pk2(o[0], o[1]); ov.y = pk2(o[2], o[3]); ov.z = pk2(o[4], o[5]); ov.w = pk2(o[6], o[7]);
              *(GAS v4u*)(yo + 8 * i) = ov; } }
        LDS_WAIT();
    }
    __syncthreads();
}

__device__ __forceinline__ void fp8_rows(const float* src, unsigned char* dst, float* inv_scale, int gw, int NGW, int lane) {
    for (int r = gw; r < NEXP; r += NGW) {
        const GAS f32x4* p = (const GAS f32x4*)(src + (size_t)r * D + 16 * lane);
        const f32x4 a = p[0], b = p[1], c = p[2], d = p[3];
        float m = fmaxf(fmaxf(fmaxf(fabsf(a.x), fabsf(a.y)), fmaxf(fabsf(a.z), fabsf(a.w))), fmaxf(fmaxf(fabsf(b.x), fabsf(b.y)), fmaxf(fabsf(b.z), fabsf(b.w))));
        m = fmaxf(m, fmaxf(fmaxf(fmaxf(fabsf(c.x), fabsf(c.y)), fmaxf(fabsf(c.z), fabsf(c.w))), fmaxf(fmaxf(fabsf(d.x), fabsf(d.y)), fmaxf(fabsf(d.z), fabsf(d.w)))));
        m = wave_max(m);
        const float sc = (m > 0.f) ? 224.f / m : 1.f;
        v4u o; int w;
        w = __builtin_amdgcn_cvt_pk_fp8_f32(a.x * sc, a.y * sc, 0, false); w = __builtin_amdgcn_cvt_pk_fp8_f32(a.z * sc, a.w * sc, w, true); o.x = (unsigned)w;
        w = __builtin_amdgcn_cvt_pk_fp8_f32(b.x * sc, b.y * sc, 0, false); w = __builtin_amdgcn_cvt_pk_fp8_f32(b.z * sc, b.w * sc, w, true); o.y = (unsigned)w;
        w = __builtin_amdgcn_cvt_pk_fp8_f32(c.x * sc, c.y * sc, 0, false); w = __builtin_amdgcn_cvt_pk_fp8_f32(c.z * sc, c.w * sc, w, true); o.z = (unsigned)w;
        w = __builtin_amdgcn_cvt_pk_fp8_f32(d.x * sc, d.y * sc, 0, false); w = __builtin_amdgcn_cvt_pk_fp8_f32(d.z * sc, d.w * sc, w, true); o.w = (unsigned)w;
        *(GAS v4u*)(dst + (size_t)(lane >> 3) * ((size_t)NEXP * 128) + (size_t)r * 128 + 16 * (lane & 7)) = o;
        if (lane == 0) inv_scale[r] = (m > 0.f) ? m * (1.f / 224.f) : 1.f;
    }
}

__device__ __forceinline__ unsigned pack_i8x4(float a, float b, float c, float d) {
    const int ia = (int)rintf(a), ib = (int)rintf(b), ic = (int)rintf(c), id = (int)rintf(d);
    return ((unsigned)ia & 255u) | (((unsigned)ib & 255u) << 8) | (((unsigned)ic & 255u) << 16) | (((unsigned)id & 255u) << 24);
}
__device__ __forceinline__ void i8_rows(const float* src, unsigned char* dst, float* inv_scale, int gw, int NGW, int lane) {
    for (int r = gw; r < NEXP; r += NGW) {
        const GAS f32x4* p = (const GAS f32x4*)(src + (size_t)r * D + 16 * lane);
        const f32x4 a = p[0], b = p[1], c = p[2], d = p[3];
        float m = fmaxf(fmaxf(fmaxf(fabsf(a.x), fabsf(a.y)), fmaxf(fabsf(a.z), fabsf(a.w))), fmaxf(fmaxf(fabsf(b.x), fabsf(b.y)), fmaxf(fabsf(b.z), fabsf(b.w))));
        m = fmaxf(m, fmaxf(fmaxf(fmaxf(fabsf(c.x), fabsf(c.y)), fmaxf(fabsf(c.z), fabsf(c.w))), fmaxf(fmaxf(fabsf(d.x), fabsf(d.y)), fmaxf(fabsf(d.z), fabsf(d.w)))));
        m = wave_max(m);
        const float sc = (m > 0.f) ? 127.f / m : 1.f;
        v4u o; o.x = pack_i8x4(a.x * sc, a.y * sc, a.z * sc, a.w * sc); o.y = pack_i8x4(b.x * sc, b.y * sc, b.z * sc, b.w * sc);
        o.z = pack_i8x4(c.x * sc, c.y * sc, c.z * sc, c.w * sc); o.w = pack_i8x4(d.x * sc, d.y * sc, d.z * sc, d.w * sc);
        *(GAS v4u*)(dst + (size_t)(lane >> 3) * ((size_t)NEXP * 128) + (size_t)r * 128 + 16 * (lane & 7)) = o;
        if (lane == 0) inv_scale[r] = (m > 0.f) ? m * (1.f / 127.f) : 1.f;
    }
}
__device__ __forceinline__ void modulate_row_q(const float* xrow, bf16* orow, unsigned char* qrow, float* qscale, const float* g, const float* shift, const float* scale, int lane) {
    const GAS f32x4* xr = (const GAS f32x4*)xrow + lane;
    f32x4 v[4]; float s2 = 0.f;
#pragma unroll
    for (int j = 0; j < 4; ++j) { v[j] = xr[64 * j]; s2 += (v[j].x * v[j].x + v[j].y * v[j].y) + (v[j].z * v[j].z + v[j].w * v[j].w); }
    const float rstd = 1.f / sqrtf(wave_sum(s2) * (1.f / D) + EPS);
    GAS v2u* o8 = (GAS v2u*)orow + lane; float m = 0.f;
#pragma unroll
    for (int j = 0; j < 4; ++j) {
        const f32x4 gg = ((const GAS f32x4*)g)[lane + 64 * j], sh = ((const GAS f32x4*)shift)[lane + 64 * j], sc = ((const GAS f32x4*)scale)[lane + 64 * j];
        v[j] = (v[j] * rstd) * gg * (sc + 1.0f) + sh;
        v2u o; o.x = pk2(v[j].x, v[j].y); o.y = pk2(v[j].z, v[j].w); o8[64 * j] = o;
        m = fmaxf(m, fmaxf(fmaxf(fabsf(v[j].x), fabsf(v[j].y)), fmaxf(fabsf(v[j].z), fabsf(v[j].w)))); }
    m = wave_max(m);
    const float qs = (m > 0.f) ? 127.f / m : 1.f;
#pragma unroll
    for (int j = 0; j < 4; ++j) ((GAS unsigned*)qrow)[lane + 64 * j] = pack_i8x4(v[j].x * qs, v[j].y * qs, v[j].z * qs, v[j].w * qs);
    if (lane == 0) *qscale = (m > 0.f) ? m * (1.f / 127.f) : 1.f;
}

constexpr int TK_S = 0, TK_SSTR = 132, TK_L = 135168;
__device__ __forceinline__ void topk_unit(Frame& F, int u) {
    const int tid = F.tid, lane = F.lane, w = F.wave, q = lane >> 4, tok0 = 64 * u;
    const bf16* Qb = (const bf16*)(F.ws + WS_QB); const bf16* KB = (const bf16*)(F.ws + WS_KEYS);
    unsigned short* eidx = (unsigned short*)(F.ws + WS_EIDX); float* gate = (float*)(F.ws + WS_GATE);
    LAS unsigned char* L = F.lds;
#pragma unroll 1
    for (int r = 0; r < 4; ++r) {
#ifdef DBG_NAIVE_S
        for (int o = tid; o < 256 * 128; o += NTHREADS) { const int row = o >> 7, key = o & 127, hpl2 = row >> 6, tt = row & 63, hp2 = 4 * r + hpl2; float sacc = 0.f;
            for (int cc = 0; cc < 128; ++cc) sacc += bflo((unsigned)Qb[(size_t)(tok0 + tt) * 2048 + hp2 * 128 + cc]) * bflo((unsigned)KB[(size_t)(hp2 * 128 + key) * 128 + cc]);
            ((LAS float*)(L + TK_S))[row * TK_SSTR + key] = sacc; }
        if (0)
#endif
        { const int hpl = w >> 1, hp = 4 * r + hpl;
          bf16x8 Aq[2][4];
#pragma unroll
          for (int t2 = 0; t2 < 2; ++t2)
#pragma unroll
              for (int s = 0; s < 4; ++s) Aq[t2][s] = *(const GAS bf16x8*)(Qb + (size_t)(tok0 + 16 * (2 * (w & 1) + t2) + (lane & 15)) * 2048 + hp * 128 + 32 * s + 8 * q);
#pragma unroll 2
          for (int kt = 0; kt < 8; ++kt) {
              bf16x8 Bk[4];
#pragma unroll
              for (int s = 0; s < 4; ++s) Bk[s] = *(const GAS bf16x8*)(KB + (size_t)(hp * 128 + 16 * kt + (lane & 15)) * 128 + 32 * s + 8 * q);
#pragma unroll
              for (int t2 = 0; t2 < 2; ++t2) { f32x4 a = (f32x4){0.f, 0.f, 0.f, 0.f};
#pragma unroll
                  for (int s = 0; s < 4; ++s) a = MFMA16(Aq[t2][s], Bk[s], a);
                  LAS float* sp = (LAS float*)(L + TK_S) + (hpl * 64 + 16 * (2 * (w & 1) + t2) + 4 * q) * TK_SSTR + 16 * kt + (lane & 15);
#pragma unroll
                  for (int j = 0; j < 4; ++j) sp[j * TK_SSTR] = a[j]; } } }
        __syncthreads();
#ifdef DBG_NAIVE_SEL
        {
            LAS float* Sg = (LAS float*)(L + TK_S); LAS float* NV = (LAS float*)(L + TK_L); LAS unsigned short* NI = (LAS unsigned short*)(L + TK_L + 16384);
            for (int o = tid; o < 256 * 128; o += NTHREADS) { const int row = o >> 7, i = o & 127; const float si = Sg[row * TK_SSTR + i]; int rank = 0;
                for (int j = 0; j < 128; ++j) { const float sj = Sg[row * TK_SSTR + j]; rank += (sj > si || (sj == si && j < i)) ? 1 : 0; }
                if (rank < 16) { NV[row * 16 + rank] = si; NI[row * 16 + rank] = (unsigned short)i; } }
            __syncthreads();
            for (int o = tid; o < 128 * 256; o += NTHREADS) { const int th = o >> 8, cnd = o & 255, hl = th >> 6, t = th & 63, r0 = (2 * hl) * 64 + t, r1 = r0 + 64, ia = cnd >> 4, ib = cnd & 15;
                const float sc_ = NV[r0 * 16 + ia] + NV[r1 * 16 + ib]; int rank = 0;
                for (int j = 0; j < 256; ++j) { const float sj = NV[r0 * 16 + (j >> 4)] + NV[r1 * 16 + (j & 15)]; rank += (sj > sc_ || (sj == sc_ && j < cnd)) ? 1 : 0; }
                if (rank < 16) { const size_t ob = (size_t)(tok0 + t) * 128 + (2 * r + hl) * 16 + rank; eidx[ob] = (unsigned short)((int)NI[r0 * 16 + ia] * 128 + (int)NI[r1 * 16 + ib]); gate[ob] = sc_; } }
            __syncthreads();
            if (tid < 128) { const int hl = tid >> 6, t = tid & 63; const size_t ob = (size_t)(tok0 + t) * 128 + (2 * r + hl) * 16; float mx = -3e38f, sum = 0.f, ex[16];
                for (int k = 0; k < 16; ++k) mx = fmaxf(mx, gate[ob + k]);
                for (int k = 0; k < 16; ++k) { ex[k] = expf(gate[ob + k] - mx); sum += ex[k]; }
                for (int k = 0; k < 16; ++k) gate[ob + k] = ex[k] / sum; }
            __syncthreads();
        }
        if (0)
#endif
        if (tid < 256) {
            float a[16];
#pragma unroll
            for (int j = 0; j < 16; ++j) a[j] = -3.0e38f;
            const LAS f32x4* sp = (const LAS f32x4*)((LAS float*)(L + TK_S) + tid * TK_SSTR);
#pragma unroll 2
            for (int i = 0; i < 32; ++i) { const f32x4 v = sp[i]; const float ve[4] = {v.x, v.y, v.z, v.w};
#pragma unroll
                for (int e = 0; e < 4; ++e) { const float x = __builtin_bit_cast(float, (__builtin_bit_cast(unsigned, ve[e]) & ~127u) | (unsigned)(4 * i + e));
#pragma unroll
                    for (int j = 15; j >= 1; --j) a[j] = __builtin_amdgcn_fmed3f(a[j - 1], a[j], x);
                    a[0] = fmaxf(a[0], x); } }
            LAS v4u* tp = (LAS v4u*)(L + TK_L + tid * 64);
#pragma unroll
            for (int i = 0; i < 4; ++i) tp[i] = (v4u){__builtin_bit_cast(unsigned, a[4 * i]), __builtin_bit_cast(unsigned, a[4 * i + 1]), __builtin_bit_cast(unsigned, a[4 * i + 2]), __builtin_bit_cast(unsigned, a[4 * i + 3])};
        }
        __syncthreads();
#ifdef DBG_NAIVE_SEL
        if (0)
#endif
        if (tid < 128) {
            const int hl = tid >> 6, t = tid & 63, r0 = (2 * hl) * 64 + t, r1 = r0 + 64;
            const LAS unsigned* t0 = (const LAS unsigned*)(L + TK_L + r0 * 64); const LAS unsigned* t1 = (const LAS unsigned*)(L + TK_L + r1 * 64);
            float v1[16], v2[16];
#pragma unroll
            for (int i = 0; i < 4; ++i) { const v4u x = ((const LAS v4u*)t0)[i], y = ((const LAS v4u*)t1)[i];
                v1[4 * i] = __builtin_bit_cast(float, x.x & ~127u); v1[4 * i + 1] = __builtin_bit_cast(float, x.y & ~127u); v1[4 * i + 2] = __builtin_bit_cast(float, x.z & ~127u); v1[4 * i + 3] = __builtin_bit_cast(float, x.w & ~127u);
                v2[4 * i] = __builtin_bit_cast(float, y.x & ~127u); v2[4 * i + 1] = __builtin_bit_cast(float, y.y & ~127u); v2[4 * i + 2] = __builtin_bit_cast(float, y.z & ~127u); v2[4 * i + 3] = __builtin_bit_cast(float, y.w & ~127u); }
            float c[16];
#pragma unroll
            for (int j = 0; j < 16; ++j) c[j] = -3.0e38f;
#pragma unroll
            for (int ia = 0; ia < 16; ++ia)
#pragma unroll
                for (int ib = 0; ib < 16; ++ib) if ((ia + 1) * (ib + 1) <= 16) {
                    const float x = __builtin_bit_cast(float, (__builtin_bit_cast(unsigned, v1[ia] + v2[ib]) & ~255u) | (unsigned)(ia * 16 + ib));
#pragma unroll
                    for (int j = 15; j >= 1; --j) c[j] = __builtin_amdgcn_fmed3f(c[j - 1], c[j], x);
                    c[0] = fmaxf(c[0], x); }
            float ex[16], sum = 0.f; const float mx = __builtin_bit_cast(float, __builtin_bit_cast(unsigned, c[0]) & ~255u);
#pragma unroll
            for (int k = 0; k < 16; ++k) { ex[k] = fast_exp(__builtin_bit_cast(float, __builtin_bit_cast(unsigned, c[k]) & ~255u) - mx); sum += ex[k]; }
            const float inv = 1.f / sum; const int h = 2 * r + hl; const size_t ob = (size_t)(tok0 + t) * 128 + h * 16;
#pragma unroll
            for (int k = 0; k < 16; ++k) { const unsigned code = __builtin_bit_cast(unsigned, c[k]) & 255u;
                const unsigned i1 = t0[code >> 4] & 127u, i2 = t1[code & 15u] & 127u;
                eidx[ob + k] = (unsigned short)(i1 * 128u + i2); gate[ob + k] = ex[k] * inv; }
        }
    }
    __syncthreads();
}


#define TRED3(d, lane, m0, m1, m2) do { \
    _Pragma("unroll") for (int _i = 0; _i < 8; ++_i) { const bool _h = ((lane) & (m0)) != 0; const float _k = _h ? d[_i + 8] : d[_i], _s = _h ? d[_i] : d[_i + 8]; d[_i] = _k + __shfl_xor(_s, (m0)); } \
    _Pragma("unroll") for (int _i = 0; _i < 4; ++_i) { const bool _h = ((lane) & (m1)) != 0; const float _k = _h ? d[_i + 4] : d[_i], _s = _h ? d[_i] : d[_i + 4]; d[_i] = _k + __shfl_xor(_s, (m1)); } \
    _Pragma("unroll") for (int _i = 0; _i < 2; ++_i) { const bool _h = ((lane) & (m2)) != 0; const float _k = _h ? d[_i + 2] : d[_i], _s = _h ? d[_i] : d[_i + 2]; d[_i] = _k + __shfl_xor(_s, (m2)); } } while (0)
typedef int i32x4 __attribute__((ext_vector_type(4)));
__device__ __forceinline__ void cvt16v(const v4u r, float (&o)[16]) {
    const unsigned rr[4] = {r.x, r.y, r.z, r.w};
#pragma unroll
    for (int d = 0; d < 4; ++d) { const f32x2 lo = __builtin_amdgcn_cvt_pk_f32_fp8((int)rr[d], false), hi = __builtin_amdgcn_cvt_pk_f32_fp8((int)rr[d], true);
        o[4 * d] = lo.x; o[4 * d + 1] = lo.y; o[4 * d + 2] = hi.x; o[4 * d + 3] = hi.y; }
}
#define PX_LOAD_E(ev, tok) do { const GAS v4u* ep_ = (const GAS v4u*)(eidx + (size_t)(tok) * 128 + 16 * pg); ev[0] = ep_[0]; ev[1] = ep_[1]; } while (0)
#define PX_LOAD_ROWS8(rows, ea, base) do { const unsigned e_[8] = {ea.x & 0xffffu, ea.x >> 16, ea.y & 0xffffu, ea.y >> 16, ea.z & 0xffffu, ea.z >> 16, ea.w & 0xffffu, ea.w >> 16}; \
    _Pragma("unroll") for (int i_ = 0; i_ < 8; ++i_) rows[i_] = *(const GAS v4u*)((base) + (e_[i_] * 128u + cgo)); } while (0)
#define PU_LOAD_H(h0, tok) do { h0 = *(const GAS v4u*)(H8 + (size_t)(tok) * D + 128 * slice + cgo); } while (0)
#define PU_DOT8(rows, dd, off) do { \
    _Pragma("unroll") for (int i_ = 0; i_ < 8; ++i_) { int s_ = __builtin_amdgcn_sdot4((int)rows[i_].x, (int)h0.x, 0, false); s_ = __builtin_amdgcn_sdot4((int)rows[i_].y, (int)h0.y, s_, false); \
        s_ = __builtin_amdgcn_sdot4((int)rows[i_].z, (int)h0.z, s_, false); s_ = __builtin_amdgcn_sdot4((int)rows[i_].w, (int)h0.w, s_, false); dd[(off) + i_] = s_; } } while (0)
#define TRED3I(d, lane, m0, m1, m2) do { \
    _Pragma("unroll") for (int _i = 0; _i < 8; ++_i) { const bool _h = ((lane) & (m0)) != 0; const int _k = _h ? d[_i + 8] : d[_i], _s = _h ? d[_i] : d[_i + 8]; d[_i] = _k + __shfl_xor(_s, (m0)); } \
    _Pragma("unroll") for (int _i = 0; _i < 4; ++_i) { const bool _h = ((lane) & (m1)) != 0; const int _k = _h ? d[_i + 4] : d[_i], _s = _h ? d[_i] : d[_i + 4]; d[_i] = _k + __shfl_xor(_s, (m1)); } \
    _Pragma("unroll") for (int _i = 0; _i < 2; ++_i) { const bool _h = ((lane) & (m2)) != 0; const int _k = _h ? d[_i + 2] : d[_i], _s = _h ? d[_i] : d[_i + 2]; d[_i] = _k + __shfl_xor(_s, (m2)); } } while (0)
typedef int i32x2 __attribute__((ext_vector_type(2)));
__device__ __forceinline__ void peer_u_slice(unsigned char* ws_, int slice, int rank, int nrank) {
    const int lane = threadIdx.x & 63, wave = __builtin_amdgcn_readfirstlane(threadIdx.x >> 6);
    const int pg = lane >> 3, cg = lane & 7, wi = rank * NWAVES + wave, nw = nrank * NWAVES;
    const unsigned char* H8 = ws_ + WS_H8; const unsigned char* Us = ws_ + WS_U8 + (size_t)slice * ((size_t)NEXP * 128); const unsigned cgo = 16u * cg;
    const unsigned short* eidx = (const unsigned short*)(ws_ + WS_EIDX); int* part = (int*)(ws_ + WS_PART) + (size_t)slice * ML * 128;
    v4u eC[2], eN[2]; v4u r0[8], r1[8]; v4u h0, g0;
    PX_LOAD_E(eC, wi); PU_LOAD_H(h0, wi); PX_LOAD_ROWS8(r0, eC[0], Us);
#pragma unroll 1
    for (int t = wi; t < ML; t += nw) {
        const int tn = (t + nw < ML) ? t + nw : t;
        PX_LOAD_ROWS8(r1, eC[1], Us); PX_LOAD_E(eN, tn); PU_LOAD_H(g0, tn);
        __builtin_amdgcn_sched_barrier(0);
        int d[16];
        PU_DOT8(r0, d, 0);
        PX_LOAD_ROWS8(r0, eN[0], Us);
        __builtin_amdgcn_sched_barrier(0);
        PU_DOT8(r1, d, 8);
        TRED3I(d, lane, 4, 2, 1);
        *(GAS i32x2*)(part + (size_t)t * 128 + 2 * lane) = (i32x2){d[0], d[1]};
        eC[0] = eN[0]; eC[1] = eN[1]; h0 = g0;
    }
}
__device__ __forceinline__ void peer_reduce(Frame& F) {
    const int* part = (const int*)(F.ws + WS_PART); const float* sh = (const float*)(F.ws + WS_SH); const unsigned short* eidx = (const unsigned short*)(F.ws + WS_EIDX); const float* gate = (const float*)(F.ws + WS_GATE);
    const float* su = (const float*)(F.ws + WS_SU); const float* sv = (const float*)(F.ws + WS_SV); bf16* wgt = (bf16*)(F.ws + WS_WGT);
    for (size_t i = (size_t)F.bid * NTHREADS + F.tid; i < (size_t)ML * 128; i += (size_t)F.G * NTHREADS) {
        int s = 0;
#pragma unroll
        for (int x = 0; x < 8; ++x) s += part[(size_t)x * ML * 128 + i];
        const int e = eidx[i]; const float z = (float)s * su[e] * sh[i >> 7];
        wgt[i] = (bf16)f2bf(gate[i] * (0.5f * z * (1.f + erff(z * 0.70710678118f))) * sv[e] * 1024.f);
    }
}
#define PV_LOAD_W(wv, tok) do { const GAS v4u* wp_ = (const GAS v4u*)(wgt + (size_t)(tok) * 128 + 16 * pg); wv[0] = wp_[0]; wv[1] = wp_[1]; } while (0)
typedef _Float16 h16x2 __attribute__((ext_vector_type(2)));
#define PV_ACC8(rows, wa) do { const unsigned w_[4] = {wa.x, wa.y, wa.z, wa.w}; \
    _Pragma("unroll") for (int i_ = 0; i_ < 8; ++i_) { const _Float16 wh_ = (_Float16)((i_ & 1) ? bfhi(w_[i_ >> 1]) : bflo(w_[i_ >> 1])); const h16x2 ww_ = {wh_, wh_}; \
        const unsigned rr_[4] = {rows[i_].x, rows[i_].y, rows[i_].z, rows[i_].w}; \
        _Pragma("unroll") for (int d_ = 0; d_ < 4; ++d_) { \
            acc[2 * d_]     = acc[2 * d_]     + __builtin_amdgcn_cvt_scalef32_pk_f16_fp8((int)rr_[d_], 1.0f, false) * ww_; \
            acc[2 * d_ + 1] = acc[2 * d_ + 1] + __builtin_amdgcn_cvt_scalef32_pk_f16_fp8((int)rr_[d_], 1.0f, true) * ww_; } } } while (0)
__device__ __forceinline__ void peer_v_slice(unsigned char* ws_, float* out_, int slice, int rank, int nrank) {
    const int lane = threadIdx.x & 63, wave = __builtin_amdgcn_readfirstlane(threadIdx.x >> 6);
    const int pg = lane >> 3, cg = lane & 7, wi = rank * NWAVES + wave, nw = nrank * NWAVES;
    const unsigned char* Vs = ws_ + WS_V8 + (size_t)slice * ((size_t)NEXP * 128); const unsigned cgo = 16u * cg;
    const unsigned short* eidx = (const unsigned short*)(ws_ + WS_EIDX); const bf16* wgt = (const bf16*)(ws_ + WS_WGT); const float* mod = (const float*)(ws_ + WS_MOD);
    float* ssq = (float*)(ws_ + WS_SSQ) + (size_t)slice * ML;
    const int col = 128 * slice + 16 * cg + 2 * pg;
    v4u eC[2], eN[2]; v4u r0[8], r1[8]; v4u wC[2], wN[2];
    PX_LOAD_E(eC, wi); PV_LOAD_W(wC, wi); PX_LOAD_ROWS8(r0, eC[0], Vs);
#pragma unroll 1
    for (int t = wi; t < ML; t += nw) {
        const int tn = (t + nw < ML) ? t + nw : t;
        PX_LOAD_ROWS8(r1, eC[1], Vs); PX_LOAD_E(eN, tn); PV_LOAD_W(wN, tn);
        float* orow = out_ + (size_t)t * D + col;
        const f32x2 x1 = *(const GAS f32x2*)orow, gg = *(const GAS f32x2*)(mod + (size_t)(t >> 12) * 6144 + 5 * 1024 + col);
        __builtin_amdgcn_sched_barrier(0);
        h16x2 acc[8];
#pragma unroll
        for (int k = 0; k < 8; ++k) acc[k] = (h16x2){(_Float16)0.f, (_Float16)0.f};
        PV_ACC8(r0, wC[0]);
        PX_LOAD_ROWS8(r0, eN[0], Vs);
        __builtin_amdgcn_sched_barrier(0);
        PV_ACC8(r1, wC[1]);
        float af[16];
#pragma unroll
        for (int k = 0; k < 8; ++k) { af[2 * k] = (float)acc[k].x; af[2 * k + 1] = (float)acc[k].y; }
        TRED3(af, lane, 32, 16, 8);
        const f32x2 x2 = (f32x2){x1.x + gg.x * (af[0] * (1.f / 1024.f)), x1.y + gg.y * (af[1] * (1.f / 1024.f))};
        *(GAS f32x2*)orow = x2;
        const float s2 = wave_sum(x2.x * x2.x + x2.y * x2.y);
        if (lane == 0) ssq[t] = s2;
        eC[0] = eN[0]; eC[1] = eN[1]; wC[0] = wN[0]; wC[1] = wN[1];
    }
}
__device__ __forceinline__ void final_norm(Frame& F) {
    const float* ssq = (const float*)(F.ws + WS_SSQ); const int lane = F.lane, gw = F.bid * NWAVES + F.wave, NGW = F.G * NWAVES;
    for (int t = gw; t < ML; t += NGW) {
        float s = 0.f;
#pragma unroll
        for (int x = 0; x < 8; ++x) s += ssq[(size_t)x * ML + t];
        const float rstd = 1.f / sqrtf(s * (1.f / D) + EPS);
        GAS f32x4* orow = (GAS f32x4*)(F.out + (size_t)t * D) + lane;
#pragma unroll
        for (int j = 0; j < 4; ++j) { const f32x4 fg = ((const GAS f32x4*)F.final_g)[lane + 64 * j]; orow[64 * j] = orow[64 * j] * rstd * fg; }
    }
}

constexpr int N_PHASES = 14;
__global__ void __launch_bounds__(NTHREADS, 2) fwd_kernel(Args args) {
    extern __shared__ __attribute__((aligned(16))) unsigned char lds[];
    Frame F;
    F.lds = (LAS unsigned char*)lds;
    F.tid = threadIdx.x; F.lane = F.tid & 63; F.wave = __builtin_amdgcn_readfirstlane(F.tid >> 6); F.G = gridDim.x; F.bid = blockIdx.x;
    F.x = args.in[0]; F.c = args.in[1]; F.ctx = args.in[2]; F.c_ctx = args.in[3]; F.w_mod = args.in[4]; F.b_mod = args.in[5]; F.n1g = args.in[6]; F.n2g = args.in[7];
    F.w_in = args.in[8]; F.pool_w = args.in[9]; F.pool_scale = args.in[10]; F.lb_logits = args.in[11]; F.hg_norm_g = args.in[12]; F.w_a = args.in[13]; F.w_b = args.in[14];
    F.w_o = args.in[15]; F.wq = args.in[16]; F.keys = args.in[17]; F.pu = args.in[18]; F.pv = args.in[19]; F.final_g = args.in[20];
    F.out = args.out; F.ws = args.ws;
    volatile LAS unsigned* MISC = (volatile LAS unsigned*)(F.lds + MISC_OFF);
    if (F.tid < 64) MISC[F.tid] = 0u;
    __syncthreads();
    unsigned* barw = (unsigned*)(F.ws + WS_CTL) + CW_BAR;
    XcdBarrier bar; bar.bar = barw; bar.x = 0; bar.st = nullptr;
    if (ONE_LAUNCH) bar = xcd_barrier_post(barw, MISC + 8);
    const int lo = args.ph_lo, hi = args.ph_hi;
#ifndef PH_MASK
#define PH_MASK 0x3fff
#endif
#define IN(k) (((PH_MASK >> (k)) & 1) && lo <= (k) && (k) < hi)
#define SEAM(k) do { if (IN(k) && IN((k) + 1)) xcd_barrier(bar); } while (0)
#ifndef REP_MASK
#define REP_MASK 0
#endif
#define REPS(k) ((((REP_MASK) >> (k)) & 1) ? 2 : 1)
#define REPSYNC(k, rep) do { if ((rep) + 1 < REPS(k)) xcd_barrier(bar); } while (0)

    if (IN(0)) for (int rep_ = 0; rep_ < REPS(0); ++rep_) { p0_prologue(F);  REPSYNC(0, rep_); } SEAM(0);
    if (IN(1)) for (int rep_ = 0; rep_ < REPS(1); ++rep_) { p1_modulate(F);  REPSYNC(1, rep_); } SEAM(1);
    if (IN(2)) for (int rep_ = 0; rep_ < REPS(2); ++rep_) {
        SchedIn S{(const char*)(F.ws + WS_H), (const char*)(F.ws + WS_WIN), F.G, F.bid};
        EpiZ E{(bf16*)(F.ws + WS_Z), (bf16*)(F.ws + WS_ZC)};
        pg8::gemm_phase<EpiZ, SchedIn, true, true>(F.lds, D, S, E);
        REPSYNC(2, rep_);
    } SEAM(2);
    if (IN(3)) for (int rep_ = 0; rep_ < REPS(3); ++rep_) {
#ifndef NO_SCAN
        for (int u = F.bid; u < NSCAN; u += F.G) scan_unit(F, u);
#endif
#ifndef NO_POOL
        for (int u = F.bid; u < NB * 64; u += F.G) pool_unit(F, u);
#endif
        REPSYNC(3, rep_);
    } SEAM(3);
    if (IN(4)) for (int rep_ = 0; rep_ < REPS(4); ++rep_) { for (int u = F.bid; u < NB * 4 * NSEG; u += F.G) fix_unit(F, u);  REPSYNC(4, rep_); } SEAM(4);
    if (IN(5)) for (int rep_ = 0; rep_ < REPS(5); ++rep_) {
        SchedMerge S{(const char*)(F.ws + WS_YPOOL), (const char*)(F.ws + WS_YHG), (const char*)(F.ws + WS_WA), (const char*)(F.ws + WS_WB), F.G, F.bid};
        EpiMerge E{(const bf16*)(F.ws + WS_Z), (bf16*)(F.ws + WS_M)};
        pg8::gemm_phase<EpiMerge, SchedMerge, true, true>(F.lds, 512, S, E);
        REPSYNC(5, rep_);
    } SEAM(5);
    if (IN(6)) for (int rep_ = 0; rep_ < REPS(6); ++rep_) {
        SchedPlain S{(const char*)(F.ws + WS_M), (const char*)(F.ws + WS_WO), 64, 4, D, F.G, F.bid};
        EpiRes E{F.x, (const float*)(F.ws + WS_MOD), F.out};
        pg8::gemm_phase<EpiRes, SchedPlain, true, true>(F.lds, D, S, E);
        REPSYNC(6, rep_);
    } SEAM(6);
    if (IN(7)) for (int rep_ = 0; rep_ < REPS(7); ++rep_) {
        const float* mod = (const float*)(F.ws + WS_MOD); bf16* H2 = (bf16*)(F.ws + WS_H);
        const int gw = F.bid * NWAVES + F.wave, NGW = F.G * NWAVES;
        for (int m = gw; m < ML; m += NGW) { const int v = m >> 12; modulate_row_q(F.out + (size_t)m * D, H2 + (size_t)m * D, F.ws + WS_H8 + (size_t)m * D, (float*)(F.ws + WS_SH) + m, F.n2g, mod + v * 6144 + 3 * 1024, mod + v * 6144 + 4 * 1024, F.lane); }
        i8_rows(F.pu, F.ws + WS_U8, (float*)(F.ws + WS_SU), gw, NGW, F.lane);
        fp8_rows(F.pv, F.ws + WS_V8, (float*)(F.ws + WS_SV), gw, NGW, F.lane);
        REPSYNC(7, rep_);
    } SEAM(7);
    if (IN(8)) for (int rep_ = 0; rep_ < REPS(8); ++rep_) {
        SchedPlain S{(const char*)(F.ws + WS_H), (const char*)(F.ws + WS_WQ), 64, 8, D, F.G, F.bid};
        EpiPlain E{(bf16*)(F.ws + WS_QB), 2048};
        pg8::gemm_phase<EpiPlain, SchedPlain, true, true>(F.lds, D, S, E);
        REPSYNC(8, rep_);
    } SEAM(8);
    if (IN(9)) for (int rep_ = 0; rep_ < REPS(9); ++rep_) { for (int u = F.bid; u < ML / 64; u += F.G) topk_unit(F, u);  REPSYNC(9, rep_); } SEAM(9);
    int pslice = F.bid & 7, prank = F.bid >> 3; const int pnrank = F.G >> 3;
    if (ONE_LAUNCH && (IN(10) || IN(12))) {
        bool okc = (F.G == 256) && (bar.x < 8u);
#pragma unroll
        for (int j = 0; j < 8; ++j) okc = okc && (xb_ld(&barw[XB_XCNT(j)]) == 32u);
        if (okc) { pslice = (int)bar.x; prank = (int)MISC[10]; }
    }
    if (IN(10)) for (int rep_ = 0; rep_ < REPS(10); ++rep_) { peer_u_slice(F.ws, pslice, prank, pnrank);  REPSYNC(10, rep_); } SEAM(10);
    if (IN(11)) for (int rep_ = 0; rep_ < REPS(11); ++rep_) { peer_reduce(F);  REPSYNC(11, rep_); } SEAM(11);
    if (IN(12)) for (int rep_ = 0; rep_ < REPS(12); ++rep_) { peer_v_slice(F.ws, F.out, pslice, prank, pnrank);  REPSYNC(12, rep_); } SEAM(12);
    if (IN(13)) for (int rep_ = 0; rep_ < REPS(13); ++rep_) { final_norm(F);  REPSYNC(13, rep_); }
#undef IN
#undef SEAM
}

extern "C" void kernel_launch(void* const* d_in, const int* in_sizes, int n_in, void* d_out, int out_size, void* d_ws, size_t ws_size, hipStream_t stream) {
    static int grid = 0;
    if (grid == 0) {
        if (n_in != 21 || out_size != ML * D || ws_size < WS_END) { fprintf(stderr, "kernel_launch: unexpected problem (n_in %d, out %d, ws %zu)\n", n_in, out_size, ws_size); grid = -1; return; }
        int dev = 0, cus = 0;
        if (hipGetDevice(&dev) != hipSuccess || hipDeviceGetAttribute(&cus, hipDeviceAttributeMultiprocessorCount, dev) != hipSuccess) { grid = -1; return; }
        if (hipFuncSetAttribute((const void*)fwd_kernel, hipFuncAttributeMaxDynamicSharedMemorySize, LDS_BYTES) != hipSuccess) { fprintf(stderr, "kernel_launch: hipFuncSetAttribute failed\n"); grid = -1; return; }
        int per_cu = 0;
        if (hipOccupancyMaxActiveBlocksPerMultiprocessor(&per_cu, (const void*)fwd_kernel, NTHREADS, LDS_BYTES) != hipSuccess || per_cu < 1) fprintf(stderr, "kernel_launch: occupancy query says %d\n", per_cu);
        (void)hipGetLastError();
        grid = cus;
    }
    if (grid < 0) return;
    (void)hipMemsetAsync((char*)d_ws + WS_CTL, 0, CTL_ZERO_BYTES, stream);
    Args a{};
    for (int i = 0; i < 21; ++i) a.in[i] = (const float*)d_in[i];
    a.out = (float*)d_out; a.ws = (unsigned char*)d_ws;
#if ONE_LAUNCH
    a.ph_lo = 0; a.ph_hi = N_PHASES;
    hipLaunchKernelGGL(fwd_kernel, dim3(grid), dim3(NTHREADS), LDS_BYTES, stream, a);
#else
    for (int p = 0; p < N_PHASES; ++p) { a.ph_lo = p; a.ph_hi = p + 1; hipLaunchKernelGGL(fwd_kernel, dim3(grid), dim3(NTHREADS), LDS_BYTES, stream, a); }
#endif
}
```

```cpp
#define ONE_LAUNCH 1
#include <hip/hip_runtime.h>
#include <cstdio>
#include <cstdint>

#ifndef ONE_LAUNCH
#define ONE_LAUNCH 1
#endif

namespace pg8 {
#define PG8_LAS __attribute__((address_space(3)))
typedef unsigned short bf16_t;
typedef short bf16x8 __attribute__((ext_vector_type(8)));
typedef float f32x4 __attribute__((ext_vector_type(4)));
typedef float f32x2 __attribute__((ext_vector_type(2)));
typedef unsigned u32x4 __attribute__((ext_vector_type(4)));
typedef unsigned u32x2 __attribute__((ext_vector_type(2)));
constexpr int BM = 256, BK = 64, HALF = 128, HTB = HALF * BK * 2, STAGE_BYTES = 8 * HTB, NXCD = 8, WGM = 8;

__host__ __device__ __forceinline__ int lds_byte(int r, int c) { const int st = (r >> 4) * 2 + (c >> 5), rr = r & 15, cc = c & 31, ob = rr * 64 + cc * 2; return st * 1024 + (ob ^ (((ob >> 9) & 1) << 5)); }
__host__ __device__ __forceinline__ void stage_rc(int b, int& R, int& C) { const int st = b / 1024, sb = b % 1024, swz = sb ^ (((sb >> 9) & 1) << 5); R = (st >> 1) * 16 + swz / 64; C = (st & 1) * 32 + (swz % 64) / 2; }
__host__ __device__ __forceinline__ int perm32(int rho) { const int n = rho >> 4, i = rho & 15; return 8 * (i >> 2) + 4 * n + (i & 3); }

struct Unit { int pm, pn, seg; };

__host__ __device__ __forceinline__ void tile_of(int wgid, int nM, int nN, int& pm, int& pn) {
    const int nwg = nM * nN;
    { const int q = nwg / NXCD, r = nwg % NXCD, xcd = wgid % NXCD, off = wgid / NXCD; wgid = (xcd < r ? xcd * (q + 1) : r * (q + 1) + (xcd - r) * q) + off; }
    const int nig = WGM * nN, gid = wgid / nig, fm = gid * WGM, gsz = (nM - fm) < WGM ? (nM - fm) : WGM;
    pm = fm + ((wgid % nig) % gsz); pn = (wgid % nig) / gsz;
}

typedef __bf16 bf16x2_t __attribute__((ext_vector_type(2)));
__device__ __forceinline__ unsigned cvt_pk_bf16(float lo, float hi) { bf16x2_t v; v.x = (__bf16)lo; v.y = (__bf16)hi; return __builtin_bit_cast(unsigned, v); }

template <class Epi, class Sched, bool ALIGN_EPI = false, bool SP2 = false>
__device__ __forceinline__ void gemm_phase(PG8_LAS unsigned char* lds, const int K, const Sched& S, const Epi& E) {
    const int tid = threadIdx.x, wid = __builtin_amdgcn_readfirstlane(tid >> 6), lane = tid & 63, wr = wid >> 2, wc = wid & 3, fr = lane & 15, fq = lane >> 4;
    const int nt = K / BK;
    unsigned voffA[2], voffB[2];
#pragma unroll
    for (int i = 0; i < 2; ++i) { int R, C; stage_rc(tid * 16 + i * 8192, R, C); const int Rb = Epi::PERM ? ((R & ~31) + perm32(R & 31)) : R;
        voffA[i] = (unsigned)(R * K + C) * 2u; voffB[i] = (unsigned)(Rb * K + C) * 2u; }
    const size_t kstep = (size_t)(BK * 2);
    const size_t hstep = (size_t)HALF * K * 2;
    const unsigned ldsw = (unsigned)wid * 1024u;
    const int aoff = lds_byte(wr * 64 + fr, fq * 8), boff = lds_byte(wc * 32 + fr, fq * 8);
#define PG8_SA(b, h) (((b) * 2 + (h)) * HTB)
#define PG8_SB(b, h) ((4 + (b) * 2 + (h)) * HTB)
#define PG8_STAGE(bufoff, gbase, voff) do { _Pragma("unroll") for (int _i = 0; _i < 2; ++_i) \
        __builtin_amdgcn_global_load_lds((const unsigned*)((const char*)(gbase) + (voff)[_i]), (PG8_LAS unsigned*)(lds + (bufoff) + ldsw + _i * 8192), 16, 0, 0); } while (0)
#define PG8_LDA(dst, b, h) do { _Pragma("unroll") for (int m = 0; m < 4; ++m) _Pragma("unroll") for (int k = 0; k < 2; ++k) dst[m][k] = *(const PG8_LAS bf16x8*)(lds + PG8_SA(b, h) + aoff + m * 2048 + k * 1024); } while (0)
#define PG8_LDB(dst, b, h) do { _Pragma("unroll") for (int n = 0; n < 2; ++n) _Pragma("unroll") for (int k = 0; k < 2; ++k) dst[n][k] = *(const PG8_LAS bf16x8*)(lds + PG8_SB(b, h) + boff + n * 2048 + k * 1024); } while (0)
#define PG8_MMA(ai, bj, At, Bt) do { __builtin_amdgcn_s_setprio(1); _Pragma("unroll") for (int m = 0; m < 4; ++m) _Pragma("unroll") for (int n = 0; n < 2; ++n) _Pragma("unroll") for (int k = 0; k < 2; ++k) \
        acc[ai][bj][m][n] = __builtin_amdgcn_mfma_f32_16x16x32_bf16(Bt[n][k], At[m][k], acc[ai][bj][m][n], 0, 0, 0); __builtin_amdgcn_s_setprio(0); } while (0)
#define PG8_WAIT_V(n) asm volatile("s_waitcnt vmcnt(" #n ")" ::: "memory")
#define PG8_WAIT_L(n) asm volatile("s_waitcnt lgkmcnt(" #n ")" ::: "memory")
#define PG8_BAR __builtin_amdgcn_s_barrier()
#define PG8_SCHED __builtin_amdgcn_sched_barrier(0)
    Unit cur, nxt; int ui = 0;
    if (!S.next(0, cur)) return;
    f32x4 acc[2][2][4][2];
#pragma unroll
    for (int a = 0; a < 2; ++a)
#pragma unroll
        for (int b = 0; b < 2; ++b)
#pragma unroll
            for (int m = 0; m < 4; ++m)
#pragma unroll
                for (int n = 0; n < 2; ++n) acc[a][b][m][n] = (f32x4){0.f, 0.f, 0.f, 0.f};
    bf16x8 At[4][2], B0[2][2], B1[2][2];
    const char* cA = S.A(cur); const char* cB = S.B(cur);
    if constexpr (SP2) {
        PG8_STAGE(PG8_SB(0, 0), cB, voffB); PG8_STAGE(PG8_SB(0, 1), cB + hstep, voffB); PG8_STAGE(PG8_SA(0, 0), cA, voffA); PG8_STAGE(PG8_SA(0, 1), cA + hstep, voffA);
        if (wr == 1) PG8_BAR;
        PG8_WAIT_V(2); PG8_BAR;
        PG8_STAGE(PG8_SB(1, 0), cB + kstep, voffB); PG8_STAGE(PG8_SA(1, 0), cA + kstep, voffA); PG8_STAGE(PG8_SB(1, 1), cB + hstep + kstep, voffB);
        PG8_WAIT_V(6); PG8_BAR;
    } else {
        PG8_STAGE(PG8_SB(0, 0), cB, voffB); PG8_STAGE(PG8_SA(0, 0), cA, voffA); PG8_STAGE(PG8_SB(0, 1), cB + hstep, voffB); PG8_STAGE(PG8_SA(0, 1), cA + hstep, voffA);
        if (wr == 1) PG8_BAR;
        PG8_WAIT_V(4); PG8_BAR;
        PG8_STAGE(PG8_SB(1, 0), cB + kstep, voffB); PG8_STAGE(PG8_SA(1, 0), cA + kstep, voffA); PG8_STAGE(PG8_SB(1, 1), cB + hstep + kstep, voffB);
        PG8_WAIT_V(6); PG8_BAR;
    }
    for (;;) {
        const bool has_next = S.next(ui + 1, nxt);
        const char* nA = has_next ? S.A(nxt) : cA; const char* nB = has_next ? S.B(nxt) : cB;
        for (int t = 0; t < nt; t += 2) {
            const bool last = (t == nt - 2);
            const char* a1 = cA + (size_t)(t + 1) * kstep;
            const char* a2 = last ? nA : cA + (size_t)(t + 2) * kstep; const char* b2 = last ? nB : cB + (size_t)(t + 2) * kstep;
            const char* a3 = a2 + kstep; const char* b3 = b2 + kstep;
            if constexpr (SP2) {
            PG8_LDB(B0, 0, 0); PG8_LDB(B1, 0, 1); PG8_SCHED; PG8_LDA(At, 0, 0); PG8_STAGE(PG8_SA(1, 1), a1 + hstep, voffA);
            PG8_WAIT_V(8); PG8_WAIT_L(0); PG8_BAR; PG8_MMA(0, 0, At, B0); PG8_MMA(0, 1, At, B1); PG8_BAR; PG8_SCHED;
            PG8_LDA(At, 0, 1); PG8_STAGE(PG8_SB(0, 0), b2, voffB); PG8_STAGE(PG8_SB(0, 1), b2 + hstep, voffB); PG8_STAGE(PG8_SA(0, 0), a2, voffA);
            PG8_WAIT_V(8); PG8_WAIT_L(0); PG8_BAR; PG8_MMA(1, 0, At, B0); PG8_MMA(1, 1, At, B1); PG8_BAR; PG8_SCHED;
            PG8_LDB(B0, 1, 0); PG8_LDB(B1, 1, 1); PG8_SCHED; PG8_LDA(At, 1, 0); PG8_STAGE(PG8_SA(0, 1), a2 + hstep, voffA);
            PG8_WAIT_V(8); PG8_WAIT_L(0); PG8_BAR; PG8_MMA(0, 0, At, B0); PG8_MMA(0, 1, At, B1); PG8_BAR; PG8_SCHED;
            PG8_LDA(At, 1, 1); PG8_STAGE(PG8_SB(1, 0), b3, voffB); PG8_STAGE(PG8_SB(1, 1), b3 + hstep, voffB); PG8_STAGE(PG8_SA(1, 0), a3, voffA);
            PG8_WAIT_V(8); PG8_WAIT_L(0); PG8_BAR; PG8_MMA(1, 0, At, B0); PG8_MMA(1, 1, At, B1); PG8_BAR; PG8_SCHED;
            } else {
            PG8_LDB(B0, 0, 0); PG8_SCHED; PG8_LDA(At, 0, 0); PG8_STAGE(PG8_SA(1, 1), a1 + hstep, voffA);
            PG8_WAIT_L(8); PG8_BAR; PG8_WAIT_L(0); PG8_MMA(0, 0, At, B0); PG8_BAR; PG8_SCHED;
            PG8_LDB(B1, 0, 1); PG8_STAGE(PG8_SB(0, 0), b2, voffB);
            PG8_BAR; PG8_WAIT_L(0); PG8_MMA(0, 1, At, B1); PG8_BAR;
            PG8_LDA(At, 0, 1); PG8_STAGE(PG8_SA(0, 0), a2, voffA);
            PG8_BAR; PG8_WAIT_L(0); PG8_MMA(1, 0, At, B0); PG8_BAR; PG8_SCHED;
            PG8_STAGE(PG8_SB(0, 1), b2 + hstep, voffB);
            PG8_WAIT_V(6); PG8_BAR; PG8_MMA(1, 1, At, B1); PG8_BAR;
            PG8_LDB(B0, 1, 0); PG8_SCHED; PG8_LDA(At, 1, 0); PG8_STAGE(PG8_SA(0, 1), a2 + hstep, voffA);
            PG8_WAIT_L(8); PG8_BAR; PG8_WAIT_L(0); PG8_MMA(0, 0, At, B0); PG8_BAR; PG8_SCHED;
            PG8_LDB(B1, 1, 1); PG8_STAGE(PG8_SB(1, 0), b3, voffB);
            PG8_BAR; PG8_WAIT_L(0); PG8_MMA(0, 1, At, B1); PG8_BAR;
            PG8_LDA(At, 1, 1); PG8_STAGE(PG8_SA(1, 0), a3, voffA);
            PG8_BAR; PG8_WAIT_L(0); PG8_MMA(1, 0, At, B0); PG8_BAR; PG8_SCHED;
            PG8_STAGE(PG8_SB(1, 1), b3 + hstep, voffB);
            PG8_WAIT_V(6); PG8_BAR; PG8_MMA(1, 1, At, B1); PG8_BAR;
            }
        }
        if constexpr (ALIGN_EPI) { if (wr == 0) PG8_BAR; }
        E(acc, cur, wr, wc, fr, fq);
        if (!has_next) break;
        if (!S.keep(cur)) {
#pragma unroll
        for (int a = 0; a < 2; ++a)
#pragma unroll
            for (int b = 0; b < 2; ++b)
#pragma unroll
                for (int m = 0; m < 4; ++m)
#pragma unroll
                    for (int n = 0; n < 2; ++n) acc[a][b][m][n] = (f32x4){0.f, 0.f, 0.f, 0.f};
        }
        cur = nxt; cA = nA; cB = nB; ++ui;
        if constexpr (ALIGN_EPI) { if (wr == 1) PG8_BAR; }
    }
    PG8_WAIT_V(0);
    if constexpr (!ALIGN_EPI) { if (wr == 0) PG8_BAR; }
    PG8_BAR;
#undef PG8_SA
#undef PG8_SB
#undef PG8_STAGE
#undef PG8_LDA
#undef PG8_LDB
#undef PG8_MMA
#undef PG8_WAIT_V
#undef PG8_WAIT_L
#undef PG8_BAR
#undef PG8_SCHED
}
}

constexpr int D = 1024, NB = 4, SEQ = 4096, CTXL = 256;
constexpr int ML = NB * SEQ;
constexpr int MC = NB * CTXL;
constexpr int MH = ML + MC;
constexpr int INW = 5120;
constexpr int ZC_W = 1536;
constexpr int NEXP = 16384, NHEAD_P = 8, TOPK = 16;
constexpr float EPS = 1e-6f;
constexpr int NWAVES = 8, NTHREADS = 512;
constexpr int SEGT = 512, NSEG = SEQ / SEGT;
constexpr int CHT = 32;
constexpr int NSCAN_L = NB * 4 * 2 * NSEG;
constexpr int NCSEG = 4;
constexpr int NSCAN = NSCAN_L + NB * 4 * 2 * NCSEG;

constexpr size_t MiB = 1u << 20;
constexpr size_t WS_CTL = 0, CTL_ZERO_BYTES = 64 * 1024;
constexpr size_t WS_MOD = 1 * MiB;
constexpr size_t WS_LBT = WS_MOD + 128 * 1024;
constexpr size_t WS_ASEG = WS_LBT + 8 * 1024;
constexpr size_t WS_SU = WS_ASEG + 200 * 1024;
constexpr size_t WS_SV = WS_SU + 64 * 1024;
constexpr size_t WS_WIN = 2 * MiB;
constexpr size_t WS_WA = 12 * MiB, WS_WB = 13 * MiB, WS_WO = 14 * MiB, WS_WQ = 16 * MiB;
constexpr size_t WS_POOLW = 20 * MiB;
constexpr size_t WS_KEYS = WS_POOLW + 128 * 1024;
constexpr size_t WS_ZC = 21 * MiB;
constexpr size_t WS_Z = 24 * MiB;
constexpr size_t WS_QB = 24 * MiB;
constexpr size_t WS_EIDX = 88 * MiB;
constexpr size_t WS_GATE = 96 * MiB;
constexpr size_t WS_U8 = 112 * MiB, WS_V8 = 128 * MiB;
constexpr size_t WS_PART = 24 * MiB;
constexpr size_t WS_WGT = 104 * MiB;
constexpr size_t WS_H8 = 144 * MiB;
constexpr size_t WS_SH = 160 * MiB;
constexpr size_t WS_PO = 144 * MiB;
constexpr size_t WS_SSQ = 21 * MiB;
constexpr size_t WS_H = 184 * MiB;
constexpr size_t WS_YHG = 184 * MiB, WS_YPOOL = 200 * MiB;
constexpr size_t WS_USEG = 218 * MiB;
constexpr size_t WS_M = 218 * MiB;
constexpr size_t WS_END = 252 * MiB;
static_assert(WS_Z + (size_t)ML * INW * 2 <= WS_H && WS_H + (size_t)MH * D * 2 <= WS_USEG && WS_USEG + (size_t)NSCAN * 128 * 128 * 4 <= WS_END && WS_M + (size_t)ML * D * 2 <= WS_END, "ws map");
static_assert(WS_QB + (size_t)ML * 2048 * 2 <= WS_EIDX && WS_V8 + (size_t)NEXP * D <= WS_H, "ws map 2");
constexpr size_t OUT_OLOC = 0, OUT_QSEG = 32 * MiB;
constexpr int CW_BAR = 1024;

constexpr int LDS_BYTES = 163840;
constexpr int MISC_OFF = LDS_BYTES - 256;

#define GAS __attribute__((address_space(1)))
#define LAS __attribute__((address_space(3)))
typedef unsigned short bf16;
typedef unsigned v4u __attribute__((ext_vector_type(4)));
typedef unsigned v2u __attribute__((ext_vector_type(2)));
typedef float f32x4 __attribute__((ext_vector_type(4)));
typedef float f32x2 __attribute__((ext_vector_type(2)));
typedef short bf16x8 __attribute__((ext_vector_type(8)));
typedef short s16x4 __attribute__((ext_vector_type(4)));
#define LDS_WAIT() asm volatile("s_waitcnt lgkmcnt(0)" ::: "memory")
#define VM_WAIT() asm volatile("s_waitcnt vmcnt(0)" ::: "memory")
#define LBAR() do { asm volatile("s_waitcnt lgkmcnt(0)" ::: "memory"); __builtin_amdgcn_s_barrier(); asm volatile("" ::: "memory"); } while (0)
__device__ __forceinline__ unsigned f2bf(float f) { unsigned u = __builtin_bit_cast(unsigned, f); return (u + 0x7fffu + ((u >> 16) & 1u)) >> 16; }
__device__ __forceinline__ unsigned pk2(float lo, float hi) { return pg8::cvt_pk_bf16(lo, hi); }
__device__ __forceinline__ float bflo(unsigned w) { return __builtin_bit_cast(float, w << 16); }
__device__ __forceinline__ float bfhi(unsigned w) { return __builtin_bit_cast(float, w & 0xffff0000u); }
__device__ __forceinline__ float fast_exp(float x) { return __builtin_amdgcn_exp2f(x * 1.4426950408889634f); }
__device__ __forceinline__ float fast_rcp(float x) { return __builtin_amdgcn_rcpf(x); }
__device__ __forceinline__ float sigmoidf_(float x) { x = fminf(fmaxf(x, -30.f), 30.f); return fast_rcp(1.f + fast_exp(-x)); }
__device__ __forceinline__ float wave_sum(float v) {
#pragma unroll
    for (int o = 1; o < 64; o <<= 1) v += __shfl_xor(v, o);
    return v;
}
__device__ __forceinline__ float wave_max(float v) {
#pragma unroll
    for (int o = 1; o < 64; o <<= 1) v = fmaxf(v, __shfl_xor(v, o));
    return v;
}

#define XB_TMO      128
#define XB_XCNT(j)  (256  + 64 * (j))
#define XB_XSUB(j)  (1280 + 64 * (j))
#define XB_XGEN(j)  (2304 + 64 * (j))
#define XB_TOP      3328
#define XB_TOPGEN   3392
#define XCD_BAR_WORDS 3456
#define XB_SPIN_CAP (1u << 18)
__device__ __forceinline__ unsigned xb_ld(unsigned* p)              { return __hip_atomic_load(p, __ATOMIC_RELAXED, __HIP_MEMORY_SCOPE_AGENT); }
__device__ __forceinline__ unsigned xb_add(unsigned* p, unsigned v) { return __hip_atomic_fetch_add(p, v, __ATOMIC_RELAXED, __HIP_MEMORY_SCOPE_AGENT); }
__device__ __forceinline__ unsigned xb_xcc_id() { return (unsigned)__builtin_amdgcn_s_getreg((3 << 11) | 20) & 0xFu; }
#define XB_SPIN(cond, bar) do { unsigned _sp = 0; while (cond) { __builtin_amdgcn_s_sleep(1); \
    if ((++_sp & 255u) == 0u) { if (xb_ld(&(bar)[XB_TMO])) break; if (_sp > XB_SPIN_CAP) { atomicAdd(&(bar)[XB_TMO], 1u); break; } } } } while (0)
struct XcdBarrier { unsigned* bar; unsigned x; volatile LAS unsigned* st; };
__device__ __forceinline__ XcdBarrier xcd_barrier_post(unsigned* bar, volatile LAS unsigned* st) {
    XcdBarrier b; b.bar = bar; b.x = xb_xcc_id(); b.st = st;
    if (threadIdx.x == 0) st[2] = xb_add(&bar[XB_XCNT(b.x)], 1u);
    return b;
}
__device__ __forceinline__ void xcd_barrier_complete(unsigned* bar, unsigned x, unsigned& nloc, unsigned& nx) {
    const unsigned G = gridDim.x * gridDim.y * gridDim.z;
    unsigned sum, cnt, mine, sp = 0u;
    for (;;) {
        sum = 0u; cnt = 0u; mine = 0u;
#pragma unroll
        for (unsigned j = 0; j < 16; ++j) { const unsigned c = xb_ld(&bar[XB_XCNT(j)]); sum += c; cnt += (c > 0u) ? 1u : 0u; mine = (j == x) ? c : mine; }
        if (sum == G) break;
        __builtin_amdgcn_s_sleep(1);
        if ((++sp & 255u) == 0u) { if (xb_ld(&bar[XB_TMO])) break; if (sp > XB_SPIN_CAP) { atomicAdd(&bar[XB_TMO], 1u); break; } }
    }
    nloc = mine > 0u ? mine : 1u; nx = cnt > 0u ? cnt : 1u;
}
__device__ __forceinline__ void xcd_barrier(const XcdBarrier& b) {
    asm volatile("s_waitcnt vmcnt(0)" ::: "memory");
    __syncthreads();
    if (threadIdx.x == 0) {
        unsigned* bar = b.bar;
        __builtin_amdgcn_s_waitcnt(0);
        unsigned nloc = b.st[0], nx = b.st[1];
        if (nloc == 0u) { xcd_barrier_complete(bar, b.x, nloc, nx); b.st[0] = nloc; b.st[1] = nx; }
        const unsigned old = xb_add(&bar[XB_XSUB(b.x)], 1u);
        const unsigned gen = old / nloc;
        if (old + 1u == (gen + 1u) * nloc) {
            __builtin_amdgcn_fence(__ATOMIC_RELEASE, "agent");
            asm volatile("s_waitcnt vmcnt(0)" ::: "memory");
            const unsigned og = xb_add(&bar[XB_TOP], 1u);
            const unsigned tg = og / nx;
            if (og + 1u == (tg + 1u) * nx) xb_add(&bar[XB_TOPGEN], 1u);
            else XB_SPIN(xb_ld(&bar[XB_TOPGEN]) == tg, bar);
            __builtin_amdgcn_fence(__ATOMIC_ACQUIRE, "agent");
            xb_add(&bar[XB_XGEN(b.x)], 1u);
            asm volatile("s_waitcnt vmcnt(0)" ::: "memory");
        } else {
            XB_SPIN(xb_ld(&bar[XB_XGEN(b.x)]) == gen, bar);
            __builtin_amdgcn_fence(__ATOMIC_ACQUIRE, "agent");
            asm volatile("s_waitcnt vmcnt(0)" ::: "memory");
        }
    }
    __syncthreads();
}

struct Args { const float* in[21]; float* out; unsigned char* ws; int ph_lo, ph_hi; };

struct Frame {
    LAS unsigned char* lds; int tid, lane, wave, G, bid;
    const float *x, *c, *ctx, *c_ctx, *w_mod, *b_mod, *n1g, *n2g, *w_in, *pool_w, *pool_scale, *lb_logits, *hg_norm_g, *w_a, *w_b, *w_o, *wq, *keys, *pu, *pv, *final_g;
    float* out; unsigned char* ws;
};

__device__ __forceinline__ void p0_transpose_item(const float* W, int K, int N, bf16* WT, LAS float* scr, int item, int lane) {
    const int nblk = N / 32, kb = item / nblk, nb = item % nblk, k0 = 64 * kb, n0 = 32 * nb;
#pragma unroll 8
    for (int i = 0; i < 32; ++i) { const int kk = 2 * i + (lane >> 5); scr[kk * 33 + (lane & 31)] = W[(size_t)(k0 + kk) * N + n0 + (lane & 31)]; }
    LDS_WAIT(); asm volatile("" ::: "memory");
    const int c = lane & 7;
#pragma unroll
    for (int j = 0; j < 4; ++j) { const int n = (lane >> 3) + 8 * j; const LAS float* s = scr + (8 * c) * 33 + n;
        v4u o; o.x = pk2(s[0 * 33], s[1 * 33]); o.y = pk2(s[2 * 33], s[3 * 33]); o.z = pk2(s[4 * 33], s[5 * 33]); o.w = pk2(s[6 * 33], s[7 * 33]);
        *(GAS v4u*)(WT + (size_t)(n0 + n) * K + k0 + 8 * c) = o; }
    LDS_WAIT(); asm volatile("" ::: "memory");
}

__device__ __forceinline__ void p0_prologue(Frame& F) {
    float* mod = (float*)(F.ws + WS_MOD);
    if (F.bid < 192) {
        LAS float* sl = (LAS float*)(F.lds + 81920);
        LAS float* red = (LAS float*)(F.lds + 81920 + 20480);
        for (int i = F.tid; i < 5 * 1024; i += NTHREADS) { const float cv = (i < 4096) ? F.c[i] : F.c_ctx[i - 4096]; sl[i] = cv * sigmoidf_(cv); }
        __syncthreads();
        const int col = F.tid & 31, kg = F.tid >> 5, col0 = 32 * F.bid;
        float a0 = 0.f, a1 = 0.f, a2 = 0.f, a3 = 0.f, a4 = 0.f;
        const float* wp = F.w_mod + (size_t)(kg * 64) * 6144 + col0 + col;
#pragma unroll 8
        for (int r = 0; r < 64; ++r) { const float w = wp[(size_t)r * 6144]; const int k = kg * 64 + r;
            a0 += w * sl[k]; a1 += w * sl[1024 + k]; a2 += w * sl[2048 + k]; a3 += w * sl[3072 + k]; a4 += w * sl[4096 + k]; }
        red[(kg * 5 + 0) * 32 + col] = a0; red[(kg * 5 + 1) * 32 + col] = a1; red[(kg * 5 + 2) * 32 + col] = a2; red[(kg * 5 + 3) * 32 + col] = a3; red[(kg * 5 + 4) * 32 + col] = a4;
        __syncthreads();
        if (F.tid < 160) { const int v = F.tid >> 5, cc = F.tid & 31; float s = 0.f;
#pragma unroll
            for (int g = 0; g < 16; ++g) s += red[(g * 5 + v) * 32 + cc];
            mod[v * 6144 + col0 + cc] = s + F.b_mod[col0 + cc]; }
        __syncthreads();
    }
    LAS float* scr = (LAS float*)(F.lds + F.wave * 8448);
    const int gw = F.bid * NWAVES + F.wave, NGW = F.G * NWAVES;
    constexpr int I_IN = (D / 64) * (INW / 32), I_A = (512 / 64) * (D / 32), I_O = (D / 64) * (D / 32), I_Q = (D / 64) * (2048 / 32), I_P = (128 / 64) * (128 / 32);
    constexpr int NITEMS = I_IN + 2 * I_A + I_O + I_Q + 4 * I_P;
    for (int it = gw; it < NITEMS; it += NGW) {
        int r = it;
        if (r < I_IN) { p0_transpose_item(F.w_in, D, INW, (bf16*)(F.ws + WS_WIN), scr, r, F.lane); continue; } r -= I_IN;
        if (r < I_A) { p0_transpose_item(F.w_a, 512, D, (bf16*)(F.ws + WS_WA), scr, r, F.lane); continue; } r -= I_A;
        if (r < I_A) { p0_transpose_item(F.w_b, 512, D, (bf16*)(F.ws + WS_WB), scr, r, F.lane); continue; } r -= I_A;
        if (r < I_O) { p0_transpose_item(F.w_o, D, D, (bf16*)(F.ws + WS_WO), scr, r, F.lane); continue; } r -= I_O;
        if (r < I_Q) { p0_transpose_item(F.wq, D, 2048, (bf16*)(F.ws + WS_WQ), scr, r, F.lane); continue; } r -= I_Q;
        { const int g = r / I_P; p0_transpose_item(F.pool_w + (size_t)g * 128 * 128, 128, 128, (bf16*)(F.ws + WS_POOLW) + (size_t)g * 128 * 128, scr, r % I_P, F.lane); }
    }
    { bf16* kb = (bf16*)(F.ws + WS_KEYS); const int gt = F.bid * NTHREADS + F.tid, NT = F.G * NTHREADS;
      for (int i = gt; i < 16 * 128 * 128 / 4; i += NT) { const f32x4 v = ((const GAS f32x4*)F.keys)[i]; v2u o; o.x = pk2(v.x, v.y); o.y = pk2(v.z, v.w); ((GAS v2u*)kb)[i] = o; }
      float* lbt = (float*)(F.ws + WS_LBT);
      if (gt < 1024) { const int dir = gt >> 9, cc = gt & 511; const float l0 = F.lb_logits[(dir * 2 + 0) * 512 + cc], l1 = F.lb_logits[(dir * 2 + 1) * 512 + cc];
          lbt[gt] = 1.f / (1.f + expf(l1 - l0)); } }
}

__device__ __forceinline__ void modulate_row(const float* xrow, bf16* orow, const float* g, const float* shift, const float* scale, int lane) {
    const GAS f32x4* xr = (const GAS f32x4*)xrow + lane;
    f32x4 v[4]; float s2 = 0.f;
#pragma unroll
    for (int j = 0; j < 4; ++j) { v[j] = xr[64 * j]; s2 += (v[j].x * v[j].x + v[j].y * v[j].y) + (v[j].z * v[j].z + v[j].w * v[j].w); }
    const float rstd = 1.f / sqrtf(wave_sum(s2) * (1.f / D) + EPS);
    GAS v2u* o8 = (GAS v2u*)orow + lane;
#pragma unroll
    for (int j = 0; j < 4; ++j) {
        const f32x4 gg = ((const GAS f32x4*)g)[lane + 64 * j], sh = ((const GAS f32x4*)shift)[lane + 64 * j], sc = ((const GAS f32x4*)scale)[lane + 64 * j];
        const f32x4 y = (v[j] * rstd) * gg * (sc + 1.0f) + sh;
        v2u o; o.x = pk2(y.x, y.y); o.y = pk2(y.z, y.w); o8[64 * j] = o; }
}
__device__ __forceinline__ void p1_modulate(Frame& F) {
    const float* mod = (const float*)(F.ws + WS_MOD); bf16* H = (bf16*)(F.ws + WS_H);
    const int gw = F.bid * NWAVES + F.wave, NGW = F.G * NWAVES;
    for (int m = gw; m < MH; m += NGW) {
        const int v = (m < ML) ? (m >> 12) : 4;
        const float* xr = (m < ML) ? F.x + (size_t)m * D : F.ctx + (size_t)(m - ML) * D;
        modulate_row(xr, H + (size_t)m * D, F.n1g, mod + v * 6144 + 0, mod + v * 6144 + 1024, F.lane);
    }
}

using pg8::Unit;
struct SchedPlain {
    const char* Ab; const char* Bb; int nM, nN, K, G, c;
    __device__ __forceinline__ bool next(int i, Unit& u) const { const int L = i * G + c; if (L >= nM * nN) return false; pg8::tile_of(L, nM, nN, u.pm, u.pn); u.seg = 0; return true; }
    __device__ __forceinline__ const char* A(const Unit& u) const { return Ab + (size_t)u.pm * 256 * K * 2; }
    __device__ __forceinline__ const char* B(const Unit& u) const { return Bb + (size_t)u.pn * 256 * K * 2; }
    __device__ __forceinline__ bool keep(const Unit&) const { return false; }
};
struct SchedIn {
    const char* Ab; const char* Bb; int G, c;
    __device__ __forceinline__ bool next(int i, Unit& u) const { const int L = i * G + c; u.seg = 0;
        if (L < 1280) { pg8::tile_of(L, 64, 20, u.pm, u.pn); return true; }
        if (L < 1304) { const int l = L - 1280; u.pm = 64 + (l & 3); u.pn = 4 + (l >> 2); return true; }
        return false; }
    __device__ __forceinline__ const char* A(const Unit& u) const { return Ab + (size_t)u.pm * 256 * D * 2; }
    __device__ __forceinline__ const char* B(const Unit& u) const { return Bb + (size_t)u.pn * 256 * D * 2; }
    __device__ __forceinline__ bool keep(const Unit&) const { return false; }
};
struct SchedMerge {
    const char *A0, *A1, *B0, *B1; int G, c;
    __device__ __forceinline__ bool next(int i, Unit& u) const { const int tile = (i >> 1) * G + c; if (tile >= 256) return false; pg8::tile_of(tile, 64, 4, u.pm, u.pn); u.seg = i & 1; return true; }
    __device__ __forceinline__ const char* A(const Unit& u) const { return (u.seg ? A1 : A0) + (size_t)u.pm * 256 * 512 * 2; }
    __device__ __forceinline__ const char* B(const Unit& u) const { return (u.seg ? B1 : B0) + (size_t)u.pn * 256 * 512 * 2; }
    __device__ __forceinline__ bool keep(const Unit& u) const { return u.seg == 0; }
};

struct EpiZ {
    static constexpr bool PERM = true;
    bf16* Z; bf16* ZC;
    __device__ __forceinline__ void operator()(pg8::f32x4 (&acc)[2][2][4][2], const Unit& u, int wr, int wc, int fr, int fq) const {
        int row0 = u.pm * 256 + wr * 64 + fr, col0 = u.pn * 256 + wc * 32 + 8 * fq, ldc = INW; bf16* base = Z;
        if (u.pm >= 64) { base = ZC; row0 -= ML; col0 -= 1024; ldc = ZC_W; }
        const bool sg = u.pn >= 12;
#pragma unroll
        for (int ai = 0; ai < 2; ++ai)
#pragma unroll
            for (int m = 0; m < 4; ++m) { bf16* rowp = base + (size_t)(row0 + ai * 128 + m * 16) * ldc + col0;
#pragma unroll
                for (int bj = 0; bj < 2; ++bj) { pg8::f32x4 v0 = acc[ai][bj][m][0], v1 = acc[ai][bj][m][1];
                    if (sg) {
#pragma unroll
                        for (int j = 0; j < 4; ++j) { v0[j] = sigmoidf_(v0[j]); v1[j] = sigmoidf_(v1[j]); } }
                    v4u w; w.x = pk2(v0[0], v0[1]); w.y = pk2(v0[2], v0[3]); w.z = pk2(v1[0], v1[1]); w.w = pk2(v1[2], v1[3]);
                    *(GAS v4u*)(rowp + bj * 128) = w; } }
    }
};
struct EpiPlain {
    static constexpr bool PERM = true;
    bf16* O; int ldc;
    __device__ __forceinline__ void operator()(pg8::f32x4 (&acc)[2][2][4][2], const Unit& u, int wr, int wc, int fr, int fq) const {
        const int row0 = u.pm * 256 + wr * 64 + fr, col0 = u.pn * 256 + wc * 32 + 8 * fq;
#pragma unroll
        for (int ai = 0; ai < 2; ++ai)
#pragma unroll
            for (int m = 0; m < 4; ++m) { bf16* rowp = O + (size_t)(row0 + ai * 128 + m * 16) * ldc + col0;
#pragma unroll
                for (int bj = 0; bj < 2; ++bj) { const pg8::f32x4 v0 = acc[ai][bj][m][0], v1 = acc[ai][bj][m][1];
                    v4u w; w.x = pk2(v0[0], v0[1]); w.y = pk2(v0[2], v0[3]); w.z = pk2(v1[0], v1[1]); w.w = pk2(v1[2], v1[3]);
                    *(GAS v4u*)(rowp + bj * 128) = w; } }
    }
};
struct EpiMerge {
    static constexpr bool PERM = true;
    const bf16* Z; bf16* Mo;
    __device__ __forceinline__ void operator()(pg8::f32x4 (&acc)[2][2][4][2], const Unit& u, int wr, int wc, int fr, int fq) const {
        const int row0 = u.pm * 256 + wr * 64 + fr, col0 = u.pn * 256 + wc * 32 + 8 * fq;
#pragma unroll
        for (int ai = 0; ai < 2; ++ai)
#pragma unroll
            for (int m = 0; m < 4; ++m) { const size_t r = (size_t)(row0 + ai * 128 + m * 16);
#pragma unroll
                for (int bj = 0; bj < 2; ++bj) { const int c = col0 + bj * 128;
                    const v4u gh = *(const GAS v4u*)(Z + r * INW + 4096 + c);
                    float h[8] = {bflo(gh.x), bfhi(gh.x), bflo(gh.y), bfhi(gh.y), bflo(gh.z), bfhi(gh.z), bflo(gh.w), bfhi(gh.w)};
                    if (u.seg == 0) {
                        const v4u gp = *(const GAS v4u*)(Z + r * INW + 3072 + c);
                        float p[8] = {bflo(gp.x), bfhi(gp.x), bflo(gp.y), bfhi(gp.y), bflo(gp.z), bfhi(gp.z), bflo(gp.w), bfhi(gp.w)};
#pragma unroll
                        for (int j = 0; j < 4; ++j) { acc[ai][bj][m][0][j] *= p[j] * fast_rcp(h[j]); acc[ai][bj][m][1][j] *= p[4 + j] * fast_rcp(h[4 + j]); }
                    } else {
                        pg8::f32x4 v0 = acc[ai][bj][m][0], v1 = acc[ai][bj][m][1];
#pragma unroll
                        for (int j = 0; j < 4; ++j) { v0[j] *= h[j]; v1[j] *= h[4 + j]; }
                        v4u w; w.x = pk2(v0[0], v0[1]); w.y = pk2(v0[2], v0[3]); w.z = pk2(v1[0], v1[1]); w.w = pk2(v1[2], v1[3]);
                        *(GAS v4u*)(Mo + r * D + c) = w; } } }
    }
};
struct EpiRes {
    static constexpr bool PERM = false;
    const float* X; const float* mod; float* O;
    __device__ __forceinline__ void operator()(pg8::f32x4 (&acc)[2][2][4][2], const Unit& u, int wr, int wc, int fr, int fq) const {
        const int row0 = u.pm * 256 + wr * 64 + fr, col0 = u.pn * 256 + wc * 32 + 4 * fq;
        const float* g1 = mod + (size_t)(u.pm >> 4) * 6144 + 2048;
        pg8::f32x4 gv[2][2];
#pragma unroll
        for (int bj = 0; bj < 2; ++bj)
#pragma unroll
            for (int n = 0; n < 2; ++n) gv[bj][n] = *(const GAS pg8::f32x4*)(g1 + col0 + bj * 128 + n * 16);
#pragma unroll
        for (int ai = 0; ai < 2; ++ai)
#pragma unroll
            for (int m = 0; m < 4; ++m) { const size_t off = (size_t)(row0 + ai * 128 + m * 16) * D + col0;
#pragma unroll
                for (int bj = 0; bj < 2; ++bj)
#pragma unroll
                    for (int n = 0; n < 2; ++n) { const pg8::f32x4 xv = *(const GAS pg8::f32x4*)(X + off + bj * 128 + n * 16);
                        *(GAS pg8::f32x4*)(O + off + bj * 128 + n * 16) = xv + gv[bj][n] * acc[ai][bj][m][n]; }
                asm volatile("" ::: "memory"); }
    }
};

__device__ __forceinline__ unsigned off_b(unsigned row, unsigned ch) { return 256u * row + 16u * (ch ^ (((row & 3) << 2) | ((row >> 2) & 3))); }
__device__ __forceinline__ unsigned row_addr16(unsigned lane, unsigned rb, unsigned s) { return off_b((lane & 15) + 16 * rb, 4 * s + (lane >> 4)); }
__device__ __forceinline__ unsigned tr_addr16(unsigned lane, unsigned c, unsigned t) { const unsigned g = lane >> 4, q = (lane & 15) >> 2, p = lane & 3; return off_b(8 * g + 4 * t + q, 2 * c + (p >> 1)) + 8 * (p & 1); }
__device__ __forceinline__ bf16x8 tr_frag(LAS unsigned char* tile, unsigned lane, unsigned c) {
    const s16x4 lo = __builtin_amdgcn_ds_read_tr16_b64_v4i16((LAS s16x4*)(tile + tr_addr16(lane, c, 0)));
    const s16x4 hi = __builtin_amdgcn_ds_read_tr16_b64_v4i16((LAS s16x4*)(tile + tr_addr16(lane, c, 1)));
    return __builtin_shufflevector(lo, hi, 0, 1, 2, 3, 4, 5, 6, 7);
}
#define MFMA16(a, b, c) __builtin_amdgcn_mfma_f32_16x16x32_bf16((a), (b), (c), 0, 0, 0)

constexpr int SC_QT = 0, SC_KT = 8192, SC_KD = 16384, SC_VT = 24576, SC_ATT = 32768, SC_EL = 35328, SC_WT = 35840;

__device__ __forceinline__ void scan_unit(Frame& F, int u) {
    const int tid = F.tid, lane = F.lane, w = F.wave, q = lane >> 4;
    const bool isctx = u >= NSCAN_L;
    int b, h, dir, rowbase, nch; const bf16* src; int ld, cq, ci, cf;
    if (!isctx) { const int j = u & 7; dir = (u >> 3) & 1; h = (u >> 4) & 3; b = u >> 6; const int tb = dir ? 7 - j : j;
        rowbase = b * SEQ + tb * SEGT; nch = SEGT / CHT; src = (const bf16*)(F.ws + WS_Z); ld = INW; cq = 512 + h * 128; ci = 1024 + h * 128; cf = (dir ? 2048 : 1536) + h * 128; }
    else { const int v = u - NSCAN_L, cs = v & (NCSEG - 1); dir = (v >> 2) & 1; h = (v >> 3) & 3; b = v >> 5;
        rowbase = b * CTXL + (dir ? NCSEG - 1 - cs : cs) * (CTXL / NCSEG); nch = CTXL / NCSEG / CHT; src = (const bf16*)(F.ws + WS_ZC); ld = ZC_W; ci = h * 128; cq = ci; cf = (dir ? 1024 : 512) + h * 128; }
    const int t = tid >> 4, k8 = tid & 15;
    const int pl = dir ? 3 - q : q;
    const float* lbt = (const float*)(F.ws + WS_LBT) + dir * 512 + h * 128 + 8 * k8;
    float lb[8], ecum[8];
#pragma unroll
    for (int i = 0; i < 8; ++i) { lb[i] = lbt[i]; ecum[i] = 1.f; }
    f32x4 S[8];
#pragma unroll
    for (int i = 0; i < 8; ++i) S[i] = (f32x4){0.f, 0.f, 0.f, 0.f};
    LAS unsigned char* L = F.lds;
    bf16* qseg = (bf16*)((unsigned char*)F.out + OUT_QSEG) + (size_t)dir * ML * 512;
    bf16* oloc = (bf16*)((unsigned char*)F.out + OUT_OLOC);
    v4u qv, vv, fv;
    { const int tc = dir ? nch - 1 : 0; const bf16* rp = src + (size_t)(rowbase + tc * CHT + t) * ld + 8 * k8;
      qv = *(const GAS v4u*)(rp + cq); vv = *(const GAS v4u*)(rp + ci); fv = *(const GAS v4u*)(rp + cf); }
    for (int pc = 0; pc < nch; ++pc) {
        const int tc = dir ? nch - 1 - pc : pc;
        const v4u q0 = qv, v0 = vv, f0 = fv;
        if (pc + 1 < nch) { const int tn = dir ? tc - 1 : tc + 1; const bf16* rp = src + (size_t)(rowbase + tn * CHT + t) * ld + 8 * k8;
            qv = *(const GAS v4u*)(rp + cq); vv = *(const GAS v4u*)(rp + ci); fv = *(const GAS v4u*)(rp + cf); }
        float fr_[8] = {bflo(f0.x), bfhi(f0.x), bflo(f0.y), bfhi(f0.y), bflo(f0.z), bfhi(f0.z), bflo(f0.w), bfhi(f0.w)};
        float e[8], kk[8];
#pragma unroll
        for (int i = 0; i < 8; ++i) { const float s = sigmoidf_(fr_[i]); const float om = 1.f - lb[i]; e[i] = lb[i] + om * s; kk[i] = om * (1.f - s); }
        { const int s1 = dir ? lane + 16 : lane - 16, s2 = dir ? lane + 32 : lane - 32;
#pragma unroll
          for (int i = 0; i < 8; ++i) { const float o = __shfl(e[i], s1 & 63); e[i] = (pl >= 1) ? e[i] * o : e[i]; }
#pragma unroll
          for (int i = 0; i < 8; ++i) { const float o = __shfl(e[i], s2 & 63); e[i] = (pl >= 2) ? e[i] * o : e[i]; } }
        if (pl == 3) { LAS f32x4* wt = (LAS f32x4*)(L + SC_WT + (w * 128 + 8 * k8) * 4); wt[0] = (f32x4){e[0], e[1], e[2], e[3]}; wt[1] = (f32x4){e[4], e[5], e[6], e[7]}; }
        LBAR();
        float etot[8];
        { float pre[8];
#pragma unroll
          for (int i = 0; i < 8; ++i) { pre[i] = 1.f; etot[i] = 1.f; }
#pragma unroll
          for (int ww = 0; ww < 8; ++ww) { const LAS f32x4* wt = (const LAS f32x4*)(L + SC_WT + (ww * 128 + 8 * k8) * 4); const f32x4 a = wt[0], c = wt[1];
              const float x[8] = {a.x, a.y, a.z, a.w, c.x, c.y, c.z, c.w};
              const bool before = dir ? (ww > w) : (ww < w);
#pragma unroll
              for (int i = 0; i < 8; ++i) { etot[i] *= x[i]; pre[i] = before ? pre[i] * x[i] : pre[i]; } }
#pragma unroll
          for (int i = 0; i < 8; ++i) e[i] *= pre[i]; }
        {
            const float qf[8] = {bflo(q0.x), bfhi(q0.x), bflo(q0.y), bfhi(q0.y), bflo(q0.z), bfhi(q0.z), bflo(q0.w), bfhi(q0.w)};
            float qt[8], kt[8], kd[8];
#pragma unroll
            for (int i = 0; i < 8; ++i) { qt[i] = qf[i] * e[i]; kt[i] = kk[i] * fast_rcp(e[i]); kd[i] = kt[i] * etot[i]; }
            const unsigned ob = off_b((unsigned)t, (unsigned)k8);
            v4u o; o.x = pk2(qt[0], qt[1]); o.y = pk2(qt[2], qt[3]); o.z = pk2(qt[4], qt[5]); o.w = pk2(qt[6], qt[7]); *(LAS v4u*)(L + SC_QT + ob) = o;
            o.x = pk2(kt[0], kt[1]); o.y = pk2(kt[2], kt[3]); o.z = pk2(kt[4], kt[5]); o.w = pk2(kt[6], kt[7]); *(LAS v4u*)(L + SC_KT + ob) = o;
            o.x = pk2(kd[0], kd[1]); o.y = pk2(kd[2], kd[3]); o.z = pk2(kd[4], kd[5]); o.w = pk2(kd[6], kd[7]); *(LAS v4u*)(L + SC_KD + ob) = o;
            *(LAS v4u*)(L + SC_VT + ob) = v0;
            if (!isctx) { o.x = pk2(qt[0] * ecum[0], qt[1] * ecum[1]); o.y = pk2(qt[2] * ecum[2], qt[3] * ecum[3]); o.z = pk2(qt[4] * ecum[4], qt[5] * ecum[5]); o.w = pk2(qt[6] * ecum[6], qt[7] * ecum[7]);
                *(GAS v4u*)(qseg + (size_t)(rowbase + tc * CHT + t) * 512 + h * 128 + 8 * k8) = o; }
            if (t == 0) { LAS f32x4* el = (LAS f32x4*)(L + SC_EL + 32 * k8); el[0] = (f32x4){etot[0], etot[1], etot[2], etot[3]}; el[1] = (f32x4){etot[4], etot[5], etot[6], etot[7]}; }
#pragma unroll
            for (int i = 0; i < 8; ++i) ecum[i] *= etot[i];
        }
        LBAR();
        if (w < 4 && !isctx) {
            const int tt = dir ? (w >> 1) : ((w + 1) >> 1), st = dir ? ((w + 1) >> 1) : (w >> 1);
            const int tz = dir ? 1 : 0, sz = dir ? 0 : 1;
            f32x4 a = (f32x4){0.f, 0.f, 0.f, 0.f};
            if (w < 3) {
#pragma unroll
                for (int s = 0; s < 4; ++s) { const bf16x8 A = *(const LAS bf16x8*)(L + SC_QT + row_addr16(lane, tt, s)); const bf16x8 B = *(const LAS bf16x8*)(L + SC_KT + row_addr16(lane, st, s)); a = MFMA16(A, B, a); }
            }
            const int tr = (w < 3 ? tt : tz) * 16 + 4 * q, sc = (w < 3 ? st : sz) * 16 + (lane & 15);
#pragma unroll
            for (int j = 0; j < 4; ++j) { const int ti = tr + j; const bool ok = (w < 3) && (dir ? (sc >= ti) : (sc <= ti));
                *(LAS unsigned short*)(L + SC_ATT + ti * 80 + sc * 2) = (unsigned short)f2bf(ok ? a[j] : 0.f); }
        }
        LBAR();
        {
            const bf16x8 Bv = tr_frag(L + SC_VT, lane, w);
            if (!isctx) {
#pragma unroll 1
                for (int tt = 0; tt < 2; ++tt) {
                    f32x4 o = (f32x4){0.f, 0.f, 0.f, 0.f};
                    const unsigned row = 16 * tt + (lane & 15);
#pragma unroll
                    for (int s = 0; s < 4; ++s) {
                        const v2u alo = *(const LAS v2u*)(L + SC_QT + off_b(row, 4 * s + (q >> 1)) + 8 * (q & 1));
                        const v2u ahi = *(const LAS v2u*)(L + SC_QT + off_b(row, 4 * s + 2 + (q >> 1)) + 8 * (q & 1));
                        const v4u av = (v4u){alo.x, alo.y, ahi.x, ahi.y};
                        v4u bv; bv.x = pk2(S[2 * s][0], S[2 * s][1]); bv.y = pk2(S[2 * s][2], S[2 * s][3]); bv.z = pk2(S[2 * s + 1][0], S[2 * s + 1][1]); bv.w = pk2(S[2 * s + 1][2], S[2 * s + 1][3]);
                        o = MFMA16(__builtin_bit_cast(bf16x8, av), __builtin_bit_cast(bf16x8, bv), o);
                    }
                    const bf16x8 At = *(const LAS bf16x8*)(L + SC_ATT + row * 80 + 16 * q);
                    o = MFMA16(At, Bv, o);
                    const int ttg = (rowbase + tc * CHT + 16 * tt) >> 4;
                    v2u ov; ov.x = pk2(o[0], o[1]); ov.y = pk2(o[2], o[3]);
                    *(GAS v2u*)(oloc + ((((size_t)(dir * 1024 + ttg) * 4 + h) * 8 + w) * 64 + lane) * 4) = ov;
                }
            }
#pragma unroll
            for (int kt = 0; kt < 8; ++kt) {
                const bf16x8 A = tr_frag(L + SC_KD, lane, kt);
                const f32x4 a4 = *(const LAS f32x4*)(L + SC_EL + (16 * kt + 4 * q) * 4);
                S[kt] = MFMA16(A, Bv, S[kt] * a4);
            }
        }
    }
    { float* us = (float*)(F.ws + WS_USEG) + (size_t)u * 128 * 128 + (4 * q) * 128 + 16 * w + (lane & 15);
#pragma unroll
      for (int kt = 0; kt < 8; ++kt) {
#pragma unroll
          for (int j = 0; j < 4; ++j) us[j * 128] = S[kt][j];
          us += 16 * 128; asm volatile("" : "+v"(us)); }
      if (t == 0) { float* as = (float*)(F.ws + WS_ASEG) + (size_t)u * 128 + 8 * k8;
#pragma unroll
          for (int i = 0; i < 8; ++i) as[i] = ecum[i]; } }
    __syncthreads();
}


constexpr int PL_V = 0, PL_VSTR = 132, PL_D = 34816, PL_DSTR = 272;
#define PL_LOAD8(ra, rd, g_, r0b_, rhi_) do { _Pragma("unroll") for (int u8 = 0; u8 < 8; ++u8) { const int rr_ = min((r0b_) + u8, (rhi_)); \
    const bf16* p_ = Z + (size_t)(b * SEQ + rr_ * 64 + c) * INW + (g_) * 128 + 16 * ch16; ra[u8] = *(const GAS v4u*)p_; rd[u8] = *(const GAS v4u*)(p_ + 8); } } while (0)
#define PL_CONSUME8(ra, rd, r0b_, rhi_) do { _Pragma("unroll") for (int u8 = 0; u8 < 8; ++u8) { const int rr_ = (r0b_) + u8; const bool in_ = rr_ <= (rhi_); const v4u a_ = ra[u8], d_ = rd[u8]; \
    const float x_[16] = {bflo(a_.x), bfhi(a_.x), bflo(a_.y), bfhi(a_.y), bflo(a_.z), bfhi(a_.z), bflo(a_.w), bfhi(a_.w), bflo(d_.x), bfhi(d_.x), bflo(d_.y), bfhi(d_.y), bflo(d_.z), bfhi(d_.z), bflo(d_.w), bfhi(d_.w)}; \
    _Pragma("unroll") for (int i_ = 0; i_ < 16; ++i_) { vs[i_] += in_ ? x_[i_] : 0.f; pc[i_] = (in_ && rr_ == r) ? x_[i_] : pc[i_]; } } } while (0)
__device__ __forceinline__ void pool_unit(Frame& F, int u) {
    const int b = u >> 6, r = u & 63, tid = F.tid, lane = F.lane, w = F.wave, q = lane >> 4;
    const int c = tid >> 3, ch16 = tid & 7;
    const bf16* Z = (const bf16*)(F.ws + WS_Z); bf16* YP = (bf16*)(F.ws + WS_YPOOL);
    LAS unsigned char* L = F.lds;
#pragma unroll 1
    for (int g = 0; g < 4; ++g) {
        v4u ra[8], rd[8];
        const int half = 1 << g;
        const int r_lo = max(0, r - half), r_hi = min(63, r + half - 1), c_lo = max(0, c - half), c_hi = min(63, c + half - 1);
        float vs[16], pc[16];
#pragma unroll
        for (int i = 0; i < 16; ++i) { vs[i] = 0.f; pc[i] = 0.f; }
        PL_LOAD8(ra, rd, g, r_lo, r_hi); PL_CONSUME8(ra, rd, r_lo, r_hi);
        if (g == 3) { PL_LOAD8(ra, rd, 3, r_lo + 8, r_hi); PL_CONSUME8(ra, rd, r_lo + 8, r_hi); }
        { LAS f32x4* vp = (LAS f32x4*)(L + PL_V + (c * PL_VSTR + 16 * ch16) * 4);
#pragma unroll
          for (int i = 0; i < 4; ++i) vp[i] = (f32x4){vs[4 * i], vs[4 * i + 1], vs[4 * i + 2], vs[4 * i + 3]}; }
        LBAR();
        float hs[16];
#pragma unroll
        for (int i = 0; i < 16; ++i) hs[i] = 0.f;
        for (int cc = c_lo; cc <= c_hi; ++cc) { const LAS f32x4* vp = (const LAS f32x4*)(L + PL_V + (cc * PL_VSTR + 16 * ch16) * 4);
#pragma unroll
            for (int i = 0; i < 4; ++i) { const f32x4 x = vp[i]; hs[4 * i] += x.x; hs[4 * i + 1] += x.y; hs[4 * i + 2] += x.z; hs[4 * i + 3] += x.w; } }
        { const float inv = 1.f / (float)((r_hi - r_lo + 1) * (c_hi - c_lo + 1));
          v4u o0, o1;
          o0.x = pk2(hs[0] * inv - pc[0], hs[1] * inv - pc[1]); o0.y = pk2(hs[2] * inv - pc[2], hs[3] * inv - pc[3]); o0.z = pk2(hs[4] * inv - pc[4], hs[5] * inv - pc[5]); o0.w = pk2(hs[6] * inv - pc[6], hs[7] * inv - pc[7]);
          o1.x = pk2(hs[8] * inv - pc[8], hs[9] * inv - pc[9]); o1.y = pk2(hs[10] * inv - pc[10], hs[11] * inv - pc[11]); o1.z = pk2(hs[12] * inv - pc[12], hs[13] * inv - pc[13]); o1.w = pk2(hs[14] * inv - pc[14], hs[15] * inv - pc[15]);
          LAS v4u* dp = (LAS v4u*)(L + PL_D + c * PL_DSTR + 32 * ch16); dp[0] = o0; dp[1] = o1; }
        LBAR();
        { const int tt = w >> 1; const bf16* wt = (const bf16*)(F.ws + WS_POOLW) + (size_t)g * 128 * 128;
          bf16x8 Bd[4];
#pragma unroll
          for (int s = 0; s < 4; ++s) Bd[s] = *(const LAS bf16x8*)(L + PL_D + (16 * tt + (lane & 15)) * PL_DSTR + (32 * s + 8 * q) * 2);
#pragma unroll
          for (int ni = 0; ni < 4; ++ni) { const int nt = 4 * (w & 1) + ni; f32x4 a = (f32x4){0.f, 0.f, 0.f, 0.f};
#pragma unroll
              for (int s = 0; s < 4; ++s) { const bf16x8 A = *(const GAS bf16x8*)(wt + (size_t)(16 * nt + (lane & 15)) * 128 + 32 * s + 8 * q); a = MFMA16(A, Bd[s], a); }
              const f32x4 sc = *(const GAS f32x4*)(F.pool_scale + g * 128 + 16 * nt + 4 * q);
              v2u o; o.x = pk2(a[0] * sc.x, a[1] * sc.y); o.y = pk2(a[2] * sc.z, a[3] * sc.w);
              *(GAS v2u*)(YP + (size_t)(b * SEQ + r * 64 + 16 * tt + (lane & 15)) * 512 + g * 128 + 16 * nt + 4 * q) = o; } }
    }
    __syncthreads();
}

constexpr int FX_SF = 0, FX_SB = 32768, FX_SCR = 65536, FX_SCRSTR = 132;
__device__ __forceinline__ void fix_fold(Frame& F, int b, int h, int dir, int nfold, int soff) {
    const int tid = F.tid, kr = tid >> 4, ch = tid & 15;
    const float* US = (const float*)(F.ws + WS_USEG); const float* AS = (const float*)(F.ws + WS_ASEG);
    const int ubase = ((b * 4 + h) * 2 + dir) * 8;
    float s[4][8], cf[4];
#pragma unroll
    for (int rr = 0; rr < 4; ++rr) { cf[rr] = 1.f;
#pragma unroll
        for (int e = 0; e < 8; ++e) s[rr][e] = 0.f; }
#pragma unroll 2
    for (int j = nfold - 1; j >= -NCSEG; --j) {
        const int u = (j >= 0) ? ubase + j : NSCAN_L + ((b * 4 + h) * 2 + dir) * NCSEG + (j + NCSEG);
#pragma unroll
        for (int rr = 0; rr < 4; ++rr) { const int k = kr + 32 * rr; const float* p = US + ((size_t)u * 128 + k) * 128 + 8 * ch; const f32x4 a = *(const GAS f32x4*)p, c = *(const GAS f32x4*)(p + 4);
            const float al = AS[u * 128 + k], w = cf[rr];
            s[rr][0] += w * a.x; s[rr][1] += w * a.y; s[rr][2] += w * a.z; s[rr][3] += w * a.w; s[rr][4] += w * c.x; s[rr][5] += w * c.y; s[rr][6] += w * c.z; s[rr][7] += w * c.w;
            cf[rr] = w * al; } }
#pragma unroll
    for (int rr = 0; rr < 4; ++rr) { v4u o; o.x = pk2(s[rr][0], s[rr][1]); o.y = pk2(s[rr][2], s[rr][3]); o.z = pk2(s[rr][4], s[rr][5]); o.w = pk2(s[rr][6], s[rr][7]);
        *(LAS v4u*)(F.lds + soff + rr * 8192 + off_b((unsigned)kr, (unsigned)ch)) = o; }
}
__device__ __forceinline__ void fix_unit(Frame& F, int u) {
    const int tb = u & 7, h = (u >> 3) & 3, b = u >> 5, lane = F.lane, w = F.wave, q = lane >> 4;
    LAS unsigned char* L = F.lds;
    fix_fold(F, b, h, 0, tb, FX_SF);
    fix_fold(F, b, h, 1, 7 - tb, FX_SB);
    __syncthreads();
    const bf16* Z = (const bf16*)(F.ws + WS_Z); bf16* YH = (bf16*)(F.ws + WS_YHG);
    const bf16* qseg = (const bf16*)((const unsigned char*)F.out + OUT_QSEG); const bf16* oloc = (const bf16*)((const unsigned char*)F.out + OUT_OLOC);
    LAS float* scr = (LAS float*)(L + FX_SCR + w * (16 * FX_SCRSTR * 4));
    const int row0 = b * SEQ + tb * SEGT;
#pragma unroll 1
    for (int ti = 0; ti < 4; ++ti) {
        const int tt = 4 * w + ti, rowt = row0 + 16 * tt;
        f32x4 acc[8];
#pragma unroll
        for (int c = 0; c < 8; ++c) acc[c] = (f32x4){0.f, 0.f, 0.f, 0.f};
        bf16x8 A[2][4]; v2u ol[2][8]; v4u ogv[4];
        const int tl = lane >> 2, v0 = 32 * (lane & 3);
#pragma unroll
        for (int dir = 0; dir < 2; ++dir)
#pragma unroll
            for (int s = 0; s < 4; ++s) A[dir][s] = *(const GAS bf16x8*)(qseg + ((size_t)dir * ML + rowt + (lane & 15)) * 512 + h * 128 + 32 * s + 8 * q);
#pragma unroll
        for (int dir = 0; dir < 2; ++dir)
#pragma unroll
            for (int c = 0; c < 8; ++c) ol[dir][c] = *(const GAS v2u*)(oloc + ((((size_t)(dir * 1024 + (rowt >> 4)) * 4 + h) * 8 + c) * 64 + lane) * 4);
#pragma unroll
        for (int i = 0; i < 4; ++i) ogv[i] = *(const GAS v4u*)(Z + (size_t)(rowt + tl) * INW + 2560 + h * 128 + v0 + 8 * i);
#pragma unroll
        for (int dir = 0; dir < 2; ++dir) {
#pragma unroll
            for (int s = 0; s < 4; ++s)
#pragma unroll
                for (int c = 0; c < 8; ++c) { const bf16x8 B = tr_frag(L + (dir ? FX_SB : FX_SF) + s * 8192, lane, c); acc[c] = MFMA16(A[dir][s], B, acc[c]); }
        }
#pragma unroll
        for (int dir = 0; dir < 2; ++dir)
#pragma unroll
            for (int c = 0; c < 8; ++c) { const v2u ov = ol[dir][c];
                acc[c][0] += bflo(ov.x); acc[c][1] += bfhi(ov.x); acc[c][2] += bflo(ov.y); acc[c][3] += bfhi(ov.y); }
        float ss[4];
#pragma unroll
        for (int j = 0; j < 4; ++j) { float s = 0.f;
#pragma unroll
            for (int c = 0; c < 8; ++c) s += acc[c][j] * acc[c][j];
            s += __shfl_xor(s, 1); s += __shfl_xor(s, 2); s += __shfl_xor(s, 4); s += __shfl_xor(s, 8);
            ss[j] = 1.f / sqrtf(s * (1.f / 128.f) + EPS); }
#pragma unroll
        for (int c = 0; c < 8; ++c)
#pragma unroll
            for (int j = 0; j < 4; ++j) scr[(4 * q + j) * FX_SCRSTR + 16 * c + (lane & 15)] = acc[c][j] * ss[j];
        LDS_WAIT();
        { const size_t row = (size_t)(rowt + tl);
          bf16* yo = YH + row * 512 + h * 128 + v0;
#pragma unroll
          for (int i = 0; i < 4; ++i) {
              const f32x4 a = *(const LAS f32x4*)(scr + tl * FX_SCRSTR + v0 + 8 * i), c2 = *(const LAS f32x4*)(scr + tl * FX_SCRSTR + v0 + 8 * i + 4);
              const v4u g = ogv[i];
              const f32x4 n0 = *(const GAS f32x4*)(F.hg_norm_g + v0 + 8 * i), n1 = *(const GAS f32x4*)(F.hg_norm_g + v0 + 8 * i + 4);
              const float gg[8] = {bflo(g.x), bfhi(g.x), bflo(g.y), bfhi(g.y), bflo(g.z), bfhi(g.z), bflo(g.w), bfhi(g.w)};
              const float yv[8] = {a.x * n0.x, a.y * n0.y, a.z * n0.z, a.w * n0.w, c2.x * n1.x, c2.y * n1.y, c2.z * n1.z, c2.w * n1.w};
              float o[8];
#pragma unroll
              for (int e = 0; e < 8; ++e) o[e] = yv[e] * gg[e] * sigmoidf_(gg[e]);
              v4u ov; ov.x = pk2(o[0], o[1]); ov.y = pk2(o[2], o[3]); ov.z = pk2(o[4], o[5]); ov.w = pk2(o[6], o[7]);
              *(GAS v4u*)(yo + 8 * i) = ov; } }
        LDS_WAIT();
    }
    __syncthreads();
}

__device__ __forceinline__ void fp8_rows(const float* src, unsigned char* dst, float* inv_scale, int gw, int NGW, int lane) {
    for (int r = gw; r < NEXP; r += NGW) {
        const GAS f32x4* p = (const GAS f32x4*)(src + (size_t)r * D + 16 * lane);
        const f32x4 a = p[0], b = p[1], c = p[2], d = p[3];
        float m = fmaxf(fmaxf(fmaxf(fabsf(a.x), fabsf(a.y)), fmaxf(fabsf(a.z), fabsf(a.w))), fmaxf(fmaxf(fabsf(b.x), fabsf(b.y)), fmaxf(fabsf(b.z), fabsf(b.w))));
        m = fmaxf(m, fmaxf(fmaxf(fmaxf(fabsf(c.x), fabsf(c.y)), fmaxf(fabsf(c.z), fabsf(c.w))), fmaxf(fmaxf(fabsf(d.x), fabsf(d.y)), fmaxf(fabsf(d.z), fabsf(d.w)))));
        m = wave_max(m);
        const float sc = (m > 0.f) ? 224.f / m : 1.f;
        v4u o; int w;
        w = __builtin_amdgcn_cvt_pk_fp8_f32(a.x * sc, a.y * sc, 0, false); w = __builtin_amdgcn_cvt_pk_fp8_f32(a.z * sc, a.w * sc, w, true); o.x = (unsigned)w;
        w = __builtin_amdgcn_cvt_pk_fp8_f32(b.x * sc, b.y * sc, 0, false); w = __builtin_amdgcn_cvt_pk_fp8_f32(b.z * sc, b.w * sc, w, true); o.y = (unsigned)w;
        w = __builtin_amdgcn_cvt_pk_fp8_f32(c.x * sc, c.y * sc, 0, false); w = __builtin_amdgcn_cvt_pk_fp8_f32(c.z * sc, c.w * sc, w, true); o.z = (unsigned)w;
        w = __builtin_amdgcn_cvt_pk_fp8_f32(d.x * sc, d.y * sc, 0, false); w = __builtin_amdgcn_cvt_pk_fp8_f32(d.z * sc, d.w * sc, w, true); o.w = (unsigned)w;
        *(GAS v4u*)(dst + (size_t)(lane >> 3) * ((size_t)NEXP * 128) + (size_t)r * 128 + 16 * (lane & 7)) = o;
        if (lane == 0) inv_scale[r] = (m > 0.f) ? m * (1.f / 224.f) : 1.f;
    }
}

__device__ __forceinline__ unsigned pack_i8x4(float a, float b, float c, float d) {
    const int ia = (int)rintf(a), ib = (int)rintf(b), ic = (int)rintf(c), id = (int)rintf(d);
    return ((unsigned)ia & 255u) | (((unsigned)ib & 255u) << 8) | (((unsigned)ic & 255u) << 16) | (((unsigned)id & 255u) << 24);
}
__device__ __forceinline__ void i8_rows(const float* src, unsigned char* dst, float* inv_scale, int gw, int NGW, int lane, unsigned bias) {
    for (int r = gw; r < NEXP; r += NGW) {
        const GAS f32x4* p = (const GAS f32x4*)(src + (size_t)r * D + 16 * lane);
        const f32x4 a = p[0], b = p[1], c = p[2], d = p[3];
        float m = fmaxf(fmaxf(fmaxf(fabsf(a.x), fabsf(a.y)), fmaxf(fabsf(a.z), fabsf(a.w))), fmaxf(fmaxf(fabsf(b.x), fabsf(b.y)), fmaxf(fabsf(b.z), fabsf(b.w))));
        m = fmaxf(m, fmaxf(fmaxf(fmaxf(fabsf(c.x), fabsf(c.y)), fmaxf(fabsf(c.z), fabsf(c.w))), fmaxf(fmaxf(fabsf(d.x), fabsf(d.y)), fmaxf(fabsf(d.z), fabsf(d.w)))));
        m = wave_max(m);
        const float sc = (m > 0.f) ? 127.f / m : 1.f;
        v4u o; o.x = pack_i8x4(a.x * sc, a.y * sc, a.z * sc, a.w * sc); o.y = pack_i8x4(b.x * sc, b.y * sc, b.z * sc, b.w * sc);
        o.z = pack_i8x4(c.x * sc, c.y * sc, c.z * sc, c.w * sc); o.w = pack_i8x4(d.x * sc, d.y * sc, d.z * sc, d.w * sc);
        o.x ^= bias; o.y ^= bias; o.z ^= bias; o.w ^= bias;
        *(GAS v4u*)(dst + (size_t)(lane >> 3) * ((size_t)NEXP * 128) + (size_t)r * 128 + 16 * (lane & 7)) = o;
        if (lane == 0) inv_scale[r] = (m > 0.f) ? m * (1.f / 127.f) : 1.f;
    }
}
__device__ __forceinline__ void modulate_row_q(const float* xrow, bf16* orow, unsigned char* qrow, float* qscale, const float* g, const float* shift, const float* scale, int lane) {
    const GAS f32x4* xr = (const GAS f32x4*)xrow + lane;
    f32x4 v[4]; float s2 = 0.f;
#pragma unroll
    for (int j = 0; j < 4; ++j) { v[j] = xr[64 * j]; s2 += (v[j].x * v[j].x + v[j].y * v[j].y) + (v[j].z * v[j].z + v[j].w * v[j].w); }
    const float rstd = 1.f / sqrtf(wave_sum(s2) * (1.f / D) + EPS);
    GAS v2u* o8 = (GAS v2u*)orow + lane; float m = 0.f;
#pragma unroll
    for (int j = 0; j < 4; ++j) {
        const f32x4 gg = ((const GAS f32x4*)g)[lane + 64 * j], sh = ((const GAS f32x4*)shift)[lane + 64 * j], sc = ((const GAS f32x4*)scale)[lane + 64 * j];
        v[j] = (v[j] * rstd) * gg * (sc + 1.0f) + sh;
        v2u o; o.x = pk2(v[j].x, v[j].y); o.y = pk2(v[j].z, v[j].w); o8[64 * j] = o;
        m = fmaxf(m, fmaxf(fmaxf(fabsf(v[j].x), fabsf(v[j].y)), fmaxf(fabsf(v[j].z), fabsf(v[j].w)))); }
    m = wave_max(m);
    const float qs = (m > 0.f) ? 127.f / m : 1.f;
#pragma unroll
    for (int j = 0; j < 4; ++j) ((GAS unsigned*)qrow)[lane + 64 * j] = pack_i8x4(v[j].x * qs, v[j].y * qs, v[j].z * qs, v[j].w * qs);
    if (lane == 0) *qscale = (m > 0.f) ? m * (1.f / 127.f) : 1.f;
}

#define SORT16_DESC(v) do { _Pragma("unroll") for (int k_ = 2; k_ <= 16; k_ <<= 1) _Pragma("unroll") for (int j_ = k_ >> 1; j_ > 0; j_ >>= 1) _Pragma("unroll") for (int i_ = 0; i_ < 16; ++i_) { const int l_ = i_ ^ j_; \
    if (l_ > i_) { const bool up_ = ((i_ & k_) == 0); const float hi_ = fmaxf(v[i_], v[l_]), lo_ = fminf(v[i_], v[l_]); v[i_] = up_ ? hi_ : lo_; v[l_] = up_ ? lo_ : hi_; } } } while (0)
#define MERGE16_TOP(a, b) do { _Pragma("unroll") for (int i_ = 0; i_ < 16; ++i_) a[i_] = fmaxf(a[i_], b[15 - i_]); \
    _Pragma("unroll") for (int j_ = 8; j_ > 0; j_ >>= 1) _Pragma("unroll") for (int i_ = 0; i_ < 16; ++i_) { const int l_ = i_ ^ j_; \
    if (l_ > i_) { const float hi_ = fmaxf(a[i_], a[l_]), lo_ = fminf(a[i_], a[l_]); a[i_] = hi_; a[l_] = lo_; } } } while (0)
constexpr int TK_S = 0, TK_SSTR = 136, TK_L = 139264;
__device__ __forceinline__ void topk_unit(Frame& F, int u) {
    const int tid = F.tid, lane = F.lane, w = F.wave, q = lane >> 4, tok0 = 64 * u;
    const bf16* Qb = (const bf16*)(F.ws + WS_QB); const bf16* KB = (const bf16*)(F.ws + WS_KEYS);
    unsigned short* eidx = (unsigned short*)(F.ws + WS_EIDX); float* gate = (float*)(F.ws + WS_GATE);
    LAS unsigned char* L = F.lds;
    bf16x8 AqN[2][4];
#pragma unroll
    for (int t2 = 0; t2 < 2; ++t2)
#pragma unroll
        for (int s = 0; s < 4; ++s) AqN[t2][s] = *(const GAS bf16x8*)(Qb + (size_t)(tok0 + 16 * (2 * (w & 1) + t2) + (lane & 15)) * 2048 + (w >> 1) * 128 + 32 * s + 8 * q);
#pragma unroll 1
    for (int r = 0; r < 4; ++r) {
#ifdef DBG_NAIVE_S
        for (int o = tid; o < 256 * 128; o += NTHREADS) { const int row = o >> 7, key = o & 127, hpl2 = row >> 6, tt = row & 63, hp2 = 4 * r + hpl2; float sacc = 0.f;
            for (int cc = 0; cc < 128; ++cc) sacc += bflo((unsigned)Qb[(size_t)(tok0 + tt) * 2048 + hp2 * 128 + cc]) * bflo((unsigned)KB[(size_t)(hp2 * 128 + key) * 128 + cc]);
            ((LAS float*)(L + TK_S))[row * TK_SSTR + key] = sacc; }
        if (0)
#endif
        { const int hpl = w >> 1, hp = 4 * r + hpl;
          bf16x8 Aq[2][4];
#pragma unroll
          for (int t2 = 0; t2 < 2; ++t2)
#pragma unroll
              for (int s = 0; s < 4; ++s) Aq[t2][s] = AqN[t2][s];
          if (r < 3) {
#pragma unroll
              for (int t2 = 0; t2 < 2; ++t2)
#pragma unroll
                  for (int s = 0; s < 4; ++s) AqN[t2][s] = *(const GAS bf16x8*)(Qb + (size_t)(tok0 + 16 * (2 * (w & 1) + t2) + (lane & 15)) * 2048 + (hp + 4) * 128 + 32 * s + 8 * q); }
          bf16x8 Bk[2][4];
#pragma unroll
          for (int s = 0; s < 4; ++s) Bk[0][s] = *(const GAS bf16x8*)(KB + (size_t)(hp * 128 + (lane & 15)) * 128 + 32 * s + 8 * q);
#pragma unroll
          for (int kt = 0; kt < 8; ++kt) {
              if (kt < 7) {
#pragma unroll
                  for (int s = 0; s < 4; ++s) Bk[(kt + 1) & 1][s] = *(const GAS bf16x8*)(KB + (size_t)(hp * 128 + 16 * (kt + 1) + (lane & 15)) * 128 + 32 * s + 8 * q); }
#pragma unroll
              for (int t2 = 0; t2 < 2; ++t2) { f32x4 a = (f32x4){0.f, 0.f, 0.f, 0.f};
#pragma unroll
                  for (int s = 0; s < 4; ++s) a = MFMA16(Aq[t2][s], Bk[kt & 1][s], a);
                  LAS float* sp = (LAS float*)(L + TK_S) + (hpl * 64 + 16 * (2 * (w & 1) + t2) + 4 * q) * TK_SSTR + 16 * kt + (lane & 15);
                  sp[0] = a[0]; sp[TK_SSTR] = a[1]; sp[2 * TK_SSTR] = a[2]; sp[3 * TK_SSTR] = a[3]; } } }
        LBAR();
#ifdef DBG_NAIVE_SEL
        {
            LAS float* Sg = (LAS float*)(L + TK_S); LAS float* NV = (LAS float*)(L + TK_L); LAS unsigned short* NI = (LAS unsigned short*)(L + TK_L + 16384);
            for (int o = tid; o < 256 * 128; o += NTHREADS) { const int row = o >> 7, i = o & 127; const float si = Sg[row * TK_SSTR + i]; int rank = 0;
                for (int j = 0; j < 128; ++j) { const float sj = Sg[row * TK_SSTR + j]; rank += (sj > si || (sj == si && j < i)) ? 1 : 0; }
                if (rank < 16) { NV[row * 16 + rank] = si; NI[row * 16 + rank] = (unsigned short)i; } }
            __syncthreads();
            for (int o = tid; o < 128 * 256; o += NTHREADS) { const int th = o >> 8, cnd = o & 255, hl = th >> 6, t = th & 63, r0 = (2 * hl) * 64 + t, r1 = r0 + 64, ia = cnd >> 4, ib = cnd & 15;
                const float sc_ = NV[r0 * 16 + ia] + NV[r1 * 16 + ib]; int rank = 0;
                for (int j = 0; j < 256; ++j) { const float sj = NV[r0 * 16 + (j >> 4)] + NV[r1 * 16 + (j & 15)]; rank += (sj > sc_ || (sj == sc_ && j < cnd)) ? 1 : 0; }
                if (rank < 16) { const size_t ob = (size_t)(tok0 + t) * 128 + (2 * r + hl) * 16 + rank; eidx[ob] = (unsigned short)((int)NI[r0 * 16 + ia] * 128 + (int)NI[r1 * 16 + ib]); gate[ob] = sc_; } }
            __syncthreads();
            if (tid < 128) { const int hl = tid >> 6, t = tid & 63; const size_t ob = (size_t)(tok0 + t) * 128 + (2 * r + hl) * 16; float mx = -3e38f, sum = 0.f, ex[16];
                for (int k = 0; k < 16; ++k) mx = fmaxf(mx, gate[ob + k]);
                for (int k = 0; k < 16; ++k) { ex[k] = expf(gate[ob + k] - mx); sum += ex[k]; }
                for (int k = 0; k < 16; ++k) gate[ob + k] = ex[k] / sum; }
            __syncthreads();
        }
        if (0)
#endif
#ifndef REP_S1
#define REP_S1 1
#endif
#ifndef REP_S2
#define REP_S2 1
#endif
        for (int rs1 = 0; rs1 < REP_S1; ++rs1)
        {
            const int row = tid >> 1, hf = tid & 1;
            float a[16];
            const LAS f32x4* sp = (const LAS f32x4*)((LAS float*)(L + TK_S) + row * TK_SSTR) + hf;
#pragma unroll
            for (int blk = 0; blk < 4; ++blk) {
                float v[16];
#pragma unroll
                for (int c4 = 0; c4 < 4; ++c4) { const int i = 4 * blk + c4; const f32x4 x4 = sp[2 * i]; const float ve[4] = {x4.x, x4.y, x4.z, x4.w};
#pragma unroll
                    for (int e = 0; e < 4; ++e) v[4 * c4 + e] = __builtin_bit_cast(float, (__builtin_bit_cast(unsigned, ve[e]) & ~127u) | (unsigned)(8 * i + 4 * hf + e)); }
                SORT16_DESC(v);
                if (blk == 0) {
#pragma unroll
                    for (int j = 0; j < 16; ++j) a[j] = v[j];
                } else { MERGE16_TOP(a, v); }
            }
            { float pb[16];
#pragma unroll
              for (int j = 0; j < 16; ++j) pb[j] = __shfl_xor(a[j], 1);
              MERGE16_TOP(a, pb); }
            if (hf == 0) { LAS v4u* tp = (LAS v4u*)(L + TK_L + row * 64);
#pragma unroll
                for (int i = 0; i < 4; ++i) tp[i] = (v4u){__builtin_bit_cast(unsigned, a[4 * i]), __builtin_bit_cast(unsigned, a[4 * i + 1]), __builtin_bit_cast(unsigned, a[4 * i + 2]), __builtin_bit_cast(unsigned, a[4 * i + 3])}; }
        }
        LBAR();
#ifdef DBG_NAIVE_SEL
        if (0)
#endif
        for (int rs2 = 0; rs2 < REP_S2; ++rs2)
        if (tid < 128) {
            const int hl = tid >> 6, t = tid & 63, r0 = (2 * hl) * 64 + t, r1 = r0 + 64;
            const LAS unsigned* t0 = (const LAS unsigned*)(L + TK_L + r0 * 64); const LAS unsigned* t1 = (const LAS unsigned*)(L + TK_L + r1 * 64);
            float v1[16], v2[16];
#pragma unroll
            for (int i = 0; i < 4; ++i) { const v4u x = ((const LAS v4u*)t0)[i], y = ((const LAS v4u*)t1)[i];
                v1[4 * i] = __builtin_bit_cast(float, x.x & ~127u); v1[4 * i + 1] = __builtin_bit_cast(float, x.y & ~127u); v1[4 * i + 2] = __builtin_bit_cast(float, x.z & ~127u); v1[4 * i + 3] = __builtin_bit_cast(float, x.w & ~127u);
                v2[4 * i] = __builtin_bit_cast(float, y.x & ~127u); v2[4 * i + 1] = __builtin_bit_cast(float, y.y & ~127u); v2[4 * i + 2] = __builtin_bit_cast(float, y.z & ~127u); v2[4 * i + 3] = __builtin_bit_cast(float, y.w & ~127u); }
            float c[16];
#pragma unroll
            for (int blk = 0; blk < 4; ++blk) {
                float v[16];
#pragma unroll
                for (int j = 0; j < 16; ++j) v[j] = -3.0e38f;
                { int n = 0, slot = 0;
#pragma unroll
                  for (int ia = 0; ia < 16; ++ia)
#pragma unroll
                      for (int ib = 0; ib < 16; ++ib) if ((ia + 1) * (ib + 1) <= 16) { if ((n >> 4) == blk) { v[slot] = __builtin_bit_cast(float, (__builtin_bit_cast(unsigned, v1[ia] + v2[ib]) & ~255u) | (unsigned)(ia * 16 + ib)); ++slot; } ++n; } }
                SORT16_DESC(v);
                if (blk == 0) {
#pragma unroll
                    for (int j = 0; j < 16; ++j) c[j] = v[j];
                } else { MERGE16_TOP(c, v); }
            }
            float ex[16], sum = 0.f; const float mx = __builtin_bit_cast(float, __builtin_bit_cast(unsigned, c[0]) & ~255u);
#pragma unroll
            for (int k = 0; k < 16; ++k) { ex[k] = fast_exp(__builtin_bit_cast(float, __builtin_bit_cast(unsigned, c[k]) & ~255u) - mx); sum += ex[k]; }
            const float inv = 1.f / sum; const int h = 2 * r + hl; const size_t ob = (size_t)(tok0 + t) * 128 + h * 16;
#pragma unroll
            for (int k = 0; k < 16; ++k) { const unsigned code = __builtin_bit_cast(unsigned, c[k]) & 255u;
                const unsigned i1 = t0[code >> 4] & 127u, i2 = t1[code & 15u] & 127u;
                eidx[ob + k] = (unsigned short)(i1 * 128u + i2); gate[ob + k] = ex[k] * inv; }
        }
    }
    __syncthreads();
}


#define TRED3(d, lane, m0, m1, m2) do { \
    _Pragma("unroll") for (int _i = 0; _i < 8; ++_i) { const bool _h = ((lane) & (m0)) != 0; const float _k = _h ? d[_i + 8] : d[_i], _s = _h ? d[_i] : d[_i + 8]; d[_i] = _k + __shfl_xor(_s, (m0)); } \
    _Pragma("unroll") for (int _i = 0; _i < 4; ++_i) { const bool _h = ((lane) & (m1)) != 0; const float _k = _h ? d[_i + 4] : d[_i], _s = _h ? d[_i] : d[_i + 4]; d[_i] = _k + __shfl_xor(_s, (m1)); } \
    _Pragma("unroll") for (int _i = 0; _i < 2; ++_i) { const bool _h = ((lane) & (m2)) != 0; const float _k = _h ? d[_i + 2] : d[_i], _s = _h ? d[_i] : d[_i + 2]; d[_i] = _k + __shfl_xor(_s, (m2)); } } while (0)
typedef int i32x4 __attribute__((ext_vector_type(4)));
__device__ __forceinline__ void cvt16v(const v4u r, float (&o)[16]) {
    const unsigned rr[4] = {r.x, r.y, r.z, r.w};
#pragma unroll
    for (int d = 0; d < 4; ++d) { const f32x2 lo = __builtin_amdgcn_cvt_pk_f32_fp8((int)rr[d], false), hi = __builtin_amdgcn_cvt_pk_f32_fp8((int)rr[d], true);
        o[4 * d] = lo.x; o[4 * d + 1] = lo.y; o[4 * d + 2] = hi.x; o[4 * d + 3] = hi.y; }
}
#define PX_LOAD_E(ev, tok) do { const GAS v4u* ep_ = (const GAS v4u*)(eidx + (size_t)(tok) * 128 + 16 * pg); ev[0] = ep_[0]; ev[1] = ep_[1]; } while (0)
#define PX_LOAD_ROWS8(rows, ea, base) do { const unsigned e_[8] = {ea.x & 0xffffu, ea.x >> 16, ea.y & 0xffffu, ea.y >> 16, ea.z & 0xffffu, ea.z >> 16, ea.w & 0xffffu, ea.w >> 16}; \
    _Pragma("unroll") for (int i_ = 0; i_ < 8; ++i_) rows[i_] = *(const GAS v4u*)((base) + (e_[i_] * 128u + cgo)); } while (0)
#define PU_LOAD_H(h0, tok) do { h0 = *(const GAS v4u*)(H8 + (size_t)(tok) * D + 128 * slice + cgo); } while (0)
#define PU_DOT8(rows, dd, off) do { \
    _Pragma("unroll") for (int i_ = 0; i_ < 8; ++i_) { int s_ = __builtin_amdgcn_sdot4((int)rows[i_].x, (int)h0.x, 0, false); s_ = __builtin_amdgcn_sdot4((int)rows[i_].y, (int)h0.y, s_, false); \
        s_ = __builtin_amdgcn_sdot4((int)rows[i_].z, (int)h0.z, s_, false); s_ = __builtin_amdgcn_sdot4((int)rows[i_].w, (int)h0.w, s_, false); dd[(off) + i_] = s_; } } while (0)
#define TRED3I(d, lane, m0, m1, m2) do { \
    _Pragma("unroll") for (int _i = 0; _i < 8; ++_i) { const bool _h = ((lane) & (m0)) != 0; const int _k = _h ? d[_i + 8] : d[_i], _s = _h ? d[_i] : d[_i + 8]; d[_i] = _k + __shfl_xor(_s, (m0)); } \
    _Pragma("unroll") for (int _i = 0; _i < 4; ++_i) { const bool _h = ((lane) & (m1)) != 0; const int _k = _h ? d[_i + 4] : d[_i], _s = _h ? d[_i] : d[_i + 4]; d[_i] = _k + __shfl_xor(_s, (m1)); } \
    _Pragma("unroll") for (int _i = 0; _i < 2; ++_i) { const bool _h = ((lane) & (m2)) != 0; const int _k = _h ? d[_i + 2] : d[_i], _s = _h ? d[_i] : d[_i + 2]; d[_i] = _k + __shfl_xor(_s, (m2)); } } while (0)
typedef int i32x2 __attribute__((ext_vector_type(2)));
__device__ __forceinline__ void peer_u_slice(unsigned char* ws_, int slice, int rank, int nrank) {
    const int lane = threadIdx.x & 63, wave = __builtin_amdgcn_readfirstlane(threadIdx.x >> 6);
    const int pg = lane >> 3, cg = lane & 7, wi = rank * NWAVES + wave, nw = nrank * NWAVES;
    const unsigned char* H8 = ws_ + WS_H8; const unsigned char* Us = ws_ + WS_U8 + (size_t)slice * ((size_t)NEXP * 128); const unsigned cgo = 16u * cg;
    const unsigned short* eidx = (const unsigned short*)(ws_ + WS_EIDX); int* part = (int*)(ws_ + WS_PART) + (size_t)slice * ML * 128;
    v4u eC[2], eN[2]; v4u r0[8], r1[8]; v4u h0, g0;
    PX_LOAD_E(eC, wi); PU_LOAD_H(h0, wi); PX_LOAD_ROWS8(r0, eC[0], Us);
#pragma unroll 1
    for (int t = wi; t < ML; t += nw) {
        const int tn = (t + nw < ML) ? t + nw : t;
        PX_LOAD_ROWS8(r1, eC[1], Us); PX_LOAD_E(eN, tn); PU_LOAD_H(g0, tn);
        __builtin_amdgcn_sched_barrier(0);
        int d[16];
        PU_DOT8(r0, d, 0);
        PX_LOAD_ROWS8(r0, eN[0], Us);
        __builtin_amdgcn_sched_barrier(0);
        PU_DOT8(r1, d, 8);
        TRED3I(d, lane, 4, 2, 1);
        *(GAS i32x2*)(part + (size_t)t * 128 + 2 * lane) = (i32x2){d[0], d[1]};
        eC[0] = eN[0]; eC[1] = eN[1]; h0 = g0;
    }
}
__device__ __forceinline__ void peer_reduce(Frame& F) {
    const int* part = (const int*)(F.ws + WS_PART); const float* sh = (const float*)(F.ws + WS_SH); const unsigned short* eidx = (const unsigned short*)(F.ws + WS_EIDX); const float* gate = (const float*)(F.ws + WS_GATE);
    const float* su = (const float*)(F.ws + WS_SU); const float* sv = (const float*)(F.ws + WS_SV); bf16* wgt = (bf16*)(F.ws + WS_WGT);
    for (size_t i = (size_t)F.bid * NTHREADS + F.tid; i < (size_t)ML * 128; i += (size_t)F.G * NTHREADS) {
        int s = 0;
#pragma unroll
        for (int x = 0; x < 8; ++x) s += part[(size_t)x * ML * 128 + i];
        const int e = eidx[i]; const float z = (float)s * su[e] * sh[i >> 7];
        wgt[i] = (bf16)f2bf(gate[i] * (0.5f * z * (1.f + erff(z * 0.70710678118f))) * sv[e] * 1024.f);
    }
}
#define PV_LOAD_W(wv, tok) do { const GAS v4u* wp_ = (const GAS v4u*)(wgt + (size_t)(tok) * 128 + 16 * pg); wv[0] = wp_[0]; wv[1] = wp_[1]; } while (0)
typedef _Float16 h16x2 __attribute__((ext_vector_type(2)));
#define PV_ACC8(rows, wa) do { const unsigned w_[4] = {wa.x, wa.y, wa.z, wa.w}; \
    _Pragma("unroll") for (int i_ = 0; i_ < 8; ++i_) { const _Float16 wh_ = (_Float16)((i_ & 1) ? bfhi(w_[i_ >> 1]) : bflo(w_[i_ >> 1])); const h16x2 ww_ = {wh_, wh_}; \
        const unsigned rr_[4] = {rows[i_].x, rows[i_].y, rows[i_].z, rows[i_].w}; \
        _Pragma("unroll") for (int d_ = 0; d_ < 4; ++d_) { \
            acc[2 * d_]     = acc[2 * d_]     + __builtin_amdgcn_cvt_scalef32_pk_f16_fp8((int)rr_[d_], 1.0f, false) * ww_; \
            acc[2 * d_ + 1] = acc[2 * d_ + 1] + __builtin_amdgcn_cvt_scalef32_pk_f16_fp8((int)rr_[d_], 1.0f, true) * ww_; } } } while (0)
__device__ __forceinline__ void peer_v_slice(unsigned char* ws_, bf16* po_, int slice, int rank, int nrank) {
    const int lane = threadIdx.x & 63, wave = __builtin_amdgcn_readfirstlane(threadIdx.x >> 6);
    const int pg = lane >> 3, cg = lane & 7, wi = rank * NWAVES + wave, nw = nrank * NWAVES;
    const unsigned char* Vs = ws_ + WS_V8 + (size_t)slice * ((size_t)NEXP * 128); const unsigned cgo = 16u * cg;
    const unsigned short* eidx = (const unsigned short*)(ws_ + WS_EIDX); const bf16* wgt = (const bf16*)(ws_ + WS_WGT);
    const int col = 128 * slice + 16 * cg + 2 * pg;
    v4u eC[2], eN[2]; v4u r0[8], r1[8]; v4u wC[2], wN[2];
    PX_LOAD_E(eC, wi); PV_LOAD_W(wC, wi); PX_LOAD_ROWS8(r0, eC[0], Vs);
#pragma unroll 1
    for (int t = wi; t < ML; t += nw) {
        const int tn = (t + nw < ML) ? t + nw : t;
        PX_LOAD_ROWS8(r1, eC[1], Vs); PX_LOAD_E(eN, tn); PV_LOAD_W(wN, tn);
        __builtin_amdgcn_sched_barrier(0);
        h16x2 acc[8];
#pragma unroll
        for (int k = 0; k < 8; ++k) acc[k] = (h16x2){(_Float16)0.f, (_Float16)0.f};
        PV_ACC8(r0, wC[0]);
        PX_LOAD_ROWS8(r0, eN[0], Vs);
        __builtin_amdgcn_sched_barrier(0);
        PV_ACC8(r1, wC[1]);
        float af[16];
#pragma unroll
        for (int k = 0; k < 8; ++k) { af[2 * k] = (float)acc[k].x; af[2 * k + 1] = (float)acc[k].y; }
        TRED3(af, lane, 32, 16, 8);
        *(GAS unsigned*)(po_ + (size_t)t * D + col) = pk2(af[0] * (1.f / 1024.f), af[1] * (1.f / 1024.f));
        eC[0] = eN[0]; eC[1] = eN[1]; wC[0] = wN[0]; wC[1] = wN[1];
    }
}
__device__ __forceinline__ void final_norm(Frame& F) {
    const bf16* po = (const bf16*)(F.ws + WS_PO); const float* mod = (const float*)(F.ws + WS_MOD); const int lane = F.lane, gw = F.bid * NWAVES + F.wave, NGW = F.G * NWAVES;
    for (int t = gw; t < ML; t += NGW) {
        GAS f32x4* orow = (GAS f32x4*)(F.out + (size_t)t * D) + lane; const GAS v2u* prow = (const GAS v2u*)(po + (size_t)t * D) + lane;
        const GAS f32x4* g2 = (const GAS f32x4*)(mod + (size_t)(t >> 12) * 6144 + 5 * 1024) + lane;
        f32x4 xv[4]; float s2 = 0.f;
#pragma unroll
        for (int j = 0; j < 4; ++j) { const f32x4 x1 = orow[64 * j], gg = g2[64 * j]; const v2u pv = prow[64 * j];
            xv[j] = x1 + gg * (f32x4){bflo(pv.x), bfhi(pv.x), bflo(pv.y), bfhi(pv.y)};
            s2 += (xv[j].x * xv[j].x + xv[j].y * xv[j].y) + (xv[j].z * xv[j].z + xv[j].w * xv[j].w); }
        const float rstd = 1.f / sqrtf(wave_sum(s2) * (1.f / D) + EPS);
#pragma unroll
        for (int j = 0; j < 4; ++j) { const f32x4 fg = ((const GAS f32x4*)F.final_g)[lane + 64 * j]; orow[64 * j] = xv[j] * rstd * fg; }
    }
}

constexpr int N_PHASES = 14;
__global__ void __launch_bounds__(NTHREADS, 2) fwd_kernel(Args args) {
    extern __shared__ __attribute__((aligned(16))) unsigned char lds[];
    Frame F;
    F.lds = (LAS unsigned char*)lds;
    F.tid = threadIdx.x; F.lane = F.tid & 63; F.wave = __builtin_amdgcn_readfirstlane(F.tid >> 6); F.G = gridDim.x; F.bid = blockIdx.x;
    F.x = args.in[0]; F.c = args.in[1]; F.ctx = args.in[2]; F.c_ctx = args.in[3]; F.w_mod = args.in[4]; F.b_mod = args.in[5]; F.n1g = args.in[6]; F.n2g = args.in[7];
    F.w_in = args.in[8]; F.pool_w = args.in[9]; F.pool_scale = args.in[10]; F.lb_logits = args.in[11]; F.hg_norm_g = args.in[12]; F.w_a = args.in[13]; F.w_b = args.in[14];
    F.w_o = args.in[15]; F.wq = args.in[16]; F.keys = args.in[17]; F.pu = args.in[18]; F.pv = args.in[19]; F.final_g = args.in[20];
    F.out = args.out; F.ws = args.ws;
    volatile LAS unsigned* MISC = (volatile LAS unsigned*)(F.lds + MISC_OFF);
    if (F.tid < 64) MISC[F.tid] = 0u;
    __syncthreads();
    unsigned* barw = (unsigned*)(F.ws + WS_CTL) + CW_BAR;
    XcdBarrier bar; bar.bar = barw; bar.x = 0; bar.st = nullptr;
    if (ONE_LAUNCH) bar = xcd_barrier_post(barw, MISC + 8);
    const int lo = args.ph_lo, hi = args.ph_hi;
#ifndef PH_MASK
#define PH_MASK 0x3fff
#endif
#define IN(k) (((PH_MASK >> (k)) & 1) && lo <= (k) && (k) < hi)
#define SEAM(k) do { if (IN(k) && IN((k) + 1)) xcd_barrier(bar); } while (0)
#ifndef REP_MASK
#define REP_MASK 0
#endif
#define REPS(k) ((((REP_MASK) >> (k)) & 1) ? 2 : 1)
#define REPSYNC(k, rep) do { if ((rep) + 1 < REPS(k)) xcd_barrier(bar); } while (0)

    if (IN(0)) for (int rep_ = 0; rep_ < REPS(0); ++rep_) { p0_prologue(F);  REPSYNC(0, rep_); } SEAM(0);
    if (IN(1)) for (int rep_ = 0; rep_ < REPS(1); ++rep_) { p1_modulate(F);  REPSYNC(1, rep_); } SEAM(1);
    if (IN(2)) for (int rep_ = 0; rep_ < REPS(2); ++rep_) {
        SchedIn S{(const char*)(F.ws + WS_H), (const char*)(F.ws + WS_WIN), F.G, F.bid};
        EpiZ E{(bf16*)(F.ws + WS_Z), (bf16*)(F.ws + WS_ZC)};
        pg8::gemm_phase<EpiZ, SchedIn, true, true>(F.lds, D, S, E);
        REPSYNC(2, rep_);
    } SEAM(2);
    if (IN(3)) for (int rep_ = 0; rep_ < REPS(3); ++rep_) {
#ifndef REP_SCAN
#define REP_SCAN 1
#endif
#ifndef REP_POOL
#define REP_POOL 1
#endif
        for (int r2 = 0; r2 < REP_SCAN; ++r2) for (int u = F.bid; u < NSCAN; u += F.G) scan_unit(F, u);
        for (int r2 = 0; r2 < REP_POOL; ++r2) for (int u = F.bid; u < NB * 64; u += F.G) pool_unit(F, u);
        REPSYNC(3, rep_);
    } SEAM(3);
    if (IN(4)) for (int rep_ = 0; rep_ < REPS(4); ++rep_) { for (int u = F.bid; u < NB * 4 * NSEG; u += F.G) fix_unit(F, u);  REPSYNC(4, rep_); } SEAM(4);
    if (IN(5)) for (int rep_ = 0; rep_ < REPS(5); ++rep_) {
        SchedMerge S{(const char*)(F.ws + WS_YPOOL), (const char*)(F.ws + WS_YHG), (const char*)(F.ws + WS_WA), (const char*)(F.ws + WS_WB), F.G, F.bid};
        EpiMerge E{(const bf16*)(F.ws + WS_Z), (bf16*)(F.ws + WS_M)};
        pg8::gemm_phase<EpiMerge, SchedMerge, true, true>(F.lds, 512, S, E);
        REPSYNC(5, rep_);
    } SEAM(5);
    if (IN(6)) for (int rep_ = 0; rep_ < REPS(6); ++rep_) {
        SchedPlain S{(const char*)(F.ws + WS_M), (const char*)(F.ws + WS_WO), 64, 4, D, F.G, F.bid};
        EpiRes E{F.x, (const float*)(F.ws + WS_MOD), F.out};
        pg8::gemm_phase<EpiRes, SchedPlain, true, true>(F.lds, D, S, E);
        REPSYNC(6, rep_);
    } SEAM(6);
    if (IN(7)) for (int rep_ = 0; rep_ < REPS(7); ++rep_) {
        const float* mod = (const float*)(F.ws + WS_MOD); bf16* H2 = (bf16*)(F.ws + WS_H);
        const int gw = F.bid * NWAVES + F.wave, NGW = F.G * NWAVES;
        for (int m = gw; m < ML; m += NGW) { const int v = m >> 12; modulate_row_q(F.out + (size_t)m * D, H2 + (size_t)m * D, F.ws + WS_H8 + (size_t)m * D, (float*)(F.ws + WS_SH) + m, F.n2g, mod + v * 6144 + 3 * 1024, mod + v * 6144 + 4 * 1024, F.lane); }
        i8_rows(F.pu, F.ws + WS_U8, (float*)(F.ws + WS_SU), gw, NGW, F.lane, 0u);
        fp8_rows(F.pv, F.ws + WS_V8, (float*)(F.ws + WS_SV), gw, NGW, F.lane);
        REPSYNC(7, rep_);
    } SEAM(7);
    if (IN(8)) for (int rep_ = 0; rep_ < REPS(8); ++rep_) {
        SchedPlain S{(const char*)(F.ws + WS_H), (const char*)(F.ws + WS_WQ), 64, 8, D, F.G, F.bid};
        EpiPlain E{(bf16*)(F.ws + WS_QB), 2048};
        pg8::gemm_phase<EpiPlain, SchedPlain, true, true>(F.lds, D, S, E);
        REPSYNC(8, rep_);
    } SEAM(8);
    if (IN(9)) for (int rep_ = 0; rep_ < REPS(9); ++rep_) { for (int u = F.bid; u < ML / 64; u += F.G) topk_unit(F, u);  REPSYNC(9, rep_); } SEAM(9);
    int pslice = F.bid & 7, prank = F.bid >> 3; const int pnrank = F.G >> 3;
    if (ONE_LAUNCH && (IN(10) || IN(12))) {
        bool okc = (F.G == 256) && (bar.x < 8u);
#pragma unroll
        for (int j = 0; j < 8; ++j) okc = okc && (xb_ld(&barw[XB_XCNT(j)]) == 32u);
        if (okc) { pslice = (int)bar.x; prank = (int)MISC[10]; }
    }
    if (IN(10)) for (int rep_ = 0; rep_ < REPS(10); ++rep_) { peer_u_slice(F.ws, pslice, prank, pnrank);  REPSYNC(10, rep_); } SEAM(10);
    if (IN(11)) for (int rep_ = 0; rep_ < REPS(11); ++rep_) { peer_reduce(F);  REPSYNC(11, rep_); } SEAM(11);
    if (IN(12)) for (int rep_ = 0; rep_ < REPS(12); ++rep_) { peer_v_slice(F.ws, (bf16*)(F.ws + WS_PO), pslice, prank, pnrank);  REPSYNC(12, rep_); } SEAM(12);
    if (IN(13)) for (int rep_ = 0; rep_ < REPS(13); ++rep_) { final_norm(F);  REPSYNC(13, rep_); }
#undef IN
#undef SEAM
}

extern "C" void kernel_launch(void* const* d_in, const int* in_sizes, int n_in, void* d_out, int out_size, void* d_ws, size_t ws_size, hipStream_t stream) {
    static int grid = 0;
    if (grid == 0) {
        if (n_in != 21 || out_size != ML * D || ws_size < WS_END) { fprintf(stderr, "kernel_launch: unexpected problem (n_in %d, out %d, ws %zu)\n", n_in, out_size, ws_size); grid = -1; return; }
        int dev = 0, cus = 0;
        if (hipGetDevice(&dev) != hipSuccess || hipDeviceGetAttribute(&cus, hipDeviceAttributeMultiprocessorCount, dev) != hipSuccess) { grid = -1; return; }
        if (hipFuncSetAttribute((const void*)fwd_kernel, hipFuncAttributeMaxDynamicSharedMemorySize, LDS_BYTES) != hipSuccess) { fprintf(stderr, "kernel_launch: hipFuncSetAttribute failed\n"); grid = -1; return; }
        int per_cu = 0;
        if (hipOccupancyMaxActiveBlocksPerMultiprocessor(&per_cu, (const void*)fwd_kernel, NTHREADS, LDS_BYTES) != hipSuccess || per_cu < 1) fprintf(stderr, "kernel_launch: occupancy query says %d\n", per_cu);
        (void)hipGetLastError();
        grid = cus;
    }
    if (grid < 0) return;
    (void)hipMemsetAsync((char*)d_ws + WS_CTL, 0, CTL_ZERO_BYTES, stream);
    Args a{};
    for (int i = 0; i < 21; ++i) a.in[i] = (const float*)d_in[i];
    a.out = (float*)d_out; a.ws = (unsigned char*)d_ws;
#if ONE_LAUNCH
    a.ph_lo = 0; a.ph_hi = N_PHASES;
    hipLaunchKernelGGL(fwd_kernel, dim3(grid), dim3(NTHREADS), LDS_BYTES, stream, a);
#else
    for (int p = 0; p < N_PHASES; ++p) { a.ph_lo = p; a.ph_hi = p + 1; hipLaunchKernelGGL(fwd_kernel, dim3(grid), dim3(NTHREADS), LDS_BYTES, stream, a); }
#endif
}
```

```cpp
#define ONE_LAUNCH 1
#include <hip/hip_runtime.h>
#include <cstdio>
#include <cstdint>

#ifndef ONE_LAUNCH
#define ONE_LAUNCH 1
#endif

namespace pg8 {
#define PG8_LAS __attribute__((address_space(3)))
typedef unsigned short bf16_t;
typedef short bf16x8 __attribute__((ext_vector_type(8)));
typedef float f32x4 __attribute__((ext_vector_type(4)));
typedef float f32x2 __attribute__((ext_vector_type(2)));
typedef unsigned u32x4 __attribute__((ext_vector_type(4)));
typedef unsigned u32x2 __attribute__((ext_vector_type(2)));
constexpr int BM = 256, BK = 64, HALF = 128, HTB = HALF * BK * 2, STAGE_BYTES = 8 * HTB, NXCD = 8, WGM = 8;

__host__ __device__ __forceinline__ int lds_byte(int r, int c) { const int st = (r >> 4) * 2 + (c >> 5), rr = r & 15, cc = c & 31, ob = rr * 64 + cc * 2; return st * 1024 + (ob ^ (((ob >> 9) & 1) << 5)); }
__host__ __device__ __forceinline__ void stage_rc(int b, int& R, int& C) { const int st = b / 1024, sb = b % 1024, swz = sb ^ (((sb >> 9) & 1) << 5); R = (st >> 1) * 16 + swz / 64; C = (st & 1) * 32 + (swz % 64) / 2; }
__host__ __device__ __forceinline__ int perm32(int rho) { const int n = rho >> 4, i = rho & 15; return 8 * (i >> 2) + 4 * n + (i & 3); }

struct Unit { int pm, pn, seg; };

__host__ __device__ __forceinline__ void tile_of(int wgid, int nM, int nN, int& pm, int& pn) {
    const int nwg = nM * nN;
    { const int q = nwg / NXCD, r = nwg % NXCD, xcd = wgid % NXCD, off = wgid / NXCD; wgid = (xcd < r ? xcd * (q + 1) : r * (q + 1) + (xcd - r) * q) + off; }
    const int nig = WGM * nN, gid = wgid / nig, fm = gid * WGM, gsz = (nM - fm) < WGM ? (nM - fm) : WGM;
    pm = fm + ((wgid % nig) % gsz); pn = (wgid % nig) / gsz;
}

typedef __bf16 bf16x2_t __attribute__((ext_vector_type(2)));
__device__ __forceinline__ unsigned cvt_pk_bf16(float lo, float hi) { bf16x2_t v; v.x = (__bf16)lo; v.y = (__bf16)hi; return __builtin_bit_cast(unsigned, v); }

template <class Epi, class Sched, bool ALIGN_EPI = false, bool SP2 = false>
__device__ __forceinline__ void gemm_phase(PG8_LAS unsigned char* lds, const int ld, const Sched& S, const Epi& E) {
    const int tid = threadIdx.x, wid = __builtin_amdgcn_readfirstlane(tid >> 6), lane = tid & 63, wr = wid >> 2, wc = wid & 3, fr = lane & 15, fq = lane >> 4;
    unsigned voffA[2], voffB[2];
#pragma unroll
    for (int i = 0; i < 2; ++i) { int R, C; stage_rc(tid * 16 + i * 8192, R, C); const int Rb = Epi::PERM ? ((R & ~31) + perm32(R & 31)) : R;
        voffA[i] = (unsigned)(R * ld + C) * 2u; voffB[i] = (unsigned)(Rb * ld + C) * 2u; }
    const size_t kstep = (size_t)(BK * 2);
    const size_t hstep = (size_t)HALF * ld * 2;
    const unsigned ldsw = (unsigned)wid * 1024u;
    const int aoff = lds_byte(wr * 64 + fr, fq * 8), boff = lds_byte(wc * 32 + fr, fq * 8);
#define PG8_SA(b, h) (((b) * 2 + (h)) * HTB)
#define PG8_SB(b, h) ((4 + (b) * 2 + (h)) * HTB)
#define PG8_STAGE(bufoff, gbase, voff) do { _Pragma("unroll") for (int _i = 0; _i < 2; ++_i) \
        __builtin_amdgcn_global_load_lds((const unsigned*)((const char*)(gbase) + (voff)[_i]), (PG8_LAS unsigned*)(lds + (bufoff) + ldsw + _i * 8192), 16, 0, 0); } while (0)
#define PG8_LDA(dst, b, h) do { _Pragma("unroll") for (int m = 0; m < 4; ++m) _Pragma("unroll") for (int k = 0; k < 2; ++k) dst[m][k] = *(const PG8_LAS bf16x8*)(lds + PG8_SA(b, h) + aoff + m * 2048 + k * 1024); } while (0)
#define PG8_LDB(dst, b, h) do { _Pragma("unroll") for (int n = 0; n < 2; ++n) _Pragma("unroll") for (int k = 0; k < 2; ++k) dst[n][k] = *(const PG8_LAS bf16x8*)(lds + PG8_SB(b, h) + boff + n * 2048 + k * 1024); } while (0)
#define PG8_MMA(ai, bj, At, Bt) do { __builtin_amdgcn_s_setprio(1); _Pragma("unroll") for (int m = 0; m < 4; ++m) _Pragma("unroll") for (int n = 0; n < 2; ++n) _Pragma("unroll") for (int k = 0; k < 2; ++k) \
        acc[ai][bj][m][n] = __builtin_amdgcn_mfma_f32_16x16x32_bf16(Bt[n][k], At[m][k], acc[ai][bj][m][n], 0, 0, 0); __builtin_amdgcn_s_setprio(0); } while (0)
#define PG8_WAIT_V(n) asm volatile("s_waitcnt vmcnt(" #n ")" ::: "memory")
#define PG8_WAIT_L(n) asm volatile("s_waitcnt lgkmcnt(" #n ")" ::: "memory")
#define PG8_BAR __builtin_amdgcn_s_barrier()
#define PG8_SCHED __builtin_amdgcn_sched_barrier(0)
    Unit cur, nxt; int ui = 0;
    if (!S.next(0, cur)) return;
    f32x4 acc[2][2][4][2];
#pragma unroll
    for (int a = 0; a < 2; ++a)
#pragma unroll
        for (int b = 0; b < 2; ++b)
#pragma unroll
            for (int m = 0; m < 4; ++m)
#pragma unroll
                for (int n = 0; n < 2; ++n) acc[a][b][m][n] = (f32x4){0.f, 0.f, 0.f, 0.f};
    bf16x8 At[4][2], B0[2][2], B1[2][2];
    const char* cA = S.A(cur); const char* cB = S.B(cur);
    if constexpr (SP2) {
        PG8_STAGE(PG8_SB(0, 0), cB, voffB); PG8_STAGE(PG8_SB(0, 1), cB + hstep, voffB); PG8_STAGE(PG8_SA(0, 0), cA, voffA); PG8_STAGE(PG8_SA(0, 1), cA + hstep, voffA);
        if (wr == 1) PG8_BAR;
        PG8_WAIT_V(2); PG8_BAR;
        PG8_STAGE(PG8_SB(1, 0), cB + kstep, voffB); PG8_STAGE(PG8_SA(1, 0), cA + kstep, voffA); PG8_STAGE(PG8_SB(1, 1), cB + hstep + kstep, voffB);
        PG8_WAIT_V(6); PG8_BAR;
    } else {
        PG8_STAGE(PG8_SB(0, 0), cB, voffB); PG8_STAGE(PG8_SA(0, 0), cA, voffA); PG8_STAGE(PG8_SB(0, 1), cB + hstep, voffB); PG8_STAGE(PG8_SA(0, 1), cA + hstep, voffA);
        if (wr == 1) PG8_BAR;
        PG8_WAIT_V(4); PG8_BAR;
        PG8_STAGE(PG8_SB(1, 0), cB + kstep, voffB); PG8_STAGE(PG8_SA(1, 0), cA + kstep, voffA); PG8_STAGE(PG8_SB(1, 1), cB + hstep + kstep, voffB);
        PG8_WAIT_V(6); PG8_BAR;
    }
    for (;;) {
        const bool has_next = S.next(ui + 1, nxt); const int nt = S.nt(cur);
        const char* nA = has_next ? S.A(nxt) : cA; const char* nB = has_next ? S.B(nxt) : cB;
        for (int t = 0; t < nt; t += 2) {
            const bool last = (t == nt - 2);
            const char* a1 = cA + (size_t)(t + 1) * kstep;
            const char* a2 = last ? nA : cA + (size_t)(t + 2) * kstep; const char* b2 = last ? nB : cB + (size_t)(t + 2) * kstep;
            const char* a3 = a2 + kstep; const char* b3 = b2 + kstep;
            if constexpr (SP2) {
            PG8_LDB(B0, 0, 0); PG8_LDB(B1, 0, 1); PG8_SCHED; PG8_LDA(At, 0, 0); PG8_STAGE(PG8_SA(1, 1), a1 + hstep, voffA);
            PG8_WAIT_V(8); PG8_WAIT_L(0); PG8_BAR; PG8_MMA(0, 0, At, B0); PG8_MMA(0, 1, At, B1); PG8_BAR; PG8_SCHED;
            PG8_LDA(At, 0, 1); PG8_STAGE(PG8_SB(0, 0), b2, voffB); PG8_STAGE(PG8_SB(0, 1), b2 + hstep, voffB); PG8_STAGE(PG8_SA(0, 0), a2, voffA);
            PG8_WAIT_V(8); PG8_WAIT_L(0); PG8_BAR; PG8_MMA(1, 0, At, B0); PG8_MMA(1, 1, At, B1); PG8_BAR; PG8_SCHED;
            PG8_LDB(B0, 1, 0); PG8_LDB(B1, 1, 1); PG8_SCHED; PG8_LDA(At, 1, 0); PG8_STAGE(PG8_SA(0, 1), a2 + hstep, voffA);
            PG8_WAIT_V(8); PG8_WAIT_L(0); PG8_BAR; PG8_MMA(0, 0, At, B0); PG8_MMA(0, 1, At, B1); PG8_BAR; PG8_SCHED;
            PG8_LDA(At, 1, 1); PG8_STAGE(PG8_SB(1, 0), b3, voffB); PG8_STAGE(PG8_SB(1, 1), b3 + hstep, voffB); PG8_STAGE(PG8_SA(1, 0), a3, voffA);
            PG8_WAIT_V(8); PG8_WAIT_L(0); PG8_BAR; PG8_MMA(1, 0, At, B0); PG8_MMA(1, 1, At, B1); PG8_BAR; PG8_SCHED;
            } else {
            PG8_LDB(B0, 0, 0); PG8_SCHED; PG8_LDA(At, 0, 0); PG8_STAGE(PG8_SA(1, 1), a1 + hstep, voffA);
            PG8_WAIT_L(8); PG8_BAR; PG8_WAIT_L(0); PG8_MMA(0, 0, At, B0); PG8_BAR; PG8_SCHED;
            PG8_LDB(B1, 0, 1); PG8_STAGE(PG8_SB(0, 0), b2, voffB);
            PG8_BAR; PG8_WAIT_L(0); PG8_MMA(0, 1, At, B1); PG8_BAR;
            PG8_LDA(At, 0, 1); PG8_STAGE(PG8_SA(0, 0), a2, voffA);
            PG8_BAR; PG8_WAIT_L(0); PG8_MMA(1, 0, At, B0); PG8_BAR; PG8_SCHED;
            PG8_STAGE(PG8_SB(0, 1), b2 + hstep, voffB);
            PG8_WAIT_V(6); PG8_BAR; PG8_MMA(1, 1, At, B1); PG8_BAR;
            PG8_LDB(B0, 1, 0); PG8_SCHED; PG8_LDA(At, 1, 0); PG8_STAGE(PG8_SA(0, 1), a2 + hstep, voffA);
            PG8_WAIT_L(8); PG8_BAR; PG8_WAIT_L(0); PG8_MMA(0, 0, At, B0); PG8_BAR; PG8_SCHED;
            PG8_LDB(B1, 1, 1); PG8_STAGE(PG8_SB(1, 0), b3, voffB);
            PG8_BAR; PG8_WAIT_L(0); PG8_MMA(0, 1, At, B1); PG8_BAR;
            PG8_LDA(At, 1, 1); PG8_STAGE(PG8_SA(1, 0), a3, voffA);
            PG8_BAR; PG8_WAIT_L(0); PG8_MMA(1, 0, At, B0); PG8_BAR; PG8_SCHED;
            PG8_STAGE(PG8_SB(1, 1), b3 + hstep, voffB);
            PG8_WAIT_V(6); PG8_BAR; PG8_MMA(1, 1, At, B1); PG8_BAR;
            }
        }
        if constexpr (ALIGN_EPI) { if (wr == 0) PG8_BAR; }
        E(acc, cur, wr, wc, fr, fq);
        if (!has_next) break;
        if (!S.keep(cur)) {
#pragma unroll
        for (int a = 0; a < 2; ++a)
#pragma unroll
            for (int b = 0; b < 2; ++b)
#pragma unroll
                for (int m = 0; m < 4; ++m)
#pragma unroll
                    for (int n = 0; n < 2; ++n) acc[a][b][m][n] = (f32x4){0.f, 0.f, 0.f, 0.f};
        }
        cur = nxt; cA = nA; cB = nB; ++ui;
        if constexpr (ALIGN_EPI) { if (wr == 1) PG8_BAR; }
    }
    PG8_WAIT_V(0);
    if constexpr (!ALIGN_EPI) { if (wr == 0) PG8_BAR; }
    PG8_BAR;
#undef PG8_SA
#undef PG8_SB
#undef PG8_STAGE
#undef PG8_LDA
#undef PG8_LDB
#undef PG8_MMA
#undef PG8_WAIT_V
#undef PG8_WAIT_L
#undef PG8_BAR
#undef PG8_SCHED
}
}

constexpr int D = 1024, NB = 4, SEQ = 4096, CTXL = 256;
constexpr int ML = NB * SEQ;
constexpr int MC = NB * CTXL;
constexpr int MH = ML + MC;
constexpr int INW = 5120;
constexpr int ZC_W = 1536;
constexpr int NEXP = 16384, NHEAD_P = 8, TOPK = 16;
constexpr float EPS = 1e-6f;
constexpr int NWAVES = 8, NTHREADS = 512;
constexpr int SEGT = 512, NSEG = SEQ / SEGT;
constexpr int CHT = 32;
constexpr int NSCAN_L = NB * 4 * 2 * NSEG;
constexpr int NCSEG = 4;
constexpr int NSCAN = NSCAN_L + NB * 4 * 2 * NCSEG;

constexpr size_t MiB = 1u << 20;
constexpr size_t WS_CTL = 0, CTL_ZERO_BYTES = 64 * 1024;
constexpr size_t WS_MOD = 1 * MiB;
constexpr size_t WS_LBT = WS_MOD + 128 * 1024;
constexpr size_t WS_ASEG = WS_LBT + 8 * 1024;
constexpr size_t WS_SU = WS_ASEG + 200 * 1024;
constexpr size_t WS_SV = WS_SU + 64 * 1024;
constexpr size_t WS_WIN = 2 * MiB;
constexpr size_t WS_WA = 12 * MiB, WS_WB = 13 * MiB, WS_WO = 14 * MiB, WS_WQ = 16 * MiB;
constexpr size_t WS_POOLW = 20 * MiB;
constexpr size_t WS_KEYS = WS_POOLW + 128 * 1024;
constexpr size_t WS_ZC = 21 * MiB;
constexpr size_t WS_Z = 24 * MiB;
constexpr size_t WS_QB = 24 * MiB;
constexpr size_t WS_EIDX = 88 * MiB;
constexpr size_t WS_GATE = 96 * MiB;
constexpr size_t WS_U8 = 112 * MiB, WS_V8 = 128 * MiB;
constexpr size_t WS_PART = 24 * MiB;
constexpr size_t WS_WGT = 104 * MiB;
constexpr size_t WS_H8 = 144 * MiB;
constexpr size_t WS_SH = 160 * MiB;
constexpr size_t WS_PO = 144 * MiB;
constexpr size_t WS_SSQ = 21 * MiB;
constexpr size_t WS_H = 184 * MiB;
constexpr size_t WS_YHG = 184 * MiB, WS_YPOOL = 200 * MiB;
constexpr size_t WS_USEG = 218 * MiB;
constexpr size_t WS_PFX = 242 * MiB;
constexpr size_t WS_M = 218 * MiB;
constexpr size_t WS_ZC2 = 252 * MiB;
constexpr size_t WS_END = 255 * MiB;
static_assert(WS_Z + (size_t)ML * INW * 2 <= WS_H && WS_H + (size_t)MH * D * 2 <= WS_USEG && WS_USEG + (size_t)NSCAN * 128 * 128 * 4 <= WS_END && WS_M + (size_t)ML * D * 2 <= WS_END && WS_USEG + (size_t)NSCAN * 128 * 128 * 4 <= WS_PFX && WS_PFX + 8 * MiB <= WS_ZC2, "ws map");
static_assert(WS_QB + (size_t)ML * 2048 * 2 <= WS_EIDX && WS_V8 + (size_t)NEXP * D <= WS_H, "ws map 2");
constexpr size_t OUT_OLOC = 0, OUT_QSEG = 32 * MiB;
constexpr int CW_BAR = 1024;

constexpr int LDS_BYTES = 163840;
constexpr int MISC_OFF = LDS_BYTES - 256;

#define GAS __attribute__((address_space(1)))
#define LAS __attribute__((address_space(3)))
typedef unsigned short bf16;
typedef unsigned v4u __attribute__((ext_vector_type(4)));
typedef unsigned v2u __attribute__((ext_vector_type(2)));
typedef float f32x4 __attribute__((ext_vector_type(4)));
typedef float f32x2 __attribute__((ext_vector_type(2)));
typedef short bf16x8 __attribute__((ext_vector_type(8)));
typedef short s16x4 __attribute__((ext_vector_type(4)));
#define LDS_WAIT() asm volatile("s_waitcnt lgkmcnt(0)" ::: "memory")
#define VM_WAIT() asm volatile("s_waitcnt vmcnt(0)" ::: "memory")
#define LBAR() do { asm volatile("s_waitcnt lgkmcnt(0)" ::: "memory"); __builtin_amdgcn_s_barrier(); asm volatile("" ::: "memory"); } while (0)
__device__ __forceinline__ unsigned f2bf(float f) { unsigned u = __builtin_bit_cast(unsigned, f); return (u + 0x7fffu + ((u >> 16) & 1u)) >> 16; }
__device__ __forceinline__ unsigned pk2(float lo, float hi) { return pg8::cvt_pk_bf16(lo, hi); }
__device__ __forceinline__ float bflo(unsigned w) { return __builtin_bit_cast(float, w << 16); }
__device__ __forceinline__ float bfhi(unsigned w) { return __builtin_bit_cast(float, w & 0xffff0000u); }
__device__ __forceinline__ float fast_exp(float x) { return __builtin_amdgcn_exp2f(x * 1.4426950408889634f); }
__device__ __forceinline__ float fast_rcp(float x) { return __builtin_amdgcn_rcpf(x); }
__device__ __forceinline__ float sigmoidf_(float x) { return fast_rcp(1.f + fast_exp(-x)); }
__device__ __forceinline__ float wave_sum(float v) {
#pragma unroll
    for (int o = 1; o < 64; o <<= 1) v += __shfl_xor(v, o);
    return v;
}
__device__ __forceinline__ float wave_max(float v) {
#pragma unroll
    for (int o = 1; o < 64; o <<= 1) v = fmaxf(v, __shfl_xor(v, o));
    return v;
}

#define XB_TMO      128
#define XB_XCNT(j)  (256  + 64 * (j))
#define XB_XSUB(j)  (1280 + 64 * (j))
#define XB_XGEN(j)  (2304 + 64 * (j))
#define XB_TOP      3328
#define XB_TOPGEN   3392
#define XCD_BAR_WORDS 3456
#define XB_SPIN_CAP (1u << 18)
__device__ __forceinline__ unsigned xb_ld(unsigned* p)              { return __hip_atomic_load(p, __ATOMIC_RELAXED, __HIP_MEMORY_SCOPE_AGENT); }
__device__ __forceinline__ unsigned xb_add(unsigned* p, unsigned v) { return __hip_atomic_fetch_add(p, v, __ATOMIC_RELAXED, __HIP_MEMORY_SCOPE_AGENT); }
__device__ __forceinline__ unsigned xb_xcc_id() { return (unsigned)__builtin_amdgcn_s_getreg((3 << 11) | 20) & 0xFu; }
#define XB_SPIN(cond, bar) do { unsigned _sp = 0; while (cond) { __builtin_amdgcn_s_sleep(1); \
    if ((++_sp & 255u) == 0u) { if (xb_ld(&(bar)[XB_TMO])) break; if (_sp > XB_SPIN_CAP) { atomicAdd(&(bar)[XB_TMO], 1u); break; } } } } while (0)
struct XcdBarrier { unsigned* bar; unsigned x; volatile LAS unsigned* st; };
__device__ __forceinline__ XcdBarrier xcd_barrier_post(unsigned* bar, volatile LAS unsigned* st) {
    XcdBarrier b; b.bar = bar; b.x = xb_xcc_id(); b.st = st;
    if (threadIdx.x == 0) st[2] = xb_add(&bar[XB_XCNT(b.x)], 1u);
    return b;
}
__device__ __forceinline__ void xcd_barrier_complete(unsigned* bar, unsigned x, unsigned& nloc, unsigned& nx) {
    const unsigned G = gridDim.x * gridDim.y * gridDim.z;
    unsigned sum, cnt, mine, sp = 0u;
    for (;;) {
        sum = 0u; cnt = 0u; mine = 0u;
#pragma unroll
        for (unsigned j = 0; j < 16; ++j) { const unsigned c = xb_ld(&bar[XB_XCNT(j)]); sum += c; cnt += (c > 0u) ? 1u : 0u; mine = (j == x) ? c : mine; }
        if (sum == G) break;
        __builtin_amdgcn_s_sleep(1);
        if ((++sp & 255u) == 0u) { if (xb_ld(&bar[XB_TMO])) break; if (sp > XB_SPIN_CAP) { atomicAdd(&bar[XB_TMO], 1u); break; } }
    }
    nloc = mine > 0u ? mine : 1u; nx = cnt > 0u ? cnt : 1u;
}
__device__ __forceinline__ void xcd_barrier(const XcdBarrier& b) {
    asm volatile("s_waitcnt vmcnt(0)" ::: "memory");
    __syncthreads();
    if (threadIdx.x == 0) {
        unsigned* bar = b.bar;
        __builtin_amdgcn_s_waitcnt(0);
        unsigned nloc = b.st[0], nx = b.st[1];
        if (nloc == 0u) { xcd_barrier_complete(bar, b.x, nloc, nx); b.st[0] = nloc; b.st[1] = nx; }
        const unsigned old = xb_add(&bar[XB_XSUB(b.x)], 1u);
        const unsigned gen = old / nloc;
        if (old + 1u == (gen + 1u) * nloc) {
            __builtin_amdgcn_fence(__ATOMIC_RELEASE, "agent");
            asm volatile("s_waitcnt vmcnt(0)" ::: "memory");
            const unsigned og = xb_add(&bar[XB_TOP], 1u);
            const unsigned tg = og / nx;
            if (og + 1u == (tg + 1u) * nx) xb_add(&bar[XB_TOPGEN], 1u);
            else XB_SPIN(xb_ld(&bar[XB_TOPGEN]) == tg, bar);
            __builtin_amdgcn_fence(__ATOMIC_ACQUIRE, "agent");
            xb_add(&bar[XB_XGEN(b.x)], 1u);
            asm volatile("s_waitcnt vmcnt(0)" ::: "memory");
        } else {
            XB_SPIN(xb_ld(&bar[XB_XGEN(b.x)]) == gen, bar);
            __builtin_amdgcn_fence(__ATOMIC_ACQUIRE, "agent");
            asm volatile("s_waitcnt vmcnt(0)" ::: "memory");
        }
    }
    __syncthreads();
}

struct Args { const float* in[21]; float* out; unsigned char* ws; int ph_lo, ph_hi; };

struct Frame {
    LAS unsigned char* lds; int tid, lane, wave, G, bid;
    const float *x, *c, *ctx, *c_ctx, *w_mod, *b_mod, *n1g, *n2g, *w_in, *pool_w, *pool_scale, *lb_logits, *hg_norm_g, *w_a, *w_b, *w_o, *wq, *keys, *pu, *pv, *final_g;
    float* out; unsigned char* ws;
};

__device__ __forceinline__ void p0_transpose_item(const float* W, int K, int N, bf16* WT, LAS float* scr, int item, int lane) {
    const int nblk = N / 32, kb = item / nblk, nb = item % nblk, k0 = 64 * kb, n0 = 32 * nb;
#pragma unroll 8
    for (int i = 0; i < 32; ++i) { const int kk = 2 * i + (lane >> 5); scr[kk * 33 + (lane & 31)] = W[(size_t)(k0 + kk) * N + n0 + (lane & 31)]; }
    LDS_WAIT(); asm volatile("" ::: "memory");
    const int c = lane & 7;
#pragma unroll
    for (int j = 0; j < 4; ++j) { const int n = (lane >> 3) + 8 * j; const LAS float* s = scr + (8 * c) * 33 + n;
        v4u o; o.x = pk2(s[0 * 33], s[1 * 33]); o.y = pk2(s[2 * 33], s[3 * 33]); o.z = pk2(s[4 * 33], s[5 * 33]); o.w = pk2(s[6 * 33], s[7 * 33]);
        *(GAS v4u*)(WT + (size_t)(n0 + n) * K + k0 + 8 * c) = o; }
    LDS_WAIT(); asm volatile("" ::: "memory");
}

__device__ __forceinline__ void p0_prologue(Frame& F) {
    float* mod = (float*)(F.ws + WS_MOD);
    if (F.bid < 192) {
        LAS float* sl = (LAS float*)(F.lds + 81920);
        LAS float* red = (LAS float*)(F.lds + 81920 + 20480);
        for (int i = F.tid; i < 5 * 1024; i += NTHREADS) { const float cv = (i < 4096) ? F.c[i] : F.c_ctx[i - 4096]; sl[i] = cv * sigmoidf_(cv); }
        __syncthreads();
        const int col = F.tid & 31, kg = F.tid >> 5, col0 = 32 * F.bid;
        float a0 = 0.f, a1 = 0.f, a2 = 0.f, a3 = 0.f, a4 = 0.f;
        const float* wp = F.w_mod + (size_t)(kg * 64) * 6144 + col0 + col;
#pragma unroll 8
        for (int r = 0; r < 64; ++r) { const float w = wp[(size_t)r * 6144]; const int k = kg * 64 + r;
            a0 += w * sl[k]; a1 += w * sl[1024 + k]; a2 += w * sl[2048 + k]; a3 += w * sl[3072 + k]; a4 += w * sl[4096 + k]; }
        red[(kg * 5 + 0) * 32 + col] = a0; red[(kg * 5 + 1) * 32 + col] = a1; red[(kg * 5 + 2) * 32 + col] = a2; red[(kg * 5 + 3) * 32 + col] = a3; red[(kg * 5 + 4) * 32 + col] = a4;
        __syncthreads();
        if (F.tid < 160) { const int v = F.tid >> 5, cc = F.tid & 31; float s = 0.f;
#pragma unroll
            for (int g = 0; g < 16; ++g) s += red[(g * 5 + v) * 32 + cc];
            mod[v * 6144 + col0 + cc] = s + F.b_mod[col0 + cc]; }
        __syncthreads();
    }
    LAS float* scr = (LAS float*)(F.lds + F.wave * 8448);
    const int gw = F.bid * NWAVES + F.wave, NGW = F.G * NWAVES;
    constexpr int I_IN = (D / 64) * (INW / 32), I_A = (512 / 64) * (D / 32), I_O = (D / 64) * (D / 32), I_Q = (D / 64) * (2048 / 32), I_P = (128 / 64) * (128 / 32);
    constexpr int NITEMS = I_IN + 2 * I_A + I_O + I_Q + 4 * I_P;
    for (int it = gw; it < NITEMS; it += NGW) {
        int r = it;
        if (r < I_IN) { p0_transpose_item(F.w_in, D, INW, (bf16*)(F.ws + WS_WIN), scr, r, F.lane); continue; } r -= I_IN;
        if (r < I_A) { p0_transpose_item(F.w_a, 512, D, (bf16*)(F.ws + WS_WA), scr, r, F.lane); continue; } r -= I_A;
        if (r < I_A) { p0_transpose_item(F.w_b, 512, D, (bf16*)(F.ws + WS_WB), scr, r, F.lane); continue; } r -= I_A;
        if (r < I_O) { p0_transpose_item(F.w_o, D, D, (bf16*)(F.ws + WS_WO), scr, r, F.lane); continue; } r -= I_O;
        if (r < I_Q) { p0_transpose_item(F.wq, D, 2048, (bf16*)(F.ws + WS_WQ), scr, r, F.lane); continue; } r -= I_Q;
        { const int g = r / I_P; p0_transpose_item(F.pool_w + (size_t)g * 128 * 128, 128, 128, (bf16*)(F.ws + WS_POOLW) + (size_t)g * 128 * 128, scr, r % I_P, F.lane); }
    }
    { bf16* kb = (bf16*)(F.ws + WS_KEYS); const int gt = F.bid * NTHREADS + F.tid, NT = F.G * NTHREADS;
      for (int i = gt; i < 16 * 128 * 128 / 4; i += NT) { const f32x4 v = ((const GAS f32x4*)F.keys)[i]; v2u o; o.x = pk2(v.x, v.y); o.y = pk2(v.z, v.w); ((GAS v2u*)kb)[i] = o; }
      float* lbt = (float*)(F.ws + WS_LBT);
      if (gt < 1024) { const int dir = gt >> 9, cc = gt & 511; const float l0 = F.lb_logits[(dir * 2 + 0) * 512 + cc], l1 = F.lb_logits[(dir * 2 + 1) * 512 + cc];
          lbt[gt] = 1.f / (1.f + expf(l1 - l0)); } }
}

__device__ __forceinline__ void modulate_row(const float* xrow, bf16* orow, const float* g, const float* shift, const float* scale, int lane) {
    const GAS f32x4* xr = (const GAS f32x4*)xrow + lane;
    f32x4 v[4]; float s2 = 0.f;
#pragma unroll
    for (int j = 0; j < 4; ++j) { v[j] = xr[64 * j]; s2 += (v[j].x * v[j].x + v[j].y * v[j].y) + (v[j].z * v[j].z + v[j].w * v[j].w); }
    const float rstd = 1.f / sqrtf(wave_sum(s2) * (1.f / D) + EPS);
    GAS v2u* o8 = (GAS v2u*)orow + lane;
#pragma unroll
    for (int j = 0; j < 4; ++j) {
        const f32x4 gg = ((const GAS f32x4*)g)[lane + 64 * j], sh = ((const GAS f32x4*)shift)[lane + 64 * j], sc = ((const GAS f32x4*)scale)[lane + 64 * j];
        const f32x4 y = (v[j] * rstd) * gg * (sc + 1.0f) + sh;
        v2u o; o.x = pk2(y.x, y.y); o.y = pk2(y.z, y.w); o8[64 * j] = o; }
}
__device__ __forceinline__ void p1_modulate(Frame& F) {
    const float* mod = (const float*)(F.ws + WS_MOD); bf16* H = (bf16*)(F.ws + WS_H);
    const int gw = F.bid * NWAVES + F.wave, NGW = F.G * NWAVES;
    for (int m = gw; m < MH; m += NGW) {
        const int v = (m < ML) ? (m >> 12) : 4;
        const float* xr = (m < ML) ? F.x + (size_t)m * D : F.ctx + (size_t)(m - ML) * D;
        modulate_row(xr, H + (size_t)m * D, F.n1g, mod + v * 6144 + 0, mod + v * 6144 + 1024, F.lane);
    }
}

using pg8::Unit;
struct SchedPlain {
    const char* Ab; const char* Bb; int nM, nN, K, G, c;
    __device__ __forceinline__ bool next(int i, Unit& u) const { const int L = i * G + c; if (L >= nM * nN) return false; pg8::tile_of(L, nM, nN, u.pm, u.pn); u.seg = 0; return true; }
    __device__ __forceinline__ const char* A(const Unit& u) const { return Ab + (size_t)u.pm * 256 * K * 2; }
    __device__ __forceinline__ const char* B(const Unit& u) const { return Bb + (size_t)u.pn * 256 * K * 2; }
    __device__ __forceinline__ bool keep(const Unit&) const { return false; }
    __device__ __forceinline__ int nt(const Unit&) const { return K / 64; }
};
struct SchedIn {
    const char* Ab; const char* Bb; int G, c;
    __device__ __forceinline__ bool next(int i, Unit& u) const { const int L = i * G + c; u.seg = 0;
        if (L < 1280) { pg8::tile_of(L, 64, 20, u.pm, u.pn); return true; }
        if (L < 1328) { const int l = L - 1280, l2 = l >> 1; u.seg = l & 1; u.pm = 64 + (l2 & 3); u.pn = 4 + (l2 >> 2); return true; }
        return false; }
    __device__ __forceinline__ const char* A(const Unit& u) const { return Ab + (size_t)u.pm * 256 * D * 2 + ((u.pm >= 64 && u.seg) ? 1024 : 0); }
    __device__ __forceinline__ const char* B(const Unit& u) const { return Bb + (size_t)u.pn * 256 * D * 2 + ((u.pm >= 64 && u.seg) ? 1024 : 0); }
    __device__ __forceinline__ bool keep(const Unit&) const { return false; }
    __device__ __forceinline__ int nt(const Unit& u) const { return u.pm >= 64 ? 8 : 16; }
};
struct SchedMerge {
    const char *A0, *A1, *B0, *B1; int G, c;
    __device__ __forceinline__ bool next(int i, Unit& u) const { const int tile = (i >> 1) * G + c; if (tile >= 256) return false; pg8::tile_of(tile, 64, 4, u.pm, u.pn); u.seg = i & 1; return true; }
    __device__ __forceinline__ const char* A(const Unit& u) const { return (u.seg ? A1 : A0) + (size_t)u.pm * 256 * 512 * 2; }
    __device__ __forceinline__ const char* B(const Unit& u) const { return (u.seg ? B1 : B0) + (size_t)u.pn * 256 * 512 * 2; }
    __device__ __forceinline__ bool keep(const Unit& u) const { return u.seg == 0; }
    __device__ __forceinline__ int nt(const Unit&) const { return 8; }
};

struct EpiZ {
    static constexpr bool PERM = true;
    bf16* Z; bf16* ZC; bf16* ZC2;
    __device__ __forceinline__ void operator()(pg8::f32x4 (&acc)[2][2][4][2], const Unit& u, int wr, int wc, int fr, int fq) const {
        int row0 = u.pm * 256 + wr * 64 + fr, col0 = u.pn * 256 + wc * 32 + 8 * fq, ldc = INW; bf16* base = Z;
        if (u.pm >= 64) { base = u.seg ? ZC2 : ZC; row0 -= ML; col0 -= 1024; ldc = ZC_W; }
        const bool sg = u.pn >= 12;
#pragma unroll
        for (int ai = 0; ai < 2; ++ai)
#pragma unroll
            for (int m = 0; m < 4; ++m) { bf16* rowp = base + (size_t)(row0 + ai * 128 + m * 16) * ldc + col0;
#pragma unroll
                for (int bj = 0; bj < 2; ++bj) { pg8::f32x4 v0 = acc[ai][bj][m][0], v1 = acc[ai][bj][m][1];
                    if (sg) {
#pragma unroll
                        for (int j = 0; j < 4; ++j) { v0[j] = sigmoidf_(v0[j]); v1[j] = sigmoidf_(v1[j]); } }
                    v4u w; w.x = pk2(v0[0], v0[1]); w.y = pk2(v0[2], v0[3]); w.z = pk2(v1[0], v1[1]); w.w = pk2(v1[2], v1[3]);
                    *(GAS v4u*)(rowp + bj * 128) = w; } }
    }
};
struct EpiPlain {
    static constexpr bool PERM = true;
    bf16* O; int ldc;
    __device__ __forceinline__ void operator()(pg8::f32x4 (&acc)[2][2][4][2], const Unit& u, int wr, int wc, int fr, int fq) const {
        const int row0 = u.pm * 256 + wr * 64 + fr, col0 = u.pn * 256 + wc * 32 + 8 * fq;
#pragma unroll
        for (int ai = 0; ai < 2; ++ai)
#pragma unroll
            for (int m = 0; m < 4; ++m) { bf16* rowp = O + (size_t)(row0 + ai * 128 + m * 16) * ldc + col0;
#pragma unroll
                for (int bj = 0; bj < 2; ++bj) { const pg8::f32x4 v0 = acc[ai][bj][m][0], v1 = acc[ai][bj][m][1];
                    v4u w; w.x = pk2(v0[0], v0[1]); w.y = pk2(v0[2], v0[3]); w.z = pk2(v1[0], v1[1]); w.w = pk2(v1[2], v1[3]);
                    *(GAS v4u*)(rowp + bj * 128) = w; } }
    }
};
struct EpiMerge {
    static constexpr bool PERM = true;
    const bf16* Z; bf16* Mo;
    __device__ __forceinline__ void operator()(pg8::f32x4 (&acc)[2][2][4][2], const Unit& u, int wr, int wc, int fr, int fq) const {
        const int row0 = u.pm * 256 + wr * 64 + fr, col0 = u.pn * 256 + wc * 32 + 8 * fq;
#pragma unroll
        for (int ai = 0; ai < 2; ++ai)
#pragma unroll
            for (int m = 0; m < 4; ++m) { const size_t r = (size_t)(row0 + ai * 128 + m * 16);
#pragma unroll
                for (int bj = 0; bj < 2; ++bj) { const int c = col0 + bj * 128;
                    const v4u gh = *(const GAS v4u*)(Z + r * INW + 4096 + c);
                    float h[8] = {bflo(gh.x), bfhi(gh.x), bflo(gh.y), bfhi(gh.y), bflo(gh.z), bfhi(gh.z), bflo(gh.w), bfhi(gh.w)};
                    if (u.seg == 0) {
                        const v4u gp = *(const GAS v4u*)(Z + r * INW + 3072 + c);
                        float p[8] = {bflo(gp.x), bfhi(gp.x), bflo(gp.y), bfhi(gp.y), bflo(gp.z), bfhi(gp.z), bflo(gp.w), bfhi(gp.w)};
#pragma unroll
                        for (int j = 0; j < 4; ++j) { acc[ai][bj][m][0][j] *= p[j] * fast_rcp(fmaxf(h[j], 1e-30f)); acc[ai][bj][m][1][j] *= p[4 + j] * fast_rcp(fmaxf(h[4 + j], 1e-30f)); }
                    } else {
                        pg8::f32x4 v0 = acc[ai][bj][m][0], v1 = acc[ai][bj][m][1];
#pragma unroll
                        for (int j = 0; j < 4; ++j) { v0[j] *= h[j]; v1[j] *= h[4 + j]; }
                        v4u w; w.x = pk2(v0[0], v0[1]); w.y = pk2(v0[2], v0[3]); w.z = pk2(v1[0], v1[1]); w.w = pk2(v1[2], v1[3]);
                        *(GAS v4u*)(Mo + r * D + c) = w; } } }
    }
};
struct EpiRes {
    static constexpr bool PERM = false;
    const float* X; const float* mod; float* O;
    __device__ __forceinline__ void operator()(pg8::f32x4 (&acc)[2][2][4][2], const Unit& u, int wr, int wc, int fr, int fq) const {
        const int row0 = u.pm * 256 + wr * 64 + fr, col0 = u.pn * 256 + wc * 32 + 4 * fq;
        const float* g1 = mod + (size_t)(u.pm >> 4) * 6144 + 2048;
        pg8::f32x4 gv[2][2];
#pragma unroll
        for (int bj = 0; bj < 2; ++bj)
#pragma unroll
            for (int n = 0; n < 2; ++n) gv[bj][n] = *(const GAS pg8::f32x4*)(g1 + col0 + bj * 128 + n * 16);
#pragma unroll
        for (int ai = 0; ai < 2; ++ai)
#pragma unroll
            for (int m = 0; m < 4; ++m) { const size_t off = (size_t)(row0 + ai * 128 + m * 16) * D + col0;
#pragma unroll
                for (int bj = 0; bj < 2; ++bj)
#pragma unroll
                    for (int n = 0; n < 2; ++n) { const pg8::f32x4 xv = *(const GAS pg8::f32x4*)(X + off + bj * 128 + n * 16);
                        *(GAS pg8::f32x4*)(O + off + bj * 128 + n * 16) = xv + gv[bj][n] * acc[ai][bj][m][n]; }
                asm volatile("" ::: "memory"); }
    }
};

__device__ __forceinline__ unsigned off_b(unsigned row, unsigned ch) { return 256u * row + 16u * (ch ^ (((row & 3) << 2) | ((row >> 2) & 3))); }
__device__ __forceinline__ unsigned row_addr16(unsigned lane, unsigned rb, unsigned s) { return off_b((lane & 15) + 16 * rb, 4 * s + (lane >> 4)); }
__device__ __forceinline__ unsigned tr_addr16(unsigned lane, unsigned c, unsigned t) { const unsigned g = lane >> 4, q = (lane & 15) >> 2, p = lane & 3; return off_b(8 * g + 4 * t + q, 2 * c + (p >> 1)) + 8 * (p & 1); }
__device__ __forceinline__ bf16x8 tr_frag(LAS unsigned char* tile, unsigned lane, unsigned c) {
    const s16x4 lo = __builtin_amdgcn_ds_read_tr16_b64_v4i16((LAS s16x4*)(tile + tr_addr16(lane, c, 0)));
    const s16x4 hi = __builtin_amdgcn_ds_read_tr16_b64_v4i16((LAS s16x4*)(tile + tr_addr16(lane, c, 1)));
    return __builtin_shufflevector(lo, hi, 0, 1, 2, 3, 4, 5, 6, 7);
}
#define MFMA16(a, b, c) __builtin_amdgcn_mfma_f32_16x16x32_bf16((a), (b), (c), 0, 0, 0)

__device__ __forceinline__ v4u add_bf16x8(const v4u a, const v4u b) {
    v4u r; r.x = pk2(bflo(a.x) + bflo(b.x), bfhi(a.x) + bfhi(b.x)); r.y = pk2(bflo(a.y) + bflo(b.y), bfhi(a.y) + bfhi(b.y));
    r.z = pk2(bflo(a.z) + bflo(b.z), bfhi(a.z) + bfhi(b.z)); r.w = pk2(bflo(a.w) + bflo(b.w), bfhi(a.w) + bfhi(b.w)); return r; }
constexpr int SC_QT = 0, SC_KT = 8192, SC_KD = 16384, SC_VT = 24576, SC_ATT = 32768, SC_EL = 35328, SC_WT = 35840;

__device__ __forceinline__ void scan_unit(Frame& F, int u) {
    const int tid = F.tid, lane = F.lane, w = F.wave, q = lane >> 4;
    const bool isctx = u >= NSCAN_L;
    int b, h, dir, rowbase, nch; const bf16* src; int ld, cq, ci, cf;
    if (!isctx) { const int j = u & 7; dir = (u >> 3) & 1; h = (u >> 4) & 3; b = u >> 6; const int tb = dir ? 7 - j : j;
        rowbase = b * SEQ + tb * SEGT; nch = SEGT / CHT; src = (const bf16*)(F.ws + WS_Z); ld = INW; cq = 512 + h * 128; ci = 1024 + h * 128; cf = (dir ? 2048 : 1536) + h * 128; }
    else { const int v = u - NSCAN_L, cs = v & (NCSEG - 1); dir = (v >> 2) & 1; h = (v >> 3) & 3; b = v >> 5;
        rowbase = b * CTXL + (dir ? NCSEG - 1 - cs : cs) * (CTXL / NCSEG); nch = CTXL / NCSEG / CHT; src = (const bf16*)(F.ws + WS_ZC); ld = ZC_W; ci = h * 128; cq = ci; cf = (dir ? 1024 : 512) + h * 128; }
    const int t = tid >> 4, k8 = tid & 15;
    const int pl = dir ? 3 - q : q;
    const float* lbt = (const float*)(F.ws + WS_LBT) + dir * 512 + h * 128 + 8 * k8;
    float lb[8], om_[8], ecum[8];
#pragma unroll
    for (int i = 0; i < 8; ++i) { lb[i] = lbt[i]; om_[i] = 1.f - lbt[i]; ecum[i] = 1.f; }
    f32x4 S[8];
#pragma unroll
    for (int i = 0; i < 8; ++i) S[i] = (f32x4){0.f, 0.f, 0.f, 0.f};
    LAS unsigned char* L = F.lds;
    bf16* qseg = (bf16*)((unsigned char*)F.out + OUT_QSEG) + (size_t)dir * ML * 512;
    bf16* oloc = (bf16*)((unsigned char*)F.out + OUT_OLOC);
    v4u qv, vv, fv;
    { const int tc = dir ? nch - 1 : 0; const bf16* rp = src + (size_t)(rowbase + tc * CHT + t) * ld + 8 * k8;
      qv = *(const GAS v4u*)(rp + cq); vv = *(const GAS v4u*)(rp + ci); fv = *(const GAS v4u*)(rp + cf);
      if (isctx) { const bf16* r2 = rp + (WS_ZC2 - WS_ZC) / 2; vv = add_bf16x8(vv, *(const GAS v4u*)(r2 + ci)); fv = add_bf16x8(fv, *(const GAS v4u*)(r2 + cf)); qv = vv; } }
    for (int pc = 0; pc < nch; ++pc) {
        const int tc = dir ? nch - 1 - pc : pc;
        const v4u q0 = qv, v0 = vv, f0 = fv;
        if (pc + 1 < nch) { const int tn = dir ? tc - 1 : tc + 1; const bf16* rp = src + (size_t)(rowbase + tn * CHT + t) * ld + 8 * k8;
            qv = *(const GAS v4u*)(rp + cq); vv = *(const GAS v4u*)(rp + ci); fv = *(const GAS v4u*)(rp + cf);
            if (isctx) { const bf16* r2 = rp + (WS_ZC2 - WS_ZC) / 2; vv = add_bf16x8(vv, *(const GAS v4u*)(r2 + ci)); fv = add_bf16x8(fv, *(const GAS v4u*)(r2 + cf)); qv = vv; } }
        float fr_[8] = {bflo(f0.x), bfhi(f0.x), bflo(f0.y), bfhi(f0.y), bflo(f0.z), bfhi(f0.z), bflo(f0.w), bfhi(f0.w)};
        float e[8], kk[8];
#pragma unroll
        for (int i = 0; i < 8; ++i) { const float s = fast_rcp(1.f + fast_exp(-fr_[i])); e[i] = lb[i] + om_[i] * s; kk[i] = om_[i] - om_[i] * s; }
        { const int s1 = dir ? lane + 16 : lane - 16, s2 = dir ? lane + 32 : lane - 32;
#pragma unroll
          for (int i = 0; i < 8; ++i) { const float o = __shfl(e[i], s1 & 63); e[i] = (pl >= 1) ? e[i] * o : e[i]; }
#pragma unroll
          for (int i = 0; i < 8; ++i) { const float o = __shfl(e[i], s2 & 63); e[i] = (pl >= 2) ? e[i] * o : e[i]; } }
        if (pl == 3) { LAS f32x4* wt = (LAS f32x4*)(L + SC_WT + (w * 128 + 8 * k8) * 4); wt[0] = (f32x4){e[0], e[1], e[2], e[3]}; wt[1] = (f32x4){e[4], e[5], e[6], e[7]}; }
        LBAR();
        float etot[8];
        { float pre[8], run[8];
#pragma unroll
          for (int i = 0; i < 8; ++i) { pre[i] = 1.f; run[i] = 1.f; }
#pragma unroll
          for (int sidx = 0; sidx < 8; ++sidx) { const int ww = dir ? 7 - sidx : sidx;
              const LAS f32x4* wt = (const LAS f32x4*)(L + SC_WT + (ww * 128 + 8 * k8) * 4); const f32x4 a = wt[0], c = wt[1];
              if (ww == w) {
#pragma unroll
                  for (int i = 0; i < 8; ++i) pre[i] = run[i]; }
              run[0] *= a.x; run[1] *= a.y; run[2] *= a.z; run[3] *= a.w; run[4] *= c.x; run[5] *= c.y; run[6] *= c.z; run[7] *= c.w; }
#pragma unroll
          for (int i = 0; i < 8; ++i) { etot[i] = run[i]; e[i] *= pre[i]; } }
        {
            const float qf[8] = {bflo(q0.x), bfhi(q0.x), bflo(q0.y), bfhi(q0.y), bflo(q0.z), bfhi(q0.z), bflo(q0.w), bfhi(q0.w)};
            float qt[8], kt[8], kd[8];
#pragma unroll
            for (int i = 0; i < 8; ++i) { qt[i] = qf[i] * e[i]; kt[i] = kk[i] * fast_rcp(e[i]); kd[i] = kt[i] * etot[i]; }
            const unsigned ob = off_b((unsigned)t, (unsigned)k8);
            v4u o; o.x = pk2(qt[0], qt[1]); o.y = pk2(qt[2], qt[3]); o.z = pk2(qt[4], qt[5]); o.w = pk2(qt[6], qt[7]); *(LAS v4u*)(L + SC_QT + ob) = o;
            o.x = pk2(kt[0], kt[1]); o.y = pk2(kt[2], kt[3]); o.z = pk2(kt[4], kt[5]); o.w = pk2(kt[6], kt[7]); *(LAS v4u*)(L + SC_KT + ob) = o;
            o.x = pk2(kd[0], kd[1]); o.y = pk2(kd[2], kd[3]); o.z = pk2(kd[4], kd[5]); o.w = pk2(kd[6], kd[7]); *(LAS v4u*)(L + SC_KD + ob) = o;
            *(LAS v4u*)(L + SC_VT + ob) = v0;
            if (!isctx) { o.x = pk2(qt[0] * ecum[0], qt[1] * ecum[1]); o.y = pk2(qt[2] * ecum[2], qt[3] * ecum[3]); o.z = pk2(qt[4] * ecum[4], qt[5] * ecum[5]); o.w = pk2(qt[6] * ecum[6], qt[7] * ecum[7]);
                *(GAS v4u*)(qseg + (size_t)(rowbase + tc * CHT + t) * 512 + h * 128 + 8 * k8) = o; }
            if (t == 0) { LAS f32x4* el = (LAS f32x4*)(L + SC_EL + 32 * k8); el[0] = (f32x4){etot[0], etot[1], etot[2], etot[3]}; el[1] = (f32x4){etot[4], etot[5], etot[6], etot[7]}; }
#pragma unroll
            for (int i = 0; i < 8; ++i) ecum[i] *= etot[i];
        }
        LBAR();
        if (w < 4 && !isctx) {
            const int tt = dir ? (w >> 1) : ((w + 1) >> 1), st = dir ? ((w + 1) >> 1) : (w >> 1);
            const int tz = dir ? 1 : 0, sz = dir ? 0 : 1;
            f32x4 a = (f32x4){0.f, 0.f, 0.f, 0.f};
            if (w < 3) {
#pragma unroll
                for (int s = 0; s < 4; ++s) { const bf16x8 A = *(const LAS bf16x8*)(L + SC_QT + row_addr16(lane, tt, s)); const bf16x8 B = *(const LAS bf16x8*)(L + SC_KT + row_addr16(lane, st, s)); a = MFMA16(A, B, a); }
            }
            const int tr = (w < 3 ? tt : tz) * 16 + 4 * q, sc = (w < 3 ? st : sz) * 16 + (lane & 15);
#pragma unroll
            for (int j = 0; j < 4; ++j) { const int ti = tr + j; const bool ok = (w < 3) && (dir ? (sc >= ti) : (sc <= ti));
                *(LAS unsigned short*)(L + SC_ATT + ti * 80 + sc * 2) = (unsigned short)f2bf(ok ? a[j] : 0.f); }
        }
        LBAR();
        {
            const bf16x8 Bv = tr_frag(L + SC_VT, lane, w);
            if (!isctx) {
                v4u sb[4];
#pragma unroll
                for (int s = 0; s < 4; ++s) { sb[s].x = pk2(S[2 * s][0], S[2 * s][1]); sb[s].y = pk2(S[2 * s][2], S[2 * s][3]); sb[s].z = pk2(S[2 * s + 1][0], S[2 * s + 1][1]); sb[s].w = pk2(S[2 * s + 1][2], S[2 * s + 1][3]); }
#pragma unroll 1
                for (int tt = 0; tt < 2; ++tt) {
                    f32x4 o = (f32x4){0.f, 0.f, 0.f, 0.f};
                    const unsigned row = 16 * tt + (lane & 15);
#pragma unroll
                    for (int s = 0; s < 4; ++s) {
                        const v2u alo = *(const LAS v2u*)(L + SC_QT + off_b(row, 4 * s + (q >> 1)) + 8 * (q & 1));
                        const v2u ahi = *(const LAS v2u*)(L + SC_QT + off_b(row, 4 * s + 2 + (q >> 1)) + 8 * (q & 1));
                        const v4u av = (v4u){alo.x, alo.y, ahi.x, ahi.y};
                        o = MFMA16(__builtin_bit_cast(bf16x8, av), __builtin_bit_cast(bf16x8, sb[s]), o);
                    }
                    const bf16x8 At = *(const LAS bf16x8*)(L + SC_ATT + row * 80 + 16 * q);
                    o = MFMA16(At, Bv, o);
                    const int ttg = (rowbase + tc * CHT + 16 * tt) >> 4;
                    v2u ov; ov.x = pk2(o[0], o[1]); ov.y = pk2(o[2], o[3]);
                    *(GAS v2u*)(oloc + ((((size_t)(dir * 1024 + ttg) * 4 + h) * 8 + w) * 64 + lane) * 4) = ov;
                }
            }
#pragma unroll
            for (int kt = 0; kt < 8; ++kt) {
                const bf16x8 A = tr_frag(L + SC_KD, lane, kt);
                const f32x4 a4 = *(const LAS f32x4*)(L + SC_EL + (16 * kt + 4 * q) * 4);
                S[kt] = MFMA16(A, Bv, S[kt] * a4);
            }
        }
    }
    { float* us = (float*)(F.ws + WS_USEG) + (size_t)u * 128 * 128 + (4 * q) * 128 + 16 * w + (lane & 15);
#pragma unroll
      for (int kt = 0; kt < 8; ++kt) {
#pragma unroll
          for (int j = 0; j < 4; ++j) us[j * 128] = S[kt][j];
          us += 16 * 128; asm volatile("" : "+v"(us)); }
      if (t == 0) { float* as = (float*)(F.ws + WS_ASEG) + (size_t)u * 128 + 8 * k8;
#pragma unroll
          for (int i = 0; i < 8; ++i) as[i] = ecum[i]; } }
    __syncthreads();
}


constexpr int PL_V = 0, PL_VSTR = 132, PL_D = 34816, PL_DSTR = 272, PL_W = 53248;
#define PL_LOAD8(ra, rd, g_, r0b_, rhi_) do { _Pragma("unroll") for (int u8 = 0; u8 < 8; ++u8) { const int rr_ = min((r0b_) + u8, (rhi_)); \
    const bf16* p_ = Z + (size_t)(b * SEQ + rr_ * 64 + c) * INW + (g_) * 128 + 16 * ch16; ra[u8] = *(const GAS v4u*)p_; rd[u8] = *(const GAS v4u*)(p_ + 8); } } while (0)
#define PL_CONSUME8(ra, rd, r0b_, rhi_) do { _Pragma("unroll") for (int u8 = 0; u8 < 8; ++u8) { const int rr_ = (r0b_) + u8; const bool in_ = rr_ <= (rhi_); const v4u a_ = ra[u8], d_ = rd[u8]; \
    const float x_[16] = {bflo(a_.x), bfhi(a_.x), bflo(a_.y), bfhi(a_.y), bflo(a_.z), bfhi(a_.z), bflo(a_.w), bfhi(a_.w), bflo(d_.x), bfhi(d_.x), bflo(d_.y), bfhi(d_.y), bflo(d_.z), bfhi(d_.z), bflo(d_.w), bfhi(d_.w)}; \
    _Pragma("unroll") for (int i_ = 0; i_ < 16; ++i_) { vs[i_] += in_ ? x_[i_] : 0.f; pc[i_] = (in_ && rr_ == r) ? x_[i_] : pc[i_]; } } } while (0)
__device__ __forceinline__ void pool_unit(Frame& F, int u) {
    const int b = u >> 6, r = u & 63, tid = F.tid, lane = F.lane, w = F.wave, q = lane >> 4;
    const int c = tid >> 3, ch16 = tid & 7;
    const bf16* Z = (const bf16*)(F.ws + WS_Z); bf16* YP = (bf16*)(F.ws + WS_YPOOL);
    LAS unsigned char* L = F.lds;
#pragma unroll 1
    for (int g = 0; g < 4; ++g) {
        v4u ra[8], rd[8];
        const int half = 1 << g;
        const int r_lo = max(0, r - half), r_hi = min(63, r + half - 1), c_lo = max(0, c - half), c_hi = min(63, c + half - 1);
        float vs[16], pc[16];
#pragma unroll
        for (int i = 0; i < 16; ++i) { vs[i] = 0.f; pc[i] = 0.f; }
        v4u wreg[4];
        { const GAS v4u* wsrc = (const GAS v4u*)((const bf16*)(F.ws + WS_POOLW) + (size_t)g * 128 * 128);
#pragma unroll
          for (int i = 0; i < 4; ++i) wreg[i] = wsrc[tid + 512 * i]; }
        PL_LOAD8(ra, rd, g, r_lo, r_hi); PL_CONSUME8(ra, rd, r_lo, r_hi);
        if (g == 3) { PL_LOAD8(ra, rd, 3, r_lo + 8, r_hi); PL_CONSUME8(ra, rd, r_lo + 8, r_hi); }
        { LAS f32x4* vp = (LAS f32x4*)(L + PL_V + (c * PL_VSTR + 16 * ch16) * 4);
#pragma unroll
          for (int i = 0; i < 4; ++i) vp[i] = (f32x4){vs[4 * i], vs[4 * i + 1], vs[4 * i + 2], vs[4 * i + 3]}; }
        LBAR();
#pragma unroll
        for (int i = 0; i < 4; ++i) { const int ci = tid + 512 * i; *(LAS v4u*)(L + PL_W + (ci >> 4) * PL_DSTR + (ci & 15) * 16) = wreg[i]; }
        float hs[16];
#pragma unroll
        for (int i = 0; i < 16; ++i) hs[i] = 0.f;
        for (int cc = c_lo; cc <= c_hi; ++cc) { const LAS f32x4* vp = (const LAS f32x4*)(L + PL_V + (cc * PL_VSTR + 16 * ch16) * 4);
#pragma unroll
            for (int i = 0; i < 4; ++i) { const f32x4 x = vp[i]; hs[4 * i] += x.x; hs[4 * i + 1] += x.y; hs[4 * i + 2] += x.z; hs[4 * i + 3] += x.w; } }
        { const float inv = 1.f / (float)((r_hi - r_lo + 1) * (c_hi - c_lo + 1));
          v4u o0, o1;
          o0.x = pk2(hs[0] * inv - pc[0], hs[1] * inv - pc[1]); o0.y = pk2(hs[2] * inv - pc[2], hs[3] * inv - pc[3]); o0.z = pk2(hs[4] * inv - pc[4], hs[5] * inv - pc[5]); o0.w = pk2(hs[6] * inv - pc[6], hs[7] * inv - pc[7]);
          o1.x = pk2(hs[8] * inv - pc[8], hs[9] * inv - pc[9]); o1.y = pk2(hs[10] * inv - pc[10], hs[11] * inv - pc[11]); o1.z = pk2(hs[12] * inv - pc[12], hs[13] * inv - pc[13]); o1.w = pk2(hs[14] * inv - pc[14], hs[15] * inv - pc[15]);
          LAS v4u* dp = (LAS v4u*)(L + PL_D + c * PL_DSTR + 32 * ch16); dp[0] = o0; dp[1] = o1; }
        LBAR();
        { const int tt = w >> 1;
          bf16x8 Bd[4];
#pragma unroll
          for (int s = 0; s < 4; ++s) Bd[s] = *(const LAS bf16x8*)(L + PL_D + (16 * tt + (lane & 15)) * PL_DSTR + (32 * s + 8 * q) * 2);
#pragma unroll
          for (int ni = 0; ni < 4; ++ni) { const int nt = 4 * (w & 1) + ni; f32x4 a = (f32x4){0.f, 0.f, 0.f, 0.f};
#pragma unroll
              for (int s = 0; s < 4; ++s) { const bf16x8 A = *(const LAS bf16x8*)(L + PL_W + (16 * nt + (lane & 15)) * PL_DSTR + (32 * s + 8 * q) * 2); a = MFMA16(A, Bd[s], a); }
              const f32x4 sc = *(const GAS f32x4*)(F.pool_scale + g * 128 + 16 * nt + 4 * q);
              v2u o; o.x = pk2(a[0] * sc.x, a[1] * sc.y); o.y = pk2(a[2] * sc.z, a[3] * sc.w);
              *(GAS v2u*)(YP + (size_t)(b * SEQ + r * 64 + 16 * tt + (lane & 15)) * 512 + g * 128 + 16 * nt + 4 * q) = o; } }
    }
    __syncthreads();
}

constexpr int FX_SF = 0, FX_SB = 32768, FX_SCR = 65536, FX_SCRSTR = 132;
__device__ __forceinline__ void prefix_unit(Frame& F, int u) {
    const int chain = u >> 3, rb = u & 7, tid = F.tid, k = 16 * rb + (tid >> 5), v = 4 * (tid & 31);
    const float* US = (const float*)(F.ws + WS_USEG); const float* AS = (const float*)(F.ws + WS_ASEG);
    unsigned char* P = F.ws + WS_PFX + (size_t)chain * 8 * 32768;
    constexpr int NU = NCSEG + 7;
    f32x4 uu[NU]; float aa[NU];
#pragma unroll
    for (int i = 0; i < NU; ++i) { const int un = (i < NCSEG) ? NSCAN_L + chain * NCSEG + i : chain * 8 + (i - NCSEG);
        uu[i] = *(const GAS f32x4*)(US + ((size_t)un * 128 + k) * 128 + v); aa[i] = AS[un * 128 + k]; }
    f32x4 s = uu[0];
#pragma unroll
    for (int i = 1; i < NCSEG; ++i) s = s * aa[i] + uu[i];
    const unsigned ob = (unsigned)(k >> 5) * 8192u + off_b((unsigned)(k & 31), (unsigned)(v >> 3)) + (unsigned)(v & 7) * 2u;
#pragma unroll
    for (int j = 0; j < 8; ++j) {
        v2u o; o.x = pk2(s.x, s.y); o.y = pk2(s.z, s.w);
        *(GAS v2u*)(P + (size_t)j * 32768 + ob) = o;
        if (j < 7) s = s * aa[NCSEG + j] + uu[NCSEG + j];
    }
}
__device__ __forceinline__ void fix_load_state(Frame& F, int chain, int seg, int soff) {
    const GAS v4u* src = (const GAS v4u*)(F.ws + WS_PFX + ((size_t)chain * 8 + seg) * 32768) + F.tid;
#pragma unroll
    for (int i = 0; i < 4; ++i) *(LAS v4u*)(F.lds + soff + (F.tid + 512 * i) * 16) = src[512 * i];
}
__device__ __forceinline__ void fix_unit(Frame& F, int u) {
    const int tb = u & 7, h = (u >> 3) & 3, b = u >> 5, lane = F.lane, w = F.wave, q = lane >> 4;
    LAS unsigned char* L = F.lds;
    fix_load_state(F, (b * 4 + h) * 2 + 0, tb, FX_SF);
    fix_load_state(F, (b * 4 + h) * 2 + 1, 7 - tb, FX_SB);
    __syncthreads();
    const bf16* Z = (const bf16*)(F.ws + WS_Z); bf16* YH = (bf16*)(F.ws + WS_YHG);
    const bf16* qseg = (const bf16*)((const unsigned char*)F.out + OUT_QSEG); const bf16* oloc = (const bf16*)((const unsigned char*)F.out + OUT_OLOC);
    LAS float* scr = (LAS float*)(L + FX_SCR + w * (16 * FX_SCRSTR * 4));
    const int row0 = b * SEQ + tb * SEGT;
#pragma unroll 1
    for (int ti = 0; ti < 4; ++ti) {
        const int tt = 4 * w + ti, rowt = row0 + 16 * tt;
        f32x4 acc[8];
#pragma unroll
        for (int c = 0; c < 8; ++c) acc[c] = (f32x4){0.f, 0.f, 0.f, 0.f};
        bf16x8 A[2][4]; v2u ol[2][8]; v4u ogv[4];
        const int tl = lane >> 2, v0 = 32 * (lane & 3);
#pragma unroll
        for (int dir = 0; dir < 2; ++dir)
#pragma unroll
            for (int s = 0; s < 4; ++s) A[dir][s] = *(const GAS bf16x8*)(qseg + ((size_t)dir * ML + rowt + (lane & 15)) * 512 + h * 128 + 32 * s + 8 * q);
#pragma unroll
        for (int dir = 0; dir < 2; ++dir)
#pragma unroll
            for (int c = 0; c < 8; ++c) ol[dir][c] = *(const GAS v2u*)(oloc + ((((size_t)(dir * 1024 + (rowt >> 4)) * 4 + h) * 8 + c) * 64 + lane) * 4);
#pragma unroll
        for (int i = 0; i < 4; ++i) ogv[i] = *(const GAS v4u*)(Z + (size_t)(rowt + tl) * INW + 2560 + h * 128 + v0 + 8 * i);
#pragma unroll
        for (int dir = 0; dir < 2; ++dir) {
#pragma unroll
            for (int s = 0; s < 4; ++s)
#pragma unroll
                for (int c = 0; c < 8; ++c) { const bf16x8 B = tr_frag(L + (dir ? FX_SB : FX_SF) + s * 8192, lane, c); acc[c] = MFMA16(A[dir][s], B, acc[c]); }
        }
#pragma unroll
        for (int dir = 0; dir < 2; ++dir)
#pragma unroll
            for (int c = 0; c < 8; ++c) { const v2u ov = ol[dir][c];
                acc[c][0] += bflo(ov.x); acc[c][1] += bfhi(ov.x); acc[c][2] += bflo(ov.y); acc[c][3] += bfhi(ov.y); }
        float ss[4];
#pragma unroll
        for (int j = 0; j < 4; ++j) { float s = 0.f;
#pragma unroll
            for (int c = 0; c < 8; ++c) s += acc[c][j] * acc[c][j];
            s += __shfl_xor(s, 1); s += __shfl_xor(s, 2); s += __shfl_xor(s, 4); s += __shfl_xor(s, 8);
            ss[j] = 1.f / sqrtf(s * (1.f / 128.f) + EPS); }
#pragma unroll
        for (int c = 0; c < 8; ++c)
#pragma unroll
            for (int j = 0; j < 4; ++j) scr[(4 * q + j) * FX_SCRSTR + 16 * c + (lane & 15)] = acc[c][j] * ss[j];
        LDS_WAIT();
        { const size_t row = (size_t)(rowt + tl);
          bf16* yo = YH + row * 512 + h * 128 + v0;
#pragma unroll
          for (int i = 0; i < 4; ++i) {
              const f32x4 a = *(const LAS f32x4*)(scr + tl * FX_SCRSTR + v0 + 8 * i), c2 = *(const LAS f32x4*)(scr + tl * FX_SCRSTR + v0 + 8 * i + 4);
              const v4u g = ogv[i];
              const f32x4 n0 = *(const GAS f32x4*)(F.hg_norm_g + v0 + 8 * i), n1 = *(const GAS f32x4*)(F.hg_norm_g + v0 + 8 * i + 4);
              const float gg[8] = {bflo(g.x), bfhi(g.x), bflo(g.y), bfhi(g.y), bflo(g.z), bfhi(g.z), bflo(g.w), bfhi(g.w)};
              const float yv[8] = {a.x * n0.x, a.y * n0.y, a.z * n0.z, a.w * n0.w, c2.x * n1.x, c2.y * n1.y, c2.z * n1.z, c2.w * n1.w};
              float o[8];
#pragma unroll
              for (int e = 0; e < 8; ++e) o[e] = yv[e] * gg[e] * sigmoidf_(gg[e]);
              v4u ov; ov.x = pk2(o[0], o[1]); ov.y = pk2(o[2], o[3]); ov.z = pk2(o[4], o[5]); ov.w = pk2(o[6], o[7]);
              *(GAS v4u*)(yo + 8 * i) = ov; } }
        LDS_WAIT();
    }
    __syncthreads();
}

__device__ __forceinline__ void fp8_rows(const float* src, unsigned char* dst, float* inv_scale, int gw, int NGW, int lane) {
    for (int r = gw; r < NEXP; r += NGW) {
        const GAS f32x4* p = (const GAS f32x4*)(src + (size_t)r * D + 16 * lane);
        const f32x4 a = p[0], b = p[1], c = p[2], d = p[3];
        float m = fmaxf(fmaxf(fmaxf(fabsf(a.x), fabsf(a.y)), fmaxf(fabsf(a.z), fabsf(a.w))), fmaxf(fmaxf(fabsf(b.x), fabsf(b.y)), fmaxf(fabsf(b.z), fabsf(b.w))));
        m = fmaxf(m, fmaxf(fmaxf(fmaxf(fabsf(c.x), fabsf(c.y)), fmaxf(fabsf(c.z), fabsf(c.w))), fmaxf(fmaxf(fabsf(d.x), fabsf(d.y)), fmaxf(fabsf(d.z), fabsf(d.w)))));
        m = wave_max(m);
        const float sc = (m > 0.f) ? 224.f / m : 1.f;
        v4u o; int w;
        w = __builtin_amdgcn_cvt_pk_fp8_f32(a.x * sc, a.y * sc, 0, false); w = __builtin_amdgcn_cvt_pk_fp8_f32(a.z * sc, a.w * sc, w, true); o.x = (unsigned)w;
        w = __builtin_amdgcn_cvt_pk_fp8_f32(b.x * sc, b.y * sc, 0, false); w = __builtin_amdgcn_cvt_pk_fp8_f32(b.z * sc, b.w * sc, w, true); o.y = (unsigned)w;
        w = __builtin_amdgcn_cvt_pk_fp8_f32(c.x * sc, c.y * sc, 0, false); w = __builtin_amdgcn_cvt_pk_fp8_f32(c.z * sc, c.w * sc, w, true); o.z = (unsigned)w;
        w = __builtin_amdgcn_cvt_pk_fp8_f32(d.x * sc, d.y * sc, 0, false); w = __builtin_amdgcn_cvt_pk_fp8_f32(d.z * sc, d.w * sc, w, true); o.w = (unsigned)w;
        *(GAS v4u*)(dst + (size_t)(lane >> 3) * ((size_t)NEXP * 128) + (size_t)r * 128 + 16 * (lane & 7)) = o;
        if (lane == 0) inv_scale[r] = (m > 0.f) ? m * (1.f / 224.f) : 1.f;
    }
}

__device__ __forceinline__ unsigned pack_i8x4(float a, float b, float c, float d) {
    const int ia = (int)rintf(a), ib = (int)rintf(b), ic = (int)rintf(c), id = (int)rintf(d);
    return ((unsigned)ia & 255u) | (((unsigned)ib & 255u) << 8) | (((unsigned)ic & 255u) << 16) | (((unsigned)id & 255u) << 24);
}
__device__ __forceinline__ void i8_rows(const float* src, unsigned char* dst, float* inv_scale, int gw, int NGW, int lane, unsigned bias) {
    for (int r = gw; r < NEXP; r += NGW) {
        const GAS f32x4* p = (const GAS f32x4*)(src + (size_t)r * D + 16 * lane);
        const f32x4 a = p[0], b = p[1], c = p[2], d = p[3];
        float m = fmaxf(fmaxf(fmaxf(fabsf(a.x), fabsf(a.y)), fmaxf(fabsf(a.z), fabsf(a.w))), fmaxf(fmaxf(fabsf(b.x), fabsf(b.y)), fmaxf(fabsf(b.z), fabsf(b.w))));
        m = fmaxf(m, fmaxf(fmaxf(fmaxf(fabsf(c.x), fabsf(c.y)), fmaxf(fabsf(c.z), fabsf(c.w))), fmaxf(fmaxf(fabsf(d.x), fabsf(d.y)), fmaxf(fabsf(d.z), fabsf(d.w)))));
        m = wave_max(m);
        const float sc = (m > 0.f) ? 127.f / m : 1.f;
        v4u o; o.x = pack_i8x4(a.x * sc, a.y * sc, a.z * sc, a.w * sc); o.y = pack_i8x4(b.x * sc, b.y * sc, b.z * sc, b.w * sc);
        o.z = pack_i8x4(c.x * sc, c.y * sc, c.z * sc, c.w * sc); o.w = pack_i8x4(d.x * sc, d.y * sc, d.z * sc, d.w * sc);
        o.x ^= bias; o.y ^= bias; o.z ^= bias; o.w ^= bias;
        *(GAS v4u*)(dst + (size_t)(lane >> 3) * ((size_t)NEXP * 128) + (size_t)r * 128 + 16 * (lane & 7)) = o;
        if (lane == 0) inv_scale[r] = (m > 0.f) ? m * (1.f / 127.f) : 1.f;
    }
}
__device__ __forceinline__ void modulate_row_q(const float* xrow, bf16* orow, unsigned char* qrow, float* qscale, const float* g, const float* shift, const float* scale, int lane) {
    const GAS f32x4* xr = (const GAS f32x4*)xrow + lane;
    f32x4 v[4]; float s2 = 0.f;
#pragma unroll
    for (int j = 0; j < 4; ++j) { v[j] = xr[64 * j]; s2 += (v[j].x * v[j].x + v[j].y * v[j].y) + (v[j].z * v[j].z + v[j].w * v[j].w); }
    const float rstd = 1.f / sqrtf(wave_sum(s2) * (1.f / D) + EPS);
    GAS v2u* o8 = (GAS v2u*)orow + lane; float m = 0.f;
#pragma unroll
    for (int j = 0; j < 4; ++j) {
        const f32x4 gg = ((const GAS f32x4*)g)[lane + 64 * j], sh = ((const GAS f32x4*)shift)[lane + 64 * j], sc = ((const GAS f32x4*)scale)[lane + 64 * j];
        v[j] = (v[j] * rstd) * gg * (sc + 1.0f) + sh;
        v2u o; o.x = pk2(v[j].x, v[j].y); o.y = pk2(v[j].z, v[j].w); o8[64 * j] = o;
        m = fmaxf(m, fmaxf(fmaxf(fabsf(v[j].x), fabsf(v[j].y)), fmaxf(fabsf(v[j].z), fabsf(v[j].w)))); }
    m = wave_max(m);
    const float qs = (m > 0.f) ? 127.f / m : 1.f;
#pragma unroll
    for (int j = 0; j < 4; ++j) ((GAS unsigned*)qrow)[lane + 64 * j] = pack_i8x4(v[j].x * qs, v[j].y * qs, v[j].z * qs, v[j].w * qs);
    if (lane == 0) *qscale = (m > 0.f) ? m * (1.f / 127.f) : 1.f;
}

#define SORT16_DESC(v) do { _Pragma("unroll") for (int k_ = 2; k_ <= 16; k_ <<= 1) _Pragma("unroll") for (int j_ = k_ >> 1; j_ > 0; j_ >>= 1) _Pragma("unroll") for (int i_ = 0; i_ < 16; ++i_) { const int l_ = i_ ^ j_; \
    if (l_ > i_) { const bool up_ = ((i_ & k_) == 0); const float hi_ = fmaxf(v[i_], v[l_]), lo_ = fminf(v[i_], v[l_]); v[i_] = up_ ? hi_ : lo_; v[l_] = up_ ? lo_ : hi_; } } } while (0)
#define MERGE16_TOP(a, b) do { _Pragma("unroll") for (int i_ = 0; i_ < 16; ++i_) a[i_] = fmaxf(a[i_], b[15 - i_]); \
    _Pragma("unroll") for (int j_ = 8; j_ > 0; j_ >>= 1) _Pragma("unroll") for (int i_ = 0; i_ < 16; ++i_) { const int l_ = i_ ^ j_; \
    if (l_ > i_) { const float hi_ = fmaxf(a[i_], a[l_]), lo_ = fminf(a[i_], a[l_]); a[i_] = hi_; a[l_] = lo_; } } } while (0)
constexpr int TK_S = 0, TK_SSTR = 136, TK_L = 139264;
__device__ __forceinline__ void topk_unit(Frame& F, int u) {
    const int tid = F.tid, lane = F.lane, w = F.wave, q = lane >> 4, tok0 = 64 * u;
    const bf16* Qb = (const bf16*)(F.ws + WS_QB); const bf16* KB = (const bf16*)(F.ws + WS_KEYS);
    unsigned short* eidx = (unsigned short*)(F.ws + WS_EIDX); float* gate = (float*)(F.ws + WS_GATE);
    LAS unsigned char* L = F.lds;
    bf16x8 AqN[2][4];
#pragma unroll
    for (int t2 = 0; t2 < 2; ++t2)
#pragma unroll
        for (int s = 0; s < 4; ++s) AqN[t2][s] = *(const GAS bf16x8*)(Qb + (size_t)(tok0 + 16 * (2 * (w & 1) + t2) + (lane & 15)) * 2048 + (w >> 1) * 128 + 32 * s + 8 * q);
#pragma unroll 1
    for (int r = 0; r < 4; ++r) {
#ifdef DBG_NAIVE_S
        for (int o = tid; o < 256 * 128; o += NTHREADS) { const int row = o >> 7, key = o & 127, hpl2 = row >> 6, tt = row & 63, hp2 = 4 * r + hpl2; float sacc = 0.f;
            for (int cc = 0; cc < 128; ++cc) sacc += bflo((unsigned)Qb[(size_t)(tok0 + tt) * 2048 + hp2 * 128 + cc]) * bflo((unsigned)KB[(size_t)(hp2 * 128 + key) * 128 + cc]);
            ((LAS float*)(L + TK_S))[row * TK_SSTR + key] = sacc; }
        if (0)
#endif
#ifndef REP_MF
#define REP_MF 1
#endif
        for (int rmf = 0; rmf < REP_MF; ++rmf)
        { const int hpl = w >> 1, hp = 4 * r + hpl;
          bf16x8 Aq[2][4];
#pragma unroll
          for (int t2 = 0; t2 < 2; ++t2)
#pragma unroll
              for (int s = 0; s < 4; ++s) Aq[t2][s] = AqN[t2][s];
          if (r < 3 && rmf == REP_MF - 1) {
#pragma unroll
              for (int t2 = 0; t2 < 2; ++t2)
#pragma unroll
                  for (int s = 0; s < 4; ++s) AqN[t2][s] = *(const GAS bf16x8*)(Qb + (size_t)(tok0 + 16 * (2 * (w & 1) + t2) + (lane & 15)) * 2048 + (hp + 4) * 128 + 32 * s + 8 * q); }
          bf16x8 Bk[8][4];
#pragma unroll
          for (int kt = 0; kt < 8; ++kt)
#pragma unroll
              for (int s = 0; s < 4; ++s) Bk[kt][s] = *(const GAS bf16x8*)(KB + (size_t)(hp * 128 + 16 * kt + (lane & 15)) * 128 + 32 * s + 8 * q);
#pragma unroll
          for (int kt = 0; kt < 8; ++kt) {
#pragma unroll
              for (int t2 = 0; t2 < 2; ++t2) { f32x4 a = (f32x4){0.f, 0.f, 0.f, 0.f};
#pragma unroll
                  for (int s = 0; s < 4; ++s) a = MFMA16(Aq[t2][s], Bk[kt][s], a);
                  LAS float* sp = (LAS float*)(L + TK_S) + (hpl * 64 + 16 * (2 * (w & 1) + t2) + 4 * q) * TK_SSTR + 16 * kt + (lane & 15);
                  sp[0] = a[0]; sp[TK_SSTR] = a[1]; sp[2 * TK_SSTR] = a[2]; sp[3 * TK_SSTR] = a[3]; } } }
        LBAR();
#ifdef DBG_NAIVE_SEL
        {
            LAS float* Sg = (LAS float*)(L + TK_S); LAS float* NV = (LAS float*)(L + TK_L); LAS unsigned short* NI = (LAS unsigned short*)(L + TK_L + 16384);
            for (int o = tid; o < 256 * 128; o += NTHREADS) { const int row = o >> 7, i = o & 127; const float si = Sg[row * TK_SSTR + i]; int rank = 0;
                for (int j = 0; j < 128; ++j) { const float sj = Sg[row * TK_SSTR + j]; rank += (sj > si || (sj == si && j < i)) ? 1 : 0; }
                if (rank < 16) { NV[row * 16 + rank] = si; NI[row * 16 + rank] = (unsigned short)i; } }
            __syncthreads();
            for (int o = tid; o < 128 * 256; o += NTHREADS) { const int th = o >> 8, cnd = o & 255, hl = th >> 6, t = th & 63, r0 = (2 * hl) * 64 + t, r1 = r0 + 64, ia = cnd >> 4, ib = cnd & 15;
                const float sc_ = NV[r0 * 16 + ia] + NV[r1 * 16 + ib]; int rank = 0;
                for (int j = 0; j < 256; ++j) { const float sj = NV[r0 * 16 + (j >> 4)] + NV[r1 * 16 + (j & 15)]; rank += (sj > sc_ || (sj == sc_ && j < cnd)) ? 1 : 0; }
                if (rank < 16) { const size_t ob = (size_t)(tok0 + t) * 128 + (2 * r + hl) * 16 + rank; eidx[ob] = (unsigned short)((int)NI[r0 * 16 + ia] * 128 + (int)NI[r1 * 16 + ib]); gate[ob] = sc_; } }
            __syncthreads();
            if (tid < 128) { const int hl = tid >> 6, t = tid & 63; const size_t ob = (size_t)(tok0 + t) * 128 + (2 * r + hl) * 16; float mx = -3e38f, sum = 0.f, ex[16];
                for (int k = 0; k < 16; ++k) mx = fmaxf(mx, gate[ob + k]);
                for (int k = 0; k < 16; ++k) { ex[k] = expf(gate[ob + k] - mx); sum += ex[k]; }
                for (int k = 0; k < 16; ++k) gate[ob + k] = ex[k] / sum; }
            __syncthreads();
        }
        if (0)
#endif
#ifndef REP_S1
#define REP_S1 1
#endif
#ifndef REP_S2
#define REP_S2 1
#endif
        for (int rs1 = 0; rs1 < REP_S1; ++rs1)
        {
            const int row = tid >> 1, hf = tid & 1;
            float a[16];
            const LAS f32x4* sp = (const LAS f32x4*)((LAS float*)(L + TK_S) + row * TK_SSTR) + hf;
#pragma unroll
            for (int blk = 0; blk < 4; ++blk) {
                float v[16];
#pragma unroll
                for (int c4 = 0; c4 < 4; ++c4) { const int i = 4 * blk + c4; const f32x4 x4 = sp[2 * i]; const float ve[4] = {x4.x, x4.y, x4.z, x4.w};
#pragma unroll
                    for (int e = 0; e < 4; ++e) v[4 * c4 + e] = __builtin_bit_cast(float, (__builtin_bit_cast(unsigned, ve[e]) & ~127u) | (unsigned)(8 * i + 4 * hf + e)); }
                SORT16_DESC(v);
                if (blk == 0) {
#pragma unroll
                    for (int j = 0; j < 16; ++j) a[j] = v[j];
                } else { MERGE16_TOP(a, v); }
            }
            { float pb[16];
#pragma unroll
              for (int j = 0; j < 16; ++j) pb[j] = __shfl_xor(a[j], 1);
              MERGE16_TOP(a, pb); }
            if (hf == 0) { LAS v4u* tp = (LAS v4u*)(L + TK_L + row * 64);
#pragma unroll
                for (int i = 0; i < 4; ++i) tp[i] = (v4u){__builtin_bit_cast(unsigned, a[4 * i]), __builtin_bit_cast(unsigned, a[4 * i + 1]), __builtin_bit_cast(unsigned, a[4 * i + 2]), __builtin_bit_cast(unsigned, a[4 * i + 3])}; }
        }
        LBAR();
#ifdef DBG_NAIVE_SEL
        if (0)
#endif
        for (int rs2 = 0; rs2 < REP_S2; ++rs2)
        if (tid < 128) {
            const int hl = tid >> 6, t = tid & 63, r0 = (2 * hl) * 64 + t, r1 = r0 + 64;
            const LAS unsigned* t0 = (const LAS unsigned*)(L + TK_L + r0 * 64); const LAS unsigned* t1 = (const LAS unsigned*)(L + TK_L + r1 * 64);
            float v1[16], v2[16];
#pragma unroll
            for (int i = 0; i < 4; ++i) { const v4u x = ((const LAS v4u*)t0)[i], y = ((const LAS v4u*)t1)[i];
                v1[4 * i] = __builtin_bit_cast(float, x.x & ~127u); v1[4 * i + 1] = __builtin_bit_cast(float, x.y & ~127u); v1[4 * i + 2] = __builtin_bit_cast(float, x.z & ~127u); v1[4 * i + 3] = __builtin_bit_cast(float, x.w & ~127u);
                v2[4 * i] = __builtin_bit_cast(float, y.x & ~127u); v2[4 * i + 1] = __builtin_bit_cast(float, y.y & ~127u); v2[4 * i + 2] = __builtin_bit_cast(float, y.z & ~127u); v2[4 * i + 3] = __builtin_bit_cast(float, y.w & ~127u); }
            float c[16];
#pragma unroll
            for (int blk = 0; blk < 4; ++blk) {
                float v[16];
#pragma unroll
                for (int j = 0; j < 16; ++j) v[j] = -3.0e38f;
                { int n = 0, slot = 0;
#pragma unroll
                  for (int ia = 0; ia < 16; ++ia)
#pragma unroll
                      for (int ib = 0; ib < 16; ++ib) if ((ia + 1) * (ib + 1) <= 16) { if ((n >> 4) == blk) { v[slot] = __builtin_bit_cast(float, (__builtin_bit_cast(unsigned, v1[ia] + v2[ib]) & ~255u) | (unsigned)(ia * 16 + ib)); ++slot; } ++n; } }
                SORT16_DESC(v);
                if (blk == 0) {
#pragma unroll
                    for (int j = 0; j < 16; ++j) c[j] = v[j];
                } else { MERGE16_TOP(c, v); }
            }
            float ex[16], sum = 0.f; const float mx = __builtin_bit_cast(float, __builtin_bit_cast(unsigned, c[0]) & ~255u);
#pragma unroll
            for (int k = 0; k < 16; ++k) { ex[k] = fast_exp(__builtin_bit_cast(float, __builtin_bit_cast(unsigned, c[k]) & ~255u) - mx); sum += ex[k]; }
            const float inv = 1.f / sum; const int h = 2 * r + hl; const size_t ob = (size_t)(tok0 + t) * 128 + h * 16;
            unsigned ee[16];
#pragma unroll
            for (int k = 0; k < 16; ++k) { const unsigned code = __builtin_bit_cast(unsigned, c[k]) & 255u;
                const unsigned i1 = t0[code >> 4] & 127u, i2 = t1[code & 15u] & 127u; ee[k] = i1 * 128u + i2; }
            { GAS v4u* ep = (GAS v4u*)(eidx + ob); ep[0] = (v4u){ee[0] | (ee[1] << 16), ee[2] | (ee[3] << 16), ee[4] | (ee[5] << 16), ee[6] | (ee[7] << 16)};
              ep[1] = (v4u){ee[8] | (ee[9] << 16), ee[10] | (ee[11] << 16), ee[12] | (ee[13] << 16), ee[14] | (ee[15] << 16)};
              GAS f32x4* gp = (GAS f32x4*)(gate + ob);
#pragma unroll
              for (int k4 = 0; k4 < 4; ++k4) gp[k4] = (f32x4){ex[4 * k4] * inv, ex[4 * k4 + 1] * inv, ex[4 * k4 + 2] * inv, ex[4 * k4 + 3] * inv}; }
        }
    }
    __syncthreads();
}


#define TRED3(d, lane, m0, m1, m2) do { \
    _Pragma("unroll") for (int _i = 0; _i < 8; ++_i) { const bool _h = ((lane) & (m0)) != 0; const float _k = _h ? d[_i + 8] : d[_i], _s = _h ? d[_i] : d[_i + 8]; d[_i] = _k + __shfl_xor(_s, (m0)); } \
    _Pragma("unroll") for (int _i = 0; _i < 4; ++_i) { const bool _h = ((lane) & (m1)) != 0; const float _k = _h ? d[_i + 4] : d[_i], _s = _h ? d[_i] : d[_i + 4]; d[_i] = _k + __shfl_xor(_s, (m1)); } \
    _Pragma("unroll") for (int _i = 0; _i < 2; ++_i) { const bool _h = ((lane) & (m2)) != 0; const float _k = _h ? d[_i + 2] : d[_i], _s = _h ? d[_i] : d[_i + 2]; d[_i] = _k + __shfl_xor(_s, (m2)); } } while (0)
typedef int i32x4 __attribute__((ext_vector_type(4)));
__device__ __forceinline__ void cvt16v(const v4u r, float (&o)[16]) {
    const unsigned rr[4] = {r.x, r.y, r.z, r.w};
#pragma unroll
    for (int d = 0; d < 4; ++d) { const f32x2 lo = __builtin_amdgcn_cvt_pk_f32_fp8((int)rr[d], false), hi = __builtin_amdgcn_cvt_pk_f32_fp8((int)rr[d], true);
        o[4 * d] = lo.x; o[4 * d + 1] = lo.y; o[4 * d + 2] = hi.x; o[4 * d + 3] = hi.y; }
}
#define PX_LOAD_E(ev, tok) do { const GAS v4u* ep_ = (const GAS v4u*)(eidx + (size_t)(tok) * 128 + 16 * pg); ev[0] = ep_[0]; ev[1] = ep_[1]; } while (0)
#define PX_LOAD_ROWS8(rows, ea, base) do { const unsigned e_[8] = {ea.x & 0xffffu, ea.x >> 16, ea.y & 0xffffu, ea.y >> 16, ea.z & 0xffffu, ea.z >> 16, ea.w & 0xffffu, ea.w >> 16}; \
    _Pragma("unroll") for (int i_ = 0; i_ < 8; ++i_) rows[i_] = *(const GAS v4u*)((base) + (e_[i_] * 128u + cgo)); } while (0)
#define PU_LOAD_H(h0, tok) do { h0 = *(const GAS v4u*)(H8 + (size_t)(tok) * D + 128 * slice + cgo); } while (0)
#define PU_DOT8(rows, dd, off) do { \
    _Pragma("unroll") for (int i_ = 0; i_ < 8; ++i_) { int s_ = __builtin_amdgcn_sdot4((int)rows[i_].x, (int)h0.x, 0, false); s_ = __builtin_amdgcn_sdot4((int)rows[i_].y, (int)h0.y, s_, false); \
        s_ = __builtin_amdgcn_sdot4((int)rows[i_].z, (int)h0.z, s_, false); s_ = __builtin_amdgcn_sdot4((int)rows[i_].w, (int)h0.w, s_, false); dd[(off) + i_] = s_; } } while (0)
#define TRED3I(d, lane, m0, m1, m2) do { \
    _Pragma("unroll") for (int _i = 0; _i < 8; ++_i) { const bool _h = ((lane) & (m0)) != 0; const int _k = _h ? d[_i + 8] : d[_i], _s = _h ? d[_i] : d[_i + 8]; d[_i] = _k + __shfl_xor(_s, (m0)); } \
    _Pragma("unroll") for (int _i = 0; _i < 4; ++_i) { const bool _h = ((lane) & (m1)) != 0; const int _k = _h ? d[_i + 4] : d[_i], _s = _h ? d[_i] : d[_i + 4]; d[_i] = _k + __shfl_xor(_s, (m1)); } \
    _Pragma("unroll") for (int _i = 0; _i < 2; ++_i) { const bool _h = ((lane) & (m2)) != 0; const int _k = _h ? d[_i + 2] : d[_i], _s = _h ? d[_i] : d[_i + 2]; d[_i] = _k + __shfl_xor(_s, (m2)); } } while (0)
typedef int i32x2 __attribute__((ext_vector_type(2)));
__device__ __forceinline__ void peer_u_slice(unsigned char* ws_, int slice, int rank, int nrank) {
    const int lane = threadIdx.x & 63, wave = __builtin_amdgcn_readfirstlane(threadIdx.x >> 6);
    const int pg = lane >> 3, cg = lane & 7, wi = rank * NWAVES + wave, nw = nrank * NWAVES;
    const unsigned char* H8 = ws_ + WS_H8; const unsigned char* Us = ws_ + WS_U8 + (size_t)slice * ((size_t)NEXP * 128); const unsigned cgo = 16u * cg;
    const unsigned short* eidx = (const unsigned short*)(ws_ + WS_EIDX); int* part = (int*)(ws_ + WS_PART) + (size_t)slice * ML * 128;
    v4u eC[2], eN[2]; v4u r0[8], r1[8]; v4u h0, g0;
    PX_LOAD_E(eC, wi); PU_LOAD_H(h0, wi); PX_LOAD_ROWS8(r0, eC[0], Us);
#pragma unroll 1
    for (int t = wi; t < ML; t += nw) {
        const int tn = (t + nw < ML) ? t + nw : t;
        PX_LOAD_ROWS8(r1, eC[1], Us); PX_LOAD_E(eN, tn); PU_LOAD_H(g0, tn);
        __builtin_amdgcn_sched_barrier(0);
        int d[16];
        PU_DOT8(r0, d, 0);
        PX_LOAD_ROWS8(r0, eN[0], Us);
        __builtin_amdgcn_sched_barrier(0);
        PU_DOT8(r1, d, 8);
        TRED3I(d, lane, 4, 2, 1);
        *(GAS i32x2*)(part + (size_t)t * 128 + 2 * lane) = (i32x2){d[0], d[1]};
        eC[0] = eN[0]; eC[1] = eN[1]; h0 = g0;
    }
}
typedef _Float16 h16x2 __attribute__((ext_vector_type(2)));
__device__ __forceinline__ void peer_reduce(Frame& F) {
    const int* part = (const int*)(F.ws + WS_PART); const float* sh = (const float*)(F.ws + WS_SH); const unsigned short* eidx = (const unsigned short*)(F.ws + WS_EIDX); const float* gate = (const float*)(F.ws + WS_GATE);
    const float* su = (const float*)(F.ws + WS_SU); const float* sv = (const float*)(F.ws + WS_SV); unsigned short* wgt = (unsigned short*)(F.ws + WS_WGT);
    for (size_t i4 = (size_t)F.bid * NTHREADS + F.tid; i4 < (size_t)ML * 32; i4 += (size_t)F.G * NTHREADS) {
        const size_t i = 4 * i4;
        i32x4 s = (i32x4){0, 0, 0, 0};
#pragma unroll
        for (int x = 0; x < 8; ++x) s += *(const GAS i32x4*)(part + (size_t)x * ML * 128 + i);
        const v2u ev = *(const GAS v2u*)(eidx + i); const f32x4 gv = *(const GAS f32x4*)(gate + i); const float sht = sh[i >> 7];
        const unsigned e[4] = {ev.x & 0xffffu, ev.x >> 16, ev.y & 0xffffu, ev.y >> 16}; const int sv4[4] = {s.x, s.y, s.z, s.w}; const float g4[4] = {gv.x, gv.y, gv.z, gv.w};
        float w[4];
#pragma unroll
        for (int k = 0; k < 4; ++k) { const float z = (float)sv4[k] * su[e[k]] * sht; w[k] = g4[k] * (0.5f * z * (1.f + erff(z * 0.70710678118f))) * sv[e[k]] * 1024.f; }
        const h16x2 o0 = {(_Float16)w[0], (_Float16)w[1]}, o1 = {(_Float16)w[2], (_Float16)w[3]};
        v2u o; o.x = __builtin_bit_cast(unsigned, o0); o.y = __builtin_bit_cast(unsigned, o1); *(GAS v2u*)(wgt + i) = o;
    }
}
#define PV_LOAD_W(wv, tok) do { const GAS v4u* wp_ = (const GAS v4u*)(wgt + (size_t)(tok) * 128 + 16 * pg); wv[0] = wp_[0]; wv[1] = wp_[1]; } while (0)
#define PV_ACC8(rows, wa) do { const unsigned w_[4] = {wa.x, wa.y, wa.z, wa.w}; \
    _Pragma("unroll") for (int i_ = 0; i_ < 8; ++i_) { const h16x2 wp_ = __builtin_bit_cast(h16x2, w_[i_ >> 1]); const _Float16 wh_ = (i_ & 1) ? wp_.y : wp_.x; const h16x2 ww_ = {wh_, wh_}; \
        const unsigned rr_[4] = {rows[i_].x, rows[i_].y, rows[i_].z, rows[i_].w}; \
        _Pragma("unroll") for (int d_ = 0; d_ < 4; ++d_) { \
            acc[2 * d_]     = acc[2 * d_]     + __builtin_amdgcn_cvt_scalef32_pk_f16_fp8((int)rr_[d_], 1.0f, false) * ww_; \
            acc[2 * d_ + 1] = acc[2 * d_ + 1] + __builtin_amdgcn_cvt_scalef32_pk_f16_fp8((int)rr_[d_], 1.0f, true) * ww_; } } } while (0)
__device__ __forceinline__ void peer_v_slice(unsigned char* ws_, bf16* po_, int slice, int rank, int nrank) {
    const int lane = threadIdx.x & 63, wave = __builtin_amdgcn_readfirstlane(threadIdx.x >> 6);
    const int pg = lane >> 3, cg = lane & 7, wi = rank * NWAVES + wave, nw = nrank * NWAVES;
    const unsigned char* Vs = ws_ + WS_V8 + (size_t)slice * ((size_t)NEXP * 128); const unsigned cgo = 16u * cg;
    const unsigned short* eidx = (const unsigned short*)(ws_ + WS_EIDX); const unsigned short* wgt = (const unsigned short*)(ws_ + WS_WGT);
    const int col = 128 * slice + 16 * cg + 2 * pg;
    v4u eC[2], eN[2]; v4u r0[8], r1[8]; v4u wC[2], wN[2];
    PX_LOAD_E(eC, wi); PV_LOAD_W(wC, wi); PX_LOAD_ROWS8(r0, eC[0], Vs);
#pragma unroll 1
    for (int t = wi; t < ML; t += nw) {
        const int tn = (t + nw < ML) ? t + nw : t;
        PX_LOAD_ROWS8(r1, eC[1], Vs); PX_LOAD_E(eN, tn); PV_LOAD_W(wN, tn);
        __builtin_amdgcn_sched_barrier(0);
        h16x2 acc[8];
#pragma unroll
        for (int k = 0; k < 8; ++k) acc[k] = (h16x2){(_Float16)0.f, (_Float16)0.f};
        PV_ACC8(r0, wC[0]);
        PX_LOAD_ROWS8(r0, eN[0], Vs);
        __builtin_amdgcn_sched_barrier(0);
        PV_ACC8(r1, wC[1]);
#pragma unroll
        for (int k = 0; k < 4; ++k) { const bool hi_ = (lane & 32) != 0; const h16x2 kp = hi_ ? acc[k + 4] : acc[k], sd = hi_ ? acc[k] : acc[k + 4];
            acc[k] = kp + __builtin_bit_cast(h16x2, __shfl_xor(__builtin_bit_cast(unsigned, sd), 32)); }
#pragma unroll
        for (int k = 0; k < 2; ++k) { const bool hi_ = (lane & 16) != 0; const h16x2 kp = hi_ ? acc[k + 2] : acc[k], sd = hi_ ? acc[k] : acc[k + 2];
            acc[k] = kp + __builtin_bit_cast(h16x2, __shfl_xor(__builtin_bit_cast(unsigned, sd), 16)); }
        { const bool hi_ = (lane & 8) != 0; const h16x2 kp = hi_ ? acc[1] : acc[0], sd = hi_ ? acc[0] : acc[1];
          acc[0] = kp + __builtin_bit_cast(h16x2, __shfl_xor(__builtin_bit_cast(unsigned, sd), 8)); }
        *(GAS unsigned*)(po_ + (size_t)t * D + col) = pk2((float)acc[0].x * (1.f / 1024.f), (float)acc[0].y * (1.f / 1024.f));
        eC[0] = eN[0]; eC[1] = eN[1]; wC[0] = wN[0]; wC[1] = wN[1];
    }
}
__device__ __forceinline__ void final_norm(Frame& F) {
    const bf16* po = (const bf16*)(F.ws + WS_PO); const float* mod = (const float*)(F.ws + WS_MOD); const int lane = F.lane, gw = F.bid * NWAVES + F.wave, NGW = F.G * NWAVES;
    for (int t0 = gw; t0 < ML; t0 += 2 * NGW) {
        f32x4 xv[2][4]; float s2[2] = {0.f, 0.f};
#pragma unroll
        for (int r = 0; r < 2; ++r) { const int t = (t0 + r * NGW < ML) ? t0 + r * NGW : t0;
            const GAS f32x4* orow = (const GAS f32x4*)(F.out + (size_t)t * D) + lane; const GAS v2u* prow = (const GAS v2u*)(po + (size_t)t * D) + lane;
            const GAS f32x4* g2 = (const GAS f32x4*)(mod + (size_t)(t >> 12) * 6144 + 5 * 1024) + lane;
#pragma unroll
            for (int j = 0; j < 4; ++j) { const f32x4 x1 = orow[64 * j], gg = g2[64 * j]; const v2u pv = prow[64 * j];
                xv[r][j] = x1 + gg * (f32x4){bflo(pv.x), bfhi(pv.x), bflo(pv.y), bfhi(pv.y)};
                s2[r] += (xv[r][j].x * xv[r][j].x + xv[r][j].y * xv[r][j].y) + (xv[r][j].z * xv[r][j].z + xv[r][j].w * xv[r][j].w); } }
#pragma unroll
        for (int r = 0; r < 2; ++r) { const int t = t0 + r * NGW; if (t < ML) {
            const float rstd = 1.f / sqrtf(wave_sum(s2[r]) * (1.f / D) + EPS); GAS f32x4* orow = (GAS f32x4*)(F.out + (size_t)t * D) + lane;
#pragma unroll
            for (int j = 0; j < 4; ++j) { const f32x4 fg = ((const GAS f32x4*)F.final_g)[lane + 64 * j]; f32x4 ov = xv[r][j] * rstd * fg;
#ifdef TS_A
                { const unsigned long long* ts = (const unsigned long long*)(F.ws + WS_CTL + 32768);
                  const float da = (float)(long long)(ts[TS_A + 1] - ts[TS_A]) * 0.01f, db = (float)(long long)(ts[TS_B + 1] - ts[TS_B]) * 0.01f;
                  ov = ov * (1.f + da * (1.f / 200.f)); (void)db; }
#endif
                orow[64 * j] = ov; } } }
    }
}

constexpr int N_PHASES = 15;
__global__ void __launch_bounds__(NTHREADS, 2) fwd_kernel(Args args) {
    extern __shared__ __attribute__((aligned(16))) unsigned char lds[];
    Frame F;
    F.lds = (LAS unsigned char*)lds;
    F.tid = threadIdx.x; F.lane = F.tid & 63; F.wave = __builtin_amdgcn_readfirstlane(F.tid >> 6); F.G = gridDim.x; F.bid = blockIdx.x;
    F.x = args.in[0]; F.c = args.in[1]; F.ctx = args.in[2]; F.c_ctx = args.in[3]; F.w_mod = args.in[4]; F.b_mod = args.in[5]; F.n1g = args.in[6]; F.n2g = args.in[7];
    F.w_in = args.in[8]; F.pool_w = args.in[9]; F.pool_scale = args.in[10]; F.lb_logits = args.in[11]; F.hg_norm_g = args.in[12]; F.w_a = args.in[13]; F.w_b = args.in[14];
    F.w_o = args.in[15]; F.wq = args.in[16]; F.keys = args.in[17]; F.pu = args.in[18]; F.pv = args.in[19]; F.final_g = args.in[20];
    F.out = args.out; F.ws = args.ws;
    volatile LAS unsigned* MISC = (volatile LAS unsigned*)(F.lds + MISC_OFF);
    if (F.tid < 64) MISC[F.tid] = 0u;
    __syncthreads();
    unsigned* barw = (unsigned*)(F.ws + WS_CTL) + CW_BAR;
    XcdBarrier bar; bar.bar = barw; bar.x = 0; bar.st = nullptr;
    if (ONE_LAUNCH) bar = xcd_barrier_post(barw, MISC + 8);
    const int lo = args.ph_lo, hi = args.ph_hi;
#ifdef TS_A
    if (F.bid == 0 && F.tid == 0) ((unsigned long long*)(F.ws + WS_CTL + 32768))[0] = __builtin_amdgcn_s_memrealtime();
#endif
#ifndef PH_MASK
#define PH_MASK 0x7fff
#endif
#define IN(k) (((PH_MASK >> (k)) & 1) && lo <= (k) && (k) < hi)
#ifdef TS_A
#define TS_STAMP(k) do { if (F.bid == 0 && F.tid == 0) ((unsigned long long*)(F.ws + WS_CTL + 32768))[(k) + 1] = __builtin_amdgcn_s_memrealtime(); } while (0)
#else
#define TS_STAMP(k) do { } while (0)
#endif
#define SEAM(k) do { if (IN(k) && IN((k) + 1)) { if ((k) == 12) TS_STAMP(k); xcd_barrier(bar); if ((k) != 12) TS_STAMP(k); } } while (0)
#ifndef REP_MASK
#define REP_MASK 0
#endif
#define REPS(k) ((((REP_MASK) >> (k)) & 1) ? 2 : 1)
#define REPSYNC(k, rep) do { if ((rep) + 1 < REPS(k)) xcd_barrier(bar); } while (0)

#ifdef EXTRA_BARRIERS
    for (int xb_ = 0; xb_ < EXTRA_BARRIERS; ++xb_) xcd_barrier(bar);
#endif
    if (IN(0)) for (int rep_ = 0; rep_ < REPS(0); ++rep_) { p0_prologue(F);  REPSYNC(0, rep_); } SEAM(0);
    if (IN(1)) for (int rep_ = 0; rep_ < REPS(1); ++rep_) { p1_modulate(F);  REPSYNC(1, rep_); } SEAM(1);
    if (IN(2)) for (int rep_ = 0; rep_ < REPS(2); ++rep_) {
        SchedIn S{(const char*)(F.ws + WS_H), (const char*)(F.ws + WS_WIN), F.G, F.bid};
        EpiZ E{(bf16*)(F.ws + WS_Z), (bf16*)(F.ws + WS_ZC), (bf16*)(F.ws + WS_ZC2)};
        pg8::gemm_phase<EpiZ, SchedIn, true, true>(F.lds, D, S, E);
        REPSYNC(2, rep_);
    } SEAM(2);
    if (IN(3)) for (int rep_ = 0; rep_ < REPS(3); ++rep_) {
#ifndef REP_SCAN
#define REP_SCAN 1
#endif
#ifndef REP_POOL
#define REP_POOL 1
#endif
        for (int r2 = 0; r2 < REP_SCAN; ++r2) for (int u = F.bid; u < NSCAN; u += F.G) scan_unit(F, u);
        for (int r2 = 0; r2 < REP_POOL; ++r2) for (int u = F.bid; u < NB * 64; u += F.G) pool_unit(F, u);
        REPSYNC(3, rep_);
    } if (IN(3) && IN(14)) xcd_barrier(bar);
    if (IN(14)) { for (int u = F.bid; u < 256; u += F.G) prefix_unit(F, u); } if (IN(14) && IN(4)) xcd_barrier(bar);
    if (IN(4)) for (int rep_ = 0; rep_ < REPS(4); ++rep_) { for (int u = F.bid; u < NB * 4 * NSEG; u += F.G) fix_unit(F, u);  REPSYNC(4, rep_); } SEAM(4);
    if (IN(5)) for (int rep_ = 0; rep_ < REPS(5); ++rep_) {
        SchedMerge S{(const char*)(F.ws + WS_YPOOL), (const char*)(F.ws + WS_YHG), (const char*)(F.ws + WS_WA), (const char*)(F.ws + WS_WB), F.G, F.bid};
        EpiMerge E{(const bf16*)(F.ws + WS_Z), (bf16*)(F.ws + WS_M)};
        pg8::gemm_phase<EpiMerge, SchedMerge, true, true>(F.lds, 512, S, E);
        REPSYNC(5, rep_);
    } SEAM(5);
    if (IN(6)) for (int rep_ = 0; rep_ < REPS(6); ++rep_) {
        SchedPlain S{(const char*)(F.ws + WS_M), (const char*)(F.ws + WS_WO), 64, 4, D, F.G, F.bid};
        EpiRes E{F.x, (const float*)(F.ws + WS_MOD), F.out};
        pg8::gemm_phase<EpiRes, SchedPlain, true, true>(F.lds, D, S, E);
        REPSYNC(6, rep_);
    } SEAM(6);
    if (IN(7)) for (int rep_ = 0; rep_ < REPS(7); ++rep_) {
        const float* mod = (const float*)(F.ws + WS_MOD); bf16* H2 = (bf16*)(F.ws + WS_H);
        const int gw = F.bid * NWAVES + F.wave, NGW = F.G * NWAVES;
        for (int m = gw; m < ML; m += NGW) { const int v = m >> 12; modulate_row_q(F.out + (size_t)m * D, H2 + (size_t)m * D, F.ws + WS_H8 + (size_t)m * D, (float*)(F.ws + WS_SH) + m, F.n2g, mod + v * 6144 + 3 * 1024, mod + v * 6144 + 4 * 1024, F.lane); }
        i8_rows(F.pu, F.ws + WS_U8, (float*)(F.ws + WS_SU), gw, NGW, F.lane, 0u);
        fp8_rows(F.pv, F.ws + WS_V8, (float*)(F.ws + WS_SV), gw, NGW, F.lane);
        REPSYNC(7, rep_);
    } SEAM(7);
    if (IN(8)) for (int rep_ = 0; rep_ < REPS(8); ++rep_) {
        SchedPlain S{(const char*)(F.ws + WS_H), (const char*)(F.ws + WS_WQ), 64, 8, D, F.G, F.bid};
        EpiPlain E{(bf16*)(F.ws + WS_QB), 2048};
        pg8::gemm_phase<EpiPlain, SchedPlain, true, true>(F.lds, D, S, E);
        REPSYNC(8, rep_);
    } SEAM(8);
    if (IN(9)) for (int rep_ = 0; rep_ < REPS(9); ++rep_) { for (int u = F.bid; u < ML / 64; u += F.G) topk_unit(F, u);  REPSYNC(9, rep_); } SEAM(9);
    int pslice = F.bid & 7, prank = F.bid >> 3; const int pnrank = F.G >> 3;
    if (ONE_LAUNCH && (IN(10) || IN(12))) {
        bool okc = (F.G == 256) && (bar.x < 8u);
#pragma unroll
        for (int j = 0; j < 8; ++j) okc = okc && (xb_ld(&barw[XB_XCNT(j)]) == 32u);
        if (okc) { pslice = (int)bar.x; prank = (int)MISC[10]; }
    }
    if (IN(10)) for (int rep_ = 0; rep_ < REPS(10); ++rep_) { peer_u_slice(F.ws, pslice, prank, pnrank);  REPSYNC(10, rep_); } SEAM(10);
    if (IN(11)) for (int rep_ = 0; rep_ < REPS(11); ++rep_) { peer_reduce(F);  REPSYNC(11, rep_); } SEAM(11);
    if (IN(12)) for (int rep_ = 0; rep_ < REPS(12); ++rep_) { peer_v_slice(F.ws, (bf16*)(F.ws + WS_PO), pslice, prank, pnrank);  REPSYNC(12, rep_); } SEAM(12);
    if (IN(13)) for (int rep_ = 0; rep_ < REPS(13); ++rep_) { final_norm(F);  REPSYNC(13, rep_); }
#undef IN
#undef SEAM
}

extern "C" void kernel_launch(void* const* d_in, const int* in_sizes, int n_in, void* d_out, int out_size, void* d_ws, size_t ws_size, hipStream_t stream) {
    static int grid = 0;
    if (grid == 0) {
        if (n_in != 21 || out_size != ML * D || ws_size < WS_END) { fprintf(stderr, "kernel_launch: unexpected problem (n_in %d, out %d, ws %zu)\n", n_in, out_size, ws_size); grid = -1; return; }
        int dev = 0, cus = 0;
        if (hipGetDevice(&dev) != hipSuccess || hipDeviceGetAttribute(&cus, hipDeviceAttributeMultiprocessorCount, dev) != hipSuccess) { grid = -1; return; }
        if (hipFuncSetAttribute((const void*)fwd_kernel, hipFuncAttributeMaxDynamicSharedMemorySize, LDS_BYTES) != hipSuccess) { fprintf(stderr, "kernel_launch: hipFuncSetAttribute failed\n"); grid = -1; return; }
        int per_cu = 0;
        if (hipOccupancyMaxActiveBlocksPerMultiprocessor(&per_cu, (const void*)fwd_kernel, NTHREADS, LDS_BYTES) != hipSuccess || per_cu < 1) fprintf(stderr, "kernel_launch: occupancy query says %d\n", per_cu);
        (void)hipGetLastError();
        grid = cus;
    }
    if (grid < 0) return;
    (void)hipMemsetAsync((char*)d_ws + WS_CTL, 0, CTL_ZERO_BYTES, stream);
    Args a{};
    for (int i = 0; i < 21; ++i) a.in[i] = (const float*)d_in[i];
    a.out = (float*)d_out; a.ws = (unsigned char*)d_ws;
#if ONE_LAUNCH
    a.ph_lo = 0; a.ph_hi = N_PHASES;
    hipLaunchKernelGGL(fwd_kernel, dim3(grid), dim3(NTHREADS), LDS_BYTES, stream, a);
#else
    static const int order[N_PHASES] = {0, 1, 2, 3, 14, 4, 5, 6, 7, 8, 9, 10, 11, 12, 13};
    for (int pi = 0; pi < N_PHASES; ++pi) { const int p = order[pi]; a.ph_lo = p; a.ph_hi = p + 1; hipLaunchKernelGGL(fwd_kernel, dim3(grid), dim3(NTHREADS), LDS_BYTES, stream, a); }
#endif
}
```

```cpp
#define ONE_LAUNCH 1
#include <hip/hip_runtime.h>
#include <cstdio>
#include <cstdint>

#ifndef ONE_LAUNCH
#define ONE_LAUNCH 1
#endif

namespace pg8 {
#define PG8_LAS __attribute__((address_space(3)))
typedef unsigned short bf16_t;
typedef short bf16x8 __attribute__((ext_vector_type(8)));
typedef float f32x4 __attribute__((ext_vector_type(4)));
typedef float f32x2 __attribute__((ext_vector_type(2)));
typedef unsigned u32x4 __attribute__((ext_vector_type(4)));
typedef unsigned u32x2 __attribute__((ext_vector_type(2)));
constexpr int BM = 256, BK = 64, HALF = 128, HTB = HALF * BK * 2, STAGE_BYTES = 8 * HTB, NXCD = 8, WGM = 8;

__host__ __device__ __forceinline__ int lds_byte(int r, int c) { const int st = (r >> 4) * 2 + (c >> 5), rr = r & 15, cc = c & 31, ob = rr * 64 + cc * 2; return st * 1024 + (ob ^ (((ob >> 9) & 1) << 5)); }
__host__ __device__ __forceinline__ void stage_rc(int b, int& R, int& C) { const int st = b / 1024, sb = b % 1024, swz = sb ^ (((sb >> 9) & 1) << 5); R = (st >> 1) * 16 + swz / 64; C = (st & 1) * 32 + (swz % 64) / 2; }
__host__ __device__ __forceinline__ int perm32(int rho) { const int n = rho >> 4, i = rho & 15; return 8 * (i >> 2) + 4 * n + (i & 3); }

struct Unit { int pm, pn, seg; };

__host__ __device__ __forceinline__ void tile_of(int wgid, int nM, int nN, int& pm, int& pn) {
    const int nwg = nM * nN;
    { const int q = nwg / NXCD, r = nwg % NXCD, xcd = wgid % NXCD, off = wgid / NXCD; wgid = (xcd < r ? xcd * (q + 1) : r * (q + 1) + (xcd - r) * q) + off; }
    const int nig = WGM * nN, gid = wgid / nig, fm = gid * WGM, gsz = (nM - fm) < WGM ? (nM - fm) : WGM;
    pm = fm + ((wgid % nig) % gsz); pn = (wgid % nig) / gsz;
}

typedef __bf16 bf16x2_t __attribute__((ext_vector_type(2)));
__device__ __forceinline__ unsigned cvt_pk_bf16(float lo, float hi) { bf16x2_t v; v.x = (__bf16)lo; v.y = (__bf16)hi; return __builtin_bit_cast(unsigned, v); }

template <class Epi, class Sched, bool ALIGN_EPI = false, bool SP2 = false>
__device__ __forceinline__ void gemm_phase(PG8_LAS unsigned char* lds, const int ld, const Sched& S, const Epi& E) {
    const int tid = threadIdx.x, wid = __builtin_amdgcn_readfirstlane(tid >> 6), lane = tid & 63, wr = wid >> 2, wc = wid & 3, fr = lane & 15, fq = lane >> 4;
    unsigned voffA[2], voffB[2];
#pragma unroll
    for (int i = 0; i < 2; ++i) { int R, C; stage_rc(tid * 16 + i * 8192, R, C); const int Rb = Epi::PERM ? ((R & ~31) + perm32(R & 31)) : R;
        voffA[i] = (unsigned)(R * ld + C) * 2u; voffB[i] = (unsigned)(Rb * ld + C) * 2u; }
    const size_t kstep = (size_t)(BK * 2);
    const size_t hstep = (size_t)HALF * ld * 2;
    const unsigned ldsw = (unsigned)wid * 1024u;
    const int aoff = lds_byte(wr * 64 + fr, fq * 8), boff = lds_byte(wc * 32 + fr, fq * 8);
#define PG8_SA(b, h) (((b) * 2 + (h)) * HTB)
#define PG8_SB(b, h) ((4 + (b) * 2 + (h)) * HTB)
#define PG8_STAGE(bufoff, gbase, voff) do { _Pragma("unroll") for (int _i = 0; _i < 2; ++_i) \
        __builtin_amdgcn_global_load_lds((const unsigned*)((const char*)(gbase) + (voff)[_i]), (PG8_LAS unsigned*)(lds + (bufoff) + ldsw + _i * 8192), 16, 0, 0); } while (0)
#define PG8_LDA(dst, b, h) do { _Pragma("unroll") for (int m = 0; m < 4; ++m) _Pragma("unroll") for (int k = 0; k < 2; ++k) dst[m][k] = *(const PG8_LAS bf16x8*)(lds + PG8_SA(b, h) + aoff + m * 2048 + k * 1024); } while (0)
#define PG8_LDB(dst, b, h) do { _Pragma("unroll") for (int n = 0; n < 2; ++n) _Pragma("unroll") for (int k = 0; k < 2; ++k) dst[n][k] = *(const PG8_LAS bf16x8*)(lds + PG8_SB(b, h) + boff + n * 2048 + k * 1024); } while (0)
#define PG8_MMA(ai, bj, At, Bt) do { __builtin_amdgcn_s_setprio(1); _Pragma("unroll") for (int m = 0; m < 4; ++m) _Pragma("unroll") for (int n = 0; n < 2; ++n) _Pragma("unroll") for (int k = 0; k < 2; ++k) \
        acc[ai][bj][m][n] = __builtin_amdgcn_mfma_f32_16x16x32_bf16(Bt[n][k], At[m][k], acc[ai][bj][m][n], 0, 0, 0); __builtin_amdgcn_s_setprio(0); } while (0)
#define PG8_WAIT_V(n) asm volatile("s_waitcnt vmcnt(" #n ")" ::: "memory")
#define PG8_WAIT_L(n) asm volatile("s_waitcnt lgkmcnt(" #n ")" ::: "memory")
#define PG8_BAR __builtin_amdgcn_s_barrier()
#define PG8_SCHED __builtin_amdgcn_sched_barrier(0)
    Unit cur, nxt; int ui = 0;
    if (!S.next(0, cur)) return;
    f32x4 acc[2][2][4][2];
#pragma unroll
    for (int a = 0; a < 2; ++a)
#pragma unroll
        for (int b = 0; b < 2; ++b)
#pragma unroll
            for (int m = 0; m < 4; ++m)
#pragma unroll
                for (int n = 0; n < 2; ++n) acc[a][b][m][n] = (f32x4){0.f, 0.f, 0.f, 0.f};
    bf16x8 At[4][2], B0[2][2], B1[2][2];
    const char* cA = S.A(cur); const char* cB = S.B(cur);
    if constexpr (SP2) {
        PG8_STAGE(PG8_SB(0, 0), cB, voffB); PG8_STAGE(PG8_SB(0, 1), cB + hstep, voffB); PG8_STAGE(PG8_SA(0, 0), cA, voffA); PG8_STAGE(PG8_SA(0, 1), cA + hstep, voffA);
        if (wr == 1) PG8_BAR;
        PG8_WAIT_V(2); PG8_BAR;
        PG8_STAGE(PG8_SB(1, 0), cB + kstep, voffB); PG8_STAGE(PG8_SA(1, 0), cA + kstep, voffA); PG8_STAGE(PG8_SB(1, 1), cB + hstep + kstep, voffB);
        PG8_WAIT_V(6); PG8_BAR;
    } else {
        PG8_STAGE(PG8_SB(0, 0), cB, voffB); PG8_STAGE(PG8_SA(0, 0), cA, voffA); PG8_STAGE(PG8_SB(0, 1), cB + hstep, voffB); PG8_STAGE(PG8_SA(0, 1), cA + hstep, voffA);
        if (wr == 1) PG8_BAR;
        PG8_WAIT_V(4); PG8_BAR;
        PG8_STAGE(PG8_SB(1, 0), cB + kstep, voffB); PG8_STAGE(PG8_SA(1, 0), cA + kstep, voffA); PG8_STAGE(PG8_SB(1, 1), cB + hstep + kstep, voffB);
        PG8_WAIT_V(6); PG8_BAR;
    }
    for (;;) {
        const bool has_next = S.next(ui + 1, nxt); const int nt = S.nt(cur);
        const char* nA = has_next ? S.A(nxt) : cA; const char* nB = has_next ? S.B(nxt) : cB;
        for (int t = 0; t < nt; t += 2) {
            const bool last = (t == nt - 2);
            const char* a1 = cA + (size_t)(t + 1) * kstep;
            const char* a2 = last ? nA : cA + (size_t)(t + 2) * kstep; const char* b2 = last ? nB : cB + (size_t)(t + 2) * kstep;
            const char* a3 = a2 + kstep; const char* b3 = b2 + kstep;
            if constexpr (SP2) {
            PG8_LDB(B0, 0, 0); PG8_LDB(B1, 0, 1); PG8_SCHED; PG8_LDA(At, 0, 0); PG8_STAGE(PG8_SA(1, 1), a1 + hstep, voffA);
            PG8_WAIT_V(8); PG8_WAIT_L(0); PG8_BAR; PG8_MMA(0, 0, At, B0); PG8_MMA(0, 1, At, B1); PG8_BAR; PG8_SCHED;
            PG8_LDA(At, 0, 1); PG8_STAGE(PG8_SB(0, 0), b2, voffB); PG8_STAGE(PG8_SB(0, 1), b2 + hstep, voffB); PG8_STAGE(PG8_SA(0, 0), a2, voffA);
            PG8_WAIT_V(8); PG8_WAIT_L(0); PG8_BAR; PG8_MMA(1, 0, At, B0); PG8_MMA(1, 1, At, B1); PG8_BAR; PG8_SCHED;
            PG8_LDB(B0, 1, 0); PG8_LDB(B1, 1, 1); PG8_SCHED; PG8_LDA(At, 1, 0); PG8_STAGE(PG8_SA(0, 1), a2 + hstep, voffA);
            PG8_WAIT_V(8); PG8_WAIT_L(0); PG8_BAR; PG8_MMA(0, 0, At, B0); PG8_MMA(0, 1, At, B1); PG8_BAR; PG8_SCHED;
            PG8_LDA(At, 1, 1); PG8_STAGE(PG8_SB(1, 0), b3, voffB); PG8_STAGE(PG8_SB(1, 1), b3 + hstep, voffB); PG8_STAGE(PG8_SA(1, 0), a3, voffA);
            PG8_WAIT_V(8); PG8_WAIT_L(0); PG8_BAR; PG8_MMA(1, 0, At, B0); PG8_MMA(1, 1, At, B1); PG8_BAR; PG8_SCHED;
            } else {
            PG8_LDB(B0, 0, 0); PG8_SCHED; PG8_LDA(At, 0, 0); PG8_STAGE(PG8_SA(1, 1), a1 + hstep, voffA);
            PG8_WAIT_L(8); PG8_BAR; PG8_WAIT_L(0); PG8_MMA(0, 0, At, B0); PG8_BAR; PG8_SCHED;
            PG8_LDB(B1, 0, 1); PG8_STAGE(PG8_SB(0, 0), b2, voffB);
            PG8_BAR; PG8_WAIT_L(0); PG8_MMA(0, 1, At, B1); PG8_BAR;
            PG8_LDA(At, 0, 1); PG8_STAGE(PG8_SA(0, 0), a2, voffA);
            PG8_BAR; PG8_WAIT_L(0); PG8_MMA(1, 0, At, B0); PG8_BAR; PG8_SCHED;
            PG8_STAGE(PG8_SB(0, 1), b2 + hstep, voffB);
            PG8_WAIT_V(6); PG8_BAR; PG8_MMA(1, 1, At, B1); PG8_BAR;
            PG8_LDB(B0, 1, 0); PG8_SCHED; PG8_LDA(At, 1, 0); PG8_STAGE(PG8_SA(0, 1), a2 + hstep, voffA);
            PG8_WAIT_L(8); PG8_BAR; PG8_WAIT_L(0); PG8_MMA(0, 0, At, B0); PG8_BAR; PG8_SCHED;
            PG8_LDB(B1, 1, 1); PG8_STAGE(PG8_SB(1, 0), b3, voffB);
            PG8_BAR; PG8_WAIT_L(0); PG8_MMA(0, 1, At, B1); PG8_BAR;
            PG8_LDA(At, 1, 1); PG8_STAGE(PG8_SA(1, 0), a3, voffA);
            PG8_BAR; PG8_WAIT_L(0); PG8_MMA(1, 0, At, B0); PG8_BAR; PG8_SCHED;
            PG8_STAGE(PG8_SB(1, 1), b3 + hstep, voffB);
            PG8_WAIT_V(6); PG8_BAR; PG8_MMA(1, 1, At, B1); PG8_BAR;
            }
        }
        if constexpr (ALIGN_EPI) { if (wr == 0) PG8_BAR; }
        E(acc, cur, wr, wc, fr, fq);
        if (!has_next) break;
        if (!S.keep(cur)) {
#pragma unroll
        for (int a = 0; a < 2; ++a)
#pragma unroll
            for (int b = 0; b < 2; ++b)
#pragma unroll
                for (int m = 0; m < 4; ++m)
#pragma unroll
                    for (int n = 0; n < 2; ++n) acc[a][b][m][n] = (f32x4){0.f, 0.f, 0.f, 0.f};
        }
        cur = nxt; cA = nA; cB = nB; ++ui;
        if constexpr (ALIGN_EPI) { if (wr == 1) PG8_BAR; }
    }
    PG8_WAIT_V(0);
    if constexpr (!ALIGN_EPI) { if (wr == 0) PG8_BAR; }
    PG8_BAR;
#undef PG8_SA
#undef PG8_SB
#undef PG8_STAGE
#undef PG8_LDA
#undef PG8_LDB
#undef PG8_MMA
#undef PG8_WAIT_V
#undef PG8_WAIT_L
#undef PG8_BAR
#undef PG8_SCHED
}
}

constexpr int D = 1024, NB = 4, SEQ = 4096, CTXL = 256;
constexpr int ML = NB * SEQ;
constexpr int MC = NB * CTXL;
constexpr int MH = ML + MC;
constexpr int INW = 5120;
constexpr int ZC_W = 1536;
constexpr int NEXP = 16384, NHEAD_P = 8, TOPK = 16;
constexpr float EPS = 1e-6f;
constexpr int NWAVES = 8, NTHREADS = 512;
constexpr int SEGT = 512, NSEG = SEQ / SEGT;
constexpr int CHT = 32;
constexpr int NSCAN_L = NB * 4 * 2 * NSEG;
constexpr int NCSEG = 4;
constexpr int NSCAN = NSCAN_L + NB * 4 * 2 * NCSEG;

constexpr size_t MiB = 1u << 20;
constexpr size_t WS_CTL = 0, CTL_ZERO_BYTES = 64 * 1024;
constexpr size_t WS_MOD = 1 * MiB;
constexpr size_t WS_LBT = WS_MOD + 128 * 1024;
constexpr size_t WS_ASEG = WS_LBT + 8 * 1024;
constexpr size_t WS_SU = WS_ASEG + 200 * 1024;
constexpr size_t WS_SV = WS_SU + 64 * 1024;
constexpr size_t WS_WIN = 2 * MiB;
constexpr size_t WS_WA = 12 * MiB, WS_WB = 13 * MiB, WS_WO = 14 * MiB, WS_WQ = 16 * MiB;
constexpr size_t WS_POOLW = 20 * MiB;
constexpr size_t WS_KEYS = WS_POOLW + 128 * 1024;
constexpr size_t WS_ZC = 21 * MiB;
constexpr size_t WS_Z = 24 * MiB;
constexpr size_t WS_QB = 24 * MiB;
constexpr size_t WS_EIDX = 88 * MiB;
constexpr size_t WS_GATE = 96 * MiB;
constexpr size_t WS_U8 = 112 * MiB, WS_V8 = 128 * MiB;
constexpr size_t WS_PART = 24 * MiB;
constexpr size_t WS_WGT = 104 * MiB;
constexpr size_t WS_H8 = 144 * MiB;
constexpr size_t WS_SH = 160 * MiB;
constexpr size_t WS_PO = 144 * MiB;
constexpr size_t WS_SSQ = 21 * MiB;
constexpr size_t WS_H = 184 * MiB;
constexpr size_t WS_YHG = 184 * MiB, WS_YPOOL = 200 * MiB;
constexpr size_t WS_USEG = 218 * MiB;
constexpr size_t WS_PFX = 242 * MiB;
constexpr size_t WS_M = 218 * MiB;
constexpr size_t WS_ZC2 = 252 * MiB;
constexpr size_t WS_END = 255 * MiB;
static_assert(WS_Z + (size_t)ML * INW * 2 <= WS_H && WS_H + (size_t)MH * D * 2 <= WS_USEG && WS_USEG + (size_t)NSCAN * 128 * 128 * 4 <= WS_END && WS_M + (size_t)ML * D * 2 <= WS_END && WS_USEG + (size_t)NSCAN * 128 * 128 * 4 <= WS_PFX && WS_PFX + 8 * MiB <= WS_ZC2, "ws map");
static_assert(WS_QB + (size_t)ML * 2048 * 2 <= WS_EIDX && WS_V8 + (size_t)NEXP * D <= WS_H, "ws map 2");
constexpr size_t OUT_OLOC = 0, OUT_QSEG = 32 * MiB;
constexpr int CW_BAR = 1024;

constexpr int LDS_BYTES = 163840;
constexpr int MISC_OFF = LDS_BYTES - 256;

#define GAS __attribute__((address_space(1)))
#define LAS __attribute__((address_space(3)))
typedef unsigned short bf16;
typedef unsigned v4u __attribute__((ext_vector_type(4)));
typedef unsigned v2u __attribute__((ext_vector_type(2)));
typedef float f32x4 __attribute__((ext_vector_type(4)));
typedef float f32x2 __attribute__((ext_vector_type(2)));
typedef short bf16x8 __attribute__((ext_vector_type(8)));
typedef short s16x4 __attribute__((ext_vector_type(4)));
#define LDS_WAIT() asm volatile("s_waitcnt lgkmcnt(0)" ::: "memory")
#define VM_WAIT() asm volatile("s_waitcnt vmcnt(0)" ::: "memory")
#define LBAR() do { asm volatile("s_waitcnt lgkmcnt(0)" ::: "memory"); __builtin_amdgcn_s_barrier(); asm volatile("" ::: "memory"); } while (0)
__device__ __forceinline__ unsigned f2bf(float f) { unsigned u = __builtin_bit_cast(unsigned, f); return (u + 0x7fffu + ((u >> 16) & 1u)) >> 16; }
__device__ __forceinline__ unsigned pk2(float lo, float hi) { return pg8::cvt_pk_bf16(lo, hi); }
__device__ __forceinline__ float bflo(unsigned w) { return __builtin_bit_cast(float, w << 16); }
__device__ __forceinline__ float bfhi(unsigned w) { return __builtin_bit_cast(float, w & 0xffff0000u); }
__device__ __forceinline__ float fast_exp(float x) { return __builtin_amdgcn_exp2f(x * 1.4426950408889634f); }
__device__ __forceinline__ float fast_rcp(float x) { return __builtin_amdgcn_rcpf(x); }
__device__ __forceinline__ float sigmoidf_(float x) { return fast_rcp(1.f + fast_exp(-x)); }
__device__ __forceinline__ float wave_sum(float v) {
#pragma unroll
    for (int o = 1; o < 64; o <<= 1) v += __shfl_xor(v, o);
    return v;
}
__device__ __forceinline__ float wave_max(float v) {
#pragma unroll
    for (int o = 1; o < 64; o <<= 1) v = fmaxf(v, __shfl_xor(v, o));
    return v;
}

#define XB_TMO      128
#define XB_XCNT(j)  (256  + 64 * (j))
#define XB_XSUB(j)  (1280 + 64 * (j))
#define XB_XGEN(j)  (2304 + 64 * (j))
#define XB_TOP      3328
#define XB_TOPGEN   3392
#define XCD_BAR_WORDS 3456
#define XB_SPIN_CAP (1u << 18)
__device__ __forceinline__ unsigned xb_ld(unsigned* p)              { return __hip_atomic_load(p, __ATOMIC_RELAXED, __HIP_MEMORY_SCOPE_AGENT); }
__device__ __forceinline__ unsigned xb_add(unsigned* p, unsigned v) { return __hip_atomic_fetch_add(p, v, __ATOMIC_RELAXED, __HIP_MEMORY_SCOPE_AGENT); }
__device__ __forceinline__ unsigned xb_xcc_id() { return (unsigned)__builtin_amdgcn_s_getreg((3 << 11) | 20) & 0xFu; }
#define XB_SPIN(cond, bar) do { unsigned _sp = 0; while (cond) { __builtin_amdgcn_s_sleep(1); \
    if ((++_sp & 255u) == 0u) { if (xb_ld(&(bar)[XB_TMO])) break; if (_sp > XB_SPIN_CAP) { atomicAdd(&(bar)[XB_TMO], 1u); break; } } } } while (0)
struct XcdBarrier { unsigned* bar; unsigned x; volatile LAS unsigned* st; };
__device__ __forceinline__ XcdBarrier xcd_barrier_post(unsigned* bar, volatile LAS unsigned* st) {
    XcdBarrier b; b.bar = bar; b.x = xb_xcc_id(); b.st = st;
    if (threadIdx.x == 0) st[2] = xb_add(&bar[XB_XCNT(b.x)], 1u);
    return b;
}
__device__ __forceinline__ void xcd_barrier_complete(unsigned* bar, unsigned x, unsigned& nloc, unsigned& nx) {
    const unsigned G = gridDim.x * gridDim.y * gridDim.z;
    unsigned sum, cnt, mine, sp = 0u;
    for (;;) {
        sum = 0u; cnt = 0u; mine = 0u;
#pragma unroll
        for (unsigned j = 0; j < 16; ++j) { const unsigned c = xb_ld(&bar[XB_XCNT(j)]); sum += c; cnt += (c > 0u) ? 1u : 0u; mine = (j == x) ? c : mine; }
        if (sum == G) break;
        __builtin_amdgcn_s_sleep(1);
        if ((++sp & 255u) == 0u) { if (xb_ld(&bar[XB_TMO])) break; if (sp > XB_SPIN_CAP) { atomicAdd(&bar[XB_TMO], 1u); break; } }
    }
    nloc = mine > 0u ? mine : 1u; nx = cnt > 0u ? cnt : 1u;
}
__device__ __forceinline__ void xcd_barrier(const XcdBarrier& b) {
    asm volatile("s_waitcnt vmcnt(0)" ::: "memory");
    __syncthreads();
    if (threadIdx.x == 0) {
        unsigned* bar = b.bar;
        __builtin_amdgcn_s_waitcnt(0);
        unsigned nloc = b.st[0], nx = b.st[1];
        if (nloc == 0u) { xcd_barrier_complete(bar, b.x, nloc, nx); b.st[0] = nloc; b.st[1] = nx; }
        const unsigned old = xb_add(&bar[XB_XSUB(b.x)], 1u);
        const unsigned gen = old / nloc;
        if (old + 1u == (gen + 1u) * nloc) {
            __builtin_amdgcn_fence(__ATOMIC_RELEASE, "agent");
            asm volatile("s_waitcnt vmcnt(0)" ::: "memory");
            const unsigned og = xb_add(&bar[XB_TOP], 1u);
            const unsigned tg = og / nx;
            if (og + 1u == (tg + 1u) * nx) xb_add(&bar[XB_TOPGEN], 1u);
            else XB_SPIN(xb_ld(&bar[XB_TOPGEN]) == tg, bar);
            __builtin_amdgcn_fence(__ATOMIC_ACQUIRE, "agent");
            xb_add(&bar[XB_XGEN(b.x)], 1u);
            asm volatile("s_waitcnt vmcnt(0)" ::: "memory");
        } else {
            XB_SPIN(xb_ld(&bar[XB_XGEN(b.x)]) == gen, bar);
            __builtin_amdgcn_fence(__ATOMIC_ACQUIRE, "agent");
            asm volatile("s_waitcnt vmcnt(0)" ::: "memory");
        }
    }
    __syncthreads();
}

struct Args { const float* in[21]; float* out; unsigned char* ws; int ph_lo, ph_hi; };

struct Frame {
    LAS unsigned char* lds; int tid, lane, wave, G, bid;
    const float *x, *c, *ctx, *c_ctx, *w_mod, *b_mod, *n1g, *n2g, *w_in, *pool_w, *pool_scale, *lb_logits, *hg_norm_g, *w_a, *w_b, *w_o, *wq, *keys, *pu, *pv, *final_g;
    float* out; unsigned char* ws;
};

__device__ __forceinline__ void p0_transpose_item(const float* W, int K, int N, bf16* WT, LAS float* scr, int item, int lane) {
    const int nblk = N / 32, kb = item / nblk, nb = item % nblk, k0 = 64 * kb, n0 = 32 * nb;
#pragma unroll 8
    for (int i = 0; i < 32; ++i) { const int kk = 2 * i + (lane >> 5); scr[kk * 33 + (lane & 31)] = W[(size_t)(k0 + kk) * N + n0 + (lane & 31)]; }
    LDS_WAIT(); asm volatile("" ::: "memory");
    const int c = lane & 7;
#pragma unroll
    for (int j = 0; j < 4; ++j) { const int n = (lane >> 3) + 8 * j; const LAS float* s = scr + (8 * c) * 33 + n;
        v4u o; o.x = pk2(s[0 * 33], s[1 * 33]); o.y = pk2(s[2 * 33], s[3 * 33]); o.z = pk2(s[4 * 33], s[5 * 33]); o.w = pk2(s[6 * 33], s[7 * 33]);
        *(GAS v4u*)(WT + (size_t)(n0 + n) * K + k0 + 8 * c) = o; }
    LDS_WAIT(); asm volatile("" ::: "memory");
}

__device__ __forceinline__ void p0_prologue(Frame& F) {
    float* mod = (float*)(F.ws + WS_MOD);
    if (F.bid < 192) {
        LAS float* sl = (LAS float*)(F.lds + 81920);
        LAS float* red = (LAS float*)(F.lds + 81920 + 20480);
        for (int i = F.tid; i < 5 * 1024; i += NTHREADS) { const float cv = (i < 4096) ? F.c[i] : F.c_ctx[i - 4096]; sl[i] = cv * sigmoidf_(cv); }
        __syncthreads();
        const int col = F.tid & 31, kg = F.tid >> 5, col0 = 32 * F.bid;
        float a0 = 0.f, a1 = 0.f, a2 = 0.f, a3 = 0.f, a4 = 0.f;
        const float* wp = F.w_mod + (size_t)(kg * 64) * 6144 + col0 + col;
#pragma unroll 8
        for (int r = 0; r < 64; ++r) { const float w = wp[(size_t)r * 6144]; const int k = kg * 64 + r;
            a0 += w * sl[k]; a1 += w * sl[1024 + k]; a2 += w * sl[2048 + k]; a3 += w * sl[3072 + k]; a4 += w * sl[4096 + k]; }
        red[(kg * 5 + 0) * 32 + col] = a0; red[(kg * 5 + 1) * 32 + col] = a1; red[(kg * 5 + 2) * 32 + col] = a2; red[(kg * 5 + 3) * 32 + col] = a3; red[(kg * 5 + 4) * 32 + col] = a4;
        __syncthreads();
        if (F.tid < 160) { const int v = F.tid >> 5, cc = F.tid & 31; float s = 0.f;
#pragma unroll
            for (int g = 0; g < 16; ++g) s += red[(g * 5 + v) * 32 + cc];
            mod[v * 6144 + col0 + cc] = s + F.b_mod[col0 + cc]; }
        __syncthreads();
    }
    LAS float* scr = (LAS float*)(F.lds + F.wave * 8448);
    const int gw = F.bid * NWAVES + F.wave, NGW = F.G * NWAVES;
    constexpr int I_IN = (D / 64) * (INW / 32), I_A = (512 / 64) * (D / 32), I_O = (D / 64) * (D / 32), I_Q = (D / 64) * (2048 / 32), I_P = (128 / 64) * (128 / 32);
    constexpr int NITEMS = I_IN + 2 * I_A + I_O + I_Q + 4 * I_P;
    for (int it = gw; it < NITEMS; it += NGW) {
        int r = it;
        if (r < I_IN) { p0_transpose_item(F.w_in, D, INW, (bf16*)(F.ws + WS_WIN), scr, r, F.lane); continue; } r -= I_IN;
        if (r < I_A) { p0_transpose_item(F.w_a, 512, D, (bf16*)(F.ws + WS_WA), scr, r, F.lane); continue; } r -= I_A;
        if (r < I_A) { p0_transpose_item(F.w_b, 512, D, (bf16*)(F.ws + WS_WB), scr, r, F.lane); continue; } r -= I_A;
        if (r < I_O) { p0_transpose_item(F.w_o, D, D, (bf16*)(F.ws + WS_WO), scr, r, F.lane); continue; } r -= I_O;
        if (r < I_Q) { p0_transpose_item(F.wq, D, 2048, (bf16*)(F.ws + WS_WQ), scr, r, F.lane); continue; } r -= I_Q;
        { const int g = r / I_P; p0_transpose_item(F.pool_w + (size_t)g * 128 * 128, 128, 128, (bf16*)(F.ws + WS_POOLW) + (size_t)g * 128 * 128, scr, r % I_P, F.lane); }
    }
    { bf16* kb = (bf16*)(F.ws + WS_KEYS); const int gt = F.bid * NTHREADS + F.tid, NT = F.G * NTHREADS;
      for (int i = gt; i < 16 * 128 * 128 / 4; i += NT) { const f32x4 v = ((const GAS f32x4*)F.keys)[i]; v2u o; o.x = pk2(v.x, v.y); o.y = pk2(v.z, v.w); ((GAS v2u*)kb)[i] = o; }
      float* lbt = (float*)(F.ws + WS_LBT);
      if (gt < 1024) { const int dir = gt >> 9, cc = gt & 511; const float l0 = F.lb_logits[(dir * 2 + 0) * 512 + cc], l1 = F.lb_logits[(dir * 2 + 1) * 512 + cc];
          lbt[gt] = 1.f / (1.f + expf(l1 - l0)); } }
}

__device__ __forceinline__ void modulate_row(const float* xrow, bf16* orow, const float* g, const float* shift, const float* scale, int lane) {
    const GAS f32x4* xr = (const GAS f32x4*)xrow + lane;
    f32x4 v[4]; float s2 = 0.f;
#pragma unroll
    for (int j = 0; j < 4; ++j) { v[j] = xr[64 * j]; s2 += (v[j].x * v[j].x + v[j].y * v[j].y) + (v[j].z * v[j].z + v[j].w * v[j].w); }
    const float rstd = 1.f / sqrtf(wave_sum(s2) * (1.f / D) + EPS);
    GAS v2u* o8 = (GAS v2u*)orow + lane;
#pragma unroll
    for (int j = 0; j < 4; ++j) {
        const f32x4 gg = ((const GAS f32x4*)g)[lane + 64 * j], sh = ((const GAS f32x4*)shift)[lane + 64 * j], sc = ((const GAS f32x4*)scale)[lane + 64 * j];
        const f32x4 y = (v[j] * rstd) * gg * (sc + 1.0f) + sh;
        v2u o; o.x = pk2(y.x, y.y); o.y = pk2(y.z, y.w); o8[64 * j] = o; }
}
__device__ __forceinline__ void p1_modulate(Frame& F) {
    const float* mod = (const float*)(F.ws + WS_MOD); bf16* H = (bf16*)(F.ws + WS_H);
    const int gw = F.bid * NWAVES + F.wave, NGW = F.G * NWAVES;
    for (int m = gw; m < MH; m += NGW) {
        const int v = (m < ML) ? (m >> 12) : 4;
        const float* xr = (m < ML) ? F.x + (size_t)m * D : F.ctx + (size_t)(m - ML) * D;
        modulate_row(xr, H + (size_t)m * D, F.n1g, mod + v * 6144 + 0, mod + v * 6144 + 1024, F.lane);
    }
}

using pg8::Unit;
struct SchedPlain {
    const char* Ab; const char* Bb; int nM, nN, K, G, c;
    __device__ __forceinline__ bool next(int i, Unit& u) const { const int L = i * G + c; if (L >= nM * nN) return false; pg8::tile_of(L, nM, nN, u.pm, u.pn); u.seg = 0; return true; }
    __device__ __forceinline__ const char* A(const Unit& u) const { return Ab + (size_t)u.pm * 256 * K * 2; }
    __device__ __forceinline__ const char* B(const Unit& u) const { return Bb + (size_t)u.pn * 256 * K * 2; }
    __device__ __forceinline__ bool keep(const Unit&) const { return false; }
    __device__ __forceinline__ int nt(const Unit&) const { return K / 64; }
};
struct SchedIn {
    const char* Ab; const char* Bb; int G, c;
    __device__ __forceinline__ bool next(int i, Unit& u) const { const int L = i * G + c; u.seg = 0;
        if (L < 1280) { pg8::tile_of(L, 64, 20, u.pm, u.pn); return true; }
        if (L < 1328) { const int l = L - 1280, l2 = l >> 1; u.seg = l & 1; u.pm = 64 + (l2 & 3); u.pn = 4 + (l2 >> 2); return true; }
        return false; }
    __device__ __forceinline__ const char* A(const Unit& u) const { return Ab + (size_t)u.pm * 256 * D * 2 + ((u.pm >= 64 && u.seg) ? 1024 : 0); }
    __device__ __forceinline__ const char* B(const Unit& u) const { return Bb + (size_t)u.pn * 256 * D * 2 + ((u.pm >= 64 && u.seg) ? 1024 : 0); }
    __device__ __forceinline__ bool keep(const Unit&) const { return false; }
    __device__ __forceinline__ int nt(const Unit& u) const { return u.pm >= 64 ? 8 : 16; }
};
struct SchedMerge {
    const char *A0, *A1, *B0, *B1; int G, c;
    __device__ __forceinline__ bool next(int i, Unit& u) const { const int tile = (i >> 1) * G + c; if (tile >= 256) return false; pg8::tile_of(tile, 64, 4, u.pm, u.pn); u.seg = i & 1; return true; }
    __device__ __forceinline__ const char* A(const Unit& u) const { return (u.seg ? A1 : A0) + (size_t)u.pm * 256 * 512 * 2; }
    __device__ __forceinline__ const char* B(const Unit& u) const { return (u.seg ? B1 : B0) + (size_t)u.pn * 256 * 512 * 2; }
    __device__ __forceinline__ bool keep(const Unit& u) const { return u.seg == 0; }
    __device__ __forceinline__ int nt(const Unit&) const { return 8; }
};

struct EpiZ {
    static constexpr bool PERM = true;
    bf16* Z; bf16* ZC; bf16* ZC2;
    __device__ __forceinline__ void operator()(pg8::f32x4 (&acc)[2][2][4][2], const Unit& u, int wr, int wc, int fr, int fq) const {
        int row0 = u.pm * 256 + wr * 64 + fr, col0 = u.pn * 256 + wc * 32 + 8 * fq, ldc = INW; bf16* base = Z;
        if (u.pm >= 64) { base = u.seg ? ZC2 : ZC; row0 -= ML; col0 -= 1024; ldc = ZC_W; }
        const bool sg = u.pn >= 12;
#pragma unroll
        for (int ai = 0; ai < 2; ++ai)
#pragma unroll
            for (int m = 0; m < 4; ++m) { bf16* rowp = base + (size_t)(row0 + ai * 128 + m * 16) * ldc + col0;
#pragma unroll
                for (int bj = 0; bj < 2; ++bj) { pg8::f32x4 v0 = acc[ai][bj][m][0], v1 = acc[ai][bj][m][1];
                    if (sg) {
#pragma unroll
                        for (int j = 0; j < 4; ++j) { v0[j] = sigmoidf_(v0[j]); v1[j] = sigmoidf_(v1[j]); } }
                    v4u w; w.x = pk2(v0[0], v0[1]); w.y = pk2(v0[2], v0[3]); w.z = pk2(v1[0], v1[1]); w.w = pk2(v1[2], v1[3]);
                    *(GAS v4u*)(rowp + bj * 128) = w; } }
    }
};
struct EpiPlain {
    static constexpr bool PERM = true;
    bf16* O; int ldc;
    __device__ __forceinline__ void operator()(pg8::f32x4 (&acc)[2][2][4][2], const Unit& u, int wr, int wc, int fr, int fq) const {
        const int row0 = u.pm * 256 + wr * 64 + fr, col0 = u.pn * 256 + wc * 32 + 8 * fq;
#pragma unroll
        for (int ai = 0; ai < 2; ++ai)
#pragma unroll
            for (int m = 0; m < 4; ++m) { bf16* rowp = O + (size_t)(row0 + ai * 128 + m * 16) * ldc + col0;
#pragma unroll
                for (int bj = 0; bj < 2; ++bj) { const pg8::f32x4 v0 = acc[ai][bj][m][0], v1 = acc[ai][bj][m][1];
                    v4u w; w.x = pk2(v0[0], v0[1]); w.y = pk2(v0[2], v0[3]); w.z = pk2(v1[0], v1[1]); w.w = pk2(v1[2], v1[3]);
                    *(GAS v4u*)(rowp + bj * 128) = w; } }
    }
};
struct EpiMerge {
    static constexpr bool PERM = true;
    const bf16* Z; bf16* Mo;
    __device__ __forceinline__ void operator()(pg8::f32x4 (&acc)[2][2][4][2], const Unit& u, int wr, int wc, int fr, int fq) const {
        const int row0 = u.pm * 256 + wr * 64 + fr, col0 = u.pn * 256 + wc * 32 + 8 * fq;
#pragma unroll
        for (int ai = 0; ai < 2; ++ai)
#pragma unroll
            for (int m = 0; m < 4; ++m) { const size_t r = (size_t)(row0 + ai * 128 + m * 16);
#pragma unroll
                for (int bj = 0; bj < 2; ++bj) { const int c = col0 + bj * 128;
                    const v4u gh = *(const GAS v4u*)(Z + r * INW + 4096 + c);
                    float h[8] = {bflo(gh.x), bfhi(gh.x), bflo(gh.y), bfhi(gh.y), bflo(gh.z), bfhi(gh.z), bflo(gh.w), bfhi(gh.w)};
                    if (u.seg == 0) {
                        const v4u gp = *(const GAS v4u*)(Z + r * INW + 3072 + c);
                        float p[8] = {bflo(gp.x), bfhi(gp.x), bflo(gp.y), bfhi(gp.y), bflo(gp.z), bfhi(gp.z), bflo(gp.w), bfhi(gp.w)};
#pragma unroll
                        for (int j = 0; j < 4; ++j) { acc[ai][bj][m][0][j] *= p[j] * fast_rcp(fmaxf(h[j], 1e-30f)); acc[ai][bj][m][1][j] *= p[4 + j] * fast_rcp(fmaxf(h[4 + j], 1e-30f)); }
                    } else {
                        pg8::f32x4 v0 = acc[ai][bj][m][0], v1 = acc[ai][bj][m][1];
#pragma unroll
                        for (int j = 0; j < 4; ++j) { v0[j] *= h[j]; v1[j] *= h[4 + j]; }
                        v4u w; w.x = pk2(v0[0], v0[1]); w.y = pk2(v0[2], v0[3]); w.z = pk2(v1[0], v1[1]); w.w = pk2(v1[2], v1[3]);
                        *(GAS v4u*)(Mo + r * D + c) = w; } } }
    }
};
struct EpiRes {
    static constexpr bool PERM = false;
    const float* X; const float* mod; float* O;
    __device__ __forceinline__ void operator()(pg8::f32x4 (&acc)[2][2][4][2], const Unit& u, int wr, int wc, int fr, int fq) const {
        const int row0 = u.pm * 256 + wr * 64 + fr, col0 = u.pn * 256 + wc * 32 + 4 * fq;
        const float* g1 = mod + (size_t)(u.pm >> 4) * 6144 + 2048;
        pg8::f32x4 gv[2][2];
#pragma unroll
        for (int bj = 0; bj < 2; ++bj)
#pragma unroll
            for (int n = 0; n < 2; ++n) gv[bj][n] = *(const GAS pg8::f32x4*)(g1 + col0 + bj * 128 + n * 16);
#pragma unroll
        for (int ai = 0; ai < 2; ++ai)
#pragma unroll
            for (int m = 0; m < 4; ++m) { const size_t off = (size_t)(row0 + ai * 128 + m * 16) * D + col0;
#pragma unroll
                for (int bj = 0; bj < 2; ++bj)
#pragma unroll
                    for (int n = 0; n < 2; ++n) { const pg8::f32x4 xv = *(const GAS pg8::f32x4*)(X + off + bj * 128 + n * 16);
                        *(GAS pg8::f32x4*)(O + off + bj * 128 + n * 16) = xv + gv[bj][n] * acc[ai][bj][m][n]; }
                asm volatile("" ::: "memory"); }
    }
};

__device__ __forceinline__ unsigned off_b(unsigned row, unsigned ch) { return 256u * row + 16u * (ch ^ (((row & 3) << 2) | ((row >> 2) & 3))); }
__device__ __forceinline__ unsigned row_addr16(unsigned lane, unsigned rb, unsigned s) { return off_b((lane & 15) + 16 * rb, 4 * s + (lane >> 4)); }
__device__ __forceinline__ unsigned tr_addr16(unsigned lane, unsigned c, unsigned t) { const unsigned g = lane >> 4, q = (lane & 15) >> 2, p = lane & 3; return off_b(8 * g + 4 * t + q, 2 * c + (p >> 1)) + 8 * (p & 1); }
__device__ __forceinline__ bf16x8 tr_frag(LAS unsigned char* tile, unsigned lane, unsigned c) {
    const s16x4 lo = __builtin_amdgcn_ds_read_tr16_b64_v4i16((LAS s16x4*)(tile + tr_addr16(lane, c, 0)));
    const s16x4 hi = __builtin_amdgcn_ds_read_tr16_b64_v4i16((LAS s16x4*)(tile + tr_addr16(lane, c, 1)));
    return __builtin_shufflevector(lo, hi, 0, 1, 2, 3, 4, 5, 6, 7);
}
#define MFMA16(a, b, c) __builtin_amdgcn_mfma_f32_16x16x32_bf16((a), (b), (c), 0, 0, 0)

__device__ __forceinline__ v4u add_bf16x8(const v4u a, const v4u b) {
    v4u r; r.x = pk2(bflo(a.x) + bflo(b.x), bfhi(a.x) + bfhi(b.x)); r.y = pk2(bflo(a.y) + bflo(b.y), bfhi(a.y) + bfhi(b.y));
    r.z = pk2(bflo(a.z) + bflo(b.z), bfhi(a.z) + bfhi(b.z)); r.w = pk2(bflo(a.w) + bflo(b.w), bfhi(a.w) + bfhi(b.w)); return r; }
constexpr int SC_QT = 0, SC_KT = 8192, SC_KD = 16384, SC_VT = 24576, SC_ATT = 32768, SC_EL = 35328, SC_WT = 35840;

__device__ __forceinline__ void scan_unit(Frame& F, int u) {
    const int tid = F.tid, lane = F.lane, w = F.wave, q = lane >> 4;
    const bool isctx = u >= NSCAN_L;
    int b, h, dir, rowbase, nch; const bf16* src; int ld, cq, ci, cf;
    if (!isctx) { const int j = u & 7; dir = (u >> 3) & 1; h = (u >> 4) & 3; b = u >> 6; const int tb = dir ? 7 - j : j;
        rowbase = b * SEQ + tb * SEGT; nch = SEGT / CHT; src = (const bf16*)(F.ws + WS_Z); ld = INW; cq = 512 + h * 128; ci = 1024 + h * 128; cf = (dir ? 2048 : 1536) + h * 128; }
    else { const int v = u - NSCAN_L, cs = v & (NCSEG - 1); dir = (v >> 2) & 1; h = (v >> 3) & 3; b = v >> 5;
        rowbase = b * CTXL + (dir ? NCSEG - 1 - cs : cs) * (CTXL / NCSEG); nch = CTXL / NCSEG / CHT; src = (const bf16*)(F.ws + WS_ZC); ld = ZC_W; ci = h * 128; cq = ci; cf = (dir ? 1024 : 512) + h * 128; }
    const int t = tid >> 4, k8 = tid & 15;
    const int pl = dir ? 3 - q : q;
    const float* lbt = (const float*)(F.ws + WS_LBT) + dir * 512 + h * 128 + 8 * k8;
    float lb[8], om_[8], ecum[8];
#pragma unroll
    for (int i = 0; i < 8; ++i) { lb[i] = lbt[i]; om_[i] = 1.f - lbt[i]; ecum[i] = 1.f; }
    f32x4 S[8];
#pragma unroll
    for (int i = 0; i < 8; ++i) S[i] = (f32x4){0.f, 0.f, 0.f, 0.f};
    LAS unsigned char* L = F.lds;
    bf16* qseg = (bf16*)((unsigned char*)F.out + OUT_QSEG) + (size_t)dir * ML * 512;
    bf16* oloc = (bf16*)((unsigned char*)F.out + OUT_OLOC);
    v4u qv, vv, fv;
    { const int tc = dir ? nch - 1 : 0; const bf16* rp = src + (size_t)(rowbase + tc * CHT + t) * ld + 8 * k8;
      qv = *(const GAS v4u*)(rp + cq); vv = *(const GAS v4u*)(rp + ci); fv = *(const GAS v4u*)(rp + cf);
      if (isctx) { const bf16* r2 = rp + (WS_ZC2 - WS_ZC) / 2; vv = add_bf16x8(vv, *(const GAS v4u*)(r2 + ci)); fv = add_bf16x8(fv, *(const GAS v4u*)(r2 + cf)); qv = vv; } }
    for (int pc = 0; pc < nch; ++pc) {
        const int tc = dir ? nch - 1 - pc : pc;
        const v4u q0 = qv, v0 = vv, f0 = fv;
        if (pc + 1 < nch) { const int tn = dir ? tc - 1 : tc + 1; const bf16* rp = src + (size_t)(rowbase + tn * CHT + t) * ld + 8 * k8;
            qv = *(const GAS v4u*)(rp + cq); vv = *(const GAS v4u*)(rp + ci); fv = *(const GAS v4u*)(rp + cf);
            if (isctx) { const bf16* r2 = rp + (WS_ZC2 - WS_ZC) / 2; vv = add_bf16x8(vv, *(const GAS v4u*)(r2 + ci)); fv = add_bf16x8(fv, *(const GAS v4u*)(r2 + cf)); qv = vv; } }
        float fr_[8] = {bflo(f0.x), bfhi(f0.x), bflo(f0.y), bfhi(f0.y), bflo(f0.z), bfhi(f0.z), bflo(f0.w), bfhi(f0.w)};
        float e[8], kk[8];
#pragma unroll
        for (int i = 0; i < 8; ++i) { const float s = fast_rcp(1.f + fast_exp(-fr_[i])); e[i] = lb[i] + om_[i] * s; kk[i] = om_[i] - om_[i] * s; }
        { const int s1 = dir ? lane + 16 : lane - 16, s2 = dir ? lane + 32 : lane - 32;
#pragma unroll
          for (int i = 0; i < 8; ++i) { const float o = __shfl(e[i], s1 & 63); e[i] = (pl >= 1) ? e[i] * o : e[i]; }
#pragma unroll
          for (int i = 0; i < 8; ++i) { const float o = __shfl(e[i], s2 & 63); e[i] = (pl >= 2) ? e[i] * o : e[i]; } }
        if (pl == 3) { LAS f32x4* wt = (LAS f32x4*)(L + SC_WT + (w * 128 + 8 * k8) * 4); wt[0] = (f32x4){e[0], e[1], e[2], e[3]}; wt[1] = (f32x4){e[4], e[5], e[6], e[7]}; }
        LBAR();
        float etot[8];
        { float pre[8], run[8];
#pragma unroll
          for (int i = 0; i < 8; ++i) { pre[i] = 1.f; run[i] = 1.f; }
#pragma unroll
          for (int sidx = 0; sidx < 8; ++sidx) { const int ww = dir ? 7 - sidx : sidx;
              const LAS f32x4* wt = (const LAS f32x4*)(L + SC_WT + (ww * 128 + 8 * k8) * 4); const f32x4 a = wt[0], c = wt[1];
              if (ww == w) {
#pragma unroll
                  for (int i = 0; i < 8; ++i) pre[i] = run[i]; }
              run[0] *= a.x; run[1] *= a.y; run[2] *= a.z; run[3] *= a.w; run[4] *= c.x; run[5] *= c.y; run[6] *= c.z; run[7] *= c.w; }
#pragma unroll
          for (int i = 0; i < 8; ++i) { etot[i] = run[i]; e[i] *= pre[i]; } }
        {
            const float qf[8] = {bflo(q0.x), bfhi(q0.x), bflo(q0.y), bfhi(q0.y), bflo(q0.z), bfhi(q0.z), bflo(q0.w), bfhi(q0.w)};
            float qt[8], kt[8], kd[8];
#pragma unroll
            for (int i = 0; i < 8; ++i) { qt[i] = qf[i] * e[i]; kt[i] = kk[i] * fast_rcp(e[i]); kd[i] = kt[i] * etot[i]; }
            const unsigned ob = off_b((unsigned)t, (unsigned)k8);
            v4u o; o.x = pk2(qt[0], qt[1]); o.y = pk2(qt[2], qt[3]); o.z = pk2(qt[4], qt[5]); o.w = pk2(qt[6], qt[7]); *(LAS v4u*)(L + SC_QT + ob) = o;
            o.x = pk2(kt[0], kt[1]); o.y = pk2(kt[2], kt[3]); o.z = pk2(kt[4], kt[5]); o.w = pk2(kt[6], kt[7]); *(LAS v4u*)(L + SC_KT + ob) = o;
            o.x = pk2(kd[0], kd[1]); o.y = pk2(kd[2], kd[3]); o.z = pk2(kd[4], kd[5]); o.w = pk2(kd[6], kd[7]); *(LAS v4u*)(L + SC_KD + ob) = o;
            *(LAS v4u*)(L + SC_VT + ob) = v0;
            if (!isctx) { o.x = pk2(qt[0] * ecum[0], qt[1] * ecum[1]); o.y = pk2(qt[2] * ecum[2], qt[3] * ecum[3]); o.z = pk2(qt[4] * ecum[4], qt[5] * ecum[5]); o.w = pk2(qt[6] * ecum[6], qt[7] * ecum[7]);
                *(GAS v4u*)(qseg + (size_t)(rowbase + tc * CHT + t) * 512 + h * 128 + 8 * k8) = o; }
            if (t == 0) { LAS f32x4* el = (LAS f32x4*)(L + SC_EL + 32 * k8); el[0] = (f32x4){etot[0], etot[1], etot[2], etot[3]}; el[1] = (f32x4){etot[4], etot[5], etot[6], etot[7]}; }
#pragma unroll
            for (int i = 0; i < 8; ++i) ecum[i] *= etot[i];
        }
        LBAR();
        if (w < 4 && !isctx) {
            const int tt = dir ? (w >> 1) : ((w + 1) >> 1), st = dir ? ((w + 1) >> 1) : (w >> 1);
            const int tz = dir ? 1 : 0, sz = dir ? 0 : 1;
            f32x4 a = (f32x4){0.f, 0.f, 0.f, 0.f};
            if (w < 3) {
#pragma unroll
                for (int s = 0; s < 4; ++s) { const bf16x8 A = *(const LAS bf16x8*)(L + SC_QT + row_addr16(lane, tt, s)); const bf16x8 B = *(const LAS bf16x8*)(L + SC_KT + row_addr16(lane, st, s)); a = MFMA16(A, B, a); }
            }
            const int tr = (w < 3 ? tt : tz) * 16 + 4 * q, sc = (w < 3 ? st : sz) * 16 + (lane & 15);
#pragma unroll
            for (int j = 0; j < 4; ++j) { const int ti = tr + j; const bool ok = (w < 3) && (dir ? (sc >= ti) : (sc <= ti));
                *(LAS unsigned short*)(L + SC_ATT + ti * 80 + sc * 2) = (unsigned short)f2bf(ok ? a[j] : 0.f); }
        }
        LBAR();
        {
            const bf16x8 Bv = tr_frag(L + SC_VT, lane, w);
            if (!isctx) {
                v4u sb[4];
#pragma unroll
                for (int s = 0; s < 4; ++s) { sb[s].x = pk2(S[2 * s][0], S[2 * s][1]); sb[s].y = pk2(S[2 * s][2], S[2 * s][3]); sb[s].z = pk2(S[2 * s + 1][0], S[2 * s + 1][1]); sb[s].w = pk2(S[2 * s + 1][2], S[2 * s + 1][3]); }
#pragma unroll 1
                for (int tt = 0; tt < 2; ++tt) {
                    f32x4 o = (f32x4){0.f, 0.f, 0.f, 0.f};
                    const unsigned row = 16 * tt + (lane & 15);
#pragma unroll
                    for (int s = 0; s < 4; ++s) {
                        const v2u alo = *(const LAS v2u*)(L + SC_QT + off_b(row, 4 * s + (q >> 1)) + 8 * (q & 1));
                        const v2u ahi = *(const LAS v2u*)(L + SC_QT + off_b(row, 4 * s + 2 + (q >> 1)) + 8 * (q & 1));
                        const v4u av = (v4u){alo.x, alo.y, ahi.x, ahi.y};
                        o = MFMA16(__builtin_bit_cast(bf16x8, av), __builtin_bit_cast(bf16x8, sb[s]), o);
                    }
                    const bf16x8 At = *(const LAS bf16x8*)(L + SC_ATT + row * 80 + 16 * q);
                    o = MFMA16(At, Bv, o);
                    const int ttg = (rowbase + tc * CHT + 16 * tt) >> 4;
                    v2u ov; ov.x = pk2(o[0], o[1]); ov.y = pk2(o[2], o[3]);
                    *(GAS v2u*)(oloc + ((((size_t)(dir * 1024 + ttg) * 4 + h) * 8 + w) * 64 + lane) * 4) = ov;
                }
            }
#pragma unroll
            for (int kt = 0; kt < 8; ++kt) {
                const bf16x8 A = tr_frag(L + SC_KD, lane, kt);
                const f32x4 a4 = *(const LAS f32x4*)(L + SC_EL + (16 * kt + 4 * q) * 4);
                S[kt] = MFMA16(A, Bv, S[kt] * a4);
            }
        }
    }
    { float* us = (float*)(F.ws + WS_USEG) + (size_t)u * 128 * 128 + (4 * q) * 128 + 16 * w + (lane & 15);
#pragma unroll
      for (int kt = 0; kt < 8; ++kt) {
#pragma unroll
          for (int j = 0; j < 4; ++j) us[j * 128] = S[kt][j];
          us += 16 * 128; asm volatile("" : "+v"(us)); }
      if (t == 0) { float* as = (float*)(F.ws + WS_ASEG) + (size_t)u * 128 + 8 * k8;
#pragma unroll
          for (int i = 0; i < 8; ++i) as[i] = ecum[i]; } }
    __syncthreads();
}


constexpr int PL_V = 0, PL_VSTR = 132, PL_D = 34816, PL_DSTR = 272, PL_W = 53248;
#define PL_LOAD8(ra, rd, g_, r0b_, rhi_) do { _Pragma("unroll") for (int u8 = 0; u8 < 8; ++u8) { const int rr_ = min((r0b_) + u8, (rhi_)); \
    const bf16* p_ = Z + (size_t)(b * SEQ + rr_ * 64 + c) * INW + (g_) * 128 + 16 * ch16; ra[u8] = *(const GAS v4u*)p_; rd[u8] = *(const GAS v4u*)(p_ + 8); } } while (0)
#define PL_CONSUME8(ra, rd, r0b_, rhi_) do { _Pragma("unroll") for (int u8 = 0; u8 < 8; ++u8) { const int rr_ = (r0b_) + u8; const bool in_ = rr_ <= (rhi_); const v4u a_ = ra[u8], d_ = rd[u8]; \
    const float x_[16] = {bflo(a_.x), bfhi(a_.x), bflo(a_.y), bfhi(a_.y), bflo(a_.z), bfhi(a_.z), bflo(a_.w), bfhi(a_.w), bflo(d_.x), bfhi(d_.x), bflo(d_.y), bfhi(d_.y), bflo(d_.z), bfhi(d_.z), bflo(d_.w), bfhi(d_.w)}; \
    _Pragma("unroll") for (int i_ = 0; i_ < 16; ++i_) { vs[i_] += in_ ? x_[i_] : 0.f; pc[i_] = (in_ && rr_ == r) ? x_[i_] : pc[i_]; } } } while (0)
__device__ __forceinline__ void pool_unit(Frame& F, int u) {
    const int b = u >> 6, r = u & 63, tid = F.tid, lane = F.lane, w = F.wave, q = lane >> 4;
    const int c = tid >> 3, ch16 = tid & 7;
    const bf16* Z = (const bf16*)(F.ws + WS_Z); bf16* YP = (bf16*)(F.ws + WS_YPOOL);
    LAS unsigned char* L = F.lds;
#pragma unroll 1
    for (int g = 0; g < 4; ++g) {
        v4u ra[8], rd[8];
        const int half = 1 << g;
        const int r_lo = max(0, r - half), r_hi = min(63, r + half - 1), c_lo = max(0, c - half), c_hi = min(63, c + half - 1);
        float vs[16], pc[16];
#pragma unroll
        for (int i = 0; i < 16; ++i) { vs[i] = 0.f; pc[i] = 0.f; }
        v4u wreg[4];
        { const GAS v4u* wsrc = (const GAS v4u*)((const bf16*)(F.ws + WS_POOLW) + (size_t)g * 128 * 128);
#pragma unroll
          for (int i = 0; i < 4; ++i) wreg[i] = wsrc[tid + 512 * i]; }
        PL_LOAD8(ra, rd, g, r_lo, r_hi); PL_CONSUME8(ra, rd, r_lo, r_hi);
        if (g == 3) { PL_LOAD8(ra, rd, 3, r_lo + 8, r_hi); PL_CONSUME8(ra, rd, r_lo + 8, r_hi); }
        { LAS f32x4* vp = (LAS f32x4*)(L + PL_V + (c * PL_VSTR + 16 * ch16) * 4);
#pragma unroll
          for (int i = 0; i < 4; ++i) vp[i] = (f32x4){vs[4 * i], vs[4 * i + 1], vs[4 * i + 2], vs[4 * i + 3]}; }
        LBAR();
#pragma unroll
        for (int i = 0; i < 4; ++i) { const int ci = tid + 512 * i; *(LAS v4u*)(L + PL_W + (ci >> 4) * PL_DSTR + (ci & 15) * 16) = wreg[i]; }
        float hs[16];
#pragma unroll
        for (int i = 0; i < 16; ++i) hs[i] = 0.f;
        for (int cc = c_lo; cc <= c_hi; ++cc) { const LAS f32x4* vp = (const LAS f32x4*)(L + PL_V + (cc * PL_VSTR + 16 * ch16) * 4);
#pragma unroll
            for (int i = 0; i < 4; ++i) { const f32x4 x = vp[i]; hs[4 * i] += x.x; hs[4 * i + 1] += x.y; hs[4 * i + 2] += x.z; hs[4 * i + 3] += x.w; } }
        { const float inv = 1.f / (float)((r_hi - r_lo + 1) * (c_hi - c_lo + 1));
          v4u o0, o1;
          o0.x = pk2(hs[0] * inv - pc[0], hs[1] * inv - pc[1]); o0.y = pk2(hs[2] * inv - pc[2], hs[3] * inv - pc[3]); o0.z = pk2(hs[4] * inv - pc[4], hs[5] * inv - pc[5]); o0.w = pk2(hs[6] * inv - pc[6], hs[7] * inv - pc[7]);
          o1.x = pk2(hs[8] * inv - pc[8], hs[9] * inv - pc[9]); o1.y = pk2(hs[10] * inv - pc[10], hs[11] * inv - pc[11]); o1.z = pk2(hs[12] * inv - pc[12], hs[13] * inv - pc[13]); o1.w = pk2(hs[14] * inv - pc[14], hs[15] * inv - pc[15]);
          LAS v4u* dp = (LAS v4u*)(L + PL_D + c * PL_DSTR + 32 * ch16); dp[0] = o0; dp[1] = o1; }
        LBAR();
        { const int tt = w >> 1;
          bf16x8 Bd[4];
#pragma unroll
          for (int s = 0; s < 4; ++s) Bd[s] = *(const LAS bf16x8*)(L + PL_D + (16 * tt + (lane & 15)) * PL_DSTR + (32 * s + 8 * q) * 2);
#pragma unroll
          for (int ni = 0; ni < 4; ++ni) { const int nt = 4 * (w & 1) + ni; f32x4 a = (f32x4){0.f, 0.f, 0.f, 0.f};
#pragma unroll
              for (int s = 0; s < 4; ++s) { const bf16x8 A = *(const LAS bf16x8*)(L + PL_W + (16 * nt + (lane & 15)) * PL_DSTR + (32 * s + 8 * q) * 2); a = MFMA16(A, Bd[s], a); }
              const f32x4 sc = *(const GAS f32x4*)(F.pool_scale + g * 128 + 16 * nt + 4 * q);
              v2u o; o.x = pk2(a[0] * sc.x, a[1] * sc.y); o.y = pk2(a[2] * sc.z, a[3] * sc.w);
              *(GAS v2u*)(YP + (size_t)(b * SEQ + r * 64 + 16 * tt + (lane & 15)) * 512 + g * 128 + 16 * nt + 4 * q) = o; } }
    }
    __syncthreads();
}

constexpr int FX_SF = 0, FX_SB = 32768, FX_SCR = 65536, FX_SCRSTR = 132;
__device__ __forceinline__ void prefix_unit(Frame& F, int u) {
    const int chain = u >> 3, rb = u & 7, tid = F.tid, k = 16 * rb + (tid >> 5), v = 4 * (tid & 31);
    const float* US = (const float*)(F.ws + WS_USEG); const float* AS = (const float*)(F.ws + WS_ASEG);
    unsigned char* P = F.ws + WS_PFX + (size_t)chain * 8 * 32768;
    constexpr int NU = NCSEG + 7;
    f32x4 uu[NU]; float aa[NU];
#pragma unroll
    for (int i = 0; i < NU; ++i) { const int un = (i < NCSEG) ? NSCAN_L + chain * NCSEG + i : chain * 8 + (i - NCSEG);
        uu[i] = *(const GAS f32x4*)(US + ((size_t)un * 128 + k) * 128 + v); aa[i] = AS[un * 128 + k]; }
    f32x4 s = uu[0];
#pragma unroll
    for (int i = 1; i < NCSEG; ++i) s = s * aa[i] + uu[i];
    const unsigned ob = (unsigned)(k >> 5) * 8192u + off_b((unsigned)(k & 31), (unsigned)(v >> 3)) + (unsigned)(v & 7) * 2u;
#pragma unroll
    for (int j = 0; j < 8; ++j) {
        v2u o; o.x = pk2(s.x, s.y); o.y = pk2(s.z, s.w);
        *(GAS v2u*)(P + (size_t)j * 32768 + ob) = o;
        if (j < 7) s = s * aa[NCSEG + j] + uu[NCSEG + j];
    }
}
__device__ __forceinline__ void fix_load_state(Frame& F, int chain, int seg, int soff) {
    const GAS v4u* src = (const GAS v4u*)(F.ws + WS_PFX + ((size_t)chain * 8 + seg) * 32768) + F.tid;
#pragma unroll
    for (int i = 0; i < 4; ++i) *(LAS v4u*)(F.lds + soff + (F.tid + 512 * i) * 16) = src[512 * i];
}
__device__ __forceinline__ void fix_unit(Frame& F, int u) {
    const int tb = u & 7, h = (u >> 3) & 3, b = u >> 5, lane = F.lane, w = F.wave, q = lane >> 4;
    LAS unsigned char* L = F.lds;
    fix_load_state(F, (b * 4 + h) * 2 + 0, tb, FX_SF);
    fix_load_state(F, (b * 4 + h) * 2 + 1, 7 - tb, FX_SB);
    __syncthreads();
    const bf16* Z = (const bf16*)(F.ws + WS_Z); bf16* YH = (bf16*)(F.ws + WS_YHG);
    const bf16* qseg = (const bf16*)((const unsigned char*)F.out + OUT_QSEG); const bf16* oloc = (const bf16*)((const unsigned char*)F.out + OUT_OLOC);
    LAS float* scr = (LAS float*)(L + FX_SCR + w * (16 * FX_SCRSTR * 4));
    const int row0 = b * SEQ + tb * SEGT;
#pragma unroll 1
    for (int ti = 0; ti < 4; ++ti) {
        const int tt = 4 * w + ti, rowt = row0 + 16 * tt;
        f32x4 acc[8];
#pragma unroll
        for (int c = 0; c < 8; ++c) acc[c] = (f32x4){0.f, 0.f, 0.f, 0.f};
        bf16x8 A[2][4]; v2u ol[2][8]; v4u ogv[4];
        const int tl = lane >> 2, v0 = 32 * (lane & 3);
#pragma unroll
        for (int dir = 0; dir < 2; ++dir)
#pragma unroll
            for (int s = 0; s < 4; ++s) A[dir][s] = *(const GAS bf16x8*)(qseg + ((size_t)dir * ML + rowt + (lane & 15)) * 512 + h * 128 + 32 * s + 8 * q);
#pragma unroll
        for (int dir = 0; dir < 2; ++dir)
#pragma unroll
            for (int c = 0; c < 8; ++c) ol[dir][c] = *(const GAS v2u*)(oloc + ((((size_t)(dir * 1024 + (rowt >> 4)) * 4 + h) * 8 + c) * 64 + lane) * 4);
#pragma unroll
        for (int i = 0; i < 4; ++i) ogv[i] = *(const GAS v4u*)(Z + (size_t)(rowt + tl) * INW + 2560 + h * 128 + v0 + 8 * i);
#pragma unroll
        for (int dir = 0; dir < 2; ++dir) {
#pragma unroll
            for (int s = 0; s < 4; ++s)
#pragma unroll
                for (int c = 0; c < 8; ++c) { const bf16x8 B = tr_frag(L + (dir ? FX_SB : FX_SF) + s * 8192, lane, c); acc[c] = MFMA16(A[dir][s], B, acc[c]); }
        }
#pragma unroll
        for (int dir = 0; dir < 2; ++dir)
#pragma unroll
            for (int c = 0; c < 8; ++c) { const v2u ov = ol[dir][c];
                acc[c][0] += bflo(ov.x); acc[c][1] += bfhi(ov.x); acc[c][2] += bflo(ov.y); acc[c][3] += bfhi(ov.y); }
        float ss[4];
#pragma unroll
        for (int j = 0; j < 4; ++j) { float s = 0.f;
#pragma unroll
            for (int c = 0; c < 8; ++c) s += acc[c][j] * acc[c][j];
            s += __shfl_xor(s, 1); s += __shfl_xor(s, 2); s += __shfl_xor(s, 4); s += __shfl_xor(s, 8);
            ss[j] = 1.f / sqrtf(s * (1.f / 128.f) + EPS); }
#pragma unroll
        for (int c = 0; c < 8; ++c)
#pragma unroll
            for (int j = 0; j < 4; ++j) scr[(4 * q + j) * FX_SCRSTR + 16 * c + (lane & 15)] = acc[c][j] * ss[j];
        LDS_WAIT();
        { const size_t row = (size_t)(rowt + tl);
          bf16* yo = YH + row * 512 + h * 128 + v0;
#pragma unroll
          for (int i = 0; i < 4; ++i) {
              const f32x4 a = *(const LAS f32x4*)(scr + tl * FX_SCRSTR + v0 + 8 * i), c2 = *(const LAS f32x4*)(scr + tl * FX_SCRSTR + v0 + 8 * i + 4);
              const v4u g = ogv[i];
              const f32x4 n0 = *(const GAS f32x4*)(F.hg_norm_g + v0 + 8 * i), n1 = *(const GAS f32x4*)(F.hg_norm_g + v0 + 8 * i + 4);
              const float gg[8] = {bflo(g.x), bfhi(g.x), bflo(g.y), bfhi(g.y), bflo(g.z), bfhi(g.z), bflo(g.w), bfhi(g.w)};
              const float yv[8] = {a.x * n0.x, a.y * n0.y, a.z * n0.z, a.w * n0.w, c2.x * n1.x, c2.y * n1.y, c2.z * n1.z, c2.w * n1.w};
              float o[8];
#pragma unroll
              for (int e = 0; e < 8; ++e) o[e] = yv[e] * gg[e] * sigmoidf_(gg[e]);
              v4u ov; ov.x = pk2(o[0], o[1]); ov.y = pk2(o[2], o[3]); ov.z = pk2(o[4], o[5]); ov.w = pk2(o[6], o[7]);
              *(GAS v4u*)(yo + 8 * i) = ov; } }
        LDS_WAIT();
    }
    __syncthreads();
}

__device__ __forceinline__ void fp8_rows(const float* src, unsigned char* dst, float* inv_scale, int gw, int NGW, int lane, int rend = NEXP) {
    for (int r = gw; r < rend; r += NGW) {
        const GAS f32x4* p = (const GAS f32x4*)(src + (size_t)r * D + 16 * lane);
        const f32x4 a = p[0], b = p[1], c = p[2], d = p[3];
        float m = fmaxf(fmaxf(fmaxf(fabsf(a.x), fabsf(a.y)), fmaxf(fabsf(a.z), fabsf(a.w))), fmaxf(fmaxf(fabsf(b.x), fabsf(b.y)), fmaxf(fabsf(b.z), fabsf(b.w))));
        m = fmaxf(m, fmaxf(fmaxf(fmaxf(fabsf(c.x), fabsf(c.y)), fmaxf(fabsf(c.z), fabsf(c.w))), fmaxf(fmaxf(fabsf(d.x), fabsf(d.y)), fmaxf(fabsf(d.z), fabsf(d.w)))));
        m = wave_max(m);
        const float sc = (m > 0.f) ? 224.f / m : 1.f;
        v4u o; int w;
        w = __builtin_amdgcn_cvt_pk_fp8_f32(a.x * sc, a.y * sc, 0, false); w = __builtin_amdgcn_cvt_pk_fp8_f32(a.z * sc, a.w * sc, w, true); o.x = (unsigned)w;
        w = __builtin_amdgcn_cvt_pk_fp8_f32(b.x * sc, b.y * sc, 0, false); w = __builtin_amdgcn_cvt_pk_fp8_f32(b.z * sc, b.w * sc, w, true); o.y = (unsigned)w;
        w = __builtin_amdgcn_cvt_pk_fp8_f32(c.x * sc, c.y * sc, 0, false); w = __builtin_amdgcn_cvt_pk_fp8_f32(c.z * sc, c.w * sc, w, true); o.z = (unsigned)w;
        w = __builtin_amdgcn_cvt_pk_fp8_f32(d.x * sc, d.y * sc, 0, false); w = __builtin_amdgcn_cvt_pk_fp8_f32(d.z * sc, d.w * sc, w, true); o.w = (unsigned)w;
        *(GAS v4u*)(dst + (size_t)(lane >> 3) * ((size_t)NEXP * 128) + (size_t)r * 128 + 16 * (lane & 7)) = o;
        if (lane == 0) inv_scale[r] = (m > 0.f) ? m * (1.f / 224.f) : 1.f;
    }
}

__device__ __forceinline__ unsigned pack_i8x4(float a, float b, float c, float d) {
    const int ia = (int)rintf(a), ib = (int)rintf(b), ic = (int)rintf(c), id = (int)rintf(d);
    return ((unsigned)ia & 255u) | (((unsigned)ib & 255u) << 8) | (((unsigned)ic & 255u) << 16) | (((unsigned)id & 255u) << 24);
}
__device__ __forceinline__ void i8_rows(const float* src, unsigned char* dst, float* inv_scale, int gw, int NGW, int lane, unsigned bias, int rend = NEXP) {
    for (int r = gw; r < rend; r += NGW) {
        const GAS f32x4* p = (const GAS f32x4*)(src + (size_t)r * D + 16 * lane);
        const f32x4 a = p[0], b = p[1], c = p[2], d = p[3];
        float m = fmaxf(fmaxf(fmaxf(fabsf(a.x), fabsf(a.y)), fmaxf(fabsf(a.z), fabsf(a.w))), fmaxf(fmaxf(fabsf(b.x), fabsf(b.y)), fmaxf(fabsf(b.z), fabsf(b.w))));
        m = fmaxf(m, fmaxf(fmaxf(fmaxf(fabsf(c.x), fabsf(c.y)), fmaxf(fabsf(c.z), fabsf(c.w))), fmaxf(fmaxf(fabsf(d.x), fabsf(d.y)), fmaxf(fabsf(d.z), fabsf(d.w)))));
        m = wave_max(m);
        const float sc = (m > 0.f) ? 127.f / m : 1.f;
        v4u o; o.x = pack_i8x4(a.x * sc, a.y * sc, a.z * sc, a.w * sc); o.y = pack_i8x4(b.x * sc, b.y * sc, b.z * sc, b.w * sc);
        o.z = pack_i8x4(c.x * sc, c.y * sc, c.z * sc, c.w * sc); o.w = pack_i8x4(d.x * sc, d.y * sc, d.z * sc, d.w * sc);
        o.x ^= bias; o.y ^= bias; o.z ^= bias; o.w ^= bias;
        *(GAS v4u*)(dst + (size_t)(lane >> 3) * ((size_t)NEXP * 128) + (size_t)r * 128 + 16 * (lane & 7)) = o;
        if (lane == 0) inv_scale[r] = (m > 0.f) ? m * (1.f / 127.f) : 1.f;
    }
}
__device__ __forceinline__ void modulate_row_q(const float* xrow, bf16* orow, unsigned char* qrow, float* qscale, const float* g, const float* shift, const float* scale, int lane) {
    const GAS f32x4* xr = (const GAS f32x4*)xrow + lane;
    f32x4 v[4]; float s2 = 0.f;
#pragma unroll
    for (int j = 0; j < 4; ++j) { v[j] = xr[64 * j]; s2 += (v[j].x * v[j].x + v[j].y * v[j].y) + (v[j].z * v[j].z + v[j].w * v[j].w); }
    const float rstd = 1.f / sqrtf(wave_sum(s2) * (1.f / D) + EPS);
    GAS v2u* o8 = (GAS v2u*)orow + lane; float m = 0.f;
#pragma unroll
    for (int j = 0; j < 4; ++j) {
        const f32x4 gg = ((const GAS f32x4*)g)[lane + 64 * j], sh = ((const GAS f32x4*)shift)[lane + 64 * j], sc = ((const GAS f32x4*)scale)[lane + 64 * j];
        v[j] = (v[j] * rstd) * gg * (sc + 1.0f) + sh;
        v2u o; o.x = pk2(v[j].x, v[j].y); o.y = pk2(v[j].z, v[j].w); o8[64 * j] = o;
        m = fmaxf(m, fmaxf(fmaxf(fabsf(v[j].x), fabsf(v[j].y)), fmaxf(fabsf(v[j].z), fabsf(v[j].w)))); }
    m = wave_max(m);
    const float qs = (m > 0.f) ? 127.f / m : 1.f;
#pragma unroll
    for (int j = 0; j < 4; ++j) ((GAS unsigned*)qrow)[lane + 64 * j] = pack_i8x4(v[j].x * qs, v[j].y * qs, v[j].z * qs, v[j].w * qs);
    if (lane == 0) *qscale = (m > 0.f) ? m * (1.f / 127.f) : 1.f;
}

#define SORT16_DESC(v) do { _Pragma("unroll") for (int k_ = 2; k_ <= 16; k_ <<= 1) _Pragma("unroll") for (int j_ = k_ >> 1; j_ > 0; j_ >>= 1) _Pragma("unroll") for (int i_ = 0; i_ < 16; ++i_) { const int l_ = i_ ^ j_; \
    if (l_ > i_) { const bool up_ = ((i_ & k_) == 0); const float hi_ = fmaxf(v[i_], v[l_]), lo_ = fminf(v[i_], v[l_]); v[i_] = up_ ? hi_ : lo_; v[l_] = up_ ? lo_ : hi_; } } } while (0)
#define MERGE16_TOP(a, b) do { _Pragma("unroll") for (int i_ = 0; i_ < 16; ++i_) a[i_] = fmaxf(a[i_], b[15 - i_]); \
    _Pragma("unroll") for (int j_ = 8; j_ > 0; j_ >>= 1) _Pragma("unroll") for (int i_ = 0; i_ < 16; ++i_) { const int l_ = i_ ^ j_; \
    if (l_ > i_) { const float hi_ = fmaxf(a[i_], a[l_]), lo_ = fminf(a[i_], a[l_]); a[i_] = hi_; a[l_] = lo_; } } } while (0)
constexpr int TK_S = 0, TK_SSTR = 136, TK_L = 139264;
__device__ __forceinline__ void topk_unit(Frame& F, int u) {
    const int tid = F.tid, lane = F.lane, w = F.wave, q = lane >> 4, tok0 = 64 * u;
    const bf16* Qb = (const bf16*)(F.ws + WS_QB); const bf16* KB = (const bf16*)(F.ws + WS_KEYS);
    unsigned short* eidx = (unsigned short*)(F.ws + WS_EIDX); float* gate = (float*)(F.ws + WS_GATE);
    LAS unsigned char* L = F.lds;
    bf16x8 AqN[2][4];
#pragma unroll
    for (int t2 = 0; t2 < 2; ++t2)
#pragma unroll
        for (int s = 0; s < 4; ++s) AqN[t2][s] = *(const GAS bf16x8*)(Qb + (size_t)(tok0 + 16 * (2 * (w & 1) + t2) + (lane & 15)) * 2048 + (w >> 1) * 128 + 32 * s + 8 * q);
#pragma unroll 1
    for (int r = 0; r < 4; ++r) {
        { const int hpl = w >> 1, hp = 4 * r + hpl;
          bf16x8 Aq[2][4];
#pragma unroll
          for (int t2 = 0; t2 < 2; ++t2)
#pragma unroll
              for (int s = 0; s < 4; ++s) Aq[t2][s] = AqN[t2][s];
          if (r < 3) {
#pragma unroll
              for (int t2 = 0; t2 < 2; ++t2)
#pragma unroll
                  for (int s = 0; s < 4; ++s) AqN[t2][s] = *(const GAS bf16x8*)(Qb + (size_t)(tok0 + 16 * (2 * (w & 1) + t2) + (lane & 15)) * 2048 + (hp + 4) * 128 + 32 * s + 8 * q); }
          bf16x8 Bk[8][4];
#pragma unroll
          for (int kt = 0; kt < 8; ++kt)
#pragma unroll
              for (int s = 0; s < 4; ++s) Bk[kt][s] = *(const GAS bf16x8*)(KB + (size_t)(hp * 128 + 16 * kt + (lane & 15)) * 128 + 32 * s + 8 * q);
#pragma unroll
          for (int kt = 0; kt < 8; ++kt) {
#pragma unroll
              for (int t2 = 0; t2 < 2; ++t2) { f32x4 a = (f32x4){0.f, 0.f, 0.f, 0.f};
#pragma unroll
                  for (int s = 0; s < 4; ++s) a = MFMA16(Aq[t2][s], Bk[kt][s], a);
                  LAS float* sp = (LAS float*)(L + TK_S) + (hpl * 64 + 16 * (2 * (w & 1) + t2) + 4 * q) * TK_SSTR + 16 * kt + (lane & 15);
                  sp[0] = a[0]; sp[TK_SSTR] = a[1]; sp[2 * TK_SSTR] = a[2]; sp[3 * TK_SSTR] = a[3]; } } }
        LBAR();
        {
            const int row = tid >> 1, hf = tid & 1;
            float a[16];
            const LAS f32x4* sp = (const LAS f32x4*)((LAS float*)(L + TK_S) + row * TK_SSTR) + hf;
#pragma unroll
            for (int blk = 0; blk < 4; ++blk) {
                float v[16];
#pragma unroll
                for (int c4 = 0; c4 < 4; ++c4) { const int i = 4 * blk + c4; const f32x4 x4 = sp[2 * i]; const float ve[4] = {x4.x, x4.y, x4.z, x4.w};
#pragma unroll
                    for (int e = 0; e < 4; ++e) v[4 * c4 + e] = __builtin_bit_cast(float, (__builtin_bit_cast(unsigned, ve[e]) & ~127u) | (unsigned)(8 * i + 4 * hf + e)); }
                SORT16_DESC(v);
                if (blk == 0) {
#pragma unroll
                    for (int j = 0; j < 16; ++j) a[j] = v[j];
                } else { MERGE16_TOP(a, v); }
            }
            { float pb[16];
#pragma unroll
              for (int j = 0; j < 16; ++j) pb[j] = __shfl_xor(a[j], 1);
              MERGE16_TOP(a, pb); }
            if (hf == 0) { LAS v4u* tp = (LAS v4u*)(L + TK_L + row * 64);
#pragma unroll
                for (int i = 0; i < 4; ++i) tp[i] = (v4u){__builtin_bit_cast(unsigned, a[4 * i]), __builtin_bit_cast(unsigned, a[4 * i + 1]), __builtin_bit_cast(unsigned, a[4 * i + 2]), __builtin_bit_cast(unsigned, a[4 * i + 3])}; }
        }
        LBAR();
        if (tid < 128) {
            const int hl = tid >> 6, t = tid & 63, r0 = (2 * hl) * 64 + t, r1 = r0 + 64;
            const LAS unsigned* t0 = (const LAS unsigned*)(L + TK_L + r0 * 64); const LAS unsigned* t1 = (const LAS unsigned*)(L + TK_L + r1 * 64);
            float v1[16], v2[16];
#pragma unroll
            for (int i = 0; i < 4; ++i) { const v4u x = ((const LAS v4u*)t0)[i], y = ((const LAS v4u*)t1)[i];
                v1[4 * i] = __builtin_bit_cast(float, x.x & ~127u); v1[4 * i + 1] = __builtin_bit_cast(float, x.y & ~127u); v1[4 * i + 2] = __builtin_bit_cast(float, x.z & ~127u); v1[4 * i + 3] = __builtin_bit_cast(float, x.w & ~127u);
                v2[4 * i] = __builtin_bit_cast(float, y.x & ~127u); v2[4 * i + 1] = __builtin_bit_cast(float, y.y & ~127u); v2[4 * i + 2] = __builtin_bit_cast(float, y.z & ~127u); v2[4 * i + 3] = __builtin_bit_cast(float, y.w & ~127u); }
            float c[16];
#pragma unroll
            for (int blk = 0; blk < 4; ++blk) {
                float v[16];
#pragma unroll
                for (int j = 0; j < 16; ++j) v[j] = -3.0e38f;
                { int n = 0, slot = 0;
#pragma unroll
                  for (int ia = 0; ia < 16; ++ia)
#pragma unroll
                      for (int ib = 0; ib < 16; ++ib) if ((ia + 1) * (ib + 1) <= 16) { if ((n >> 4) == blk) { v[slot] = __builtin_bit_cast(float, (__builtin_bit_cast(unsigned, v1[ia] + v2[ib]) & ~255u) | (unsigned)(ia * 16 + ib)); ++slot; } ++n; } }
                SORT16_DESC(v);
                if (blk == 0) {
#pragma unroll
                    for (int j = 0; j < 16; ++j) c[j] = v[j];
                } else { MERGE16_TOP(c, v); }
            }
            float ex[16], sum = 0.f; const float mx = __builtin_bit_cast(float, __builtin_bit_cast(unsigned, c[0]) & ~255u);
#pragma unroll
            for (int k = 0; k < 16; ++k) { ex[k] = fast_exp(__builtin_bit_cast(float, __builtin_bit_cast(unsigned, c[k]) & ~255u) - mx); sum += ex[k]; }
            const float inv = 1.f / sum; const int h = 2 * r + hl; const size_t ob = (size_t)(tok0 + t) * 128 + h * 16;
            unsigned ee[16];
#pragma unroll
            for (int k = 0; k < 16; ++k) { const unsigned code = __builtin_bit_cast(unsigned, c[k]) & 255u;
                const unsigned i1 = t0[code >> 4] & 127u, i2 = t1[code & 15u] & 127u; ee[k] = i1 * 128u + i2; }
            { GAS v4u* ep = (GAS v4u*)(eidx + ob); ep[0] = (v4u){ee[0] | (ee[1] << 16), ee[2] | (ee[3] << 16), ee[4] | (ee[5] << 16), ee[6] | (ee[7] << 16)};
              ep[1] = (v4u){ee[8] | (ee[9] << 16), ee[10] | (ee[11] << 16), ee[12] | (ee[13] << 16), ee[14] | (ee[15] << 16)};
              GAS f32x4* gp = (GAS f32x4*)(gate + ob);
#pragma unroll
              for (int k4 = 0; k4 < 4; ++k4) gp[k4] = (f32x4){ex[4 * k4] * inv, ex[4 * k4 + 1] * inv, ex[4 * k4 + 2] * inv, ex[4 * k4 + 3] * inv}; }
        }
    }
    __syncthreads();
}


#define TRED3(d, lane, m0, m1, m2) do { \
    _Pragma("unroll") for (int _i = 0; _i < 8; ++_i) { const bool _h = ((lane) & (m0)) != 0; const float _k = _h ? d[_i + 8] : d[_i], _s = _h ? d[_i] : d[_i + 8]; d[_i] = _k + __shfl_xor(_s, (m0)); } \
    _Pragma("unroll") for (int _i = 0; _i < 4; ++_i) { const bool _h = ((lane) & (m1)) != 0; const float _k = _h ? d[_i + 4] : d[_i], _s = _h ? d[_i] : d[_i + 4]; d[_i] = _k + __shfl_xor(_s, (m1)); } \
    _Pragma("unroll") for (int _i = 0; _i < 2; ++_i) { const bool _h = ((lane) & (m2)) != 0; const float _k = _h ? d[_i + 2] : d[_i], _s = _h ? d[_i] : d[_i + 2]; d[_i] = _k + __shfl_xor(_s, (m2)); } } while (0)
typedef int i32x4 __attribute__((ext_vector_type(4)));
__device__ __forceinline__ void cvt16v(const v4u r, float (&o)[16]) {
    const unsigned rr[4] = {r.x, r.y, r.z, r.w};
#pragma unroll
    for (int d = 0; d < 4; ++d) { const f32x2 lo = __builtin_amdgcn_cvt_pk_f32_fp8((int)rr[d], false), hi = __builtin_amdgcn_cvt_pk_f32_fp8((int)rr[d], true);
        o[4 * d] = lo.x; o[4 * d + 1] = lo.y; o[4 * d + 2] = hi.x; o[4 * d + 3] = hi.y; }
}
#define PX_LOAD_E(ev, tok) do { const GAS v4u* ep_ = (const GAS v4u*)(eidx + (size_t)(tok) * 128 + 16 * pg); ev[0] = ep_[0]; ev[1] = ep_[1]; } while (0)
#define PX_LOAD_ROWS8(rows, ea, base) do { const unsigned e_[8] = {ea.x & 0xffffu, ea.x >> 16, ea.y & 0xffffu, ea.y >> 16, ea.z & 0xffffu, ea.z >> 16, ea.w & 0xffffu, ea.w >> 16}; \
    _Pragma("unroll") for (int i_ = 0; i_ < 8; ++i_) rows[i_] = *(const GAS v4u*)((base) + (e_[i_] * 128u + cgo)); } while (0)
#define PU_LOAD_H(h0, tok) do { h0 = *(const GAS v4u*)(H8 + (size_t)(tok) * D + 128 * slice + cgo); } while (0)
#define PU_DOT8(rows, dd, off) do { \
    _Pragma("unroll") for (int i_ = 0; i_ < 8; ++i_) { int s_ = __builtin_amdgcn_sdot4((int)rows[i_].x, (int)h0.x, 0, false); s_ = __builtin_amdgcn_sdot4((int)rows[i_].y, (int)h0.y, s_, false); \
        s_ = __builtin_amdgcn_sdot4((int)rows[i_].z, (int)h0.z, s_, false); s_ = __builtin_amdgcn_sdot4((int)rows[i_].w, (int)h0.w, s_, false); dd[(off) + i_] = s_; } } while (0)
#define TRED3I(d, lane, m0, m1, m2) do { \
    _Pragma("unroll") for (int _i = 0; _i < 8; ++_i) { const bool _h = ((lane) & (m0)) != 0; const int _k = _h ? d[_i + 8] : d[_i], _s = _h ? d[_i] : d[_i + 8]; d[_i] = _k + __shfl_xor(_s, (m0)); } \
    _Pragma("unroll") for (int _i = 0; _i < 4; ++_i) { const bool _h = ((lane) & (m1)) != 0; const int _k = _h ? d[_i + 4] : d[_i], _s = _h ? d[_i] : d[_i + 4]; d[_i] = _k + __shfl_xor(_s, (m1)); } \
    _Pragma("unroll") for (int _i = 0; _i < 2; ++_i) { const bool _h = ((lane) & (m2)) != 0; const int _k = _h ? d[_i + 2] : d[_i], _s = _h ? d[_i] : d[_i + 2]; d[_i] = _k + __shfl_xor(_s, (m2)); } } while (0)
typedef int i32x2 __attribute__((ext_vector_type(2)));
__device__ __forceinline__ void peer_u_slice(unsigned char* ws_, int slice, int rank, int nrank) {
    const int lane = threadIdx.x & 63, wave = __builtin_amdgcn_readfirstlane(threadIdx.x >> 6);
    const int pg = lane >> 3, cg = lane & 7, wi = rank * NWAVES + wave, nw = nrank * NWAVES;
    const unsigned char* H8 = ws_ + WS_H8; const unsigned char* Us = ws_ + WS_U8 + (size_t)slice * ((size_t)NEXP * 128); const unsigned cgo = 16u * cg;
    const unsigned short* eidx = (const unsigned short*)(ws_ + WS_EIDX); int* part = (int*)(ws_ + WS_PART) + (size_t)slice * ML * 128;
    v4u eC[2], eN[2]; v4u r0[8], r1[8]; v4u h0, g0;
    PX_LOAD_E(eC, wi); PU_LOAD_H(h0, wi); PX_LOAD_ROWS8(r0, eC[0], Us);
#pragma unroll 1
    for (int t = wi; t < ML; t += nw) {
        const int tn = (t + nw < ML) ? t + nw : t;
        PX_LOAD_ROWS8(r1, eC[1], Us); PX_LOAD_E(eN, tn); PU_LOAD_H(g0, tn);
        __builtin_amdgcn_sched_barrier(0);
        int d[16];
        PU_DOT8(r0, d, 0);
        PX_LOAD_ROWS8(r0, eN[0], Us);
        __builtin_amdgcn_sched_barrier(0);
        PU_DOT8(r1, d, 8);
        TRED3I(d, lane, 4, 2, 1);
        *(GAS i32x2*)(part + (size_t)t * 128 + 2 * lane) = (i32x2){d[0], d[1]};
        eC[0] = eN[0]; eC[1] = eN[1]; h0 = g0;
    }
}
typedef _Float16 h16x2 __attribute__((ext_vector_type(2)));
__device__ __forceinline__ void peer_reduce(Frame& F) {
    const int* part = (const int*)(F.ws + WS_PART); const float* sh = (const float*)(F.ws + WS_SH); const unsigned short* eidx = (const unsigned short*)(F.ws + WS_EIDX); const float* gate = (const float*)(F.ws + WS_GATE);
    const float* su = (const float*)(F.ws + WS_SU); const float* sv = (const float*)(F.ws + WS_SV); unsigned short* wgt = (unsigned short*)(F.ws + WS_WGT);
    for (size_t i4 = (size_t)F.bid * NTHREADS + F.tid; i4 < (size_t)ML * 32; i4 += (size_t)F.G * NTHREADS) {
        const size_t i = 4 * i4;
        i32x4 s = (i32x4){0, 0, 0, 0};
#pragma unroll
        for (int x = 0; x < 8; ++x) s += *(const GAS i32x4*)(part + (size_t)x * ML * 128 + i);
        const v2u ev = *(const GAS v2u*)(eidx + i); const f32x4 gv = *(const GAS f32x4*)(gate + i); const float sht = sh[i >> 7];
        const unsigned e[4] = {ev.x & 0xffffu, ev.x >> 16, ev.y & 0xffffu, ev.y >> 16}; const int sv4[4] = {s.x, s.y, s.z, s.w}; const float g4[4] = {gv.x, gv.y, gv.z, gv.w};
        float w[4];
#pragma unroll
        for (int k = 0; k < 4; ++k) { const float z = (float)sv4[k] * su[e[k]] * sht; w[k] = g4[k] * (0.5f * z * (1.f + erff(z * 0.70710678118f))) * sv[e[k]] * 1024.f; }
        const h16x2 o0 = {(_Float16)w[0], (_Float16)w[1]}, o1 = {(_Float16)w[2], (_Float16)w[3]};
        v2u o; o.x = __builtin_bit_cast(unsigned, o0); o.y = __builtin_bit_cast(unsigned, o1); *(GAS v2u*)(wgt + i) = o;
    }
}
#define PV_LOAD_W(wv, tok) do { const GAS v4u* wp_ = (const GAS v4u*)(wgt + (size_t)(tok) * 128 + 16 * pg); wv[0] = wp_[0]; wv[1] = wp_[1]; } while (0)
#define PV_ACC8(rows, wa) do { const unsigned w_[4] = {wa.x, wa.y, wa.z, wa.w}; \
    _Pragma("unroll") for (int i_ = 0; i_ < 8; ++i_) { const h16x2 wp_ = __builtin_bit_cast(h16x2, w_[i_ >> 1]); const _Float16 wh_ = (i_ & 1) ? wp_.y : wp_.x; const h16x2 ww_ = {wh_, wh_}; \
        const unsigned rr_[4] = {rows[i_].x, rows[i_].y, rows[i_].z, rows[i_].w}; \
        _Pragma("unroll") for (int d_ = 0; d_ < 4; ++d_) { \
            acc[2 * d_]     = acc[2 * d_]     + __builtin_amdgcn_cvt_scalef32_pk_f16_fp8((int)rr_[d_], 1.0f, false) * ww_; \
            acc[2 * d_ + 1] = acc[2 * d_ + 1] + __builtin_amdgcn_cvt_scalef32_pk_f16_fp8((int)rr_[d_], 1.0f, true) * ww_; } } } while (0)
__device__ __forceinline__ void peer_v_slice(unsigned char* ws_, bf16* po_, int slice, int rank, int nrank) {
    const int lane = threadIdx.x & 63, wave = __builtin_amdgcn_readfirstlane(threadIdx.x >> 6);
    const int pg = lane >> 3, cg = lane & 7, wi = rank * NWAVES + wave, nw = nrank * NWAVES;
    const unsigned char* Vs = ws_ + WS_V8 + (size_t)slice * ((size_t)NEXP * 128); const unsigned cgo = 16u * cg;
    const unsigned short* eidx = (const unsigned short*)(ws_ + WS_EIDX); const unsigned short* wgt = (const unsigned short*)(ws_ + WS_WGT);
    const int col = 128 * slice + 16 * cg + 2 * pg;
    v4u eC[2], eN[2]; v4u r0[8], r1[8]; v4u wC[2], wN[2];
    PX_LOAD_E(eC, wi); PV_LOAD_W(wC, wi); PX_LOAD_ROWS8(r0, eC[0], Vs);
#pragma unroll 1
    for (int t = wi; t < ML; t += nw) {
        const int tn = (t + nw < ML) ? t + nw : t;
        PX_LOAD_ROWS8(r1, eC[1], Vs); PX_LOAD_E(eN, tn); PV_LOAD_W(wN, tn);
        __builtin_amdgcn_sched_barrier(0);
        h16x2 acc[8];
#pragma unroll
        for (int k = 0; k < 8; ++k) acc[k] = (h16x2){(_Float16)0.f, (_Float16)0.f};
        PV_ACC8(r0, wC[0]);
        PX_LOAD_ROWS8(r0, eN[0], Vs);
        __builtin_amdgcn_sched_barrier(0);
        PV_ACC8(r1, wC[1]);
#pragma unroll
        for (int k = 0; k < 4; ++k) { const bool hi_ = (lane & 32) != 0; const h16x2 kp = hi_ ? acc[k + 4] : acc[k], sd = hi_ ? acc[k] : acc[k + 4];
            acc[k] = kp + __builtin_bit_cast(h16x2, __shfl_xor(__builtin_bit_cast(unsigned, sd), 32)); }
#pragma unroll
        for (int k = 0; k < 2; ++k) { const bool hi_ = (lane & 16) != 0; const h16x2 kp = hi_ ? acc[k + 2] : acc[k], sd = hi_ ? acc[k] : acc[k + 2];
            acc[k] = kp + __builtin_bit_cast(h16x2, __shfl_xor(__builtin_bit_cast(unsigned, sd), 16)); }
        { const bool hi_ = (lane & 8) != 0; const h16x2 kp = hi_ ? acc[1] : acc[0], sd = hi_ ? acc[0] : acc[1];
          acc[0] = kp + __builtin_bit_cast(h16x2, __shfl_xor(__builtin_bit_cast(unsigned, sd), 8)); }
        *(GAS unsigned*)(po_ + (size_t)t * D + col) = pk2((float)acc[0].x * (1.f / 1024.f), (float)acc[0].y * (1.f / 1024.f));
        eC[0] = eN[0]; eC[1] = eN[1]; wC[0] = wN[0]; wC[1] = wN[1];
    }
}
__device__ __forceinline__ void final_norm(Frame& F) {
    const bf16* po = (const bf16*)(F.ws + WS_PO); const float* mod = (const float*)(F.ws + WS_MOD); const int lane = F.lane, gw = F.bid * NWAVES + F.wave, NGW = F.G * NWAVES;
    for (int t0 = gw; t0 < ML; t0 += 2 * NGW) {
        f32x4 xv[2][4]; float s2[2] = {0.f, 0.f};
#pragma unroll
        for (int r = 0; r < 2; ++r) { const int t = (t0 + r * NGW < ML) ? t0 + r * NGW : t0;
            const GAS f32x4* orow = (const GAS f32x4*)(F.out + (size_t)t * D) + lane; const GAS v2u* prow = (const GAS v2u*)(po + (size_t)t * D) + lane;
            const GAS f32x4* g2 = (const GAS f32x4*)(mod + (size_t)(t >> 12) * 6144 + 5 * 1024) + lane;
#pragma unroll
            for (int j = 0; j < 4; ++j) { const f32x4 x1 = orow[64 * j], gg = g2[64 * j]; const v2u pv = prow[64 * j];
                xv[r][j] = x1 + gg * (f32x4){bflo(pv.x), bfhi(pv.x), bflo(pv.y), bfhi(pv.y)};
                s2[r] += (xv[r][j].x * xv[r][j].x + xv[r][j].y * xv[r][j].y) + (xv[r][j].z * xv[r][j].z + xv[r][j].w * xv[r][j].w); } }
#pragma unroll
        for (int r = 0; r < 2; ++r) { const int t = t0 + r * NGW; if (t < ML) {
            const float rstd = 1.f / sqrtf(wave_sum(s2[r]) * (1.f / D) + EPS); GAS f32x4* orow = (GAS f32x4*)(F.out + (size_t)t * D) + lane;
#pragma unroll
            for (int j = 0; j < 4; ++j) { const f32x4 fg = ((const GAS f32x4*)F.final_g)[lane + 64 * j]; f32x4 ov = xv[r][j] * rstd * fg;
                orow[64 * j] = ov; } } }
    }
}

constexpr int N_PHASES = 15;
__global__ void __launch_bounds__(NTHREADS, 2) fwd_kernel(Args args) {
    extern __shared__ __attribute__((aligned(16))) unsigned char lds[];
    Frame F;
    F.lds = (LAS unsigned char*)lds;
    F.tid = threadIdx.x; F.lane = F.tid & 63; F.wave = __builtin_amdgcn_readfirstlane(F.tid >> 6); F.G = gridDim.x; F.bid = blockIdx.x;
    F.x = args.in[0]; F.c = args.in[1]; F.ctx = args.in[2]; F.c_ctx = args.in[3]; F.w_mod = args.in[4]; F.b_mod = args.in[5]; F.n1g = args.in[6]; F.n2g = args.in[7];
    F.w_in = args.in[8]; F.pool_w = args.in[9]; F.pool_scale = args.in[10]; F.lb_logits = args.in[11]; F.hg_norm_g = args.in[12]; F.w_a = args.in[13]; F.w_b = args.in[14];
    F.w_o = args.in[15]; F.wq = args.in[16]; F.keys = args.in[17]; F.pu = args.in[18]; F.pv = args.in[19]; F.final_g = args.in[20];
    F.out = args.out; F.ws = args.ws;
    volatile LAS unsigned* MISC = (volatile LAS unsigned*)(F.lds + MISC_OFF);
    if (F.tid < 64) MISC[F.tid] = 0u;
    __syncthreads();
    unsigned* barw = (unsigned*)(F.ws + WS_CTL) + CW_BAR;
    XcdBarrier bar; bar.bar = barw; bar.x = 0; bar.st = nullptr;
    if (ONE_LAUNCH) bar = xcd_barrier_post(barw, MISC + 8);
    const int lo = args.ph_lo, hi = args.ph_hi;
#ifndef PH_MASK
#define PH_MASK 0x7fff
#endif
#define IN(k) (((PH_MASK >> (k)) & 1) && lo <= (k) && (k) < hi)
#define SEAM(k) do { if (IN(k) && IN((k) + 1)) xcd_barrier(bar); } while (0)

    if (IN(0)) { p0_prologue(F); } SEAM(0);
    if (IN(1)) { p1_modulate(F); } SEAM(1);
    if (IN(2)) {
        SchedIn S{(const char*)(F.ws + WS_H), (const char*)(F.ws + WS_WIN), F.G, F.bid};
        EpiZ E{(bf16*)(F.ws + WS_Z), (bf16*)(F.ws + WS_ZC), (bf16*)(F.ws + WS_ZC2)};
        pg8::gemm_phase<EpiZ, SchedIn, true, true>(F.lds, D, S, E);
    } SEAM(2);
    if (IN(3)) {
        for (int u = F.bid; u < NSCAN; u += F.G) scan_unit(F, u);
        for (int u = F.bid; u < NB * 64; u += F.G) pool_unit(F, u);
    } if (IN(3) && IN(14)) xcd_barrier(bar);
    if (IN(14)) { for (int u = F.bid; u < 256; u += F.G) prefix_unit(F, u); } if (IN(14) && IN(4)) xcd_barrier(bar);
    if (IN(4)) { for (int u = F.bid; u < NB * 4 * NSEG; u += F.G) fix_unit(F, u); } SEAM(4);
    if (IN(5)) {
        SchedMerge S{(const char*)(F.ws + WS_YPOOL), (const char*)(F.ws + WS_YHG), (const char*)(F.ws + WS_WA), (const char*)(F.ws + WS_WB), F.G, F.bid};
        EpiMerge E{(const bf16*)(F.ws + WS_Z), (bf16*)(F.ws + WS_M)};
        pg8::gemm_phase<EpiMerge, SchedMerge, true, true>(F.lds, 512, S, E);
    } SEAM(5);
    if (IN(6)) {
        SchedPlain S{(const char*)(F.ws + WS_M), (const char*)(F.ws + WS_WO), 64, 4, D, F.G, F.bid};
        EpiRes E{F.x, (const float*)(F.ws + WS_MOD), F.out};
        pg8::gemm_phase<EpiRes, SchedPlain, true, true>(F.lds, D, S, E);
    } SEAM(6);
    if (IN(7)) {
        const float* mod = (const float*)(F.ws + WS_MOD); bf16* H2 = (bf16*)(F.ws + WS_H);
        const int gw = F.bid * NWAVES + F.wave, NGW = F.G * NWAVES;
        for (int m = gw; m < ML; m += NGW) { const int v = m >> 12; modulate_row_q(F.out + (size_t)m * D, H2 + (size_t)m * D, F.ws + WS_H8 + (size_t)m * D, (float*)(F.ws + WS_SH) + m, F.n2g, mod + v * 6144 + 3 * 1024, mod + v * 6144 + 4 * 1024, F.lane); }
        i8_rows(F.pu, F.ws + WS_U8, (float*)(F.ws + WS_SU), gw, NGW, F.lane, 0u);
        fp8_rows(F.pv, F.ws + WS_V8, (float*)(F.ws + WS_SV), gw, NGW, F.lane);
    } SEAM(7);
    if (IN(8)) {
        SchedPlain S{(const char*)(F.ws + WS_H), (const char*)(F.ws + WS_WQ), 64, 8, D, F.G, F.bid};
        EpiPlain E{(bf16*)(F.ws + WS_QB), 2048};
        pg8::gemm_phase<EpiPlain, SchedPlain, true, true>(F.lds, D, S, E);
    } SEAM(8);
    if (IN(9)) { for (int u = F.bid; u < ML / 64; u += F.G) topk_unit(F, u); } SEAM(9);
    int pslice = F.bid & 7, prank = F.bid >> 3; const int pnrank = F.G >> 3;
    if (ONE_LAUNCH && (IN(10) || IN(12))) {
        bool okc = (F.G == 256) && (bar.x < 8u);
#pragma unroll
        for (int j = 0; j < 8; ++j) okc = okc && (xb_ld(&barw[XB_XCNT(j)]) == 32u);
        if (okc) { pslice = (int)bar.x; prank = (int)MISC[10]; }
    }
    if (IN(10)) { peer_u_slice(F.ws, pslice, prank, pnrank); } SEAM(10);
    if (IN(11)) { peer_reduce(F); } SEAM(11);
    if (IN(12)) { peer_v_slice(F.ws, (bf16*)(F.ws + WS_PO), pslice, prank, pnrank); } SEAM(12);
    if (IN(13)) { final_norm(F); }
#undef IN
#undef SEAM
}

extern "C" void kernel_launch(void* const* d_in, const int* in_sizes, int n_in, void* d_out, int out_size, void* d_ws, size_t ws_size, hipStream_t stream) {
    static int grid = 0;
    if (grid == 0) {
        if (n_in != 21 || out_size != ML * D || ws_size < WS_END) { fprintf(stderr, "kernel_launch: unexpected problem (n_in %d, out %d, ws %zu)\n", n_in, out_size, ws_size); grid = -1; return; }
        int dev = 0, cus = 0;
        if (hipGetDevice(&dev) != hipSuccess || hipDeviceGetAttribute(&cus, hipDeviceAttributeMultiprocessorCount, dev) != hipSuccess) { grid = -1; return; }
        if (hipFuncSetAttribute((const void*)fwd_kernel, hipFuncAttributeMaxDynamicSharedMemorySize, LDS_BYTES) != hipSuccess) { fprintf(stderr, "kernel_launch: hipFuncSetAttribute failed\n"); grid = -1; return; }
        int per_cu = 0;
        if (hipOccupancyMaxActiveBlocksPerMultiprocessor(&per_cu, (const void*)fwd_kernel, NTHREADS, LDS_BYTES) != hipSuccess || per_cu < 1) fprintf(stderr, "kernel_launch: occupancy query says %d\n", per_cu);
        (void)hipGetLastError();
        grid = cus;
    }
    if (grid < 0) return;
    (void)hipMemsetAsync((char*)d_ws + WS_CTL, 0, CTL_ZERO_BYTES, stream);
    Args a{};
    for (int i = 0; i < 21; ++i) a.in[i] = (const float*)d_in[i];
    a.out = (float*)d_out; a.ws = (unsigned char*)d_ws;
#if ONE_LAUNCH
    a.ph_lo = 0; a.ph_hi = N_PHASES;
    hipLaunchKernelGGL(fwd_kernel, dim3(grid), dim3(NTHREADS), LDS_BYTES, stream, a);
#else
    static const int order[N_PHASES] = {0, 1, 2, 3, 14, 4, 5, 6, 7, 8, 9, 10, 11, 12, 13};
    for (int pi = 0; pi < N_PHASES; ++pi) { const int p = order[pi]; a.ph_lo = p; a.ph_hi = p + 1; hipLaunchKernelGGL(fwd_kernel, dim3(grid), dim3(NTHREADS), LDS_BYTES, stream, a); }
#endif
}
```

```cpp
#define ONE_LAUNCH 1
#include <hip/hip_runtime.h>
#include <cstdio>
#include <cstdint>

#ifndef ONE_LAUNCH
#define ONE_LAUNCH 1
#endif

namespace pg8 {
#define PG8_LAS __attribute__((address_space(3)))
typedef unsigned short bf16_t;
typedef short bf16x8 __attribute__((ext_vector_type(8)));
typedef float f32x4 __attribute__((ext_vector_type(4)));
typedef float f32x2 __attribute__((ext_vector_type(2)));
typedef unsigned u32x4 __attribute__((ext_vector_type(4)));
typedef unsigned u32x2 __attribute__((ext_vector_type(2)));
constexpr int BM = 256, BK = 64, HALF = 128, HTB = HALF * BK * 2, STAGE_BYTES = 8 * HTB, NXCD = 8, WGM = 8;

__host__ __device__ __forceinline__ int lds_byte(int r, int c) { const int st = (r >> 4) * 2 + (c >> 5), rr = r & 15, cc = c & 31, ob = rr * 64 + cc * 2; return st * 1024 + (ob ^ (((ob >> 9) & 1) << 5)); }
__host__ __device__ __forceinline__ void stage_rc(int b, int& R, int& C) { const int st = b / 1024, sb = b % 1024, swz = sb ^ (((sb >> 9) & 1) << 5); R = (st >> 1) * 16 + swz / 64; C = (st & 1) * 32 + (swz % 64) / 2; }
__host__ __device__ __forceinline__ int perm32(int rho) { const int n = rho >> 4, i = rho & 15; return 8 * (i >> 2) + 4 * n + (i & 3); }

struct Unit { int pm, pn, seg; };

__host__ __device__ __forceinline__ void tile_of(int wgid, int nM, int nN, int& pm, int& pn) {
    const int nwg = nM * nN;
    { const int q = nwg / NXCD, r = nwg % NXCD, xcd = wgid % NXCD, off = wgid / NXCD; wgid = (xcd < r ? xcd * (q + 1) : r * (q + 1) + (xcd - r) * q) + off; }
    const int nig = WGM * nN, gid = wgid / nig, fm = gid * WGM, gsz = (nM - fm) < WGM ? (nM - fm) : WGM;
    pm = fm + ((wgid % nig) % gsz); pn = (wgid % nig) / gsz;
}

typedef __bf16 bf16x2_t __attribute__((ext_vector_type(2)));
__device__ __forceinline__ unsigned cvt_pk_bf16(float lo, float hi) { bf16x2_t v; v.x = (__bf16)lo; v.y = (__bf16)hi; return __builtin_bit_cast(unsigned, v); }
__device__ __forceinline__ void st_wt16(void* p, u32x4 v) { asm volatile("global_store_dwordx4 %0, %1, off sc1\n\ts_nop 1" :: "v"(p), "v"(v)); }

template <class Epi, class Sched, bool ALIGN_EPI = false, bool SP2 = false>
__device__ __forceinline__ void gemm_phase(PG8_LAS unsigned char* lds, const int ld, const Sched& S, const Epi& E) {
    const int tid = threadIdx.x, wid = __builtin_amdgcn_readfirstlane(tid >> 6), lane = tid & 63, wr = wid >> 2, wc = wid & 3, fr = lane & 15, fq = lane >> 4;
    unsigned voffA[2], voffB[2];
#pragma unroll
    for (int i = 0; i < 2; ++i) { int R, C; stage_rc(tid * 16 + i * 8192, R, C); const int Rb = Epi::PERM ? ((R & ~31) + perm32(R & 31)) : R;
        voffA[i] = (unsigned)(R * ld + C) * 2u; voffB[i] = (unsigned)(Rb * ld + C) * 2u; }
    const size_t kstep = (size_t)(BK * 2);
    const size_t hstep = (size_t)HALF * ld * 2;
    const unsigned ldsw = (unsigned)wid * 1024u;
    const int aoff = lds_byte(wr * 64 + fr, fq * 8), boff = lds_byte(wc * 32 + fr, fq * 8);
#define PG8_SA(b, h) (((b) * 2 + (h)) * HTB)
#define PG8_SB(b, h) ((4 + (b) * 2 + (h)) * HTB)
#define PG8_STAGE(bufoff, gbase, voff) do { _Pragma("unroll") for (int _i = 0; _i < 2; ++_i) \
        __builtin_amdgcn_global_load_lds((const unsigned*)((const char*)(gbase) + (voff)[_i]), (PG8_LAS unsigned*)(lds + (bufoff) + ldsw + _i * 8192), 16, 0, 0); } while (0)
#define PG8_LDA(dst, b, h) do { _Pragma("unroll") for (int m = 0; m < 4; ++m) _Pragma("unroll") for (int k = 0; k < 2; ++k) dst[m][k] = *(const PG8_LAS bf16x8*)(lds + PG8_SA(b, h) + aoff + m * 2048 + k * 1024); } while (0)
#define PG8_LDB(dst, b, h) do { _Pragma("unroll") for (int n = 0; n < 2; ++n) _Pragma("unroll") for (int k = 0; k < 2; ++k) dst[n][k] = *(const PG8_LAS bf16x8*)(lds + PG8_SB(b, h) + boff + n * 2048 + k * 1024); } while (0)
#define PG8_MMA(ai, bj, At, Bt) do { __builtin_amdgcn_s_setprio(1); _Pragma("unroll") for (int m = 0; m < 4; ++m) _Pragma("unroll") for (int n = 0; n < 2; ++n) _Pragma("unroll") for (int k = 0; k < 2; ++k) \
        acc[ai][bj][m][n] = __builtin_amdgcn_mfma_f32_16x16x32_bf16(Bt[n][k], At[m][k], acc[ai][bj][m][n], 0, 0, 0); __builtin_amdgcn_s_setprio(0); } while (0)
#define PG8_WAIT_V(n) asm volatile("s_waitcnt vmcnt(" #n ")" ::: "memory")
#define PG8_WAIT_L(n) asm volatile("s_waitcnt lgkmcnt(" #n ")" ::: "memory")
#define PG8_BAR __builtin_amdgcn_s_barrier()
#define PG8_SCHED __builtin_amdgcn_sched_barrier(0)
    Unit cur, nxt; int ui = 0;
    if (!S.next(0, cur)) return;
    f32x4 acc[2][2][4][2];
#pragma unroll
    for (int a = 0; a < 2; ++a)
#pragma unroll
        for (int b = 0; b < 2; ++b)
#pragma unroll
            for (int m = 0; m < 4; ++m)
#pragma unroll
                for (int n = 0; n < 2; ++n) acc[a][b][m][n] = (f32x4){0.f, 0.f, 0.f, 0.f};
    bf16x8 At[4][2], B0[2][2], B1[2][2];
    const char* cA = S.A(cur); const char* cB = S.B(cur);
    if constexpr (SP2) {
        PG8_STAGE(PG8_SB(0, 0), cB, voffB); PG8_STAGE(PG8_SB(0, 1), cB + hstep, voffB); PG8_STAGE(PG8_SA(0, 0), cA, voffA); PG8_STAGE(PG8_SA(0, 1), cA + hstep, voffA);
        if (wr == 1) PG8_BAR;
        PG8_WAIT_V(2); PG8_BAR;
        PG8_STAGE(PG8_SB(1, 0), cB + kstep, voffB); PG8_STAGE(PG8_SA(1, 0), cA + kstep, voffA); PG8_STAGE(PG8_SB(1, 1), cB + hstep + kstep, voffB);
        PG8_WAIT_V(6); PG8_BAR;
    } else {
        PG8_STAGE(PG8_SB(0, 0), cB, voffB); PG8_STAGE(PG8_SA(0, 0), cA, voffA); PG8_STAGE(PG8_SB(0, 1), cB + hstep, voffB); PG8_STAGE(PG8_SA(0, 1), cA + hstep, voffA);
        if (wr == 1) PG8_BAR;
        PG8_WAIT_V(4); PG8_BAR;
        PG8_STAGE(PG8_SB(1, 0), cB + kstep, voffB); PG8_STAGE(PG8_SA(1, 0), cA + kstep, voffA); PG8_STAGE(PG8_SB(1, 1), cB + hstep + kstep, voffB);
        PG8_WAIT_V(6); PG8_BAR;
    }
    for (;;) {
        const bool has_next = S.next(ui + 1, nxt); const int nt = S.nt(cur);
        const char* nA = has_next ? S.A(nxt) : cA; const char* nB = has_next ? S.B(nxt) : cB;
        for (int t = 0; t < nt; t += 2) {
            const bool last = (t == nt - 2);
            const char* a1 = cA + (size_t)(t + 1) * kstep;
            const char* a2 = last ? nA : cA + (size_t)(t + 2) * kstep; const char* b2 = last ? nB : cB + (size_t)(t + 2) * kstep;
            const char* a3 = a2 + kstep; const char* b3 = b2 + kstep;
            if constexpr (SP2) {
            PG8_LDB(B0, 0, 0); PG8_LDB(B1, 0, 1); PG8_SCHED; PG8_LDA(At, 0, 0); PG8_STAGE(PG8_SA(1, 1), a1 + hstep, voffA);
            PG8_WAIT_V(8); PG8_WAIT_L(0); PG8_BAR; PG8_MMA(0, 0, At, B0); PG8_MMA(0, 1, At, B1); PG8_BAR; PG8_SCHED;
            PG8_LDA(At, 0, 1); PG8_STAGE(PG8_SB(0, 0), b2, voffB); PG8_STAGE(PG8_SB(0, 1), b2 + hstep, voffB); PG8_STAGE(PG8_SA(0, 0), a2, voffA);
            PG8_WAIT_V(8); PG8_WAIT_L(0); PG8_BAR; PG8_MMA(1, 0, At, B0); PG8_MMA(1, 1, At, B1); PG8_BAR; PG8_SCHED;
            PG8_LDB(B0, 1, 0); PG8_LDB(B1, 1, 1); PG8_SCHED; PG8_LDA(At, 1, 0); PG8_STAGE(PG8_SA(0, 1), a2 + hstep, voffA);
            PG8_WAIT_V(8); PG8_WAIT_L(0); PG8_BAR; PG8_MMA(0, 0, At, B0); PG8_MMA(0, 1, At, B1); PG8_BAR; PG8_SCHED;
            PG8_LDA(At, 1, 1); PG8_STAGE(PG8_SB(1, 0), b3, voffB); PG8_STAGE(PG8_SB(1, 1), b3 + hstep, voffB); PG8_STAGE(PG8_SA(1, 0), a3, voffA);
            PG8_WAIT_V(8); PG8_WAIT_L(0); PG8_BAR; PG8_MMA(1, 0, At, B0); PG8_MMA(1, 1, At, B1); PG8_BAR; PG8_SCHED;
            } else {
            PG8_LDB(B0, 0, 0); PG8_SCHED; PG8_LDA(At, 0, 0); PG8_STAGE(PG8_SA(1, 1), a1 + hstep, voffA);
            PG8_WAIT_L(8); PG8_BAR; PG8_WAIT_L(0); PG8_MMA(0, 0, At, B0); PG8_BAR; PG8_SCHED;
            PG8_LDB(B1, 0, 1); PG8_STAGE(PG8_SB(0, 0), b2, voffB);
            PG8_BAR; PG8_WAIT_L(0); PG8_MMA(0, 1, At, B1); PG8_BAR;
            PG8_LDA(At, 0, 1); PG8_STAGE(PG8_SA(0, 0), a2, voffA);
            PG8_BAR; PG8_WAIT_L(0); PG8_MMA(1, 0, At, B0); PG8_BAR; PG8_SCHED;
            PG8_STAGE(PG8_SB(0, 1), b2 + hstep, voffB);
            PG8_WAIT_V(6); PG8_BAR; PG8_MMA(1, 1, At, B1); PG8_BAR;
            PG8_LDB(B0, 1, 0); PG8_SCHED; PG8_LDA(At, 1, 0); PG8_STAGE(PG8_SA(0, 1), a2 + hstep, voffA);
            PG8_WAIT_L(8); PG8_BAR; PG8_WAIT_L(0); PG8_MMA(0, 0, At, B0); PG8_BAR; PG8_SCHED;
            PG8_LDB(B1, 1, 1); PG8_STAGE(PG8_SB(1, 0), b3, voffB);
            PG8_BAR; PG8_WAIT_L(0); PG8_MMA(0, 1, At, B1); PG8_BAR;
            PG8_LDA(At, 1, 1); PG8_STAGE(PG8_SA(1, 0), a3, voffA);
            PG8_BAR; PG8_WAIT_L(0); PG8_MMA(1, 0, At, B0); PG8_BAR; PG8_SCHED;
            PG8_STAGE(PG8_SB(1, 1), b3 + hstep, voffB);
            PG8_WAIT_V(6); PG8_BAR; PG8_MMA(1, 1, At, B1); PG8_BAR;
            }
        }
        if constexpr (ALIGN_EPI) { if (wr == 0) PG8_BAR; }
        if constexpr (!Epi::AFTER_DRAIN) E(acc, cur, wr, wc, fr, fq);
        if (!has_next) break;
        if (!S.keep(cur)) {
#pragma unroll
        for (int a = 0; a < 2; ++a)
#pragma unroll
            for (int b = 0; b < 2; ++b)
#pragma unroll
                for (int m = 0; m < 4; ++m)
#pragma unroll
                    for (int n = 0; n < 2; ++n) acc[a][b][m][n] = (f32x4){0.f, 0.f, 0.f, 0.f};
        }
        cur = nxt; cA = nA; cB = nB; ++ui;
        if constexpr (ALIGN_EPI) { if (wr == 1) PG8_BAR; }
    }
    PG8_WAIT_V(0);
    if constexpr (!ALIGN_EPI) { if (wr == 0) PG8_BAR; }
    PG8_BAR;
    if constexpr (Epi::AFTER_DRAIN) E.fused(acc, cur, wr, wc, fr, fq, lds);
#undef PG8_SA
#undef PG8_SB
#undef PG8_STAGE
#undef PG8_LDA
#undef PG8_LDB
#undef PG8_MMA
#undef PG8_WAIT_V
#undef PG8_WAIT_L
#undef PG8_BAR
#undef PG8_SCHED
}
}

constexpr int D = 1024, NB = 4, SEQ = 4096, CTXL = 256;
constexpr int ML = NB * SEQ;
constexpr int MC = NB * CTXL;
constexpr int MH = ML + MC;
constexpr int INW = 5120;
constexpr int ZC_W = 1536;
constexpr int NEXP = 16384, NHEAD_P = 8, TOPK = 16;
constexpr float EPS = 1e-6f;
constexpr int NWAVES = 8, NTHREADS = 512;
constexpr int SEGT = 512, NSEG = SEQ / SEGT;
constexpr int CHT = 32;
constexpr int NSCAN_L = NB * 4 * 2 * NSEG;
constexpr int NCSEG = 4;
constexpr int NSCAN = NSCAN_L + NB * 4 * 2 * NCSEG;

constexpr size_t MiB = 1u << 20;
constexpr size_t WS_CTL = 0, CTL_ZERO_BYTES = 64 * 1024;
constexpr size_t WS_MOD = 1 * MiB;
constexpr size_t WS_LBT = WS_MOD + 128 * 1024;
constexpr size_t WS_ASEG = WS_LBT + 8 * 1024;
constexpr size_t WS_SU = WS_ASEG + 200 * 1024;
constexpr size_t WS_SV = WS_SU + 64 * 1024;
constexpr size_t WS_WIN = 2 * MiB;
constexpr size_t WS_WA = 12 * MiB, WS_WB = 13 * MiB, WS_WO = 14 * MiB, WS_WQ = 16 * MiB;
constexpr size_t WS_WPA = 20 * MiB;
constexpr size_t WS_ZC = 21 * MiB;
constexpr size_t WS_Z = 24 * MiB;
constexpr size_t WS_EIDX = 88 * MiB;
constexpr size_t WS_GATE = 96 * MiB;
constexpr size_t WS_U8 = 112 * MiB, WS_V8 = 128 * MiB;
constexpr size_t WS_PART = 24 * MiB;
constexpr size_t WS_WGT = 104 * MiB;
constexpr size_t WS_SH = WS_ASEG;
constexpr size_t WS_PO = 144 * MiB;
constexpr size_t WS_SSQ = 21 * MiB;
constexpr size_t WS_H = 184 * MiB;
constexpr size_t WS_YHG = 184 * MiB, WS_YPOOL = 200 * MiB;
constexpr size_t WS_USEG = 218 * MiB;
constexpr size_t WS_PFX = 2 * MiB;
constexpr size_t WS_M = 218 * MiB;
constexpr size_t WS_ZC2 = 252 * MiB;
constexpr size_t WS_END = 255 * MiB;
static_assert(WS_Z + (size_t)ML * INW * 2 <= WS_H && WS_H + (size_t)MH * D * 2 <= WS_USEG && WS_USEG + (size_t)NSCAN * 128 * 128 * 4 <= WS_END && WS_M + (size_t)ML * D * 2 <= WS_END && WS_USEG + (size_t)NSCAN * 128 * 128 * 4 <= WS_ZC2 && WS_PFX + 8 * MiB <= WS_WA, "ws map");
static_assert(WS_V8 + (size_t)NEXP * D <= WS_H, "ws map 2");
constexpr size_t OUT_OLOC = 0, OUT_QSEG = 32 * MiB;
constexpr int CW_BAR = 1024;
constexpr int CW_MODCNT = 12288;
constexpr int CW_PANEL = 8192;

constexpr int LDS_BYTES = 163840;
constexpr int MISC_OFF = LDS_BYTES - 256;

#define GAS __attribute__((address_space(1)))
#define LAS __attribute__((address_space(3)))
typedef unsigned short bf16;
typedef unsigned v4u __attribute__((ext_vector_type(4)));
typedef unsigned v2u __attribute__((ext_vector_type(2)));
typedef float f32x4 __attribute__((ext_vector_type(4)));
typedef float f32x2 __attribute__((ext_vector_type(2)));
typedef short bf16x8 __attribute__((ext_vector_type(8)));
typedef short s16x4 __attribute__((ext_vector_type(4)));
#define LDS_WAIT() asm volatile("s_waitcnt lgkmcnt(0)" ::: "memory")
#define VM_WAIT() asm volatile("s_waitcnt vmcnt(0)" ::: "memory")
#define LBAR() do { asm volatile("s_waitcnt lgkmcnt(0)" ::: "memory"); __builtin_amdgcn_s_barrier(); asm volatile("" ::: "memory"); } while (0)
__device__ __forceinline__ unsigned f2bf(float f) { unsigned u = __builtin_bit_cast(unsigned, f); return (u + 0x7fffu + ((u >> 16) & 1u)) >> 16; }
__device__ __forceinline__ unsigned pk2(float lo, float hi) { return pg8::cvt_pk_bf16(lo, hi); }
__device__ __forceinline__ float bflo(unsigned w) { return __builtin_bit_cast(float, w << 16); }
__device__ __forceinline__ float bfhi(unsigned w) { return __builtin_bit_cast(float, w & 0xffff0000u); }
__device__ __forceinline__ float fast_exp(float x) { return __builtin_amdgcn_exp2f(x * 1.4426950408889634f); }
__device__ __forceinline__ float fast_rcp(float x) { return __builtin_amdgcn_rcpf(x); }
__device__ __forceinline__ float sigmoidf_(float x) { return fast_rcp(1.f + fast_exp(-x)); }
__device__ __forceinline__ unsigned pack_i8x4(float a, float b, float c, float d) {
    const int ia = (int)rintf(a), ib = (int)rintf(b), ic = (int)rintf(c), id = (int)rintf(d);
    return ((unsigned)ia & 255u) | (((unsigned)ib & 255u) << 8) | (((unsigned)ic & 255u) << 16) | (((unsigned)id & 255u) << 24);
}
#define WDPP_(v, ctrl) __builtin_bit_cast(float, __builtin_amdgcn_mov_dpp(__builtin_bit_cast(int, (v)), (ctrl), 0xf, 0xf, true))
typedef unsigned wr_u2 __attribute__((ext_vector_type(2)));
#define WSWAP_(v, which, OP) do { unsigned w_ = __builtin_bit_cast(unsigned, (v)); asm volatile("" : "+v"(w_)); \
    const wr_u2 r_ = __builtin_amdgcn_permlane##which##_swap(__builtin_bit_cast(unsigned, (v)), w_, false, false); const unsigned ra_ = r_.x, rb_ = r_.y; (v) = OP(__builtin_bit_cast(float, ra_), __builtin_bit_cast(float, rb_)); } while (0)
#define WADD_(a, b) ((a) + (b))
__device__ __forceinline__ float wave_sum(float v) {
    v += WDPP_(v, 0xb1); v += WDPP_(v, 0x4e); v += WDPP_(v, 0x141); v += WDPP_(v, 0x140);
    WSWAP_(v, 16, WADD_); WSWAP_(v, 32, WADD_);
    return v;
}
__device__ __forceinline__ float wave_max(float v) {
    v = fmaxf(v, WDPP_(v, 0xb1)); v = fmaxf(v, WDPP_(v, 0x4e)); v = fmaxf(v, WDPP_(v, 0x141)); v = fmaxf(v, WDPP_(v, 0x140));
    WSWAP_(v, 16, fmaxf); WSWAP_(v, 32, fmaxf);
    return v;
}

#define XB_TMO      128
#define XB_XCNT(j)  (256  + 64 * (j))
#define XB_XSUB(j)  (1280 + 64 * (j))
#define XB_XGEN(j)  (2304 + 64 * (j))
#define XB_TOP      3328
#define XB_TOPGEN   3392
#define XCD_BAR_WORDS 3456
#define XB_SPIN_CAP (1u << 18)
__device__ __forceinline__ unsigned xb_ld(unsigned* p)              { return __hip_atomic_load(p, __ATOMIC_RELAXED, __HIP_MEMORY_SCOPE_AGENT); }
__device__ __forceinline__ unsigned xb_add(unsigned* p, unsigned v) { return __hip_atomic_fetch_add(p, v, __ATOMIC_RELAXED, __HIP_MEMORY_SCOPE_AGENT); }
__device__ __forceinline__ unsigned xb_xcc_id() { return (unsigned)__builtin_amdgcn_s_getreg((3 << 11) | 20) & 0xFu; }
#define XB_SPIN(cond, bar) do { unsigned _sp = 0; while (cond) { __builtin_amdgcn_s_sleep(1); \
    if ((++_sp & 255u) == 0u) { if (xb_ld(&(bar)[XB_TMO])) break; if (_sp > XB_SPIN_CAP) { atomicAdd(&(bar)[XB_TMO], 1u); break; } } } } while (0)
struct XcdBarrier { unsigned* bar; unsigned x; volatile LAS unsigned* st; };
__device__ __forceinline__ XcdBarrier xcd_barrier_post(unsigned* bar, volatile LAS unsigned* st) {
    XcdBarrier b; b.bar = bar; b.x = xb_xcc_id(); b.st = st;
    if (threadIdx.x == 0) st[2] = xb_add(&bar[XB_XCNT(b.x)], 1u);
    return b;
}
__device__ __forceinline__ void xcd_barrier_complete(unsigned* bar, unsigned x, unsigned& nloc, unsigned& nx) {
    const unsigned G = gridDim.x * gridDim.y * gridDim.z;
    unsigned sum, cnt, mine, sp = 0u;
    for (;;) {
        sum = 0u; cnt = 0u; mine = 0u;
#pragma unroll
        for (unsigned j = 0; j < 16; ++j) { const unsigned c = xb_ld(&bar[XB_XCNT(j)]); sum += c; cnt += (c > 0u) ? 1u : 0u; mine = (j == x) ? c : mine; }
        if (sum == G) break;
        __builtin_amdgcn_s_sleep(1);
        if ((++sp & 255u) == 0u) { if (xb_ld(&bar[XB_TMO])) break; if (sp > XB_SPIN_CAP) { atomicAdd(&bar[XB_TMO], 1u); break; } }
    }
    nloc = mine > 0u ? mine : 1u; nx = cnt > 0u ? cnt : 1u;
}
__device__ __forceinline__ void xcd_barrier(const XcdBarrier& b) {
    asm volatile("s_waitcnt vmcnt(0)" ::: "memory");
    __syncthreads();
    if (threadIdx.x == 0) {
        unsigned* bar = b.bar;
        __builtin_amdgcn_s_waitcnt(0);
        unsigned nloc = b.st[0], nx = b.st[1];
        if (nloc == 0u) { xcd_barrier_complete(bar, b.x, nloc, nx); b.st[0] = nloc; b.st[1] = nx; }
        const unsigned old = xb_add(&bar[XB_XSUB(b.x)], 1u);
        const unsigned gen = old / nloc;
        if (old + 1u == (gen + 1u) * nloc) {
            __builtin_amdgcn_fence(__ATOMIC_RELEASE, "agent");
            asm volatile("s_waitcnt vmcnt(0)" ::: "memory");
            const unsigned og = xb_add(&bar[XB_TOP], 1u);
            const unsigned tg = og / nx;
            if (og + 1u == (tg + 1u) * nx) xb_add(&bar[XB_TOPGEN], 1u);
            else XB_SPIN(xb_ld(&bar[XB_TOPGEN]) == tg, bar);
            __builtin_amdgcn_fence(__ATOMIC_ACQUIRE, "agent");
            xb_add(&bar[XB_XGEN(b.x)], 1u);
            asm volatile("s_waitcnt vmcnt(0)" ::: "memory");
        } else {
            XB_SPIN(xb_ld(&bar[XB_XGEN(b.x)]) == gen, bar);
            __builtin_amdgcn_fence(__ATOMIC_ACQUIRE, "agent");
            asm volatile("s_waitcnt vmcnt(0)" ::: "memory");
        }
    }
    __syncthreads();
}

struct Args { const float* in[21]; float* out; unsigned char* ws; int ph_lo, ph_hi; };

struct Frame {
    LAS unsigned char* lds; int tid, lane, wave, G, bid;
    const float *x, *c, *ctx, *c_ctx, *w_mod, *b_mod, *n1g, *n2g, *w_in, *pool_w, *pool_scale, *lb_logits, *hg_norm_g, *w_a, *w_b, *w_o, *wq, *keys, *pu, *pv, *final_g;
    float* out; unsigned char* ws;
};

__device__ __forceinline__ void p0_transpose_item(const float* W, int K, int N, bf16* WT, LAS float* scr, int item, int lane) {
    const int nblk = N / 32, kb = item / nblk, nb = item % nblk, k0 = 64 * kb, n0 = 32 * nb;
#pragma unroll 8
    for (int i = 0; i < 32; ++i) { const int kk = 2 * i + (lane >> 5); scr[kk * 33 + (lane & 31)] = W[(size_t)(k0 + kk) * N + n0 + (lane & 31)]; }
    LDS_WAIT(); asm volatile("" ::: "memory");
    const int c = lane & 7;
#pragma unroll
    for (int j = 0; j < 4; ++j) { const int n = (lane >> 3) + 8 * j; const LAS float* s = scr + (8 * c) * 33 + n;
        v4u o; o.x = pk2(s[0 * 33], s[1 * 33]); o.y = pk2(s[2 * 33], s[3 * 33]); o.z = pk2(s[4 * 33], s[5 * 33]); o.w = pk2(s[6 * 33], s[7 * 33]);
        *(GAS v4u*)(WT + (size_t)(n0 + n) * K + k0 + 8 * c) = o; }
    LDS_WAIT(); asm volatile("" ::: "memory");
}

__device__ __forceinline__ void p0_prologue(Frame& F) {
    float* mod = (float*)(F.ws + WS_MOD);
    if (F.bid < 192) {
        LAS float* sl = (LAS float*)(F.lds + 81920);
        LAS float* red = (LAS float*)(F.lds + 81920 + 20480);
        for (int i = F.tid; i < 5 * 1024; i += NTHREADS) { const float cv = (i < 4096) ? F.c[i] : F.c_ctx[i - 4096]; sl[i] = cv * sigmoidf_(cv); }
        __syncthreads();
        const int col = F.tid & 31, kg = F.tid >> 5, col0 = 32 * F.bid;
        float a0 = 0.f, a1 = 0.f, a2 = 0.f, a3 = 0.f, a4 = 0.f;
        const float* wp = F.w_mod + (size_t)(kg * 64) * 6144 + col0 + col;
#pragma unroll 8
        for (int r = 0; r < 64; ++r) { const float w = wp[(size_t)r * 6144]; const int k = kg * 64 + r;
            a0 += w * sl[k]; a1 += w * sl[1024 + k]; a2 += w * sl[2048 + k]; a3 += w * sl[3072 + k]; a4 += w * sl[4096 + k]; }
        red[(kg * 5 + 0) * 32 + col] = a0; red[(kg * 5 + 1) * 32 + col] = a1; red[(kg * 5 + 2) * 32 + col] = a2; red[(kg * 5 + 3) * 32 + col] = a3; red[(kg * 5 + 4) * 32 + col] = a4;
        __syncthreads();
        if (F.tid < 160) { const int v = F.tid >> 5, cc = F.tid & 31; float s = 0.f;
#pragma unroll
            for (int g = 0; g < 16; ++g) s += red[(g * 5 + v) * 32 + cc];
            __hip_atomic_store(&mod[v * 6144 + col0 + cc], s + F.b_mod[col0 + cc], __ATOMIC_RELAXED, __HIP_MEMORY_SCOPE_AGENT); }
        asm volatile("s_waitcnt vmcnt(0)" ::: "memory");
        __syncthreads();
        if (F.tid == 0) xb_add((unsigned*)(F.ws + WS_CTL) + CW_MODCNT, 1u);
    }
    LAS float* scr = (LAS float*)(F.lds + F.wave * 8448);
    const int gw = F.bid * NWAVES + F.wave, NGW = F.G * NWAVES;
    constexpr int I_IN = (D / 64) * (INW / 32), I_A = (512 / 64) * (D / 32), I_O = (D / 64) * (D / 32);
    constexpr int NITEMS = I_IN + 2 * I_A + I_O;
    for (int it = gw; it < NITEMS; it += NGW) {
        int r = it;
        if (r < I_IN) { p0_transpose_item(F.w_in, D, INW, (bf16*)(F.ws + WS_WIN), scr, r, F.lane); continue; } r -= I_IN;
        if (r < I_A) { p0_transpose_item(F.w_a, 512, D, (bf16*)(F.ws + WS_WA), scr, r, F.lane); continue; } r -= I_A;
        if (r < I_A) { p0_transpose_item(F.w_b, 512, D, (bf16*)(F.ws + WS_WB), scr, r, F.lane); continue; } r -= I_A;
        p0_transpose_item(F.w_o, D, D, (bf16*)(F.ws + WS_WO), scr, r, F.lane);
    }
    for (int it = gw; it < 16 * 64 * 2; it += NGW) {
        const int kh = it & 1, dt = (it >> 1) & 63, hp = it >> 7, lane = F.lane, q = lane >> 4;
        bf16x8 Aw[4];
#pragma unroll
        for (int sk = 0; sk < 4; ++sk) { const GAS f32x4* p = (const GAS f32x4*)(F.wq + (size_t)(16 * dt + (lane & 15)) * 2048 + hp * 128 + 32 * sk + 8 * q); const f32x4 a = p[0], b = p[1];
            v4u w; w.x = pk2(a.x, a.y); w.y = pk2(a.z, a.w); w.z = pk2(b.x, b.y); w.w = pk2(b.z, b.w); Aw[sk] = __builtin_bit_cast(bf16x8, w); }
        bf16* wc = (bf16*)(F.ws + WS_WQ);
        f32x4 kf[4][4][2];
#pragma unroll
        for (int k4 = 0; k4 < 4; ++k4)
#pragma unroll
            for (int sk = 0; sk < 4; ++sk) { const GAS f32x4* p = (const GAS f32x4*)(F.keys + (size_t)(hp * 128 + 16 * (4 * kh + k4) + (lane & 15)) * 128 + 32 * sk + 8 * q); kf[k4][sk][0] = p[0]; kf[k4][sk][1] = p[1]; }
#pragma unroll
        for (int k4 = 0; k4 < 4; ++k4) { const int kt = 4 * kh + k4;
            f32x4 acc = (f32x4){0.f, 0.f, 0.f, 0.f};
#pragma unroll
            for (int sk = 0; sk < 4; ++sk) { const f32x4 a = kf[k4][sk][0], b = kf[k4][sk][1];
                v4u w; w.x = pk2(a.x, a.y); w.y = pk2(a.z, a.w); w.z = pk2(b.x, b.y); w.w = pk2(b.z, b.w);
                acc = __builtin_amdgcn_mfma_f32_16x16x32_bf16(Aw[sk], __builtin_bit_cast(bf16x8, w), acc, 0, 0, 0); }
            v2u o; o.x = pk2(acc[0], acc[1]); o.y = pk2(acc[2], acc[3]);
            *(GAS v2u*)(wc + (size_t)(hp * 128 + 16 * kt + (lane & 15)) * D + 16 * dt + 4 * q) = o;
        }
    }
    for (int it = gw; it < 4 * 64 * 8; it += NGW) {
        const int ct = it & 7, ntile = (it >> 3) & 63, g = it >> 9, lane = F.lane, q = lane >> 4;
        f32x4 acc = (f32x4){0.f, 0.f, 0.f, 0.f};
#pragma unroll
        for (int sk = 0; sk < 4; ++sk) {
            const GAS f32x4* p = (const GAS f32x4*)(F.pool_w + ((size_t)g * 128 + 16 * ct + (lane & 15)) * 128 + 32 * sk + 8 * q); const GAS f32x4* sp = (const GAS f32x4*)(F.pool_scale + g * 128 + 32 * sk + 8 * q);
            const f32x4 a = p[0] * sp[0], b = p[1] * sp[1];
            v4u wa_; wa_.x = pk2(a.x, a.y); wa_.y = pk2(a.z, a.w); wa_.z = pk2(b.x, b.y); wa_.w = pk2(b.z, b.w);
            const float* wcol = F.w_a + (size_t)(g * 128 + 32 * sk + 8 * q) * D + 16 * ntile + (lane & 15);
            v4u wb_; wb_.x = pk2(wcol[0], wcol[D]); wb_.y = pk2(wcol[2 * D], wcol[3 * D]); wb_.z = pk2(wcol[4 * D], wcol[5 * D]); wb_.w = pk2(wcol[6 * D], wcol[7 * D]);
            acc = __builtin_amdgcn_mfma_f32_16x16x32_bf16(__builtin_bit_cast(bf16x8, wa_), __builtin_bit_cast(bf16x8, wb_), acc, 0, 0, 0); }
        v2u o; o.x = pk2(acc[0], acc[1]); o.y = pk2(acc[2], acc[3]);
        *(GAS v2u*)((bf16*)(F.ws + WS_WPA) + (size_t)(16 * ntile + (lane & 15)) * 512 + g * 128 + 16 * ct + 4 * q) = o;
    }
    { const int gt = F.bid * NTHREADS + F.tid; float* lbt = (float*)(F.ws + WS_LBT);
      if (gt < 1024) { const int dir = gt >> 9, cc = gt & 511; const float l0 = F.lb_logits[(dir * 2 + 0) * 512 + cc], l1 = F.lb_logits[(dir * 2 + 1) * 512 + cc];
          lbt[gt] = 1.f / (1.f + expf(l1 - l0)); } }
}

__device__ __forceinline__ void modulate_row(const float* xrow, bf16* orow, const float* g, const float* shift, const float* scale, int lane) {
    const GAS f32x4* xr = (const GAS f32x4*)xrow + lane;
    f32x4 v[4]; float s2 = 0.f;
#pragma unroll
    for (int j = 0; j < 4; ++j) { v[j] = xr[64 * j]; s2 += (v[j].x * v[j].x + v[j].y * v[j].y) + (v[j].z * v[j].z + v[j].w * v[j].w); }
    const float rstd = 1.f / sqrtf(wave_sum(s2) * (1.f / D) + EPS);
    GAS v2u* o8 = (GAS v2u*)orow + lane;
#pragma unroll
    for (int j = 0; j < 4; ++j) {
        const f32x4 gg = ((const GAS f32x4*)g)[lane + 64 * j], sh = ((const GAS f32x4*)shift)[lane + 64 * j], sc = ((const GAS f32x4*)scale)[lane + 64 * j];
        const f32x4 y = (v[j] * rstd) * gg * (sc + 1.0f) + sh;
        v2u o; o.x = pk2(y.x, y.y); o.y = pk2(y.z, y.w); o8[64 * j] = o; }
}
__device__ __forceinline__ void p1_modulate(Frame& F) {
    const float* mod = (const float*)(F.ws + WS_MOD); bf16* H = (bf16*)(F.ws + WS_H);
    const int gw = F.bid * NWAVES + F.wave, NGW = F.G * NWAVES;
    for (int m = gw; m < MH; m += NGW) {
        const int v = (m < ML) ? (m >> 12) : 4;
        const float* xr = (m < ML) ? F.x + (size_t)m * D : F.ctx + (size_t)(m - ML) * D;
        modulate_row(xr, H + (size_t)m * D, F.n1g, mod + v * 6144 + 0, mod + v * 6144 + 1024, F.lane);
    }
}

using pg8::Unit;
struct SchedPlain {
    const char* Ab; const char* Bb; int nM, nN, K, G, c;
    __device__ __forceinline__ bool next(int i, Unit& u) const { const int L = i * G + c; if (L >= nM * nN) return false; pg8::tile_of(L, nM, nN, u.pm, u.pn); u.seg = 0; return true; }
    __device__ __forceinline__ const char* A(const Unit& u) const { return Ab + (size_t)u.pm * 256 * K * 2; }
    __device__ __forceinline__ const char* B(const Unit& u) const { return Bb + (size_t)u.pn * 256 * K * 2; }
    __device__ __forceinline__ bool keep(const Unit&) const { return false; }
    __device__ __forceinline__ int nt(const Unit&) const { return K / 64; }
};
struct SchedOnce {
    const char* Ab; const char* Bb; int nM, nN, K, base, c;
    __device__ __forceinline__ bool next(int i, Unit& u) const { const int L = base + c; if (i != 0 || L >= nM * nN) return false; pg8::tile_of(L, nM, nN, u.pm, u.pn); u.seg = 0; return true; }
    __device__ __forceinline__ const char* A(const Unit& u) const { return Ab + (size_t)u.pm * 256 * K * 2; }
    __device__ __forceinline__ const char* B(const Unit& u) const { return Bb + (size_t)u.pn * 256 * K * 2; }
    __device__ __forceinline__ bool keep(const Unit&) const { return false; }
    __device__ __forceinline__ int nt(const Unit&) const { return K / 64; }
};
struct SchedTile {
    const char* Ab; const char* Bb; int K, pm, pn;
    __device__ __forceinline__ bool next(int i, Unit& u) const { if (i != 0) return false; u.pm = pm; u.pn = pn; u.seg = 0; return true; }
    __device__ __forceinline__ const char* A(const Unit& u) const { return Ab + (size_t)u.pm * 256 * K * 2; }
    __device__ __forceinline__ const char* B(const Unit& u) const { return Bb + (size_t)u.pn * 256 * K * 2; }
    __device__ __forceinline__ bool keep(const Unit&) const { return false; }
    __device__ __forceinline__ int nt(const Unit&) const { return K / 64; }
};
struct SchedIn {
    const char* Ab; const char* Bb; int G, c;
    __device__ __forceinline__ bool next(int i, Unit& u) const { const int L = i * G + c; u.seg = 0;
        if (L < 1280) { pg8::tile_of(L, 64, 20, u.pm, u.pn); return true; }
        if (L < 1328) { const int l = L - 1280, l2 = l >> 1; u.seg = l & 1; u.pm = 64 + (l2 & 3); u.pn = 4 + (l2 >> 2); return true; }
        return false; }
    __device__ __forceinline__ const char* A(const Unit& u) const { return Ab + (size_t)u.pm * 256 * D * 2 + ((u.pm >= 64 && u.seg) ? 1024 : 0); }
    __device__ __forceinline__ const char* B(const Unit& u) const { return Bb + (size_t)u.pn * 256 * D * 2 + ((u.pm >= 64 && u.seg) ? 1024 : 0); }
    __device__ __forceinline__ bool keep(const Unit&) const { return false; }
    __device__ __forceinline__ int nt(const Unit& u) const { return u.pm >= 64 ? 8 : 16; }
};
struct SchedMerge {
    const char *A0, *A1, *B0, *B1; int G, c;
    __device__ __forceinline__ bool next(int i, Unit& u) const { const int tile = (i >> 1) * G + c; if (tile >= 256) return false; pg8::tile_of(tile, 64, 4, u.pm, u.pn); u.seg = i & 1; return true; }
    __device__ __forceinline__ const char* A(const Unit& u) const { return (u.seg ? A1 : A0) + (size_t)u.pm * 256 * 512 * 2; }
    __device__ __forceinline__ const char* B(const Unit& u) const { return (u.seg ? B1 : B0) + (size_t)u.pn * 256 * 512 * 2; }
    __device__ __forceinline__ bool keep(const Unit& u) const { return u.seg == 0; }
    __device__ __forceinline__ int nt(const Unit&) const { return 8; }
};

struct EpiZ {
    static constexpr bool PERM = true, AFTER_DRAIN = false;
    bf16* Z; bf16* ZC; bf16* ZC2;
    __device__ __forceinline__ void operator()(pg8::f32x4 (&acc)[2][2][4][2], const Unit& u, int wr, int wc, int fr, int fq) const {
        int row0 = u.pm * 256 + wr * 64 + fr, col0 = u.pn * 256 + wc * 32 + 8 * fq, ldc = INW; bf16* base = Z;
        if (u.pm >= 64) { base = u.seg ? ZC2 : ZC; row0 -= ML; col0 -= 1024; ldc = ZC_W; }
        const bool sg = u.pn >= 12;
#pragma unroll
        for (int ai = 0; ai < 2; ++ai)
#pragma unroll
            for (int m = 0; m < 4; ++m) { bf16* rowp = base + (size_t)(row0 + ai * 128 + m * 16) * ldc + col0;
#pragma unroll
                for (int bj = 0; bj < 2; ++bj) { pg8::f32x4 v0 = acc[ai][bj][m][0], v1 = acc[ai][bj][m][1];
                    if (sg) {
#pragma unroll
                        for (int j = 0; j < 4; ++j) { v0[j] = sigmoidf_(v0[j]); v1[j] = sigmoidf_(v1[j]); } }
                    v4u w; w.x = pk2(v0[0], v0[1]); w.y = pk2(v0[2], v0[3]); w.z = pk2(v1[0], v1[1]); w.w = pk2(v1[2], v1[3]);
                    *(GAS v4u*)(rowp + bj * 128) = w; } }
    }
};
struct EpiPlain {
    static constexpr bool PERM = true, AFTER_DRAIN = false;
    bf16* O; int ldc;
    __device__ __forceinline__ void operator()(pg8::f32x4 (&acc)[2][2][4][2], const Unit& u, int wr, int wc, int fr, int fq) const {
        const int row0 = u.pm * 256 + wr * 64 + fr, col0 = u.pn * 256 + wc * 32 + 8 * fq;
#pragma unroll
        for (int ai = 0; ai < 2; ++ai)
#pragma unroll
            for (int m = 0; m < 4; ++m) { bf16* rowp = O + (size_t)(row0 + ai * 128 + m * 16) * ldc + col0;
#pragma unroll
                for (int bj = 0; bj < 2; ++bj) { const pg8::f32x4 v0 = acc[ai][bj][m][0], v1 = acc[ai][bj][m][1];
                    v4u w; w.x = pk2(v0[0], v0[1]); w.y = pk2(v0[2], v0[3]); w.z = pk2(v1[0], v1[1]); w.w = pk2(v1[2], v1[3]);
                    *(GAS v4u*)(rowp + bj * 128) = w; } }
    }
};
struct EpiMerge {
    static constexpr bool PERM = true, AFTER_DRAIN = false;
    const bf16* Z; bf16* Mo;
    __device__ __forceinline__ void operator()(pg8::f32x4 (&acc)[2][2][4][2], const Unit& u, int wr, int wc, int fr, int fq) const {
        const int row0 = u.pm * 256 + wr * 64 + fr, col0 = u.pn * 256 + wc * 32 + 8 * fq;
#pragma unroll
        for (int ai = 0; ai < 2; ++ai)
#pragma unroll
            for (int m = 0; m < 4; ++m) { const size_t r = (size_t)(row0 + ai * 128 + m * 16);
#pragma unroll
                for (int bj = 0; bj < 2; ++bj) { const int c = col0 + bj * 128;
                    const v4u gh = *(const GAS v4u*)(Z + r * INW + 4096 + c);
                    float h[8] = {bflo(gh.x), bfhi(gh.x), bflo(gh.y), bfhi(gh.y), bflo(gh.z), bfhi(gh.z), bflo(gh.w), bfhi(gh.w)};
                    if (u.seg == 0) {
                        const v4u gp = *(const GAS v4u*)(Z + r * INW + 3072 + c);
                        float p[8] = {bflo(gp.x), bfhi(gp.x), bflo(gp.y), bfhi(gp.y), bflo(gp.z), bfhi(gp.z), bflo(gp.w), bfhi(gp.w)};
#pragma unroll
                        for (int j = 0; j < 4; ++j) { acc[ai][bj][m][0][j] *= p[j] * fast_rcp(fmaxf(h[j], 1e-30f)); acc[ai][bj][m][1][j] *= p[4 + j] * fast_rcp(fmaxf(h[4 + j], 1e-30f)); }
                    } else {
                        pg8::f32x4 v0 = acc[ai][bj][m][0], v1 = acc[ai][bj][m][1];
#pragma unroll
                        for (int j = 0; j < 4; ++j) { v0[j] *= h[j]; v1[j] *= h[4 + j]; }
                        v4u w; w.x = pk2(v0[0], v0[1]); w.y = pk2(v0[2], v0[3]); w.z = pk2(v1[0], v1[1]); w.w = pk2(v1[2], v1[3]);
                        pg8::st_wt16(Mo + r * D + c, w); } } }
    }
};
struct EpiRes {
    static constexpr bool PERM = true, AFTER_DRAIN = false;
    const float* X; const float* mod; bf16* O0; bf16* O1;
    __device__ __forceinline__ void operator()(pg8::f32x4 (&acc)[2][2][4][2], const Unit& u, int wr, int wc, int fr, int fq) const {
        const int row0 = u.pm * 256 + wr * 64 + fr, col0 = u.pn * 256 + wc * 32 + 8 * fq;
        const float* g1 = mod + (size_t)(u.pm >> 4) * 6144 + 2048;
        bf16* Ob = ((u.pn & 2) ? O1 : O0) + (u.pn & 1) * 256 + wc * 32 + 8 * fq;
        pg8::f32x4 gv[2][2];
#pragma unroll
        for (int bj = 0; bj < 2; ++bj)
#pragma unroll
            for (int n = 0; n < 2; ++n) gv[bj][n] = *(const GAS pg8::f32x4*)(g1 + col0 + bj * 128 + n * 4);
#pragma unroll
        for (int ai = 0; ai < 2; ++ai)
#pragma unroll
            for (int m = 0; m < 4; ++m) { const size_t row = (size_t)(row0 + ai * 128 + m * 16), off = row * D + col0;
#pragma unroll
                for (int bj = 0; bj < 2; ++bj) { const pg8::f32x4 x0 = *(const GAS pg8::f32x4*)(X + off + bj * 128), x1 = *(const GAS pg8::f32x4*)(X + off + bj * 128 + 4);
                    const pg8::f32x4 v0 = x0 + gv[bj][0] * acc[ai][bj][m][0], v1 = x1 + gv[bj][1] * acc[ai][bj][m][1];
                    v4u w; w.x = pk2(v0[0], v0[1]); w.y = pk2(v0[2], v0[3]); w.z = pk2(v1[0], v1[1]); w.w = pk2(v1[2], v1[3]);
                    pg8::st_wt16(Ob + row * 512 + bj * 128, w); }
                asm volatile("" ::: "memory"); }
    }
};

__device__ __forceinline__ unsigned off_b(unsigned row, unsigned ch) { return 256u * row + 16u * (ch ^ (((row & 3) << 2) | ((row >> 2) & 3))); }
__device__ __forceinline__ unsigned row_addr16(unsigned lane, unsigned rb, unsigned s) { return off_b((lane & 15) + 16 * rb, 4 * s + (lane >> 4)); }
__device__ __forceinline__ unsigned tr_addr16(unsigned lane, unsigned c, unsigned t) { const unsigned g = lane >> 4, q = (lane & 15) >> 2, p = lane & 3; return off_b(8 * g + 4 * t + q, 2 * c + (p >> 1)) + 8 * (p & 1); }
__device__ __forceinline__ bf16x8 tr_frag(LAS unsigned char* tile, unsigned lane, unsigned c) {
    const s16x4 lo = __builtin_amdgcn_ds_read_tr16_b64_v4i16((LAS s16x4*)(tile + tr_addr16(lane, c, 0)));
    const s16x4 hi = __builtin_amdgcn_ds_read_tr16_b64_v4i16((LAS s16x4*)(tile + tr_addr16(lane, c, 1)));
    return __builtin_shufflevector(lo, hi, 0, 1, 2, 3, 4, 5, 6, 7);
}
#define MFMA16(a, b, c) __builtin_amdgcn_mfma_f32_16x16x32_bf16((a), (b), (c), 0, 0, 0)

__device__ __forceinline__ v4u add_bf16x8(const v4u a, const v4u b) {
    v4u r; r.x = pk2(bflo(a.x) + bflo(b.x), bfhi(a.x) + bfhi(b.x)); r.y = pk2(bflo(a.y) + bflo(b.y), bfhi(a.y) + bfhi(b.y));
    r.z = pk2(bflo(a.z) + bflo(b.z), bfhi(a.z) + bfhi(b.z)); r.w = pk2(bflo(a.w) + bflo(b.w), bfhi(a.w) + bfhi(b.w)); return r; }
constexpr int SC_QT = 0, SC_KT = 8192, SC_KD = 16384, SC_VT = 24576, SC_ATT = 32768, SC_EL = 35328, SC_WT = 35840;

__device__ __forceinline__ void scan_unit(Frame& F, int u) {
    const int tid = F.tid, lane = F.lane, w = F.wave, q = lane >> 4;
    const bool isctx = u >= NSCAN_L;
    int b, h, dir, rowbase, nch; const bf16* src; int ld, cq, ci, cf;
    if (!isctx) { const int j = u & 7; dir = (u >> 3) & 1; h = (u >> 4) & 3; b = u >> 6; const int tb = dir ? 7 - j : j;
        rowbase = b * SEQ + tb * SEGT; nch = SEGT / CHT; src = (const bf16*)(F.ws + WS_Z); ld = INW; cq = 512 + h * 128; ci = 1024 + h * 128; cf = (dir ? 2048 : 1536) + h * 128; }
    else { const int v = u - NSCAN_L, cs = v & (NCSEG - 1); dir = (v >> 2) & 1; h = (v >> 3) & 3; b = v >> 5;
        rowbase = b * CTXL + (dir ? NCSEG - 1 - cs : cs) * (CTXL / NCSEG); nch = CTXL / NCSEG / CHT; src = (const bf16*)(F.ws + WS_ZC); ld = ZC_W; ci = h * 128; cq = ci; cf = (dir ? 1024 : 512) + h * 128; }
    const int t = tid >> 4, k8 = tid & 15;
    const int pl = dir ? 3 - q : q;
    const float* lbt = (const float*)(F.ws + WS_LBT) + dir * 512 + h * 128 + 8 * k8;
    float lb[8], om_[8], ecum[8];
#pragma unroll
    for (int i = 0; i < 8; ++i) { lb[i] = lbt[i]; om_[i] = 1.f - lbt[i]; ecum[i] = 1.f; }
    f32x4 S[8];
#pragma unroll
    for (int i = 0; i < 8; ++i) S[i] = (f32x4){0.f, 0.f, 0.f, 0.f};
    LAS unsigned char* L = F.lds;
    bf16* qseg = (bf16*)((unsigned char*)F.out + OUT_QSEG) + (size_t)dir * ML * 512;
    bf16* oloc = (bf16*)((unsigned char*)F.out + OUT_OLOC);
    v4u qv, vv, fv;
    { const int tc = dir ? nch - 1 : 0; const bf16* rp = src + (size_t)(rowbase + tc * CHT + t) * ld + 8 * k8;
      qv = *(const GAS v4u*)(rp + cq); vv = *(const GAS v4u*)(rp + ci); fv = *(const GAS v4u*)(rp + cf);
      if (isctx) { const bf16* r2 = rp + (WS_ZC2 - WS_ZC) / 2; vv = add_bf16x8(vv, *(const GAS v4u*)(r2 + ci)); fv = add_bf16x8(fv, *(const GAS v4u*)(r2 + cf)); qv = vv; } }
    for (int pc = 0; pc < nch; ++pc) {
        const int tc = dir ? nch - 1 - pc : pc;
        const v4u q0 = qv, v0 = vv, f0 = fv;
        if (pc + 1 < nch) { const int tn = dir ? tc - 1 : tc + 1; const bf16* rp = src + (size_t)(rowbase + tn * CHT + t) * ld + 8 * k8;
            qv = *(const GAS v4u*)(rp + cq); vv = *(const GAS v4u*)(rp + ci); fv = *(const GAS v4u*)(rp + cf);
            if (isctx) { const bf16* r2 = rp + (WS_ZC2 - WS_ZC) / 2; vv = add_bf16x8(vv, *(const GAS v4u*)(r2 + ci)); fv = add_bf16x8(fv, *(const GAS v4u*)(r2 + cf)); qv = vv; } }
        float fr_[8] = {bflo(f0.x), bfhi(f0.x), bflo(f0.y), bfhi(f0.y), bflo(f0.z), bfhi(f0.z), bflo(f0.w), bfhi(f0.w)};
        float e[8], kk[8];
#pragma unroll
        for (int i = 0; i < 8; ++i) { const float s = fast_rcp(1.f + fast_exp(-fr_[i])); e[i] = lb[i] + om_[i] * s; kk[i] = om_[i] - om_[i] * s; }
        { const int s1 = dir ? lane + 16 : lane - 16, s2 = dir ? lane + 32 : lane - 32;
#pragma unroll
          for (int i = 0; i < 8; ++i) { const float o = __shfl(e[i], s1 & 63); e[i] = (pl >= 1) ? e[i] * o : e[i]; }
#pragma unroll
          for (int i = 0; i < 8; ++i) { const float o = __shfl(e[i], s2 & 63); e[i] = (pl >= 2) ? e[i] * o : e[i]; } }
        if (pl == 3) { LAS f32x4* wt = (LAS f32x4*)(L + SC_WT + (w * 128 + 8 * k8) * 4); wt[0] = (f32x4){e[0], e[1], e[2], e[3]}; wt[1] = (f32x4){e[4], e[5], e[6], e[7]}; }
        LBAR();
        float etot[8];
        { float pre[8], run[8];
#pragma unroll
          for (int i = 0; i < 8; ++i) { pre[i] = 1.f; run[i] = 1.f; }
#pragma unroll
          for (int sidx = 0; sidx < 8; ++sidx) { const int ww = dir ? 7 - sidx : sidx;
              const LAS f32x4* wt = (const LAS f32x4*)(L + SC_WT + (ww * 128 + 8 * k8) * 4); const f32x4 a = wt[0], c = wt[1];
              if (ww == w) {
#pragma unroll
                  for (int i = 0; i < 8; ++i) pre[i] = run[i]; }
              run[0] *= a.x; run[1] *= a.y; run[2] *= a.z; run[3] *= a.w; run[4] *= c.x; run[5] *= c.y; run[6] *= c.z; run[7] *= c.w; }
#pragma unroll
          for (int i = 0; i < 8; ++i) { etot[i] = run[i]; e[i] *= pre[i]; } }
        {
            const float qf[8] = {bflo(q0.x), bfhi(q0.x), bflo(q0.y), bfhi(q0.y), bflo(q0.z), bfhi(q0.z), bflo(q0.w), bfhi(q0.w)};
            float qt[8], kt[8], kd[8];
#pragma unroll
            for (int i = 0; i < 8; ++i) { qt[i] = qf[i] * e[i]; kt[i] = kk[i] * fast_rcp(e[i]); kd[i] = kt[i] * etot[i]; }
            const unsigned ob = off_b((unsigned)t, (unsigned)k8);
            v4u o; o.x = pk2(qt[0], qt[1]); o.y = pk2(qt[2], qt[3]); o.z = pk2(qt[4], qt[5]); o.w = pk2(qt[6], qt[7]); *(LAS v4u*)(L + SC_QT + ob) = o;
            o.x = pk2(kt[0], kt[1]); o.y = pk2(kt[2], kt[3]); o.z = pk2(kt[4], kt[5]); o.w = pk2(kt[6], kt[7]); *(LAS v4u*)(L + SC_KT + ob) = o;
            o.x = pk2(kd[0], kd[1]); o.y = pk2(kd[2], kd[3]); o.z = pk2(kd[4], kd[5]); o.w = pk2(kd[6], kd[7]); *(LAS v4u*)(L + SC_KD + ob) = o;
            *(LAS v4u*)(L + SC_VT + ob) = v0;
            if (!isctx) { o.x = pk2(qt[0] * ecum[0], qt[1] * ecum[1]); o.y = pk2(qt[2] * ecum[2], qt[3] * ecum[3]); o.z = pk2(qt[4] * ecum[4], qt[5] * ecum[5]); o.w = pk2(qt[6] * ecum[6], qt[7] * ecum[7]);
                *(GAS v4u*)(qseg + (size_t)(rowbase + tc * CHT + t) * 512 + h * 128 + 8 * k8) = o; }
            if (t == 0) { LAS f32x4* el = (LAS f32x4*)(L + SC_EL + 32 * k8); el[0] = (f32x4){etot[0], etot[1], etot[2], etot[3]}; el[1] = (f32x4){etot[4], etot[5], etot[6], etot[7]}; }
#pragma unroll
            for (int i = 0; i < 8; ++i) ecum[i] *= etot[i];
        }
        LBAR();
        if (w < 4 && !isctx) {
            const int tt = dir ? (w >> 1) : ((w + 1) >> 1), st = dir ? ((w + 1) >> 1) : (w >> 1);
            const int tz = dir ? 1 : 0, sz = dir ? 0 : 1;
            f32x4 a = (f32x4){0.f, 0.f, 0.f, 0.f};
            if (w < 3) {
#pragma unroll
                for (int s = 0; s < 4; ++s) { const bf16x8 A = *(const LAS bf16x8*)(L + SC_QT + row_addr16(lane, tt, s)); const bf16x8 B = *(const LAS bf16x8*)(L + SC_KT + row_addr16(lane, st, s)); a = MFMA16(A, B, a); }
            }
            const int tr = (w < 3 ? tt : tz) * 16 + 4 * q, sc = (w < 3 ? st : sz) * 16 + (lane & 15);
#pragma unroll
            for (int j = 0; j < 4; ++j) { const int ti = tr + j; const bool ok = (w < 3) && (dir ? (sc >= ti) : (sc <= ti));
                *(LAS unsigned short*)(L + SC_ATT + ti * 80 + sc * 2) = (unsigned short)f2bf(ok ? a[j] : 0.f); }
        }
        LBAR();
        {
            const bf16x8 Bv = tr_frag(L + SC_VT, lane, w);
            if (!isctx) {
                v4u sb[4];
#pragma unroll
                for (int s = 0; s < 4; ++s) { sb[s].x = pk2(S[2 * s][0], S[2 * s][1]); sb[s].y = pk2(S[2 * s][2], S[2 * s][3]); sb[s].z = pk2(S[2 * s + 1][0], S[2 * s + 1][1]); sb[s].w = pk2(S[2 * s + 1][2], S[2 * s + 1][3]); }
#pragma unroll 1
                for (int tt = 0; tt < 2; ++tt) {
                    f32x4 o = (f32x4){0.f, 0.f, 0.f, 0.f};
                    const unsigned row = 16 * tt + (lane & 15);
#pragma unroll
                    for (int s = 0; s < 4; ++s) {
                        const v2u alo = *(const LAS v2u*)(L + SC_QT + off_b(row, 4 * s + (q >> 1)) + 8 * (q & 1));
                        const v2u ahi = *(const LAS v2u*)(L + SC_QT + off_b(row, 4 * s + 2 + (q >> 1)) + 8 * (q & 1));
                        const v4u av = (v4u){alo.x, alo.y, ahi.x, ahi.y};
                        o = MFMA16(__builtin_bit_cast(bf16x8, av), __builtin_bit_cast(bf16x8, sb[s]), o);
                    }
                    const bf16x8 At = *(const LAS bf16x8*)(L + SC_ATT + row * 80 + 16 * q);
                    o = MFMA16(At, Bv, o);
                    const int ttg = (rowbase + tc * CHT + 16 * tt) >> 4;
                    v2u ov; ov.x = pk2(o[0], o[1]); ov.y = pk2(o[2], o[3]);
                    *(GAS v2u*)(oloc + ((((size_t)(dir * 1024 + ttg) * 4 + h) * 8 + w) * 64 + lane) * 4) = ov;
                }
            }
#pragma unroll
            for (int kt = 0; kt < 8; ++kt) {
                const bf16x8 A = tr_frag(L + SC_KD, lane, kt);
                const f32x4 a4 = *(const LAS f32x4*)(L + SC_EL + (16 * kt + 4 * q) * 4);
                S[kt] = MFMA16(A, Bv, S[kt] * a4);
            }
        }
    }
    { float* us = (float*)(F.ws + WS_USEG) + (size_t)u * 128 * 128 + (4 * q) * 128 + 16 * w + (lane & 15);
#pragma unroll
      for (int kt = 0; kt < 8; ++kt) {
#pragma unroll
          for (int j = 0; j < 4; ++j) us[j * 128] = S[kt][j];
          us += 16 * 128; asm volatile("" : "+v"(us)); }
      if (t == 0) { float* as = (float*)(F.ws + WS_ASEG) + (size_t)u * 128 + 8 * k8;
#pragma unroll
          for (int i = 0; i < 8; ++i) as[i] = ecum[i]; } }
    __syncthreads();
}


constexpr int PL_VSTR = 132, PL_VBYTES = 64 * PL_VSTR * 4;
#define PL_LOAD8(ra, rd, g_, r0b_, rhi_) do { _Pragma("unroll") for (int u8 = 0; u8 < 8; ++u8) { const int rr_ = min((r0b_) + u8, (rhi_)); \
    const bf16* p_ = Z + (size_t)(b * SEQ + rr_ * 64 + c) * INW + (g_) * 128 + 16 * ch16; ra[u8] = *(const GAS v4u*)p_; rd[u8] = *(const GAS v4u*)(p_ + 8); } } while (0)
#define PL_CONSUME8(ra, rd, r0b_, rhi_) do { _Pragma("unroll") for (int u8 = 0; u8 < 8; ++u8) { const int rr_ = (r0b_) + u8; if (rr_ <= (rhi_)) { const v4u a_ = ra[u8], d_ = rd[u8]; \
    const float x_[16] = {bflo(a_.x), bfhi(a_.x), bflo(a_.y), bfhi(a_.y), bflo(a_.z), bfhi(a_.z), bflo(a_.w), bfhi(a_.w), bflo(d_.x), bfhi(d_.x), bflo(d_.y), bfhi(d_.y), bflo(d_.z), bfhi(d_.z), bflo(d_.w), bfhi(d_.w)}; \
    _Pragma("unroll") for (int i_ = 0; i_ < 16; ++i_) vs[i_] += x_[i_]; \
    if (rr_ == r) { _Pragma("unroll") for (int i_ = 0; i_ < 16; ++i_) pc[i_] = x_[i_]; } } } } while (0)
__device__ __forceinline__ void pool_unit(Frame& F, int u) {
    const int b = u >> 6, r = u & 63, tid = F.tid;
    const int c = tid >> 3, ch16 = tid & 7;
    const bf16* Z = (const bf16*)(F.ws + WS_Z); bf16* YP = (bf16*)(F.ws + WS_YPOOL);
    v4u ra[8], rd[8];
    PL_LOAD8(ra, rd, 0, max(0, r - 1), r);
#pragma unroll 1
    for (int g = 0; g < 4; ++g) {
        LAS unsigned char* L = F.lds + (g & 1) * PL_VBYTES;
        const int half = 1 << g;
        const int r_lo = max(0, r - half), r_hi = min(63, r + half - 1), c_lo = max(0, c - half), c_hi = min(63, c + half - 1);
        float vs[16], pc[16];
#pragma unroll
        for (int i = 0; i < 16; ++i) { vs[i] = 0.f; pc[i] = 0.f; }
        PL_CONSUME8(ra, rd, r_lo, r_hi);
        if (g == 3) { PL_LOAD8(ra, rd, 3, r_lo + 8, r_hi); PL_CONSUME8(ra, rd, r_lo + 8, r_hi); }
        else { const int h2 = 2 * half; PL_LOAD8(ra, rd, g + 1, max(0, r - h2), min(63, r + h2 - 1)); }
        { LAS f32x4* vp = (LAS f32x4*)(L + (c * PL_VSTR + 16 * ch16) * 4);
#pragma unroll
          for (int i = 0; i < 4; ++i) vp[i] = (f32x4){vs[4 * i], vs[4 * i + 1], vs[4 * i + 2], vs[4 * i + 3]}; }
        LBAR();
        float hs[16];
#pragma unroll
        for (int i = 0; i < 16; ++i) hs[i] = 0.f;
        for (int cc = c_lo; cc <= c_hi; ++cc) { const LAS f32x4* vp = (const LAS f32x4*)(L + (cc * PL_VSTR + 16 * ch16) * 4);
#pragma unroll
            for (int i = 0; i < 4; ++i) { const f32x4 x = vp[i]; hs[4 * i] += x.x; hs[4 * i + 1] += x.y; hs[4 * i + 2] += x.z; hs[4 * i + 3] += x.w; } }
        { const float inv = 1.f / (float)((r_hi - r_lo + 1) * (c_hi - c_lo + 1));
          v4u o0, o1;
          o0.x = pk2(hs[0] * inv - pc[0], hs[1] * inv - pc[1]); o0.y = pk2(hs[2] * inv - pc[2], hs[3] * inv - pc[3]); o0.z = pk2(hs[4] * inv - pc[4], hs[5] * inv - pc[5]); o0.w = pk2(hs[6] * inv - pc[6], hs[7] * inv - pc[7]);
          o1.x = pk2(hs[8] * inv - pc[8], hs[9] * inv - pc[9]); o1.y = pk2(hs[10] * inv - pc[10], hs[11] * inv - pc[11]); o1.z = pk2(hs[12] * inv - pc[12], hs[13] * inv - pc[13]); o1.w = pk2(hs[14] * inv - pc[14], hs[15] * inv - pc[15]);
          GAS v4u* dp = (GAS v4u*)(YP + (size_t)(b * SEQ + r * 64 + c) * 512 + g * 128 + 16 * ch16); dp[0] = o0; dp[1] = o1; }
    }
    __syncthreads();
}

constexpr int FX_SF = 0, FX_SB = 32768, FX_SCR = 65536, FX_SCRSTR = 132;
__device__ __forceinline__ void prefix_unit(Frame& F, int u) {
    const int chain = u >> 3, rb = u & 7, tid = F.tid, k = 16 * rb + (tid >> 5), v = 4 * (tid & 31);
    const float* US = (const float*)(F.ws + WS_USEG); const float* AS = (const float*)(F.ws + WS_ASEG);
    unsigned char* P = F.ws + WS_PFX + (size_t)chain * 8 * 32768;
    constexpr int NU = NCSEG + 7;
    f32x4 uu[NU]; float aa[NU];
#pragma unroll
    for (int i = 0; i < NU; ++i) { const int un = (i < NCSEG) ? NSCAN_L + chain * NCSEG + i : chain * 8 + (i - NCSEG);
        uu[i] = *(const GAS f32x4*)(US + ((size_t)un * 128 + k) * 128 + v); aa[i] = AS[un * 128 + k]; }
    f32x4 s = uu[0];
#pragma unroll
    for (int i = 1; i < NCSEG; ++i) s = s * aa[i] + uu[i];
    const unsigned ob = (unsigned)(k >> 5) * 8192u + off_b((unsigned)(k & 31), (unsigned)(v >> 3)) + (unsigned)(v & 7) * 2u;
#pragma unroll
    for (int j = 0; j < 8; ++j) {
        v2u o; o.x = pk2(s.x, s.y); o.y = pk2(s.z, s.w);
        *(GAS v2u*)(P + (size_t)j * 32768 + ob) = o;
        if (j < 7) s = s * aa[NCSEG + j] + uu[NCSEG + j];
    }
}
__device__ __forceinline__ void fix_load_state(Frame& F, int chain, int seg, int soff) {
    const GAS v4u* src = (const GAS v4u*)(F.ws + WS_PFX + ((size_t)chain * 8 + seg) * 32768) + F.tid;
#pragma unroll
    for (int i = 0; i < 4; ++i) *(LAS v4u*)(F.lds + soff + (F.tid + 512 * i) * 16) = src[512 * i];
}
__device__ __forceinline__ void fix_unit(Frame& F, int b, int h, int tb, int half) {
    const int lane = F.lane, w = F.wave, q = lane >> 4;
    LAS unsigned char* L = F.lds;
    fix_load_state(F, (b * 4 + h) * 2 + 0, tb, FX_SF);
    fix_load_state(F, (b * 4 + h) * 2 + 1, 7 - tb, FX_SB);
    __syncthreads();
    const bf16* Z = (const bf16*)(F.ws + WS_Z); bf16* YH = (bf16*)(F.ws + WS_YHG);
    const bf16* qseg = (const bf16*)((const unsigned char*)F.out + OUT_QSEG); const bf16* oloc = (const bf16*)((const unsigned char*)F.out + OUT_OLOC);
    LAS float* scr = (LAS float*)(L + FX_SCR + w * (16 * FX_SCRSTR * 4));
    const int row0 = b * SEQ + tb * SEGT;
#pragma unroll 1
    for (int ti = 0; ti < 2; ++ti) {
        const int tt = 16 * half + 2 * w + ti, rowt = row0 + 16 * tt;
        f32x4 acc[8];
#pragma unroll
        for (int c = 0; c < 8; ++c) acc[c] = (f32x4){0.f, 0.f, 0.f, 0.f};
        bf16x8 A[2][4]; v2u ol[2][8]; v4u ogv[4];
        const int tl = lane >> 2, v0 = 8 * (lane & 3);
#pragma unroll
        for (int dir = 0; dir < 2; ++dir)
#pragma unroll
            for (int s = 0; s < 4; ++s) A[dir][s] = *(const GAS bf16x8*)(qseg + ((size_t)dir * ML + rowt + (lane & 15)) * 512 + h * 128 + 32 * s + 8 * q);
#pragma unroll
        for (int dir = 0; dir < 2; ++dir)
#pragma unroll
            for (int c = 0; c < 8; ++c) ol[dir][c] = *(const GAS v2u*)(oloc + ((((size_t)(dir * 1024 + (rowt >> 4)) * 4 + h) * 8 + c) * 64 + lane) * 4);
#pragma unroll
        for (int i = 0; i < 4; ++i) ogv[i] = *(const GAS v4u*)(Z + (size_t)(rowt + tl) * INW + 2560 + h * 128 + v0 + 32 * i);
#pragma unroll
        for (int dir = 0; dir < 2; ++dir) {
#pragma unroll
            for (int s = 0; s < 4; ++s)
#pragma unroll
                for (int c = 0; c < 8; ++c) { const bf16x8 B = tr_frag(L + (dir ? FX_SB : FX_SF) + s * 8192, lane, c); acc[c] = MFMA16(A[dir][s], B, acc[c]); }
        }
#pragma unroll
        for (int dir = 0; dir < 2; ++dir)
#pragma unroll
            for (int c = 0; c < 8; ++c) { const v2u ov = ol[dir][c];
                acc[c][0] += bflo(ov.x); acc[c][1] += bfhi(ov.x); acc[c][2] += bflo(ov.y); acc[c][3] += bfhi(ov.y); }
        float ss[4];
#pragma unroll
        for (int j = 0; j < 4; ++j) { float s = 0.f;
#pragma unroll
            for (int c = 0; c < 8; ++c) s += acc[c][j] * acc[c][j];
            s += WDPP_(s, 0xb1); s += WDPP_(s, 0x4e); s += WDPP_(s, 0x141); s += WDPP_(s, 0x140);
            ss[j] = 1.f / sqrtf(s * (1.f / 128.f) + EPS); }
#pragma unroll
        for (int c = 0; c < 8; ++c)
#pragma unroll
            for (int j = 0; j < 4; ++j) scr[(4 * q + j) * FX_SCRSTR + 16 * c + (lane & 15)] = acc[c][j] * ss[j];
        LDS_WAIT();
        { const size_t row = (size_t)(rowt + tl);
          bf16* yo = YH + row * 512 + h * 128 + v0;
#pragma unroll
          for (int i = 0; i < 4; ++i) {
              const f32x4 a = *(const LAS f32x4*)(scr + tl * FX_SCRSTR + v0 + 32 * i), c2 = *(const LAS f32x4*)(scr + tl * FX_SCRSTR + v0 + 32 * i + 4);
              const v4u g = ogv[i];
              const f32x4 n0 = *(const GAS f32x4*)(F.hg_norm_g + v0 + 32 * i), n1 = *(const GAS f32x4*)(F.hg_norm_g + v0 + 32 * i + 4);
              const float gg[8] = {bflo(g.x), bfhi(g.x), bflo(g.y), bfhi(g.y), bflo(g.z), bfhi(g.z), bflo(g.w), bfhi(g.w)};
              const float yv[8] = {a.x * n0.x, a.y * n0.y, a.z * n0.z, a.w * n0.w, c2.x * n1.x, c2.y * n1.y, c2.z * n1.z, c2.w * n1.w};
              float o[8];
#pragma unroll
              for (int e = 0; e < 8; ++e) o[e] = yv[e] * gg[e] * sigmoidf_(gg[e]);
              v4u ov; ov.x = pk2(o[0], o[1]); ov.y = pk2(o[2], o[3]); ov.z = pk2(o[4], o[5]); ov.w = pk2(o[6], o[7]);
              pg8::st_wt16(yo + 32 * i, ov); } }
        LDS_WAIT();
    }
    __syncthreads();
}


__device__ __forceinline__ void i8_rows(const float* src, unsigned char* dst, float* inv_scale, int gw, int NGW, int lane, unsigned bias, int rend = NEXP) {
    for (int r = gw; r < rend; r += NGW) {
        const GAS f32x4* p = (const GAS f32x4*)(src + (size_t)r * D + 16 * lane);
        const f32x4 a = p[0], b = p[1], c = p[2], d = p[3];
        float m = fmaxf(fmaxf(fmaxf(fabsf(a.x), fabsf(a.y)), fmaxf(fabsf(a.z), fabsf(a.w))), fmaxf(fmaxf(fabsf(b.x), fabsf(b.y)), fmaxf(fabsf(b.z), fabsf(b.w))));
        m = fmaxf(m, fmaxf(fmaxf(fmaxf(fabsf(c.x), fabsf(c.y)), fmaxf(fabsf(c.z), fabsf(c.w))), fmaxf(fmaxf(fabsf(d.x), fabsf(d.y)), fmaxf(fabsf(d.z), fabsf(d.w)))));
        m = wave_max(m);
        const float sc = (m > 0.f) ? 127.f / m : 1.f;
        v4u o; o.x = pack_i8x4(a.x * sc, a.y * sc, a.z * sc, a.w * sc); o.y = pack_i8x4(b.x * sc, b.y * sc, b.z * sc, b.w * sc);
        o.z = pack_i8x4(c.x * sc, c.y * sc, c.z * sc, c.w * sc); o.w = pack_i8x4(d.x * sc, d.y * sc, d.z * sc, d.w * sc);
        o.x ^= bias; o.y ^= bias; o.z ^= bias; o.w ^= bias;
        *(GAS v4u*)(dst + (size_t)(lane >> 3) * ((size_t)NEXP * 128) + (size_t)r * 128 + 16 * (lane & 7)) = o;
        if (lane == 0) inv_scale[r] = (m > 0.f) ? m * (1.f / 127.f) : 1.f;
    }
}
__device__ __forceinline__ void i4_rows(const float* src, unsigned char* dst, float* inv_scale, int gw, int NGW, int lane, const bool vtab) {
    for (int r0 = gw; r0 < NEXP; r0 += 2 * NGW) {
        f32x4 x[2][4]; float s2[2];
#pragma unroll
        for (int k = 0; k < 2; ++k) { const int r = (r0 + k * NGW < NEXP) ? r0 + k * NGW : r0; const GAS f32x4* p = (const GAS f32x4*)(src + (size_t)r * D + 16 * lane);
            x[k][0] = p[0]; x[k][1] = p[1]; x[k][2] = p[2]; x[k][3] = p[3]; }
#pragma unroll
        for (int k = 0; k < 2; ++k) { float t = 0.f;
#pragma unroll
            for (int i = 0; i < 4; ++i) t += (x[k][i].x * x[k][i].x + x[k][i].y * x[k][i].y) + (x[k][i].z * x[k][i].z + x[k][i].w * x[k][i].w);
            s2[k] = t; }
        s2[0] = wave_sum(s2[0]); s2[1] = wave_sum(s2[1]);
#pragma unroll
        for (int k = 0; k < 2; ++k) { const int r = r0 + k * NGW; if (r < NEXP) {
            const f32x4 a = x[k][0], b = x[k][1], c = x[k][2], d = x[k][3];
            const float step = 0.3352f * sqrtf(s2[k] * (1.f / D)), is = (step > 0.f) ? 1.f / step : 0.f;
#define Q4_(x) ((unsigned)(int)fminf(fmaxf(floorf((x) * is), -8.f), 7.f))
#define Q4B_(h, l) (((Q4_(h) & 15u) << 4) | ((Q4_(l) + 8u) & 15u))
#define Q4N_(lo, hi) ((Q4_(lo) & 15u) | ((Q4_(hi) & 15u) << 4))
            v2u o;
            if (vtab) { o.x = Q4B_(a.x, a.y) | (Q4B_(a.z, a.w) << 8) | (Q4B_(b.x, b.y) << 16) | (Q4B_(b.z, b.w) << 24); o.y = Q4B_(c.x, c.y) | (Q4B_(c.z, c.w) << 8) | (Q4B_(d.x, d.y) << 16) | (Q4B_(d.z, d.w) << 24); }
            else      { o.x = Q4N_(a.x, a.y) | (Q4N_(a.z, a.w) << 8) | (Q4N_(b.x, b.y) << 16) | (Q4N_(b.z, b.w) << 24); o.y = Q4N_(c.x, c.y) | (Q4N_(c.z, c.w) << 8) | (Q4N_(d.x, d.y) << 16) | (Q4N_(d.z, d.w) << 24); }
#undef Q4N_
#undef Q4B_
#undef Q4_
            *(GAS v2u*)(dst + (size_t)(lane >> 4) * ((size_t)NEXP * 128) + (size_t)r * 128 + 8 * (lane & 15)) = o;
            if (lane == 0) inv_scale[r] = step; } }
    }
}
__device__ __forceinline__ void mrq_load(const bf16* xlo, const bf16* xhi, int lane, v2u (&xw)[4]) {
    const GAS v2u* xr0 = (const GAS v2u*)xlo + lane; const GAS v2u* xr1 = (const GAS v2u*)xhi + lane;
    xw[0] = xr0[0]; xw[1] = xr0[64]; xw[2] = xr1[0]; xw[3] = xr1[64];
}
__device__ __forceinline__ void mrq_finish(const v2u (&xw)[4], bf16* orow, unsigned char* qrow, float* qscale, float* qsum, const float* g, const float* shift, const float* scale, int lane) {
    f32x4 v[4]; float s2 = 0.f;
#pragma unroll
    for (int j = 0; j < 4; ++j) { v[j] = (f32x4){bflo(xw[j].x), bfhi(xw[j].x), bflo(xw[j].y), bfhi(xw[j].y)}; s2 += (v[j].x * v[j].x + v[j].y * v[j].y) + (v[j].z * v[j].z + v[j].w * v[j].w); }
    const float rstd = 1.f / sqrtf(wave_sum(s2) * (1.f / D) + EPS);
    GAS v2u* o8 = (GAS v2u*)orow + lane; float m = 0.f;
#pragma unroll
    for (int j = 0; j < 4; ++j) {
        const f32x4 gg = ((const GAS f32x4*)g)[lane + 64 * j], sh = ((const GAS f32x4*)shift)[lane + 64 * j], sc = ((const GAS f32x4*)scale)[lane + 64 * j];
        v[j] = (v[j] * rstd) * gg * (sc + 1.0f) + sh;
        v2u o; o.x = pk2(v[j].x, v[j].y); o.y = pk2(v[j].z, v[j].w); o8[64 * j] = o;
        m = fmaxf(m, fmaxf(fmaxf(fabsf(v[j].x), fabsf(v[j].y)), fmaxf(fabsf(v[j].z), fabsf(v[j].w)))); }
    m = wave_max(m);
    const float qs = (m > 0.f) ? 119.f / m : 1.f;
    int hs = 0;
#pragma unroll
    for (int j = 0; j < 4; ++j) {
        const int q_[4] = {(int)rintf(v[j].x * qs), (int)rintf(v[j].y * qs), (int)rintf(v[j].z * qs), (int)rintf(v[j].w * qs)};
        unsigned A16 = 0u, B16 = 0u;
#pragma unroll
        for (int k = 0; k < 4; ++k) { const int b_ = ((q_[k] + 8) & 15) - 8, a_ = (q_[k] - b_) >> 4; A16 |= ((unsigned)a_ & 15u) << (4 * k); B16 |= ((unsigned)b_ & 15u) << (4 * k); hs += q_[k]; }
        const unsigned nA = (unsigned)__builtin_amdgcn_mov_dpp((int)A16, 0xb1, 0xf, 0xf, true), nB = (unsigned)__builtin_amdgcn_mov_dpp((int)B16, 0xb1, 0xf, 0xf, true);
        const unsigned dw = (lane & 1) ? (nB | (B16 << 16)) : (A16 | (nA << 16));
        *(GAS unsigned*)(qrow + j * 256 + (lane >> 3) * 32 + (lane & 1) * 16 + ((lane & 7) >> 1) * 4) = dw; }
    const float hsum = wave_sum((float)hs);
    if (lane == 0) { *qscale = (m > 0.f) ? m * (1.f / 119.f) : 1.f; *qsum = hsum; }
}

#define SORT16_DESC(v) do { float hi_, lo_; \
    hi_ = fmaxf(v[0], v[1]); lo_ = fminf(v[0], v[1]); v[0] = hi_; v[1] = lo_; \
    hi_ = fmaxf(v[2], v[3]); lo_ = fminf(v[2], v[3]); v[2] = hi_; v[3] = lo_; \
    hi_ = fmaxf(v[0], v[2]); lo_ = fminf(v[0], v[2]); v[0] = hi_; v[2] = lo_; \
    hi_ = fmaxf(v[1], v[3]); lo_ = fminf(v[1], v[3]); v[1] = hi_; v[3] = lo_; \
    hi_ = fmaxf(v[1], v[2]); lo_ = fminf(v[1], v[2]); v[1] = hi_; v[2] = lo_; \
    hi_ = fmaxf(v[4], v[5]); lo_ = fminf(v[4], v[5]); v[4] = hi_; v[5] = lo_; \
    hi_ = fmaxf(v[6], v[7]); lo_ = fminf(v[6], v[7]); v[6] = hi_; v[7] = lo_; \
    hi_ = fmaxf(v[4], v[6]); lo_ = fminf(v[4], v[6]); v[4] = hi_; v[6] = lo_; \
    hi_ = fmaxf(v[5], v[7]); lo_ = fminf(v[5], v[7]); v[5] = hi_; v[7] = lo_; \
    hi_ = fmaxf(v[5], v[6]); lo_ = fminf(v[5], v[6]); v[5] = hi_; v[6] = lo_; \
    hi_ = fmaxf(v[0], v[4]); lo_ = fminf(v[0], v[4]); v[0] = hi_; v[4] = lo_; \
    hi_ = fmaxf(v[2], v[6]); lo_ = fminf(v[2], v[6]); v[2] = hi_; v[6] = lo_; \
    hi_ = fmaxf(v[2], v[4]); lo_ = fminf(v[2], v[4]); v[2] = hi_; v[4] = lo_; \
    hi_ = fmaxf(v[1], v[5]); lo_ = fminf(v[1], v[5]); v[1] = hi_; v[5] = lo_; \
    hi_ = fmaxf(v[3], v[7]); lo_ = fminf(v[3], v[7]); v[3] = hi_; v[7] = lo_; \
    hi_ = fmaxf(v[3], v[5]); lo_ = fminf(v[3], v[5]); v[3] = hi_; v[5] = lo_; \
    hi_ = fmaxf(v[1], v[2]); lo_ = fminf(v[1], v[2]); v[1] = hi_; v[2] = lo_; \
    hi_ = fmaxf(v[3], v[4]); lo_ = fminf(v[3], v[4]); v[3] = hi_; v[4] = lo_; \
    hi_ = fmaxf(v[5], v[6]); lo_ = fminf(v[5], v[6]); v[5] = hi_; v[6] = lo_; \
    hi_ = fmaxf(v[8], v[9]); lo_ = fminf(v[8], v[9]); v[8] = hi_; v[9] = lo_; \
    hi_ = fmaxf(v[10], v[11]); lo_ = fminf(v[10], v[11]); v[10] = hi_; v[11] = lo_; \
    hi_ = fmaxf(v[8], v[10]); lo_ = fminf(v[8], v[10]); v[8] = hi_; v[10] = lo_; \
    hi_ = fmaxf(v[9], v[11]); lo_ = fminf(v[9], v[11]); v[9] = hi_; v[11] = lo_; \
    hi_ = fmaxf(v[9], v[10]); lo_ = fminf(v[9], v[10]); v[9] = hi_; v[10] = lo_; \
    hi_ = fmaxf(v[12], v[13]); lo_ = fminf(v[12], v[13]); v[12] = hi_; v[13] = lo_; \
    hi_ = fmaxf(v[14], v[15]); lo_ = fminf(v[14], v[15]); v[14] = hi_; v[15] = lo_; \
    hi_ = fmaxf(v[12], v[14]); lo_ = fminf(v[12], v[14]); v[12] = hi_; v[14] = lo_; \
    hi_ = fmaxf(v[13], v[15]); lo_ = fminf(v[13], v[15]); v[13] = hi_; v[15] = lo_; \
    hi_ = fmaxf(v[13], v[14]); lo_ = fminf(v[13], v[14]); v[13] = hi_; v[14] = lo_; \
    hi_ = fmaxf(v[8], v[12]); lo_ = fminf(v[8], v[12]); v[8] = hi_; v[12] = lo_; \
    hi_ = fmaxf(v[10], v[14]); lo_ = fminf(v[10], v[14]); v[10] = hi_; v[14] = lo_; \
    hi_ = fmaxf(v[10], v[12]); lo_ = fminf(v[10], v[12]); v[10] = hi_; v[12] = lo_; \
    hi_ = fmaxf(v[9], v[13]); lo_ = fminf(v[9], v[13]); v[9] = hi_; v[13] = lo_; \
    hi_ = fmaxf(v[11], v[15]); lo_ = fminf(v[11], v[15]); v[11] = hi_; v[15] = lo_; \
    hi_ = fmaxf(v[11], v[13]); lo_ = fminf(v[11], v[13]); v[11] = hi_; v[13] = lo_; \
    hi_ = fmaxf(v[9], v[10]); lo_ = fminf(v[9], v[10]); v[9] = hi_; v[10] = lo_; \
    hi_ = fmaxf(v[11], v[12]); lo_ = fminf(v[11], v[12]); v[11] = hi_; v[12] = lo_; \
    hi_ = fmaxf(v[13], v[14]); lo_ = fminf(v[13], v[14]); v[13] = hi_; v[14] = lo_; \
    hi_ = fmaxf(v[0], v[8]); lo_ = fminf(v[0], v[8]); v[0] = hi_; v[8] = lo_; \
    hi_ = fmaxf(v[4], v[12]); lo_ = fminf(v[4], v[12]); v[4] = hi_; v[12] = lo_; \
    hi_ = fmaxf(v[4], v[8]); lo_ = fminf(v[4], v[8]); v[4] = hi_; v[8] = lo_; \
    hi_ = fmaxf(v[2], v[10]); lo_ = fminf(v[2], v[10]); v[2] = hi_; v[10] = lo_; \
    hi_ = fmaxf(v[6], v[14]); lo_ = fminf(v[6], v[14]); v[6] = hi_; v[14] = lo_; \
    hi_ = fmaxf(v[6], v[10]); lo_ = fminf(v[6], v[10]); v[6] = hi_; v[10] = lo_; \
    hi_ = fmaxf(v[2], v[4]); lo_ = fminf(v[2], v[4]); v[2] = hi_; v[4] = lo_; \
    hi_ = fmaxf(v[6], v[8]); lo_ = fminf(v[6], v[8]); v[6] = hi_; v[8] = lo_; \
    hi_ = fmaxf(v[10], v[12]); lo_ = fminf(v[10], v[12]); v[10] = hi_; v[12] = lo_; \
    hi_ = fmaxf(v[1], v[9]); lo_ = fminf(v[1], v[9]); v[1] = hi_; v[9] = lo_; \
    hi_ = fmaxf(v[5], v[13]); lo_ = fminf(v[5], v[13]); v[5] = hi_; v[13] = lo_; \
    hi_ = fmaxf(v[5], v[9]); lo_ = fminf(v[5], v[9]); v[5] = hi_; v[9] = lo_; \
    hi_ = fmaxf(v[3], v[11]); lo_ = fminf(v[3], v[11]); v[3] = hi_; v[11] = lo_; \
    hi_ = fmaxf(v[7], v[15]); lo_ = fminf(v[7], v[15]); v[7] = hi_; v[15] = lo_; \
    hi_ = fmaxf(v[7], v[11]); lo_ = fminf(v[7], v[11]); v[7] = hi_; v[11] = lo_; \
    hi_ = fmaxf(v[3], v[5]); lo_ = fminf(v[3], v[5]); v[3] = hi_; v[5] = lo_; \
    hi_ = fmaxf(v[7], v[9]); lo_ = fminf(v[7], v[9]); v[7] = hi_; v[9] = lo_; \
    hi_ = fmaxf(v[11], v[13]); lo_ = fminf(v[11], v[13]); v[11] = hi_; v[13] = lo_; \
    hi_ = fmaxf(v[1], v[2]); lo_ = fminf(v[1], v[2]); v[1] = hi_; v[2] = lo_; \
    hi_ = fmaxf(v[3], v[4]); lo_ = fminf(v[3], v[4]); v[3] = hi_; v[4] = lo_; \
    hi_ = fmaxf(v[5], v[6]); lo_ = fminf(v[5], v[6]); v[5] = hi_; v[6] = lo_; \
    hi_ = fmaxf(v[7], v[8]); lo_ = fminf(v[7], v[8]); v[7] = hi_; v[8] = lo_; \
    hi_ = fmaxf(v[9], v[10]); lo_ = fminf(v[9], v[10]); v[9] = hi_; v[10] = lo_; \
    hi_ = fmaxf(v[11], v[12]); lo_ = fminf(v[11], v[12]); v[11] = hi_; v[12] = lo_; \
    hi_ = fmaxf(v[13], v[14]); lo_ = fminf(v[13], v[14]); v[13] = hi_; v[14] = lo_; \
    } while (0)
#define MERGE16_TOP(a, b) do { _Pragma("unroll") for (int i_ = 0; i_ < 16; ++i_) a[i_] = fmaxf(a[i_], b[15 - i_]); \
    _Pragma("unroll") for (int j_ = 8; j_ > 0; j_ >>= 1) _Pragma("unroll") for (int i_ = 0; i_ < 16; ++i_) { const int l_ = i_ ^ j_; \
    if (l_ > i_) { const float hi_ = fmaxf(a[i_], a[l_]), lo_ = fminf(a[i_], a[l_]); a[i_] = hi_; a[l_] = lo_; } } } while (0)
constexpr int TK_S = 0, TK_SSTR = 136, TK_L = 139264;
__device__ __forceinline__ void topk_select(LAS unsigned char* L, int tid, size_t tok_base, int h, unsigned short* eidx, float* gate) {
    {
        const int row = tid >> 1, hf = tid & 1;
        float a[16];
        const LAS f32x4* sp = (const LAS f32x4*)((LAS float*)(L + TK_S) + row * TK_SSTR) + hf;
#pragma unroll
        for (int blk = 0; blk < 4; ++blk) {
            float v[16];
#pragma unroll
            for (int c4 = 0; c4 < 4; ++c4) { const int i = 4 * blk + c4; const f32x4 x4 = sp[2 * i]; const float ve[4] = {x4.x, x4.y, x4.z, x4.w};
#pragma unroll
                for (int e = 0; e < 4; ++e) v[4 * c4 + e] = __builtin_bit_cast(float, (__builtin_bit_cast(unsigned, ve[e]) & ~127u) | (unsigned)(8 * i + 4 * hf + e)); }
            SORT16_DESC(v);
            if (blk == 0) {
#pragma unroll
                for (int j = 0; j < 16; ++j) a[j] = v[j];
            } else { MERGE16_TOP(a, v); }
        }
        { float pb[16];
#pragma unroll
          for (int j = 0; j < 16; ++j) pb[j] = WDPP_(a[j], 0xb1);
          MERGE16_TOP(a, pb); }
        if (hf == 0) { LAS v4u* tp = (LAS v4u*)(L + TK_L + row * 64);
#pragma unroll
            for (int i = 0; i < 4; ++i) tp[i] = (v4u){__builtin_bit_cast(unsigned, a[4 * i]), __builtin_bit_cast(unsigned, a[4 * i + 1]), __builtin_bit_cast(unsigned, a[4 * i + 2]), __builtin_bit_cast(unsigned, a[4 * i + 3])}; }
    }
    LBAR();
    if (tid < 128) {
        const int t = tid, r0 = t, r1 = 128 + t;
        const LAS unsigned* t0 = (const LAS unsigned*)(L + TK_L + r0 * 64); const LAS unsigned* t1 = (const LAS unsigned*)(L + TK_L + r1 * 64);
        float v1[16], v2[16];
#pragma unroll
        for (int i = 0; i < 4; ++i) { const v4u x = ((const LAS v4u*)t0)[i], y = ((const LAS v4u*)t1)[i];
            v1[4 * i] = __builtin_bit_cast(float, x.x & ~127u); v1[4 * i + 1] = __builtin_bit_cast(float, x.y & ~127u); v1[4 * i + 2] = __builtin_bit_cast(float, x.z & ~127u); v1[4 * i + 3] = __builtin_bit_cast(float, x.w & ~127u);
            v2[4 * i] = __builtin_bit_cast(float, y.x & ~127u); v2[4 * i + 1] = __builtin_bit_cast(float, y.y & ~127u); v2[4 * i + 2] = __builtin_bit_cast(float, y.z & ~127u); v2[4 * i + 3] = __builtin_bit_cast(float, y.w & ~127u); }
        float c[16];
#pragma unroll
        for (int blk = 0; blk < 4; ++blk) {
            float v[16];
#pragma unroll
            for (int j = 0; j < 16; ++j) v[j] = -3.0e38f;
            { int n = 0, slot = 0;
#pragma unroll
              for (int ia = 0; ia < 16; ++ia)
#pragma unroll
                  for (int ib = 0; ib < 16; ++ib) if ((ia + 1) * (ib + 1) <= 16) { if ((n >> 4) == blk) { v[slot] = __builtin_bit_cast(float, (__builtin_bit_cast(unsigned, v1[ia] + v2[ib]) & ~255u) | (unsigned)(ia * 16 + ib)); ++slot; } ++n; } }
            SORT16_DESC(v);
            if (blk == 0) {
#pragma unroll
                for (int j = 0; j < 16; ++j) c[j] = v[j];
            } else { MERGE16_TOP(c, v); }
        }
        float ex[16], sum = 0.f; const float mx = __builtin_bit_cast(float, __builtin_bit_cast(unsigned, c[0]) & ~255u);
#pragma unroll
        for (int k = 0; k < 16; ++k) { ex[k] = fast_exp(__builtin_bit_cast(float, __builtin_bit_cast(unsigned, c[k]) & ~255u) - mx); sum += ex[k]; }
        const float inv = 1.f / sum; const size_t ob = (tok_base + t) * 128 + h * 16;
        unsigned ee[16];
#pragma unroll
        for (int k = 0; k < 16; ++k) { const unsigned code = __builtin_bit_cast(unsigned, c[k]) & 255u;
            const unsigned i1 = t0[code >> 4] & 127u, i2 = t1[code & 15u] & 127u; ee[k] = i1 * 128u + i2; }
        { GAS v4u* ep = (GAS v4u*)(eidx + ob); ep[0] = (v4u){ee[0] | (ee[1] << 16), ee[2] | (ee[3] << 16), ee[4] | (ee[5] << 16), ee[6] | (ee[7] << 16)};
          ep[1] = (v4u){ee[8] | (ee[9] << 16), ee[10] | (ee[11] << 16), ee[12] | (ee[13] << 16), ee[14] | (ee[15] << 16)};
          GAS f32x4* gp = (GAS f32x4*)(gate + ob);
#pragma unroll
          for (int k4 = 0; k4 < 4; ++k4) gp[k4] = (f32x4){ex[4 * k4] * inv, ex[4 * k4 + 1] * inv, ex[4 * k4 + 2] * inv, ex[4 * k4 + 3] * inv}; }
    }
}
struct EpiTopk {
    static constexpr bool PERM = false, AFTER_DRAIN = true;
    unsigned short* eidx; float* gate;
    __device__ __forceinline__ void operator()(pg8::f32x4 (&)[2][2][4][2], const Unit&, int, int, int, int) const {}
    __device__ __forceinline__ void fused(pg8::f32x4 (&acc)[2][2][4][2], const Unit& u, int wr, int wc, int fr, int fq, PG8_LAS unsigned char* lds) const {
        const int tid = threadIdx.x; LAS unsigned char* L = (LAS unsigned char*)lds;
#pragma unroll
        for (int ai = 0; ai < 2; ++ai) {
#pragma unroll
            for (int bj = 0; bj < 2; ++bj)
#pragma unroll
                for (int m = 0; m < 4; ++m)
#pragma unroll
                    for (int n = 0; n < 2; ++n) *(LAS f32x4*)((LAS float*)(L + TK_S) + (bj * 128 + wr * 64 + m * 16 + fr) * TK_SSTR + wc * 32 + n * 16 + 4 * fq) = acc[ai][bj][m][n];
            LBAR();
            topk_select(L, tid, (size_t)u.pm * 256 + 128 * ai, u.pn, eidx, gate);
        }
        __syncthreads();
    }
};

#define TRED3(d, lane, m0, m1, m2) do { \
    _Pragma("unroll") for (int _i = 0; _i < 8; ++_i) { const bool _h = ((lane) & (m0)) != 0; const float _k = _h ? d[_i + 8] : d[_i], _s = _h ? d[_i] : d[_i + 8]; d[_i] = _k + __shfl_xor(_s, (m0)); } \
    _Pragma("unroll") for (int _i = 0; _i < 4; ++_i) { const bool _h = ((lane) & (m1)) != 0; const float _k = _h ? d[_i + 4] : d[_i], _s = _h ? d[_i] : d[_i + 4]; d[_i] = _k + __shfl_xor(_s, (m1)); } \
    _Pragma("unroll") for (int _i = 0; _i < 2; ++_i) { const bool _h = ((lane) & (m2)) != 0; const float _k = _h ? d[_i + 2] : d[_i], _s = _h ? d[_i] : d[_i + 2]; d[_i] = _k + __shfl_xor(_s, (m2)); } } while (0)
typedef int i32x4 __attribute__((ext_vector_type(4)));
#define PX_LOAD_E(ev, tok) do { const GAS v4u* ep_ = (const GAS v4u*)(eidx + (size_t)(tok) * 128 + 16 * pg); ev[0] = ep_[0]; ev[1] = ep_[1]; } while (0)
#define PX_LOAD_ROWS8(rows, ea, base) do { const unsigned e_[8] = {ea.x & 0xffffu, ea.x >> 16, ea.y & 0xffffu, ea.y >> 16, ea.z & 0xffffu, ea.z >> 16, ea.w & 0xffffu, ea.w >> 16}; \
    _Pragma("unroll") for (int i_ = 0; i_ < 8; ++i_) rows[i_] = *(const GAS v4u*)((base) + (e_[i_] * 128u + cgo)); } while (0)
#define TRED3I(d, lane, m0, m1, m2) do { \
    _Pragma("unroll") for (int _i = 0; _i < 8; ++_i) { const bool _h = ((lane) & (m0)) != 0; const int _k = _h ? d[_i + 8] : d[_i], _s = _h ? d[_i] : d[_i + 8]; d[_i] = _k + __shfl_xor(_s, (m0)); } \
    _Pragma("unroll") for (int _i = 0; _i < 4; ++_i) { const bool _h = ((lane) & (m1)) != 0; const int _k = _h ? d[_i + 4] : d[_i], _s = _h ? d[_i] : d[_i + 4]; d[_i] = _k + __shfl_xor(_s, (m1)); } \
    _Pragma("unroll") for (int _i = 0; _i < 2; ++_i) { const bool _h = ((lane) & (m2)) != 0; const int _k = _h ? d[_i + 2] : d[_i], _s = _h ? d[_i] : d[_i + 2]; d[_i] = _k + __shfl_xor(_s, (m2)); } } while (0)
typedef int i32x2 __attribute__((ext_vector_type(2)));
typedef unsigned u32x2_t __attribute__((ext_vector_type(2)));
#define PU4_LOAD_H(ha, hb, tok) do { const GAS v4u* hp_ = (const GAS v4u*)(H8 + (size_t)(tok) * D + 256 * slice + 32 * cg); ha = hp_[0]; hb = hp_[1]; } while (0)
#define QDPP_(x, ctrl) __builtin_amdgcn_mov_dpp((x), (ctrl), 0xf, 0xf, true)
#define PU4_DOT8(rows, dd, off) do { \
    _Pragma("unroll") for (int i_ = 0; i_ < 8; ++i_) { const unsigned w_[4] = {rows[i_].x, rows[i_].y, rows[i_].z, rows[i_].w}; int sa_ = 0, sb_ = 0; \
        _Pragma("unroll") for (int q_ = 0; q_ < 4; ++q_) { sa_ = __builtin_amdgcn_sdot8((int)w_[q_], ha_[q_], sa_, false); sb_ = __builtin_amdgcn_sdot8((int)w_[q_], hb_[q_], sb_, false); } \
        dd[(off) + i_] = (sa_ << 4) + sb_; } } while (0)
__device__ __forceinline__ void peer_u_slice(unsigned char* ws_, const unsigned char* H8, int slice, int rank, int nrank) {
    const int lane = threadIdx.x & 63, wave = __builtin_amdgcn_readfirstlane(threadIdx.x >> 6);
    const int pg = lane >> 3, cg = lane & 7, wi = rank * NWAVES + wave, nw = nrank * NWAVES;
    const unsigned char* Us = ws_ + WS_U8 + (size_t)slice * ((size_t)NEXP * 128); const unsigned cgo = 16u * cg;
    const unsigned short* eidx = (const unsigned short*)(ws_ + WS_EIDX); bf16* part = (bf16*)(ws_ + WS_PART) + (size_t)slice * ML * 128;
    v4u eC[2], eN[2]; v4u r0[8], r1[8]; v4u hC0, hC1, hN0, hN1;
    PX_LOAD_E(eC, wi); PU4_LOAD_H(hC0, hC1, wi); PX_LOAD_ROWS8(r0, eC[0], Us);
#pragma unroll 1
    for (int t = wi; t < ML; t += nw) {
        const int tn = (t + nw < ML) ? t + nw : t;
        PX_LOAD_ROWS8(r1, eC[1], Us); PX_LOAD_E(eN, tn); PU4_LOAD_H(hN0, hN1, tn);
        __builtin_amdgcn_sched_barrier(0);
        const int ha_[4] = {(int)hC0.x, (int)hC0.y, (int)hC0.z, (int)hC0.w}, hb_[4] = {(int)hC1.x, (int)hC1.y, (int)hC1.z, (int)hC1.w};
        int d[16];
        PU4_DOT8(r0, d, 0);
        PX_LOAD_ROWS8(r0, eN[0], Us);
        __builtin_amdgcn_sched_barrier(0);
        PU4_DOT8(r1, d, 8);
#pragma unroll
        for (int i_ = 0; i_ < 8; ++i_) { const int a_ = d[i_] + QDPP_(d[i_], 0x12c), b_ = d[i_ + 8] + QDPP_(d[i_ + 8], 0x124); d[i_] = (lane & 4) ? b_ : a_; }
#pragma unroll
        for (int i_ = 0; i_ < 4; ++i_) { const bool h_ = (lane & 2) != 0; const int k_ = h_ ? d[i_ + 4] : d[i_], s_ = h_ ? d[i_] : d[i_ + 4]; d[i_] = k_ + QDPP_(s_, 0x4e); }
#pragma unroll
        for (int i_ = 0; i_ < 2; ++i_) { const bool h_ = (lane & 1) != 0; const int k_ = h_ ? d[i_ + 2] : d[i_], s_ = h_ ? d[i_] : d[i_ + 2]; d[i_] = k_ + QDPP_(s_, 0xb1); }
        *(GAS unsigned*)(part + (size_t)t * 128 + 2 * lane) = pk2((float)d[0], (float)d[1]);
        eC[0] = eN[0]; eC[1] = eN[1]; hC0 = hN0; hC1 = hN1;
    }
}
typedef _Float16 h16x2 __attribute__((ext_vector_type(2)));
__device__ __forceinline__ void peer_reduce(Frame& F) {
    const bf16* part = (const bf16*)(F.ws + WS_PART); const float* sh = (const float*)(F.ws + WS_SH); const unsigned short* eidx = (const unsigned short*)(F.ws + WS_EIDX); const float* gate = (const float*)(F.ws + WS_GATE);
    const float* su = (const float*)(F.ws + WS_SU); const float* sv = (const float*)(F.ws + WS_SV); unsigned* wq = (unsigned*)(F.ws + WS_WGT); float* wsc = (float*)(F.ws + WS_WGT + 4 * MiB);
    for (size_t i4 = (size_t)F.bid * NTHREADS + F.tid; i4 < (size_t)ML * 32; i4 += (size_t)F.G * NTHREADS) {
        const size_t i = 4 * i4;
        f32x4 s = (f32x4){0.f, 0.f, 0.f, 0.f};
#pragma unroll
        for (int x = 0; x < 4; ++x) { const v2u pv = *(const GAS v2u*)(part + (size_t)x * ML * 128 + i); s += (f32x4){bflo(pv.x), bfhi(pv.x), bflo(pv.y), bfhi(pv.y)}; }
        const v2u ev = *(const GAS v2u*)(eidx + i); const f32x4 gv = *(const GAS f32x4*)(gate + i); const float sht = sh[i >> 7];
        { const float hh = 0.5f * sh[ML + (i >> 7)]; s.x += hh; s.y += hh; s.z += hh; s.w += hh; }
        const unsigned e[4] = {ev.x & 0xffffu, ev.x >> 16, ev.y & 0xffffu, ev.y >> 16}; const float sv4[4] = {s.x, s.y, s.z, s.w}; const float g4[4] = {gv.x, gv.y, gv.z, gv.w};
        float w[4];
#pragma unroll
        for (int k = 0; k < 4; ++k) { const float z = sv4[k] * su[e[k]] * sht; w[k] = g4[k] * (0.5f * z * (1.f + erff(z * 0.70710678118f))) * sv[e[k]]; }
        float m = fmaxf(fmaxf(fabsf(w[0]), fabsf(w[1])), fmaxf(fabsf(w[2]), fabsf(w[3])));
        m = fmaxf(m, WDPP_(m, 0xb1)); m = fmaxf(m, WDPP_(m, 0x4e)); m = fmaxf(m, WDPP_(m, 0x141)); m = fmaxf(m, WDPP_(m, 0x140)); WSWAP_(m, 16, fmaxf);
        const float qs = (m > 0.f) ? 127.f / m : 1.f;
        const float q0 = rintf(w[0] * qs), q1 = rintf(w[1] * qs), q2 = rintf(w[2] * qs), q3 = rintf(w[3] * qs);
        wq[i4] = pack_i8x4(q0, q1, q2, q3);
        float qsum = (q0 + q1) + (q2 + q3);
        qsum += WDPP_(qsum, 0xb1); qsum += WDPP_(qsum, 0x4e); qsum += WDPP_(qsum, 0x141); qsum += WDPP_(qsum, 0x140); WSWAP_(qsum, 16, WADD_);
        if ((i4 & 31) == 0) { const float st = (m > 0.f) ? m * (1.f / 127.f) : 0.f; wsc[i >> 7] = st * (1.f / 16.f); wsc[ML + (i >> 7)] = st * 0.5f * qsum; wsc[2 * ML + (i >> 7)] = st * 8.f * qsum; }
    }
}
#define PV_LOAD_W(wv, tok) do { wv = *(const GAS v4u*)(wq + (size_t)(tok) * 128 + 16 * pg); } while (0)
#define PV4_ACC4(ra, rb, rc, rd, wd) do { const unsigned a_[4] = {ra.x, ra.y, ra.z, ra.w}, b_[4] = {rb.x, rb.y, rb.z, rb.w}, c_[4] = {rc.x, rc.y, rc.z, rc.w}, d_[4] = {rd.x, rd.y, rd.z, rd.w}; \
    _Pragma("unroll") for (int q_ = 0; q_ < 4; ++q_) { \
        const unsigned t0_ = __builtin_amdgcn_perm(b_[q_], a_[q_], 0x05010400u), t1_ = __builtin_amdgcn_perm(b_[q_], a_[q_], 0x07030602u); \
        const unsigned t2_ = __builtin_amdgcn_perm(d_[q_], c_[q_], 0x05010400u), t3_ = __builtin_amdgcn_perm(d_[q_], c_[q_], 0x07030602u); \
        const unsigned T_[4] = {__builtin_amdgcn_perm(t2_, t0_, 0x05040100u), __builtin_amdgcn_perm(t2_, t0_, 0x07060302u), __builtin_amdgcn_perm(t3_, t1_, 0x05040100u), __builtin_amdgcn_perm(t3_, t1_, 0x07060302u)}; \
        _Pragma("unroll") for (int k_ = 0; k_ < 4; ++k_) { \
            acc[8 * q_ + 2 * k_]     = __builtin_amdgcn_sdot4((int)T_[k_], (int)(wd), acc[8 * q_ + 2 * k_], false); \
            acc[8 * q_ + 2 * k_ + 1] = __builtin_amdgcn_sdot4((int)(T_[k_] & 0x0f0f0f0fu), (int)(wd), acc[8 * q_ + 2 * k_ + 1], false); } } } while (0)
__device__ __forceinline__ void peer_v_slice(unsigned char* ws_, bf16* po_, int slice, int rank, int nrank) {
    const int lane = threadIdx.x & 63, wave = __builtin_amdgcn_readfirstlane(threadIdx.x >> 6);
    const int pg = lane >> 3, cg = lane & 7, wi = rank * NWAVES + wave, nw = nrank * NWAVES;
    const unsigned char* Vs = ws_ + WS_V8 + (size_t)slice * ((size_t)NEXP * 128); const unsigned cgo = 16u * cg;
    const unsigned short* eidx = (const unsigned short*)(ws_ + WS_EIDX); const unsigned char* wq = ws_ + WS_WGT; const float* wsc = (const float*)(ws_ + WS_WGT + 4 * MiB);
    const int col = 256 * slice + 32 * cg + 4 * pg;
    v4u eC[2], eN[2]; v4u r0[8], r1[8]; v4u wC, wN; float sC, sN, oC, oN, pC, pN;
    PX_LOAD_E(eC, wi); PV_LOAD_W(wC, wi); sC = wsc[wi]; oC = wsc[ML + wi]; pC = wsc[2 * ML + wi]; PX_LOAD_ROWS8(r0, eC[0], Vs);
#pragma unroll 1
    for (int t = wi; t < ML; t += nw) {
        const int tn = (t + nw < ML) ? t + nw : t;
        PX_LOAD_ROWS8(r1, eC[1], Vs); PX_LOAD_E(eN, tn); PV_LOAD_W(wN, tn); sN = wsc[tn]; oN = wsc[ML + tn]; pN = wsc[2 * ML + tn];
        __builtin_amdgcn_sched_barrier(0);
        int acc[32];
#pragma unroll
        for (int k = 0; k < 32; ++k) acc[k] = 0;
        PV4_ACC4(r0[0], r0[1], r0[2], r0[3], wC.x); __builtin_amdgcn_sched_barrier(0);
        PV4_ACC4(r0[4], r0[5], r0[6], r0[7], wC.y);
        PX_LOAD_ROWS8(r0, eN[0], Vs);
        __builtin_amdgcn_sched_barrier(0);
        PV4_ACC4(r1[0], r1[1], r1[2], r1[3], wC.z); __builtin_amdgcn_sched_barrier(0);
        PV4_ACC4(r1[4], r1[5], r1[6], r1[7], wC.w);
#pragma unroll
        for (int i_ = 0; i_ < 16; ++i_) { const u32x2_t r_ = __builtin_amdgcn_permlane32_swap((unsigned)acc[i_], (unsigned)acc[i_ + 16], false, false); acc[i_] = (int)(r_.x + r_.y); }
#pragma unroll
        for (int i_ = 0; i_ < 8; ++i_) { const u32x2_t r_ = __builtin_amdgcn_permlane16_swap((unsigned)acc[i_], (unsigned)acc[i_ + 8], false, false); acc[i_] = (int)(r_.x + r_.y); }
#pragma unroll
        for (int i_ = 0; i_ < 4; ++i_) { const int a_ = acc[i_] + QDPP_(acc[i_], 0x128), b_ = acc[i_ + 4] + QDPP_(acc[i_ + 4], 0x128); acc[i_] = (lane & 8) ? b_ : a_; }
        v2u ov; ov.x = pk2((float)(acc[0] - acc[1]) * sC + oC, (float)acc[1] * (16.f * sC) - pC + oC); ov.y = pk2((float)(acc[2] - acc[3]) * sC + oC, (float)acc[3] * (16.f * sC) - pC + oC);
        *(GAS v2u*)(po_ + (size_t)t * D + col) = ov;
        eC[0] = eN[0]; eC[1] = eN[1]; wC = wN; sC = sN; oC = oN; pC = pN;
    }
}
__device__ __forceinline__ void final_norm(Frame& F) {
    const bf16* po = (const bf16*)(F.ws + WS_PO); const float* mod = (const float*)(F.ws + WS_MOD); const int lane = F.lane, gw = F.bid * NWAVES + F.wave, NGW = F.G * NWAVES;
    for (int t0 = gw; t0 < ML; t0 += 2 * NGW) {
        f32x4 xv[2][4]; float s2[2] = {0.f, 0.f};
#pragma unroll
        for (int r = 0; r < 2; ++r) { const int t = (t0 + r * NGW < ML) ? t0 + r * NGW : t0;
            const GAS v2u* orow0 = (const GAS v2u*)((const bf16*)(F.ws + WS_YHG) + (size_t)t * 512) + lane; const GAS v2u* orow1 = (const GAS v2u*)((const bf16*)(F.ws + WS_YPOOL) + (size_t)t * 512) + lane; const GAS v2u* prow = (const GAS v2u*)(po + (size_t)t * D) + lane;
            const GAS f32x4* g2 = (const GAS f32x4*)(mod + (size_t)(t >> 12) * 6144 + 5 * 1024) + lane;
#pragma unroll
            for (int j = 0; j < 4; ++j) { const v2u xw = (j < 2) ? orow0[64 * j] : orow1[64 * (j - 2)]; const f32x4 x1 = (f32x4){bflo(xw.x), bfhi(xw.x), bflo(xw.y), bfhi(xw.y)}, gg = g2[64 * j]; const v2u pv = prow[64 * j];
                xv[r][j] = x1 + gg * (f32x4){bflo(pv.x), bfhi(pv.x), bflo(pv.y), bfhi(pv.y)};
                s2[r] += (xv[r][j].x * xv[r][j].x + xv[r][j].y * xv[r][j].y) + (xv[r][j].z * xv[r][j].z + xv[r][j].w * xv[r][j].w); } }
#pragma unroll
        for (int r = 0; r < 2; ++r) { const int t = t0 + r * NGW; if (t < ML) {
            const float rstd = 1.f / sqrtf(wave_sum(s2[r]) * (1.f / D) + EPS); GAS f32x4* orow = (GAS f32x4*)(F.out + (size_t)t * D) + lane;
#pragma unroll
            for (int j = 0; j < 4; ++j) { const f32x4 fg = ((const GAS f32x4*)F.final_g)[lane + 64 * j]; f32x4 ov = xv[r][j] * rstd * fg;
                orow[64 * j] = ov; } } }
    }
}

constexpr int N_PHASES = 15;
__global__ void __launch_bounds__(NTHREADS, 2) fwd_kernel(Args args) {
    extern __shared__ __attribute__((aligned(16))) unsigned char lds[];
    Frame F;
    F.lds = (LAS unsigned char*)lds;
    F.tid = threadIdx.x; F.lane = F.tid & 63; F.wave = __builtin_amdgcn_readfirstlane(F.tid >> 6); F.G = gridDim.x; F.bid = blockIdx.x;
    F.x = args.in[0]; F.c = args.in[1]; F.ctx = args.in[2]; F.c_ctx = args.in[3]; F.w_mod = args.in[4]; F.b_mod = args.in[5]; F.n1g = args.in[6]; F.n2g = args.in[7];
    F.w_in = args.in[8]; F.pool_w = args.in[9]; F.pool_scale = args.in[10]; F.lb_logits = args.in[11]; F.hg_norm_g = args.in[12]; F.w_a = args.in[13]; F.w_b = args.in[14];
    F.w_o = args.in[15]; F.wq = args.in[16]; F.keys = args.in[17]; F.pu = args.in[18]; F.pv = args.in[19]; F.final_g = args.in[20];
    F.out = args.out; F.ws = args.ws;
    volatile LAS unsigned* MISC = (volatile LAS unsigned*)(F.lds + MISC_OFF);
    if (F.tid < 64) MISC[F.tid] = 0u;
    __syncthreads();
    unsigned* barw = (unsigned*)(F.ws + WS_CTL) + CW_BAR;
    XcdBarrier bar; bar.bar = barw; bar.x = 0; bar.st = nullptr;
    if (ONE_LAUNCH) bar = xcd_barrier_post(barw, MISC + 8);
    const int lo = args.ph_lo, hi = args.ph_hi;
#ifndef PH_MASK
#define PH_MASK 0x7fff
#endif
#define IN(k) (((PH_MASK >> (k)) & 1) && lo <= (k) && (k) < hi)
#define SEAM(k) do { if (IN(k) && IN((k) + 1)) xcd_barrier(bar); } while (0)

#ifndef REPP
#define REPP (-1)
#endif
#define RUNP(k, ...) do { if (IN(k)) { __VA_ARGS__ if (REPP == (k)) { __syncthreads(); __VA_ARGS__ } } } while (0)
    RUNP(0, p0_prologue(F););
    { __syncthreads(); if (F.tid == 0) { unsigned* c_ = (unsigned*)(F.ws + WS_CTL) + CW_MODCNT; XB_SPIN(xb_ld(c_) < 192u, barw); __builtin_amdgcn_fence(__ATOMIC_ACQUIRE, "agent"); asm volatile("s_waitcnt vmcnt(0)" ::: "memory"); } __syncthreads(); }
    RUNP(1, p1_modulate(F);); SEAM(1);
    RUNP(2, {
        SchedIn S{(const char*)(F.ws + WS_H), (const char*)(F.ws + WS_WIN), F.G, F.bid};
        EpiZ E{(bf16*)(F.ws + WS_Z), (bf16*)(F.ws + WS_ZC), (bf16*)(F.ws + WS_ZC2)};
        pg8::gemm_phase<EpiZ, SchedIn, true, true>(F.lds, D, S, E);
    }); SEAM(2);
    RUNP(3, {
        if (F.bid & 1) { for (int u = F.bid; u < NB * 64; u += F.G) pool_unit(F, u); }
        for (int u = F.bid; u < NSCAN; u += F.G) scan_unit(F, u);
        if (!(F.bid & 1)) { for (int u = F.bid; u < NB * 64; u += F.G) pool_unit(F, u); }
    }); if (IN(3) && IN(14)) xcd_barrier(bar);
    RUNP(14, { for (int u = F.bid; u < 256; u += F.G) prefix_unit(F, u); }); if (IN(14) && IN(4)) xcd_barrier(bar);
    int pm = 0, pn = 0; pg8::tile_of(F.bid, 64, 4, pm, pn);
    unsigned* pcnt = (unsigned*)(F.ws + WS_CTL) + CW_PANEL + pm * 16;
#define PANEL_SYNC(seam) do { asm volatile("s_waitcnt vmcnt(0)" ::: "memory"); __syncthreads(); \
        if (F.tid == 0) { unsigned* c_ = pcnt + (seam) * 1024; xb_add(c_, 1u); XB_SPIN(xb_ld(c_) < 4u, barw); __builtin_amdgcn_fence(__ATOMIC_ACQUIRE, "agent"); asm volatile("s_waitcnt vmcnt(0)" ::: "memory"); } \
        __syncthreads(); } while (0)
    RUNP(4, { fix_unit(F, pm >> 4, pn, (pm >> 1) & 7, pm & 1); });
    PANEL_SYNC(0);
    RUNP(5, {
        SchedMerge S{(const char*)(F.ws + WS_YPOOL), (const char*)(F.ws + WS_YHG), (const char*)(F.ws + WS_WPA), (const char*)(F.ws + WS_WB), F.G, F.bid};
        EpiMerge E{(const bf16*)(F.ws + WS_Z), (bf16*)(F.ws + WS_M)};
        pg8::gemm_phase<EpiMerge, SchedMerge, true, true>(F.lds, 512, S, E);
    });
    PANEL_SYNC(1);
    RUNP(6, {
        SchedTile S{(const char*)(F.ws + WS_M), (const char*)(F.ws + WS_WO), D, pm, pn};
        EpiRes E{F.x, (const float*)(F.ws + WS_MOD), (bf16*)(F.ws + WS_YHG), (bf16*)(F.ws + WS_YPOOL)};
        pg8::gemm_phase<EpiRes, SchedTile, true, true>(F.lds, D, S, E);
    });
    PANEL_SYNC(2);
    RUNP(7, {
        const float* mod = (const float*)(F.ws + WS_MOD) + (pm >> 4) * 6144; bf16* H2 = (bf16*)(F.ws + WS_M);
        const bf16* X0 = (const bf16*)(F.ws + WS_YHG); const bf16* X1 = (const bf16*)(F.ws + WS_YPOOL); unsigned char* H8 = (unsigned char*)F.out + OUT_QSEG;
        const size_t m0 = (size_t)pm * 256 + pn * 64 + F.wave * 8;
        v2u xc[4]; mrq_load(X0 + m0 * 512, X1 + m0 * 512, F.lane, xc);
        _Pragma("unroll 1") for (int i = 0; i < 8; ++i) { const size_t m = m0 + i, mn = m0 + (i < 7 ? i + 1 : i);
            v2u xn[4]; mrq_load(X0 + mn * 512, X1 + mn * 512, F.lane, xn);
            mrq_finish(xc, H2 + m * D, H8 + m * D, (float*)(F.ws + WS_SH) + m, (float*)(F.ws + WS_SH) + ML + m, F.n2g, mod + 3 * 1024, mod + 4 * 1024, F.lane);
            xc[0] = xn[0]; xc[1] = xn[1]; xc[2] = xn[2]; xc[3] = xn[3]; }
    }); xcd_barrier(bar);
    RUNP(8, {
#define P7B_TABLES() do { const int gw = F.bid * NWAVES + F.wave, NGW = F.G * NWAVES; \
          i4_rows(F.pu, F.ws + WS_U8, (float*)(F.ws + WS_SU), gw, NGW, F.lane, false); \
          i4_rows(F.pv, F.ws + WS_V8, (float*)(F.ws + WS_SV), gw, NGW, F.lane, true); } while (0)
        if (F.bid & 1) { P7B_TABLES(); __syncthreads(); }
        EpiTopk E{(unsigned short*)(F.ws + WS_EIDX), (float*)(F.ws + WS_GATE)};
        { SchedTile S{(const char*)(F.ws + WS_M), (const char*)(F.ws + WS_WQ), D, pm, pn};
          pg8::gemm_phase<EpiTopk, SchedTile, true, true>(F.lds, D, S, E); }
        __syncthreads();
        { SchedTile S{(const char*)(F.ws + WS_M), (const char*)(F.ws + WS_WQ), D, pm, pn + 4};
          pg8::gemm_phase<EpiTopk, SchedTile, true, true>(F.lds, D, S, E); }
        if (!(F.bid & 1)) { __syncthreads(); P7B_TABLES(); }
    }); xcd_barrier(bar);
    int pslice = F.bid & 7, prank = F.bid >> 3; const int pnrank = F.G >> 3;
    if (ONE_LAUNCH && (IN(10) || IN(12))) {
        bool okc = (F.G == 256) && (bar.x < 8u);
#pragma unroll
        for (int j = 0; j < 8; ++j) okc = okc && (xb_ld(&barw[XB_XCNT(j)]) == 32u);
        if (okc) { pslice = (int)bar.x; prank = (int)MISC[10]; }
    }
    RUNP(10, peer_u_slice(F.ws, (const unsigned char*)F.out + OUT_QSEG, pslice & 3, (pslice >> 2) * pnrank + prank, 2 * pnrank);); SEAM(10);
    RUNP(11, peer_reduce(F);); SEAM(11);
    RUNP(12, peer_v_slice(F.ws, (bf16*)(F.ws + WS_PO), pslice & 3, (pslice >> 2) * pnrank + prank, 2 * pnrank);); SEAM(12);
    RUNP(13, final_norm(F););
#undef RUNP
#undef IN
#undef SEAM
}

extern "C" void kernel_launch(void* const* d_in, const int* in_sizes, int n_in, void* d_out, int out_size, void* d_ws, size_t ws_size, hipStream_t stream) {
    static int grid = 0;
    if (grid == 0) {
        if (n_in != 21 || out_size != ML * D || ws_size < WS_END) { fprintf(stderr, "kernel_launch: unexpected problem (n_in %d, out %d, ws %zu)\n", n_in, out_size, ws_size); grid = -1; return; }
        int dev = 0, cus = 0;
        if (hipGetDevice(&dev) != hipSuccess || hipDeviceGetAttribute(&cus, hipDeviceAttributeMultiprocessorCount, dev) != hipSuccess) { grid = -1; return; }
        if (hipFuncSetAttribute((const void*)fwd_kernel, hipFuncAttributeMaxDynamicSharedMemorySize, LDS_BYTES) != hipSuccess) { fprintf(stderr, "kernel_launch: hipFuncSetAttribute failed\n"); grid = -1; return; }
        int per_cu = 0;
        if (hipOccupancyMaxActiveBlocksPerMultiprocessor(&per_cu, (const void*)fwd_kernel, NTHREADS, LDS_BYTES) != hipSuccess || per_cu < 1) fprintf(stderr, "kernel_launch: occupancy query says %d\n", per_cu);
        (void)hipGetLastError();
        if (cus != 256) { fprintf(stderr, "kernel_launch: the row-panel chain is laid out for 256 workgroups (one per CU), found %d CUs\n", cus); grid = -1; return; }
        grid = cus;
    }
    if (grid < 0) return;
    (void)hipMemsetAsync((char*)d_ws + WS_CTL, 0, CTL_ZERO_BYTES, stream);
    Args a{};
    for (int i = 0; i < 21; ++i) a.in[i] = (const float*)d_in[i];
    a.out = (float*)d_out; a.ws = (unsigned char*)d_ws;
#if ONE_LAUNCH
    a.ph_lo = 0; a.ph_hi = N_PHASES;
    hipLaunchKernelGGL(fwd_kernel, dim3(grid), dim3(NTHREADS), LDS_BYTES, stream, a);
#else
    static const int order[N_PHASES - 1] = {0, 1, 2, 3, 14, 4, 5, 6, 7, 8, 10, 11, 12, 13};
    for (int pi = 0; pi < N_PHASES - 1; ++pi) { const int p = order[pi]; a.ph_lo = p; a.ph_hi = p + 1; hipLaunchKernelGGL(fwd_kernel, dim3(grid), dim3(NTHREADS), LDS_BYTES, stream, a); }
#endif
}
```

```cpp
#define ONE_LAUNCH 1
#include <hip/hip_runtime.h>
#include <cstdio>
#include <cstdint>

#ifndef ONE_LAUNCH
#define ONE_LAUNCH 1
#endif

namespace pg8 {
#define PG8_LAS __attribute__((address_space(3)))
typedef unsigned short bf16_t;
typedef short bf16x8 __attribute__((ext_vector_type(8)));
typedef float f32x4 __attribute__((ext_vector_type(4)));
typedef float f32x2 __attribute__((ext_vector_type(2)));
typedef unsigned u32x4 __attribute__((ext_vector_type(4)));
typedef unsigned u32x2 __attribute__((ext_vector_type(2)));
constexpr int BM = 256, BK = 64, HALF = 128, HTB = HALF * BK * 2, STAGE_BYTES = 8 * HTB, NXCD = 8, WGM = 8;

__host__ __device__ __forceinline__ int lds_byte(int r, int c) { const int st = (r >> 4) * 2 + (c >> 5), rr = r & 15, cc = c & 31, ob = rr * 64 + cc * 2; return st * 1024 + (ob ^ (((ob >> 9) & 1) << 5)); }
__host__ __device__ __forceinline__ void stage_rc(int b, int& R, int& C) { const int st = b / 1024, sb = b % 1024, swz = sb ^ (((sb >> 9) & 1) << 5); R = (st >> 1) * 16 + swz / 64; C = (st & 1) * 32 + (swz % 64) / 2; }
__host__ __device__ __forceinline__ int perm32(int rho) { const int n = rho >> 4, i = rho & 15; return 8 * (i >> 2) + 4 * n + (i & 3); }

struct Unit { int pm, pn, seg; };

__host__ __device__ __forceinline__ void tile_of(int wgid, int nM, int nN, int& pm, int& pn) {
    const int nwg = nM * nN;
    { const int q = nwg / NXCD, r = nwg % NXCD, xcd = wgid % NXCD, off = wgid / NXCD; wgid = (xcd < r ? xcd * (q + 1) : r * (q + 1) + (xcd - r) * q) + off; }
    const int nig = WGM * nN, gid = wgid / nig, fm = gid * WGM, gsz = (nM - fm) < WGM ? (nM - fm) : WGM;
    pm = fm + ((wgid % nig) % gsz); pn = (wgid % nig) / gsz;
}

typedef __bf16 bf16x2_t __attribute__((ext_vector_type(2)));
__device__ __forceinline__ unsigned cvt_pk_bf16(float lo, float hi) { bf16x2_t v; v.x = (__bf16)lo; v.y = (__bf16)hi; return __builtin_bit_cast(unsigned, v); }
__device__ __forceinline__ void st_wt8(void* p, u32x2 v) { asm volatile("global_store_dwordx2 %0, %1, off sc1\n\ts_nop 1" :: "v"(p), "v"(v)); }
__device__ __forceinline__ void st_wt16(void* p, u32x4 v) { asm volatile("global_store_dwordx4 %0, %1, off sc1\n\ts_nop 1" :: "v"(p), "v"(v)); }

template <class Epi, class Sched, bool ALIGN_EPI = false, bool SP2 = false>
__device__ __forceinline__ void gemm_phase(PG8_LAS unsigned char* lds, const int ld, const Sched& S, const Epi& E) {
    const int tid = threadIdx.x, wid = __builtin_amdgcn_readfirstlane(tid >> 6), lane = tid & 63, wr = wid >> 2, wc = wid & 3, fr = lane & 15, fq = lane >> 4;
    unsigned voffA[2], voffB[2];
#pragma unroll
    for (int i = 0; i < 2; ++i) { int R, C; stage_rc(tid * 16 + i * 8192, R, C); const int Rb = Epi::PERM ? ((R & ~31) + perm32(R & 31)) : R;
        voffA[i] = (unsigned)(R * ld + C) * 2u; voffB[i] = (unsigned)(Rb * ld + C) * 2u; }
    const size_t kstep = (size_t)(BK * 2);
    const size_t hstep = (size_t)HALF * ld * 2;
    const unsigned ldsw = (unsigned)wid * 1024u;
    const int aoff = lds_byte(wr * 64 + fr, fq * 8), boff = lds_byte(wc * 32 + fr, fq * 8);
#define PG8_SA(b, h) (((b) * 2 + (h)) * HTB)
#define PG8_SB(b, h) ((4 + (b) * 2 + (h)) * HTB)
#define PG8_STAGE(bufoff, gbase, voff) do { _Pragma("unroll") for (int _i = 0; _i < 2; ++_i) \
        __builtin_amdgcn_global_load_lds((const unsigned*)((const char*)(gbase) + (voff)[_i]), (PG8_LAS unsigned*)(lds + (bufoff) + ldsw + _i * 8192), 16, 0, 0); } while (0)
#define PG8_LDA(dst, b, h) do { _Pragma("unroll") for (int m = 0; m < 4; ++m) _Pragma("unroll") for (int k = 0; k < 2; ++k) dst[m][k] = *(const PG8_LAS bf16x8*)(lds + PG8_SA(b, h) + aoff + m * 2048 + k * 1024); } while (0)
#define PG8_LDB(dst, b, h) do { _Pragma("unroll") for (int n = 0; n < 2; ++n) _Pragma("unroll") for (int k = 0; k < 2; ++k) dst[n][k] = *(const PG8_LAS bf16x8*)(lds + PG8_SB(b, h) + boff + n * 2048 + k * 1024); } while (0)
#define PG8_MMA(ai, bj, At, Bt) do { __builtin_amdgcn_s_setprio(1); _Pragma("unroll") for (int m = 0; m < 4; ++m) _Pragma("unroll") for (int n = 0; n < 2; ++n) _Pragma("unroll") for (int k = 0; k < 2; ++k) \
        acc[ai][bj][m][n] = __builtin_amdgcn_mfma_f32_16x16x32_bf16(Bt[n][k], At[m][k], acc[ai][bj][m][n], 0, 0, 0); __builtin_amdgcn_s_setprio(0); } while (0)
#define PG8_WAIT_V(n) asm volatile("s_waitcnt vmcnt(" #n ")" ::: "memory")
#define PG8_WAIT_L(n) asm volatile("s_waitcnt lgkmcnt(" #n ")" ::: "memory")
#define PG8_BAR __builtin_amdgcn_s_barrier()
#define PG8_SCHED __builtin_amdgcn_sched_barrier(0)
    Unit cur, nxt; int ui = 0;
    if (!S.next(0, cur)) return;
    f32x4 acc[2][2][4][2];
#pragma unroll
    for (int a = 0; a < 2; ++a)
#pragma unroll
        for (int b = 0; b < 2; ++b)
#pragma unroll
            for (int m = 0; m < 4; ++m)
#pragma unroll
                for (int n = 0; n < 2; ++n) acc[a][b][m][n] = (f32x4){0.f, 0.f, 0.f, 0.f};
    bf16x8 At[4][2], B0[2][2], B1[2][2];
    const char* cA = S.A(cur); const char* cB = S.B(cur);
    if constexpr (SP2) {
        PG8_STAGE(PG8_SB(0, 0), cB, voffB); PG8_STAGE(PG8_SB(0, 1), cB + hstep, voffB); PG8_STAGE(PG8_SA(0, 0), cA, voffA); PG8_STAGE(PG8_SA(0, 1), cA + hstep, voffA);
        if (wr == 1) PG8_BAR;
        PG8_WAIT_V(2); PG8_BAR;
        PG8_STAGE(PG8_SB(1, 0), cB + kstep, voffB); PG8_STAGE(PG8_SA(1, 0), cA + kstep, voffA); PG8_STAGE(PG8_SB(1, 1), cB + hstep + kstep, voffB);
        PG8_WAIT_V(6); PG8_BAR;
    } else {
        PG8_STAGE(PG8_SB(0, 0), cB, voffB); PG8_STAGE(PG8_SA(0, 0), cA, voffA); PG8_STAGE(PG8_SB(0, 1), cB + hstep, voffB); PG8_STAGE(PG8_SA(0, 1), cA + hstep, voffA);
        if (wr == 1) PG8_BAR;
        PG8_WAIT_V(4); PG8_BAR;
        PG8_STAGE(PG8_SB(1, 0), cB + kstep, voffB); PG8_STAGE(PG8_SA(1, 0), cA + kstep, voffA); PG8_STAGE(PG8_SB(1, 1), cB + hstep + kstep, voffB);
        PG8_WAIT_V(6); PG8_BAR;
    }
    for (;;) {
        const bool has_next = S.next(ui + 1, nxt); const int nt = S.nt(cur);
        const char* nA = has_next ? S.A(nxt) : cA; const char* nB = has_next ? S.B(nxt) : cB;
        for (int t = 0; t < nt; t += 2) {
            const bool last = (t == nt - 2);
            const char* a1 = cA + (size_t)(t + 1) * kstep;
            const char* a2 = last ? nA : cA + (size_t)(t + 2) * kstep; const char* b2 = last ? nB : cB + (size_t)(t + 2) * kstep;
            const char* a3 = a2 + kstep; const char* b3 = b2 + kstep;
            if constexpr (SP2) {
            PG8_LDB(B0, 0, 0); PG8_LDB(B1, 0, 1); PG8_SCHED; PG8_LDA(At, 0, 0); PG8_STAGE(PG8_SA(1, 1), a1 + hstep, voffA);
            PG8_WAIT_V(8); PG8_WAIT_L(0); PG8_BAR; PG8_MMA(0, 0, At, B0); PG8_MMA(0, 1, At, B1); PG8_BAR; PG8_SCHED;
            PG8_LDA(At, 0, 1); PG8_STAGE(PG8_SB(0, 0), b2, voffB); PG8_STAGE(PG8_SB(0, 1), b2 + hstep, voffB); PG8_STAGE(PG8_SA(0, 0), a2, voffA);
            PG8_WAIT_V(8); PG8_WAIT_L(0); PG8_BAR; PG8_MMA(1, 0, At, B0); PG8_MMA(1, 1, At, B1); PG8_BAR; PG8_SCHED;
            PG8_LDB(B0, 1, 0); PG8_LDB(B1, 1, 1); PG8_SCHED; PG8_LDA(At, 1, 0); PG8_STAGE(PG8_SA(0, 1), a2 + hstep, voffA);
            PG8_WAIT_V(8); PG8_WAIT_L(0); PG8_BAR; PG8_MMA(0, 0, At, B0); PG8_MMA(0, 1, At, B1); PG8_BAR; PG8_SCHED;
            PG8_LDA(At, 1, 1); PG8_STAGE(PG8_SB(1, 0), b3, voffB); PG8_STAGE(PG8_SB(1, 1), b3 + hstep, voffB); PG8_STAGE(PG8_SA(1, 0), a3, voffA);
            PG8_WAIT_V(8); PG8_WAIT_L(0); PG8_BAR; PG8_MMA(1, 0, At, B0); PG8_MMA(1, 1, At, B1); PG8_BAR; PG8_SCHED;
            } else {
            PG8_LDB(B0, 0, 0); PG8_SCHED; PG8_LDA(At, 0, 0); PG8_STAGE(PG8_SA(1, 1), a1 + hstep, voffA);
            PG8_WAIT_L(8); PG8_BAR; PG8_WAIT_L(0); PG8_MMA(0, 0, At, B0); PG8_BAR; PG8_SCHED;
            PG8_LDB(B1, 0, 1); PG8_STAGE(PG8_SB(0, 0), b2, voffB);
            PG8_BAR; PG8_WAIT_L(0); PG8_MMA(0, 1, At, B1); PG8_BAR;
            PG8_LDA(At, 0, 1); PG8_STAGE(PG8_SA(0, 0), a2, voffA);
            PG8_BAR; PG8_WAIT_L(0); PG8_MMA(1, 0, At, B0); PG8_BAR; PG8_SCHED;
            PG8_STAGE(PG8_SB(0, 1), b2 + hstep, voffB);
            PG8_WAIT_V(6); PG8_BAR; PG8_MMA(1, 1, At, B1); PG8_BAR;
            PG8_LDB(B0, 1, 0); PG8_SCHED; PG8_LDA(At, 1, 0); PG8_STAGE(PG8_SA(0, 1), a2 + hstep, voffA);
            PG8_WAIT_L(8); PG8_BAR; PG8_WAIT_L(0); PG8_MMA(0, 0, At, B0); PG8_BAR; PG8_SCHED;
            PG8_LDB(B1, 1, 1); PG8_STAGE(PG8_SB(1, 0), b3, voffB);
            PG8_BAR; PG8_WAIT_L(0); PG8_MMA(0, 1, At, B1); PG8_BAR;
            PG8_LDA(At, 1, 1); PG8_STAGE(PG8_SA(1, 0), a3, voffA);
            PG8_BAR; PG8_WAIT_L(0); PG8_MMA(1, 0, At, B0); PG8_BAR; PG8_SCHED;
            PG8_STAGE(PG8_SB(1, 1), b3 + hstep, voffB);
            PG8_WAIT_V(6); PG8_BAR; PG8_MMA(1, 1, At, B1); PG8_BAR;
            }
        }
        if constexpr (ALIGN_EPI) { if (wr == 0) PG8_BAR; }
        if constexpr (!Epi::AFTER_DRAIN) E(acc, cur, wr, wc, fr, fq);
        if (!has_next) break;
        if (!S.keep(cur)) {
#pragma unroll
        for (int a = 0; a < 2; ++a)
#pragma unroll
            for (int b = 0; b < 2; ++b)
#pragma unroll
                for (int m = 0; m < 4; ++m)
#pragma unroll
                    for (int n = 0; n < 2; ++n) acc[a][b][m][n] = (f32x4){0.f, 0.f, 0.f, 0.f};
        }
        cur = nxt; cA = nA; cB = nB; ++ui;
        if constexpr (ALIGN_EPI) { if (wr == 1) PG8_BAR; }
    }
    PG8_WAIT_V(0);
    if constexpr (!ALIGN_EPI) { if (wr == 0) PG8_BAR; }
    PG8_BAR;
    if constexpr (Epi::AFTER_DRAIN) E.fused(acc, cur, wr, wc, fr, fq, lds);
#undef PG8_SA
#undef PG8_SB
#undef PG8_STAGE
#undef PG8_LDA
#undef PG8_LDB
#undef PG8_MMA
#undef PG8_WAIT_V
#undef PG8_WAIT_L
#undef PG8_BAR
#undef PG8_SCHED
}
}

constexpr int D = 1024, NB = 4, SEQ = 4096, CTXL = 256;
constexpr int ML = NB * SEQ;
constexpr int MC = NB * CTXL;
constexpr int MH = ML + MC;
constexpr int INW = 5120;
constexpr int ZC_W = 1536;
constexpr int NEXP = 16384, NHEAD_P = 8, TOPK = 16;
constexpr float EPS = 1e-6f;
constexpr int NWAVES = 8, NTHREADS = 512;
constexpr int SEGT = 512, NSEG = SEQ / SEGT;
constexpr int CHT = 32;
constexpr int NSCAN_L = NB * 4 * 2 * NSEG;
constexpr int NCSEG = 4;
constexpr int NSCAN = NSCAN_L + NB * 4 * 2 * NCSEG;

constexpr size_t MiB = 1u << 20;
constexpr size_t WS_CTL = 0, CTL_ZERO_BYTES = 64 * 1024;
constexpr size_t WS_MOD = 1 * MiB;
constexpr size_t WS_LBT = WS_MOD + 128 * 1024;
constexpr size_t WS_ASEG = WS_LBT + 8 * 1024;
constexpr size_t WS_SU = WS_ASEG + 200 * 1024;
constexpr size_t WS_SV = WS_SU + 64 * 1024;
constexpr size_t WS_WIN = 2 * MiB;
constexpr size_t WS_WA = 12 * MiB, WS_WB = 13 * MiB, WS_WO = 14 * MiB, WS_WQ = 16 * MiB;
constexpr size_t WS_WPA = 20 * MiB;
constexpr size_t WS_ZC = 21 * MiB;
constexpr int ZW = 2560;
constexpr size_t WS_ZA = 24 * MiB, WS_ZB = 104 * MiB;
constexpr size_t WS_EIDX = 88 * MiB;
constexpr size_t WS_GATE = 96 * MiB;
constexpr size_t WS_U8 = 40 * MiB, WS_V8 = 48 * MiB;
constexpr size_t WS_PART = 24 * MiB;
constexpr size_t WS_WGT = 104 * MiB;
constexpr size_t WS_SH = WS_ASEG;
constexpr size_t WS_PO = 144 * MiB;
constexpr size_t WS_SSQ = 21 * MiB;
constexpr size_t WS_H = 184 * MiB;
constexpr size_t WS_YHG = 184 * MiB, WS_YPOOL = 200 * MiB;
constexpr size_t WS_USEG = 218 * MiB;
constexpr size_t WS_PFX = 2 * MiB;
constexpr size_t WS_M = 218 * MiB;
constexpr size_t WS_ZC2 = 252 * MiB;
constexpr size_t WS_END = 255 * MiB;
static_assert(WS_ZA + (size_t)ML * ZW * 2 <= WS_ZB && WS_ZB + (size_t)ML * ZW * 2 <= WS_H && WS_H + (size_t)MH * D * 2 <= WS_USEG && WS_USEG + (size_t)NSCAN * 128 * 128 * 4 <= WS_END && WS_M + (size_t)ML * D * 2 <= WS_END && WS_USEG + (size_t)NSCAN * 128 * 128 * 4 <= WS_ZC2 && WS_PFX + 8 * MiB <= WS_WA, "ws map");
static_assert(WS_PART + (size_t)4 * ML * 128 * 2 <= WS_U8 && WS_U8 + (size_t)NEXP * 512 <= WS_V8 && WS_V8 + (size_t)NEXP * 512 <= WS_EIDX, "ws map 2");
constexpr size_t OUT_OLOC = 0, OUT_QSEG = 32 * MiB;
constexpr int CW_BAR = 1024;
constexpr int CW_MODCNT = 12544;
constexpr int CW_PANEL = 8192;

constexpr int LDS_BYTES = 163840;
constexpr int MISC_OFF = LDS_BYTES - 256;

#define GAS __attribute__((address_space(1)))
#define LAS __attribute__((address_space(3)))
typedef unsigned short bf16;
typedef unsigned v4u __attribute__((ext_vector_type(4)));
typedef unsigned v2u __attribute__((ext_vector_type(2)));
typedef float f32x4 __attribute__((ext_vector_type(4)));
typedef float f32x2 __attribute__((ext_vector_type(2)));
typedef short bf16x8 __attribute__((ext_vector_type(8)));
typedef short s16x4 __attribute__((ext_vector_type(4)));
#define LDS_WAIT() asm volatile("s_waitcnt lgkmcnt(0)" ::: "memory")
#define VM_WAIT() asm volatile("s_waitcnt vmcnt(0)" ::: "memory")
#define LBAR() do { asm volatile("s_waitcnt lgkmcnt(0)" ::: "memory"); __builtin_amdgcn_s_barrier(); asm volatile("" ::: "memory"); } while (0)
__device__ __forceinline__ unsigned f2bf(float f) { unsigned u = __builtin_bit_cast(unsigned, f); return (u + 0x7fffu + ((u >> 16) & 1u)) >> 16; }
__device__ __forceinline__ unsigned pk2(float lo, float hi) { return pg8::cvt_pk_bf16(lo, hi); }
__device__ __forceinline__ float bflo(unsigned w) { return __builtin_bit_cast(float, w << 16); }
__device__ __forceinline__ float bfhi(unsigned w) { return __builtin_bit_cast(float, w & 0xffff0000u); }
__device__ __forceinline__ float fast_exp(float x) { return __builtin_amdgcn_exp2f(x * 1.4426950408889634f); }
__device__ __forceinline__ float fast_rcp(float x) { return __builtin_amdgcn_rcpf(x); }
__device__ __forceinline__ float sigmoidf_(float x) { return fast_rcp(1.f + fast_exp(-x)); }
__device__ __forceinline__ unsigned pack_i8x4(float a, float b, float c, float d) {
    const int ia = (int)rintf(a), ib = (int)rintf(b), ic = (int)rintf(c), id = (int)rintf(d);
    return ((unsigned)ia & 255u) | (((unsigned)ib & 255u) << 8) | (((unsigned)ic & 255u) << 16) | (((unsigned)id & 255u) << 24);
}
#define WDPP_(v, ctrl) __builtin_bit_cast(float, __builtin_amdgcn_mov_dpp(__builtin_bit_cast(int, (v)), (ctrl), 0xf, 0xf, true))
typedef unsigned wr_u2 __attribute__((ext_vector_type(2)));
#define WSWAP_(v, which, OP) do { unsigned w_ = __builtin_bit_cast(unsigned, (v)); asm volatile("" : "+v"(w_)); \
    const wr_u2 r_ = __builtin_amdgcn_permlane##which##_swap(__builtin_bit_cast(unsigned, (v)), w_, false, false); const unsigned ra_ = r_.x, rb_ = r_.y; (v) = OP(__builtin_bit_cast(float, ra_), __builtin_bit_cast(float, rb_)); } while (0)
#define WADD_(a, b) ((a) + (b))
__device__ __forceinline__ float wave_sum(float v) {
    v += WDPP_(v, 0xb1); v += WDPP_(v, 0x4e); v += WDPP_(v, 0x141); v += WDPP_(v, 0x140);
    WSWAP_(v, 16, WADD_); WSWAP_(v, 32, WADD_);
    return v;
}
__device__ __forceinline__ float wave_max(float v) {
    v = fmaxf(v, WDPP_(v, 0xb1)); v = fmaxf(v, WDPP_(v, 0x4e)); v = fmaxf(v, WDPP_(v, 0x141)); v = fmaxf(v, WDPP_(v, 0x140));
    WSWAP_(v, 16, fmaxf); WSWAP_(v, 32, fmaxf);
    return v;
}

#define XB_TMO      128
#define XB_XCNT(j)  (256  + 64 * (j))
#define XB_XSUB(j)  (1280 + 64 * (j))
#define XB_XGEN(j)  (2304 + 64 * (j))
#define XB_TOP      3328
#define XB_TOPGEN   3392
#define XCD_BAR_WORDS 3456
#define XB_SPIN_CAP (1u << 18)
__device__ __forceinline__ unsigned xb_ld(unsigned* p)              { return __hip_atomic_load(p, __ATOMIC_RELAXED, __HIP_MEMORY_SCOPE_AGENT); }
__device__ __forceinline__ unsigned xb_add(unsigned* p, unsigned v) { return __hip_atomic_fetch_add(p, v, __ATOMIC_RELAXED, __HIP_MEMORY_SCOPE_AGENT); }
__device__ __forceinline__ unsigned xb_xcc_id() { return (unsigned)__builtin_amdgcn_s_getreg((3 << 11) | 20) & 0xFu; }
#define XB_SPIN(cond, bar) do { unsigned _sp = 0; while (cond) { __builtin_amdgcn_s_sleep(1); \
    if ((++_sp & 255u) == 0u) { if (xb_ld(&(bar)[XB_TMO])) break; if (_sp > XB_SPIN_CAP) { atomicAdd(&(bar)[XB_TMO], 1u); break; } } } } while (0)
struct XcdBarrier { unsigned* bar; unsigned x; volatile LAS unsigned* st; };
__device__ __forceinline__ XcdBarrier xcd_barrier_post(unsigned* bar, volatile LAS unsigned* st) {
    XcdBarrier b; b.bar = bar; b.x = xb_xcc_id(); b.st = st;
    if (threadIdx.x == 0) st[2] = xb_add(&bar[XB_XCNT(b.x)], 1u);
    return b;
}
__device__ __forceinline__ void xcd_barrier_complete(unsigned* bar, unsigned x, unsigned& nloc, unsigned& nx) {
    const unsigned G = gridDim.x * gridDim.y * gridDim.z;
    unsigned sum, cnt, mine, sp = 0u;
    for (;;) {
        sum = 0u; cnt = 0u; mine = 0u;
#pragma unroll
        for (unsigned j = 0; j < 16; ++j) { const unsigned c = xb_ld(&bar[XB_XCNT(j)]); sum += c; cnt += (c > 0u) ? 1u : 0u; mine = (j == x) ? c : mine; }
        if (sum == G) break;
        __builtin_amdgcn_s_sleep(1);
        if ((++sp & 255u) == 0u) { if (xb_ld(&bar[XB_TMO])) break; if (sp > XB_SPIN_CAP) { atomicAdd(&bar[XB_TMO], 1u); break; } }
    }
    nloc = mine > 0u ? mine : 1u; nx = cnt > 0u ? cnt : 1u;
}
__device__ __forceinline__ void xcd_barrier(const XcdBarrier& b) {
    asm volatile("s_waitcnt vmcnt(0)" ::: "memory");
    __syncthreads();
    if (threadIdx.x == 0) {
        unsigned* bar = b.bar;
        __builtin_amdgcn_s_waitcnt(0);
        unsigned nloc = b.st[0], nx = b.st[1];
        if (nloc == 0u) { xcd_barrier_complete(bar, b.x, nloc, nx); b.st[0] = nloc; b.st[1] = nx; }
        const unsigned old = xb_add(&bar[XB_XSUB(b.x)], 1u);
        const unsigned gen = old / nloc;
        if (old + 1u == (gen + 1u) * nloc) {
            __builtin_amdgcn_fence(__ATOMIC_RELEASE, "agent");
            asm volatile("s_waitcnt vmcnt(0)" ::: "memory");
            const unsigned og = xb_add(&bar[XB_TOP], 1u);
            const unsigned tg = og / nx;
            if (og + 1u == (tg + 1u) * nx) xb_add(&bar[XB_TOPGEN], 1u);
            else XB_SPIN(xb_ld(&bar[XB_TOPGEN]) == tg, bar);
            __builtin_amdgcn_fence(__ATOMIC_ACQUIRE, "agent");
            xb_add(&bar[XB_XGEN(b.x)], 1u);
            asm volatile("s_waitcnt vmcnt(0)" ::: "memory");
        } else {
            XB_SPIN(xb_ld(&bar[XB_XGEN(b.x)]) == gen, bar);
            __builtin_amdgcn_fence(__ATOMIC_ACQUIRE, "agent");
            asm volatile("s_waitcnt vmcnt(0)" ::: "memory");
        }
    }
    __syncthreads();
}

struct Args { const float* in[21]; float* out; unsigned char* ws; int ph_lo, ph_hi; };

struct Frame {
    LAS unsigned char* lds; int tid, lane, wave, G, bid;
    const float *x, *c, *ctx, *c_ctx, *w_mod, *b_mod, *n1g, *n2g, *w_in, *pool_w, *pool_scale, *lb_logits, *hg_norm_g, *w_a, *w_b, *w_o, *wq, *keys, *pu, *pv, *final_g;
    float* out; unsigned char* ws;
};

__device__ __forceinline__ void p0_transpose_item(const float* W, int K, int N, bf16* WT, LAS float* scr, int item, int lane) {
    const int nblk = N / 32, kb = item / nblk, nb = item % nblk, k0 = 64 * kb, n0 = 32 * nb;
#pragma unroll 8
    for (int i = 0; i < 32; ++i) { const int kk = 2 * i + (lane >> 5); scr[kk * 33 + (lane & 31)] = W[(size_t)(k0 + kk) * N + n0 + (lane & 31)]; }
    LDS_WAIT(); asm volatile("" ::: "memory");
    const int c = lane & 7;
#pragma unroll
    for (int j = 0; j < 4; ++j) { const int n = (lane >> 3) + 8 * j; const LAS float* s = scr + (8 * c) * 33 + n;
        v4u o; o.x = pk2(s[0 * 33], s[1 * 33]); o.y = pk2(s[2 * 33], s[3 * 33]); o.z = pk2(s[4 * 33], s[5 * 33]); o.w = pk2(s[6 * 33], s[7 * 33]);
        *(GAS v4u*)(WT + (size_t)(n0 + n) * K + k0 + 8 * c) = o; }
    LDS_WAIT(); asm volatile("" ::: "memory");
}

__device__ __forceinline__ void p0_prologue(Frame& F) {
    float* mod = (float*)(F.ws + WS_MOD);
    if (F.bid < 192) {
        LAS float* sl = (LAS float*)(F.lds + 81920);
        LAS float* red = (LAS float*)(F.lds + 81920 + 20480);
        for (int i = F.tid; i < 5 * 1024; i += NTHREADS) { const float cv = (i < 4096) ? F.c[i] : F.c_ctx[i - 4096]; sl[i] = cv * sigmoidf_(cv); }
        __syncthreads();
        const int col = F.tid & 31, kg = F.tid >> 5, col0 = 32 * F.bid;
        float a0 = 0.f, a1 = 0.f, a2 = 0.f, a3 = 0.f, a4 = 0.f;
        const float* wp = F.w_mod + (size_t)(kg * 64) * 6144 + col0 + col;
#pragma unroll 8
        for (int r = 0; r < 64; ++r) { const float w = wp[(size_t)r * 6144]; const int k = kg * 64 + r;
            a0 += w * sl[k]; a1 += w * sl[1024 + k]; a2 += w * sl[2048 + k]; a3 += w * sl[3072 + k]; a4 += w * sl[4096 + k]; }
        red[(kg * 5 + 0) * 32 + col] = a0; red[(kg * 5 + 1) * 32 + col] = a1; red[(kg * 5 + 2) * 32 + col] = a2; red[(kg * 5 + 3) * 32 + col] = a3; red[(kg * 5 + 4) * 32 + col] = a4;
        __syncthreads();
        if (F.tid < 160) { const int v = F.tid >> 5, cc = F.tid & 31; float s = 0.f;
#pragma unroll
            for (int g = 0; g < 16; ++g) s += red[(g * 5 + v) * 32 + cc];
            __hip_atomic_store(&mod[v * 6144 + col0 + cc], s + F.b_mod[col0 + cc], __ATOMIC_RELAXED, __HIP_MEMORY_SCOPE_AGENT); }
        asm volatile("s_waitcnt vmcnt(0)" ::: "memory");
        __syncthreads();
        if (F.tid == 0) xb_add((unsigned*)(F.ws + WS_CTL) + CW_MODCNT, 1u);
    }
    LAS float* scr = (LAS float*)(F.lds + F.wave * 8448);
    const int gw = F.bid * NWAVES + F.wave, NGW = F.G * NWAVES;
    constexpr int I_IN = (D / 64) * (INW / 32), I_A = (512 / 64) * (D / 32), I_O = (D / 64) * (D / 32);
    constexpr int NITEMS = I_IN + 2 * I_A + I_O;
    for (int it = gw; it < NITEMS; it += NGW) {
        int r = it;
        if (r < I_IN) { p0_transpose_item(F.w_in, D, INW, (bf16*)(F.ws + WS_WIN), scr, r, F.lane); continue; } r -= I_IN;
        if (r < I_A) { p0_transpose_item(F.w_a, 512, D, (bf16*)(F.ws + WS_WA), scr, r, F.lane); continue; } r -= I_A;
        if (r < I_A) { p0_transpose_item(F.w_b, 512, D, (bf16*)(F.ws + WS_WB), scr, r, F.lane); continue; } r -= I_A;
        p0_transpose_item(F.w_o, D, D, (bf16*)(F.ws + WS_WO), scr, r, F.lane);
    }
    for (int it = gw; it < 16 * 64 * 2; it += NGW) {
        const int kh = it & 1, dt = (it >> 1) & 63, hp = it >> 7, lane = F.lane, q = lane >> 4;
        bf16x8 Aw[4];
#pragma unroll
        for (int sk = 0; sk < 4; ++sk) { const GAS f32x4* p = (const GAS f32x4*)(F.wq + (size_t)(16 * dt + (lane & 15)) * 2048 + hp * 128 + 32 * sk + 8 * q); const f32x4 a = p[0], b = p[1];
            v4u w; w.x = pk2(a.x, a.y); w.y = pk2(a.z, a.w); w.z = pk2(b.x, b.y); w.w = pk2(b.z, b.w); Aw[sk] = __builtin_bit_cast(bf16x8, w); }
        bf16* wc = (bf16*)(F.ws + WS_WQ);
        f32x4 kf[4][4][2];
#pragma unroll
        for (int k4 = 0; k4 < 4; ++k4)
#pragma unroll
            for (int sk = 0; sk < 4; ++sk) { const GAS f32x4* p = (const GAS f32x4*)(F.keys + (size_t)(hp * 128 + 16 * (4 * kh + k4) + (lane & 15)) * 128 + 32 * sk + 8 * q); kf[k4][sk][0] = p[0]; kf[k4][sk][1] = p[1]; }
#pragma unroll
        for (int k4 = 0; k4 < 4; ++k4) { const int kt = 4 * kh + k4;
            f32x4 acc = (f32x4){0.f, 0.f, 0.f, 0.f};
#pragma unroll
            for (int sk = 0; sk < 4; ++sk) { const f32x4 a = kf[k4][sk][0], b = kf[k4][sk][1];
                v4u w; w.x = pk2(a.x, a.y); w.y = pk2(a.z, a.w); w.z = pk2(b.x, b.y); w.w = pk2(b.z, b.w);
                acc = __builtin_amdgcn_mfma_f32_16x16x32_bf16(Aw[sk], __builtin_bit_cast(bf16x8, w), acc, 0, 0, 0); }
            v2u o; o.x = pk2(acc[0], acc[1]); o.y = pk2(acc[2], acc[3]);
            *(GAS v2u*)(wc + (size_t)(hp * 128 + 16 * kt + (lane & 15)) * D + 16 * dt + 4 * q) = o;
        }
    }
    for (int it = gw; it < 4 * 64 * 8; it += NGW) {
        const int ct = it & 7, ntile = (it >> 3) & 63, g = it >> 9, lane = F.lane, q = lane >> 4;
        f32x4 acc = (f32x4){0.f, 0.f, 0.f, 0.f};
#pragma unroll
        for (int sk = 0; sk < 4; ++sk) {
            const GAS f32x4* p = (const GAS f32x4*)(F.pool_w + ((size_t)g * 128 + 16 * ct + (lane & 15)) * 128 + 32 * sk + 8 * q); const GAS f32x4* sp = (const GAS f32x4*)(F.pool_scale + g * 128 + 32 * sk + 8 * q);
            const f32x4 a = p[0] * sp[0], b = p[1] * sp[1];
            v4u wa_; wa_.x = pk2(a.x, a.y); wa_.y = pk2(a.z, a.w); wa_.z = pk2(b.x, b.y); wa_.w = pk2(b.z, b.w);
            const float* wcol = F.w_a + (size_t)(g * 128 + 32 * sk + 8 * q) * D + 16 * ntile + (lane & 15);
            v4u wb_; wb_.x = pk2(wcol[0], wcol[D]); wb_.y = pk2(wcol[2 * D], wcol[3 * D]); wb_.z = pk2(wcol[4 * D], wcol[5 * D]); wb_.w = pk2(wcol[6 * D], wcol[7 * D]);
            acc = __builtin_amdgcn_mfma_f32_16x16x32_bf16(__builtin_bit_cast(bf16x8, wa_), __builtin_bit_cast(bf16x8, wb_), acc, 0, 0, 0); }
        v2u o; o.x = pk2(acc[0], acc[1]); o.y = pk2(acc[2], acc[3]);
        *(GAS v2u*)((bf16*)(F.ws + WS_WPA) + (size_t)(16 * ntile + (lane & 15)) * 512 + g * 128 + 16 * ct + 4 * q) = o;
    }
    { const int gt = F.bid * NTHREADS + F.tid; float* lbt = (float*)(F.ws + WS_LBT);
      if (gt < 1024) { const int dir = gt >> 9, cc = gt & 511; const float l0 = F.lb_logits[(dir * 2 + 0) * 512 + cc], l1 = F.lb_logits[(dir * 2 + 1) * 512 + cc];
          lbt[gt] = 1.f / (1.f + expf(l1 - l0)); } }
}

__device__ __forceinline__ void modulate_row(const float* xrow, bf16* orow, const float* g, const float* shift, const float* scale, int lane) {
    const GAS f32x4* xr = (const GAS f32x4*)xrow + lane;
    f32x4 v[4]; float s2 = 0.f;
#pragma unroll
    for (int j = 0; j < 4; ++j) { v[j] = xr[64 * j]; s2 += (v[j].x * v[j].x + v[j].y * v[j].y) + (v[j].z * v[j].z + v[j].w * v[j].w); }
    const float rstd = 1.f / sqrtf(wave_sum(s2) * (1.f / D) + EPS);
    GAS v2u* o8 = (GAS v2u*)orow + lane;
#pragma unroll
    for (int j = 0; j < 4; ++j) {
        const f32x4 gg = ((const GAS f32x4*)g)[lane + 64 * j], sh = ((const GAS f32x4*)shift)[lane + 64 * j], sc = ((const GAS f32x4*)scale)[lane + 64 * j];
        const f32x4 y = (v[j] * rstd) * gg * (sc + 1.0f) + sh;
        v2u o; o.x = pk2(y.x, y.y); o.y = pk2(y.z, y.w); o8[64 * j] = o; }
}
__device__ __forceinline__ void p1_modulate(Frame& F) {
    const float* mod = (const float*)(F.ws + WS_MOD); bf16* H = (bf16*)(F.ws + WS_H);
    const int gw = F.bid * NWAVES + F.wave, NGW = F.G * NWAVES;
    for (int m = gw; m < MH; m += NGW) {
        const int v = (m < ML) ? (m >> 12) : 4;
        const float* xr = (m < ML) ? F.x + (size_t)m * D : F.ctx + (size_t)(m - ML) * D;
        modulate_row(xr, H + (size_t)m * D, F.n1g, mod + v * 6144 + 0, mod + v * 6144 + 1024, F.lane);
    }
}

using pg8::Unit;
struct SchedPlain {
    const char* Ab; const char* Bb; int nM, nN, K, G, c;
    __device__ __forceinline__ bool next(int i, Unit& u) const { const int L = i * G + c; if (L >= nM * nN) return false; pg8::tile_of(L, nM, nN, u.pm, u.pn); u.seg = 0; return true; }
    __device__ __forceinline__ const char* A(const Unit& u) const { return Ab + (size_t)u.pm * 256 * K * 2; }
    __device__ __forceinline__ const char* B(const Unit& u) const { return Bb + (size_t)u.pn * 256 * K * 2; }
    __device__ __forceinline__ bool keep(const Unit&) const { return false; }
    __device__ __forceinline__ int nt(const Unit&) const { return K / 64; }
};
struct SchedOnce {
    const char* Ab; const char* Bb; int nM, nN, K, base, c;
    __device__ __forceinline__ bool next(int i, Unit& u) const { const int L = base + c; if (i != 0 || L >= nM * nN) return false; pg8::tile_of(L, nM, nN, u.pm, u.pn); u.seg = 0; return true; }
    __device__ __forceinline__ const char* A(const Unit& u) const { return Ab + (size_t)u.pm * 256 * K * 2; }
    __device__ __forceinline__ const char* B(const Unit& u) const { return Bb + (size_t)u.pn * 256 * K * 2; }
    __device__ __forceinline__ bool keep(const Unit&) const { return false; }
    __device__ __forceinline__ int nt(const Unit&) const { return K / 64; }
};
struct SchedTile {
    const char* Ab; const char* Bb; int K, pm, pn;
    __device__ __forceinline__ bool next(int i, Unit& u) const { if (i != 0) return false; u.pm = pm; u.pn = pn; u.seg = 0; return true; }
    __device__ __forceinline__ const char* A(const Unit& u) const { return Ab + (size_t)u.pm * 256 * K * 2; }
    __device__ __forceinline__ const char* B(const Unit& u) const { return Bb + (size_t)u.pn * 256 * K * 2; }
    __device__ __forceinline__ bool keep(const Unit&) const { return false; }
    __device__ __forceinline__ int nt(const Unit&) const { return K / 64; }
};
struct SchedIn {
    const char* Ab; const char* Bb; int G, c;
    __device__ __forceinline__ bool next(int i, Unit& u) const { const int L = i * G + c; u.seg = 0;
        if (L < 1280) { pg8::tile_of(L, 64, 20, u.pm, u.pn); return true; }
        if (L < 1328) { const int l = L - 1280, l2 = l >> 1; u.seg = l & 1; u.pm = 64 + (l2 & 3); u.pn = 4 + (l2 >> 2); return true; }
        return false; }
    __device__ __forceinline__ const char* A(const Unit& u) const { return Ab + (size_t)u.pm * 256 * D * 2 + ((u.pm >= 64 && u.seg) ? 1024 : 0); }
    __device__ __forceinline__ const char* B(const Unit& u) const { return Bb + (size_t)u.pn * 256 * D * 2 + ((u.pm >= 64 && u.seg) ? 1024 : 0); }
    __device__ __forceinline__ bool keep(const Unit&) const { return false; }
    __device__ __forceinline__ int nt(const Unit& u) const { return u.pm >= 64 ? 8 : 16; }
};
struct SchedMerge {
    const char *A0, *A1, *B0, *B1; int G, c;
    __device__ __forceinline__ bool next(int i, Unit& u) const { const int tile = (i >> 1) * G + c; if (tile >= 256) return false; pg8::tile_of(tile, 64, 4, u.pm, u.pn); u.seg = i & 1; return true; }
    __device__ __forceinline__ const char* A(const Unit& u) const { return (u.seg ? A1 : A0) + (size_t)u.pm * 256 * 512 * 2; }
    __device__ __forceinline__ const char* B(const Unit& u) const { return (u.seg ? B1 : B0) + (size_t)u.pn * 256 * 512 * 2; }
    __device__ __forceinline__ bool keep(const Unit& u) const { return u.seg == 0; }
    __device__ __forceinline__ int nt(const Unit&) const { return 8; }
};

struct EpiZ {
    static constexpr bool PERM = true, AFTER_DRAIN = false;
    bf16* Z; bf16* ZBp; bf16* ZC; bf16* ZC2;
    __device__ __forceinline__ void operator()(pg8::f32x4 (&acc)[2][2][4][2], const Unit& u, int wr, int wc, int fr, int fq) const {
        int row0 = u.pm * 256 + wr * 64 + fr, col0 = u.pn * 256 + wc * 32 + 8 * fq, ldc = ZW; bf16* base = Z;
        if (u.pm < 64 && u.pn >= 10) { base = ZBp; col0 -= ZW; }
        if (u.pm >= 64) { base = u.seg ? ZC2 : ZC; row0 -= ML; col0 -= 1024; ldc = ZC_W; }
        const bool sg = u.pn >= 12;
#pragma unroll
        for (int ai = 0; ai < 2; ++ai)
#pragma unroll
            for (int m = 0; m < 4; ++m) { bf16* rowp = base + (size_t)(row0 + ai * 128 + m * 16) * ldc + col0;
#pragma unroll
                for (int bj = 0; bj < 2; ++bj) { pg8::f32x4 v0 = acc[ai][bj][m][0], v1 = acc[ai][bj][m][1];
                    if (sg) {
#pragma unroll
                        for (int j = 0; j < 4; ++j) { v0[j] = sigmoidf_(v0[j]); v1[j] = sigmoidf_(v1[j]); } }
                    v4u w; w.x = pk2(v0[0], v0[1]); w.y = pk2(v0[2], v0[3]); w.z = pk2(v1[0], v1[1]); w.w = pk2(v1[2], v1[3]);
                    *(GAS v4u*)(rowp + bj * 128) = w; } }
    }
};
struct EpiPlain {
    static constexpr bool PERM = true, AFTER_DRAIN = false;
    bf16* O; int ldc;
    __device__ __forceinline__ void operator()(pg8::f32x4 (&acc)[2][2][4][2], const Unit& u, int wr, int wc, int fr, int fq) const {
        const int row0 = u.pm * 256 + wr * 64 + fr, col0 = u.pn * 256 + wc * 32 + 8 * fq;
#pragma unroll
        for (int ai = 0; ai < 2; ++ai)
#pragma unroll
            for (int m = 0; m < 4; ++m) { bf16* rowp = O + (size_t)(row0 + ai * 128 + m * 16) * ldc + col0;
#pragma unroll
                for (int bj = 0; bj < 2; ++bj) { const pg8::f32x4 v0 = acc[ai][bj][m][0], v1 = acc[ai][bj][m][1];
                    v4u w; w.x = pk2(v0[0], v0[1]); w.y = pk2(v0[2], v0[3]); w.z = pk2(v1[0], v1[1]); w.w = pk2(v1[2], v1[3]);
                    *(GAS v4u*)(rowp + bj * 128) = w; } }
    }
};
struct EpiMerge {
    static constexpr bool PERM = true, AFTER_DRAIN = false;
    const bf16* Z; bf16* Mo;
    __device__ __forceinline__ void operator()(pg8::f32x4 (&acc)[2][2][4][2], const Unit& u, int wr, int wc, int fr, int fq) const {
        const int row0 = u.pm * 256 + wr * 64 + fr, col0 = u.pn * 256 + wc * 32 + 8 * fq;
#pragma unroll
        for (int ai = 0; ai < 2; ++ai)
#pragma unroll
            for (int m = 0; m < 4; ++m) { const size_t r = (size_t)(row0 + ai * 128 + m * 16);
#pragma unroll
                for (int bj = 0; bj < 2; ++bj) { const int c = col0 + bj * 128;
                    const v4u gh = *(const GAS v4u*)(Z + r * ZW + 1536 + c);
                    float h[8] = {bflo(gh.x), bfhi(gh.x), bflo(gh.y), bfhi(gh.y), bflo(gh.z), bfhi(gh.z), bflo(gh.w), bfhi(gh.w)};
                    if (u.seg == 0) {
                        const v4u gp = *(const GAS v4u*)(Z + r * ZW + 512 + c);
                        float p[8] = {bflo(gp.x), bfhi(gp.x), bflo(gp.y), bfhi(gp.y), bflo(gp.z), bfhi(gp.z), bflo(gp.w), bfhi(gp.w)};
#pragma unroll
                        for (int j = 0; j < 4; ++j) { acc[ai][bj][m][0][j] *= p[j] * fast_rcp(fmaxf(h[j], 1e-30f)); acc[ai][bj][m][1][j] *= p[4 + j] * fast_rcp(fmaxf(h[4 + j], 1e-30f)); }
                    } else {
                        pg8::f32x4 v0 = acc[ai][bj][m][0], v1 = acc[ai][bj][m][1];
#pragma unroll
                        for (int j = 0; j < 4; ++j) { v0[j] *= h[j]; v1[j] *= h[4 + j]; }
                        v4u w; w.x = pk2(v0[0], v0[1]); w.y = pk2(v0[2], v0[3]); w.z = pk2(v1[0], v1[1]); w.w = pk2(v1[2], v1[3]);
                        pg8::st_wt16(Mo + r * D + c, w); } } }
    }
};
struct EpiRes {
    static constexpr bool PERM = true, AFTER_DRAIN = false;
    const float* X; const float* mod; bf16* O0; bf16* O1;
    __device__ __forceinline__ void operator()(pg8::f32x4 (&acc)[2][2][4][2], const Unit& u, int wr, int wc, int fr, int fq) const {
        const int row0 = u.pm * 256 + wr * 64 + fr, col0 = u.pn * 256 + wc * 32 + 8 * fq;
        const float* g1 = mod + (size_t)(u.pm >> 4) * 6144 + 2048;
        bf16* Ob = ((u.pn & 2) ? O1 : O0) + (u.pn & 1) * 256 + wc * 32 + 8 * fq;
        pg8::f32x4 gv[2][2];
#pragma unroll
        for (int bj = 0; bj < 2; ++bj)
#pragma unroll
            for (int n = 0; n < 2; ++n) gv[bj][n] = *(const GAS pg8::f32x4*)(g1 + col0 + bj * 128 + n * 4);
#pragma unroll
        for (int ai = 0; ai < 2; ++ai)
#pragma unroll
            for (int m = 0; m < 4; ++m) { const size_t row = (size_t)(row0 + ai * 128 + m * 16), off = row * D + col0;
#pragma unroll
                for (int bj = 0; bj < 2; ++bj) { const pg8::f32x4 x0 = *(const GAS pg8::f32x4*)(X + off + bj * 128), x1 = *(const GAS pg8::f32x4*)(X + off + bj * 128 + 4);
                    const pg8::f32x4 v0 = x0 + gv[bj][0] * acc[ai][bj][m][0], v1 = x1 + gv[bj][1] * acc[ai][bj][m][1];
                    v4u w; w.x = pk2(v0[0], v0[1]); w.y = pk2(v0[2], v0[3]); w.z = pk2(v1[0], v1[1]); w.w = pk2(v1[2], v1[3]);
                    pg8::st_wt16(Ob + row * 512 + bj * 128, w); }
                asm volatile("" ::: "memory"); }
    }
};

__device__ __forceinline__ unsigned off_b(unsigned row, unsigned ch) { return 256u * row + 16u * (ch ^ (((row & 3) << 2) | ((row >> 2) & 3))); }
__device__ __forceinline__ unsigned row_addr16(unsigned lane, unsigned rb, unsigned s) { return off_b((lane & 15) + 16 * rb, 4 * s + (lane >> 4)); }
__device__ __forceinline__ unsigned tr_addr16(unsigned lane, unsigned c, unsigned t) { const unsigned g = lane >> 4, q = (lane & 15) >> 2, p = lane & 3; return off_b(8 * g + 4 * t + q, 2 * c + (p >> 1)) + 8 * (p & 1); }
__device__ __forceinline__ bf16x8 tr_frag(LAS unsigned char* tile, unsigned lane, unsigned c) {
    const s16x4 lo = __builtin_amdgcn_ds_read_tr16_b64_v4i16((LAS s16x4*)(tile + tr_addr16(lane, c, 0)));
    const s16x4 hi = __builtin_amdgcn_ds_read_tr16_b64_v4i16((LAS s16x4*)(tile + tr_addr16(lane, c, 1)));
    return __builtin_shufflevector(lo, hi, 0, 1, 2, 3, 4, 5, 6, 7);
}
#define MFMA16(a, b, c) __builtin_amdgcn_mfma_f32_16x16x32_bf16((a), (b), (c), 0, 0, 0)

__device__ __forceinline__ v4u add_bf16x8(const v4u a, const v4u b) {
    v4u r; r.x = pk2(bflo(a.x) + bflo(b.x), bfhi(a.x) + bfhi(b.x)); r.y = pk2(bflo(a.y) + bflo(b.y), bfhi(a.y) + bfhi(b.y));
    r.z = pk2(bflo(a.z) + bflo(b.z), bfhi(a.z) + bfhi(b.z)); r.w = pk2(bflo(a.w) + bflo(b.w), bfhi(a.w) + bfhi(b.w)); return r; }
constexpr int SC_QT = 0, SC_KT = 8192, SC_KD = 16384, SC_VT = 24576, SC_ATT = 32768, SC_EL = 35328, SC_WT = 35840;

__device__ __forceinline__ void scan_unit(Frame& F, int u) {
    const int tid = F.tid, lane = F.lane, w = F.wave, q = lane >> 4;
    const bool isctx = u >= NSCAN_L;
    int b, h, dir, rowbase, nch; const bf16* src; int ld, cq, ci, cf;
    if (!isctx) { const int j = u & 7; dir = (u >> 3) & 1; h = (u >> 4) & 3; b = u >> 6; const int tb = dir ? 7 - j : j;
        rowbase = b * SEQ + tb * SEGT; nch = SEGT / CHT; src = (const bf16*)(F.ws + WS_ZA); ld = ZW; cq = 512 + h * 128; ci = 1024 + h * 128; cf = (dir ? 2048 : 1536) + h * 128; }
    else { const int v = u - NSCAN_L, cs = v & (NCSEG - 1); dir = (v >> 2) & 1; h = (v >> 3) & 3; b = v >> 5;
        rowbase = b * CTXL + (dir ? NCSEG - 1 - cs : cs) * (CTXL / NCSEG); nch = CTXL / NCSEG / CHT; src = (const bf16*)(F.ws + WS_ZC); ld = ZC_W; ci = h * 128; cq = ci; cf = (dir ? 1024 : 512) + h * 128; }
    const int t = tid >> 4, k8 = tid & 15;
    const int pl = dir ? 3 - q : q;
    const float* lbt = (const float*)(F.ws + WS_LBT) + dir * 512 + h * 128 + 8 * k8;
    float lb[8], om_[8], ecum[8];
#pragma unroll
    for (int i = 0; i < 8; ++i) { lb[i] = lbt[i]; om_[i] = 1.f - lbt[i]; ecum[i] = 1.f; }
    f32x4 S[8];
#pragma unroll
    for (int i = 0; i < 8; ++i) S[i] = (f32x4){0.f, 0.f, 0.f, 0.f};
    LAS unsigned char* L = F.lds;
    bf16* qseg = (bf16*)((unsigned char*)F.out + OUT_QSEG) + (size_t)dir * ML * 512;
    bf16* oloc = (bf16*)((unsigned char*)F.out + OUT_OLOC);
    v4u qv, vv, fv;
    { const int tc = dir ? nch - 1 : 0; const bf16* rp = src + (size_t)(rowbase + tc * CHT + t) * ld + 8 * k8;
      qv = *(const GAS v4u*)(rp + cq); vv = *(const GAS v4u*)(rp + ci); fv = *(const GAS v4u*)(rp + cf);
      if (isctx) { const bf16* r2 = rp + (WS_ZC2 - WS_ZC) / 2; vv = add_bf16x8(vv, *(const GAS v4u*)(r2 + ci)); fv = add_bf16x8(fv, *(const GAS v4u*)(r2 + cf)); qv = vv; } }
    for (int pc = 0; pc < nch; ++pc) {
        const int tc = dir ? nch - 1 - pc : pc;
        const v4u q0 = qv, v0 = vv, f0 = fv;
        if (pc + 1 < nch) { const int tn = dir ? tc - 1 : tc + 1; const bf16* rp = src + (size_t)(rowbase + tn * CHT + t) * ld + 8 * k8;
            qv = *(const GAS v4u*)(rp + cq); vv = *(const GAS v4u*)(rp + ci); fv = *(const GAS v4u*)(rp + cf);
            if (isctx) { const bf16* r2 = rp + (WS_ZC2 - WS_ZC) / 2; vv = add_bf16x8(vv, *(const GAS v4u*)(r2 + ci)); fv = add_bf16x8(fv, *(const GAS v4u*)(r2 + cf)); qv = vv; } }
        float fr_[8] = {bflo(f0.x), bfhi(f0.x), bflo(f0.y), bfhi(f0.y), bflo(f0.z), bfhi(f0.z), bflo(f0.w), bfhi(f0.w)};
        float e[8], kk[8];
#pragma unroll
        for (int i = 0; i < 8; ++i) { const float s = fast_rcp(1.f + fast_exp(-fr_[i])); e[i] = lb[i] + om_[i] * s; kk[i] = om_[i] - om_[i] * s; }
        { const int s1 = dir ? lane + 16 : lane - 16, s2 = dir ? lane + 32 : lane - 32;
#pragma unroll
          for (int i = 0; i < 8; ++i) { const float o = __shfl(e[i], s1 & 63); e[i] = (pl >= 1) ? e[i] * o : e[i]; }
#pragma unroll
          for (int i = 0; i < 8; ++i) { const float o = __shfl(e[i], s2 & 63); e[i] = (pl >= 2) ? e[i] * o : e[i]; } }
        if (pl == 3) { LAS f32x4* wt = (LAS f32x4*)(L + SC_WT + (w * 128 + 8 * k8) * 4); wt[0] = (f32x4){e[0], e[1], e[2], e[3]}; wt[1] = (f32x4){e[4], e[5], e[6], e[7]}; }
        LBAR();
        float etot[8];
        { float pre[8], run[8];
#pragma unroll
          for (int i = 0; i < 8; ++i) { pre[i] = 1.f; run[i] = 1.f; }
#pragma unroll
          for (int sidx = 0; sidx < 8; ++sidx) { const int ww = dir ? 7 - sidx : sidx;
              const LAS f32x4* wt = (const LAS f32x4*)(L + SC_WT + (ww * 128 + 8 * k8) * 4); const f32x4 a = wt[0], c = wt[1];
              if (ww == w) {
#pragma unroll
                  for (int i = 0; i < 8; ++i) pre[i] = run[i]; }
              run[0] *= a.x; run[1] *= a.y; run[2] *= a.z; run[3] *= a.w; run[4] *= c.x; run[5] *= c.y; run[6] *= c.z; run[7] *= c.w; }
#pragma unroll
          for (int i = 0; i < 8; ++i) { etot[i] = run[i]; e[i] *= pre[i]; } }
        {
            const float qf[8] = {bflo(q0.x), bfhi(q0.x), bflo(q0.y), bfhi(q0.y), bflo(q0.z), bfhi(q0.z), bflo(q0.w), bfhi(q0.w)};
            float qt[8], kt[8], kd[8];
#pragma unroll
            for (int i = 0; i < 8; ++i) { qt[i] = qf[i] * e[i]; kt[i] = kk[i] * fast_rcp(e[i]); kd[i] = kt[i] * etot[i]; }
            const unsigned ob = off_b((unsigned)t, (unsigned)k8);
            v4u o; o.x = pk2(qt[0], qt[1]); o.y = pk2(qt[2], qt[3]); o.z = pk2(qt[4], qt[5]); o.w = pk2(qt[6], qt[7]); *(LAS v4u*)(L + SC_QT + ob) = o;
            o.x = pk2(kt[0], kt[1]); o.y = pk2(kt[2], kt[3]); o.z = pk2(kt[4], kt[5]); o.w = pk2(kt[6], kt[7]); *(LAS v4u*)(L + SC_KT + ob) = o;
            o.x = pk2(kd[0], kd[1]); o.y = pk2(kd[2], kd[3]); o.z = pk2(kd[4], kd[5]); o.w = pk2(kd[6], kd[7]); *(LAS v4u*)(L + SC_KD + ob) = o;
            *(LAS v4u*)(L + SC_VT + ob) = v0;
            if (!isctx) { o.x = pk2(qt[0] * ecum[0], qt[1] * ecum[1]); o.y = pk2(qt[2] * ecum[2], qt[3] * ecum[3]); o.z = pk2(qt[4] * ecum[4], qt[5] * ecum[5]); o.w = pk2(qt[6] * ecum[6], qt[7] * ecum[7]);
                *(GAS v4u*)(qseg + (size_t)(rowbase + tc * CHT + t) * 512 + h * 128 + 8 * k8) = o; }
            if (t == 0) { LAS f32x4* el = (LAS f32x4*)(L + SC_EL + 32 * k8); el[0] = (f32x4){etot[0], etot[1], etot[2], etot[3]}; el[1] = (f32x4){etot[4], etot[5], etot[6], etot[7]}; }
#pragma unroll
            for (int i = 0; i < 8; ++i) ecum[i] *= etot[i];
        }
        LBAR();
        if (w < 4 && !isctx) {
            const int tt = dir ? (w >> 1) : ((w + 1) >> 1), st = dir ? ((w + 1) >> 1) : (w >> 1);
            const int tz = dir ? 1 : 0, sz = dir ? 0 : 1;
            f32x4 a = (f32x4){0.f, 0.f, 0.f, 0.f};
            if (w < 3) {
#pragma unroll
                for (int s = 0; s < 4; ++s) { const bf16x8 A = *(const LAS bf16x8*)(L + SC_QT + row_addr16(lane, tt, s)); const bf16x8 B = *(const LAS bf16x8*)(L + SC_KT + row_addr16(lane, st, s)); a = MFMA16(A, B, a); }
            }
            const int tr = (w < 3 ? tt : tz) * 16 + 4 * q, sc = (w < 3 ? st : sz) * 16 + (lane & 15);
#pragma unroll
            for (int j = 0; j < 4; ++j) { const int ti = tr + j; const bool ok = (w < 3) && (dir ? (sc >= ti) : (sc <= ti));
                *(LAS unsigned short*)(L + SC_ATT + ti * 80 + sc * 2) = (unsigned short)f2bf(ok ? a[j] : 0.f); }
        }
        LBAR();
        {
            const bf16x8 Bv = tr_frag(L + SC_VT, lane, w);
            if (!isctx) {
                v4u sb[4];
#pragma unroll
                for (int s = 0; s < 4; ++s) { sb[s].x = pk2(S[2 * s][0], S[2 * s][1]); sb[s].y = pk2(S[2 * s][2], S[2 * s][3]); sb[s].z = pk2(S[2 * s + 1][0], S[2 * s + 1][1]); sb[s].w = pk2(S[2 * s + 1][2], S[2 * s + 1][3]); }
#pragma unroll 1
                for (int tt = 0; tt < 2; ++tt) {
                    f32x4 o = (f32x4){0.f, 0.f, 0.f, 0.f};
                    const unsigned row = 16 * tt + (lane & 15);
#pragma unroll
                    for (int s = 0; s < 4; ++s) {
                        const v2u alo = *(const LAS v2u*)(L + SC_QT + off_b(row, 4 * s + (q >> 1)) + 8 * (q & 1));
                        const v2u ahi = *(const LAS v2u*)(L + SC_QT + off_b(row, 4 * s + 2 + (q >> 1)) + 8 * (q & 1));
                        const v4u av = (v4u){alo.x, alo.y, ahi.x, ahi.y};
                        o = MFMA16(__builtin_bit_cast(bf16x8, av), __builtin_bit_cast(bf16x8, sb[s]), o);
                    }
                    const bf16x8 At = *(const LAS bf16x8*)(L + SC_ATT + row * 80 + 16 * q);
                    o = MFMA16(At, Bv, o);
                    const int ttg = (rowbase + tc * CHT + 16 * tt) >> 4;
                    v2u ov; ov.x = pk2(o[0], o[1]); ov.y = pk2(o[2], o[3]);
                    *(GAS v2u*)(oloc + ((((size_t)(dir * 1024 + ttg) * 4 + h) * 8 + w) * 64 + lane) * 4) = ov;
                }
            }
#pragma unroll
            for (int kt = 0; kt < 8; ++kt) {
                const bf16x8 A = tr_frag(L + SC_KD, lane, kt);
                const f32x4 a4 = *(const LAS f32x4*)(L + SC_EL + (16 * kt + 4 * q) * 4);
                S[kt] = MFMA16(A, Bv, S[kt] * a4);
            }
        }
    }
    { float* us = (float*)(F.ws + WS_USEG) + (size_t)u * 128 * 128 + (4 * q) * 128 + 16 * w + (lane & 15);
#pragma unroll
      for (int kt = 0; kt < 8; ++kt) {
#pragma unroll
          for (int j = 0; j < 4; ++j) us[j * 128] = S[kt][j];
          us += 16 * 128; asm volatile("" : "+v"(us)); }
      if (t == 0) { float* as = (float*)(F.ws + WS_ASEG) + (size_t)u * 128 + 8 * k8;
#pragma unroll
          for (int i = 0; i < 8; ++i) as[i] = ecum[i]; } }
    __syncthreads();
}


constexpr int PL_VSTR = 132, PL_VBYTES = 64 * PL_VSTR * 4;
#define PL_LOAD8(ra, rd, g_, r0b_, rhi_) do { _Pragma("unroll") for (int u8 = 0; u8 < 8; ++u8) { const int rr_ = min((r0b_) + u8, (rhi_)); \
    const bf16* p_ = Z + (size_t)(b * SEQ + rr_ * 64 + c) * ZW + (g_) * 128 + 16 * ch16; ra[u8] = *(const GAS v4u*)p_; rd[u8] = *(const GAS v4u*)(p_ + 8); } } while (0)
#define PL_CONSUME8(ra, rd, r0b_, rhi_) do { _Pragma("unroll") for (int u8 = 0; u8 < 8; ++u8) { const int rr_ = (r0b_) + u8; if (rr_ <= (rhi_)) { const v4u a_ = ra[u8], d_ = rd[u8]; \
    const float x_[16] = {bflo(a_.x), bfhi(a_.x), bflo(a_.y), bfhi(a_.y), bflo(a_.z), bfhi(a_.z), bflo(a_.w), bfhi(a_.w), bflo(d_.x), bfhi(d_.x), bflo(d_.y), bfhi(d_.y), bflo(d_.z), bfhi(d_.z), bflo(d_.w), bfhi(d_.w)}; \
    _Pragma("unroll") for (int i_ = 0; i_ < 16; ++i_) vs[i_] += x_[i_]; \
    if (rr_ == r) { _Pragma("unroll") for (int i_ = 0; i_ < 16; ++i_) pc[i_] = x_[i_]; } } } } while (0)
__device__ __forceinline__ void pool_unit(Frame& F, int u) {
    const int b = u >> 6, r = u & 63, tid = F.tid;
    const int c = tid >> 3, ch16 = tid & 7;
    const bf16* Z = (const bf16*)(F.ws + WS_ZA); bf16* YP = (bf16*)(F.ws + WS_YPOOL);
    v4u ra[8], rd[8];
    PL_LOAD8(ra, rd, 0, max(0, r - 1), r);
#pragma unroll 1
    for (int g = 0; g < 4; ++g) {
        LAS unsigned char* L = F.lds + (g & 1) * PL_VBYTES;
        const int half = 1 << g;
        const int r_lo = max(0, r - half), r_hi = min(63, r + half - 1), c_lo = max(0, c - half), c_hi = min(63, c + half - 1);
        float vs[16], pc[16];
#pragma unroll
        for (int i = 0; i < 16; ++i) { vs[i] = 0.f; pc[i] = 0.f; }
        PL_CONSUME8(ra, rd, r_lo, r_hi);
        if (g == 3) { PL_LOAD8(ra, rd, 3, r_lo + 8, r_hi); PL_CONSUME8(ra, rd, r_lo + 8, r_hi); }
        else { const int h2 = 2 * half; PL_LOAD8(ra, rd, g + 1, max(0, r - h2), min(63, r + h2 - 1)); }
        { LAS f32x4* vp = (LAS f32x4*)(L + (c * PL_VSTR + 16 * ch16) * 4);
#pragma unroll
          for (int i = 0; i < 4; ++i) vp[i] = (f32x4){vs[4 * i], vs[4 * i + 1], vs[4 * i + 2], vs[4 * i + 3]}; }
        LBAR();
        float hs[16];
#pragma unroll
        for (int i = 0; i < 16; ++i) hs[i] = 0.f;
        for (int cc = c_lo; cc <= c_hi; ++cc) { const LAS f32x4* vp = (const LAS f32x4*)(L + (cc * PL_VSTR + 16 * ch16) * 4);
#pragma unroll
            for (int i = 0; i < 4; ++i) { const f32x4 x = vp[i]; hs[4 * i] += x.x; hs[4 * i + 1] += x.y; hs[4 * i + 2] += x.z; hs[4 * i + 3] += x.w; } }
        { const float inv = 1.f / (float)((r_hi - r_lo + 1) * (c_hi - c_lo + 1));
          v4u o0, o1;
          o0.x = pk2(hs[0] * inv - pc[0], hs[1] * inv - pc[1]); o0.y = pk2(hs[2] * inv - pc[2], hs[3] * inv - pc[3]); o0.z = pk2(hs[4] * inv - pc[4], hs[5] * inv - pc[5]); o0.w = pk2(hs[6] * inv - pc[6], hs[7] * inv - pc[7]);
          o1.x = pk2(hs[8] * inv - pc[8], hs[9] * inv - pc[9]); o1.y = pk2(hs[10] * inv - pc[10], hs[11] * inv - pc[11]); o1.z = pk2(hs[12] * inv - pc[12], hs[13] * inv - pc[13]); o1.w = pk2(hs[14] * inv - pc[14], hs[15] * inv - pc[15]);
          GAS v4u* dp = (GAS v4u*)(YP + (size_t)(b * SEQ + r * 64 + c) * 512 + g * 128 + 16 * ch16); dp[0] = o0; dp[1] = o1; }
    }
    __syncthreads();
}

constexpr int FX_SF = 0, FX_SB = 32768, FX_SCR = 65536, FX_SCRSTR = 132;
__device__ __forceinline__ void prefix_unit(Frame& F, int u) {
    const int chain = u >> 3, rb = u & 7, tid = F.tid, k = 16 * rb + (tid >> 5), v = 4 * (tid & 31);
    const float* US = (const float*)(F.ws + WS_USEG); const float* AS = (const float*)(F.ws + WS_ASEG);
    unsigned char* P = F.ws + WS_PFX + (size_t)chain * 8 * 32768;
    constexpr int NU = NCSEG + 7;
    f32x4 uu[NU]; float aa[NU];
#pragma unroll
    for (int i = 0; i < NU; ++i) { const int un = (i < NCSEG) ? NSCAN_L + chain * NCSEG + i : chain * 8 + (i - NCSEG);
        uu[i] = *(const GAS f32x4*)(US + ((size_t)un * 128 + k) * 128 + v); aa[i] = AS[un * 128 + k]; }
    f32x4 s = uu[0];
#pragma unroll
    for (int i = 1; i < NCSEG; ++i) s = s * aa[i] + uu[i];
    const unsigned ob = (unsigned)(k >> 5) * 8192u + off_b((unsigned)(k & 31), (unsigned)(v >> 3)) + (unsigned)(v & 7) * 2u;
#pragma unroll
    for (int j = 0; j < 8; ++j) {
        v2u o; o.x = pk2(s.x, s.y); o.y = pk2(s.z, s.w);
        *(GAS v2u*)(P + (size_t)j * 32768 + ob) = o;
        if (j < 7) s = s * aa[NCSEG + j] + uu[NCSEG + j];
    }
}
__device__ __forceinline__ void fix_load_state(Frame& F, int chain, int seg, int soff) {
    const GAS v4u* src = (const GAS v4u*)(F.ws + WS_PFX + ((size_t)chain * 8 + seg) * 32768) + F.tid;
#pragma unroll
    for (int i = 0; i < 4; ++i) *(LAS v4u*)(F.lds + soff + (F.tid + 512 * i) * 16) = src[512 * i];
}
__device__ __forceinline__ void fix_unit(Frame& F, int b, int h, int tb, int half) {
    const int lane = F.lane, w = F.wave, q = lane >> 4;
    LAS unsigned char* L = F.lds;
    fix_load_state(F, (b * 4 + h) * 2 + 0, tb, FX_SF);
    fix_load_state(F, (b * 4 + h) * 2 + 1, 7 - tb, FX_SB);
    __syncthreads();
    const bf16* Z = (const bf16*)(F.ws + WS_ZB); bf16* YH = (bf16*)(F.ws + WS_YHG);
    const bf16* qseg = (const bf16*)((const unsigned char*)F.out + OUT_QSEG); const bf16* oloc = (const bf16*)((const unsigned char*)F.out + OUT_OLOC);
    LAS float* scr = (LAS float*)(L + FX_SCR + w * (16 * FX_SCRSTR * 4));
    const int row0 = b * SEQ + tb * SEGT;
#pragma unroll 1
    for (int ti = 0; ti < 2; ++ti) {
        const int tt = 16 * half + 2 * w + ti, rowt = row0 + 16 * tt;
        f32x4 acc[8];
#pragma unroll
        for (int c = 0; c < 8; ++c) acc[c] = (f32x4){0.f, 0.f, 0.f, 0.f};
        bf16x8 A[2][4]; v2u ol[2][8]; v4u ogv[4];
        const int tl = lane >> 2, v0 = 8 * (lane & 3);
#pragma unroll
        for (int dir = 0; dir < 2; ++dir)
#pragma unroll
            for (int s = 0; s < 4; ++s) A[dir][s] = *(const GAS bf16x8*)(qseg + ((size_t)dir * ML + rowt + (lane & 15)) * 512 + h * 128 + 32 * s + 8 * q);
#pragma unroll
        for (int dir = 0; dir < 2; ++dir)
#pragma unroll
            for (int c = 0; c < 8; ++c) ol[dir][c] = *(const GAS v2u*)(oloc + ((((size_t)(dir * 1024 + (rowt >> 4)) * 4 + h) * 8 + c) * 64 + lane) * 4);
#pragma unroll
        for (int i = 0; i < 4; ++i) ogv[i] = *(const GAS v4u*)(Z + (size_t)(rowt + tl) * ZW + h * 128 + v0 + 32 * i);
#pragma unroll
        for (int dir = 0; dir < 2; ++dir) {
#pragma unroll
            for (int s = 0; s < 4; ++s)
#pragma unroll
                for (int c = 0; c < 8; ++c) { const bf16x8 B = tr_frag(L + (dir ? FX_SB : FX_SF) + s * 8192, lane, c); acc[c] = MFMA16(A[dir][s], B, acc[c]); }
        }
#pragma unroll
        for (int dir = 0; dir < 2; ++dir)
#pragma unroll
            for (int c = 0; c < 8; ++c) { const v2u ov = ol[dir][c];
                acc[c][0] += bflo(ov.x); acc[c][1] += bfhi(ov.x); acc[c][2] += bflo(ov.y); acc[c][3] += bfhi(ov.y); }
        float ss[4];
#pragma unroll
        for (int j = 0; j < 4; ++j) { float s = 0.f;
#pragma unroll
            for (int c = 0; c < 8; ++c) s += acc[c][j] * acc[c][j];
            s += WDPP_(s, 0xb1); s += WDPP_(s, 0x4e); s += WDPP_(s, 0x141); s += WDPP_(s, 0x140);
            ss[j] = 1.f / sqrtf(s * (1.f / 128.f) + EPS); }
#pragma unroll
        for (int c = 0; c < 8; ++c)
#pragma unroll
            for (int j = 0; j < 4; ++j) scr[(4 * q + j) * FX_SCRSTR + 16 * c + (lane & 15)] = acc[c][j] * ss[j];
        LDS_WAIT();
        { const size_t row = (size_t)(rowt + tl);
          bf16* yo = YH + row * 512 + h * 128 + v0;
#pragma unroll
          for (int i = 0; i < 4; ++i) {
              const f32x4 a = *(const LAS f32x4*)(scr + tl * FX_SCRSTR + v0 + 32 * i), c2 = *(const LAS f32x4*)(scr + tl * FX_SCRSTR + v0 + 32 * i + 4);
              const v4u g = ogv[i];
              const f32x4 n0 = *(const GAS f32x4*)(F.hg_norm_g + v0 + 32 * i), n1 = *(const GAS f32x4*)(F.hg_norm_g + v0 + 32 * i + 4);
              const float gg[8] = {bflo(g.x), bfhi(g.x), bflo(g.y), bfhi(g.y), bflo(g.z), bfhi(g.z), bflo(g.w), bfhi(g.w)};
              const float yv[8] = {a.x * n0.x, a.y * n0.y, a.z * n0.z, a.w * n0.w, c2.x * n1.x, c2.y * n1.y, c2.z * n1.z, c2.w * n1.w};
              float o[8];
#pragma unroll
              for (int e = 0; e < 8; ++e) o[e] = yv[e] * gg[e] * sigmoidf_(gg[e]);
              v4u ov; ov.x = pk2(o[0], o[1]); ov.y = pk2(o[2], o[3]); ov.z = pk2(o[4], o[5]); ov.w = pk2(o[6], o[7]);
              pg8::st_wt16(yo + 32 * i, ov); } }
        LDS_WAIT();
    }
    __syncthreads();
}


__device__ __forceinline__ void i8_rows(const float* src, unsigned char* dst, float* inv_scale, int gw, int NGW, int lane, unsigned bias, int rend = NEXP) {
    for (int r = gw; r < rend; r += NGW) {
        const GAS f32x4* p = (const GAS f32x4*)(src + (size_t)r * D + 16 * lane);
        const f32x4 a = p[0], b = p[1], c = p[2], d = p[3];
        float m = fmaxf(fmaxf(fmaxf(fabsf(a.x), fabsf(a.y)), fmaxf(fabsf(a.z), fabsf(a.w))), fmaxf(fmaxf(fabsf(b.x), fabsf(b.y)), fmaxf(fabsf(b.z), fabsf(b.w))));
        m = fmaxf(m, fmaxf(fmaxf(fmaxf(fabsf(c.x), fabsf(c.y)), fmaxf(fabsf(c.z), fabsf(c.w))), fmaxf(fmaxf(fabsf(d.x), fabsf(d.y)), fmaxf(fabsf(d.z), fabsf(d.w)))));
        m = wave_max(m);
        const float sc = (m > 0.f) ? 127.f / m : 1.f;
        v4u o; o.x = pack_i8x4(a.x * sc, a.y * sc, a.z * sc, a.w * sc); o.y = pack_i8x4(b.x * sc, b.y * sc, b.z * sc, b.w * sc);
        o.z = pack_i8x4(c.x * sc, c.y * sc, c.z * sc, c.w * sc); o.w = pack_i8x4(d.x * sc, d.y * sc, d.z * sc, d.w * sc);
        o.x ^= bias; o.y ^= bias; o.z ^= bias; o.w ^= bias;
        *(GAS v4u*)(dst + (size_t)(lane >> 3) * ((size_t)NEXP * 128) + (size_t)r * 128 + 16 * (lane & 7)) = o;
        if (lane == 0) inv_scale[r] = (m > 0.f) ? m * (1.f / 127.f) : 1.f;
    }
}
__device__ __forceinline__ void i4_rows(const float* src, unsigned char* dst, float* inv_scale, int gw, int NGW, int lane, const bool vtab) {
    for (int r0 = gw; r0 < NEXP; r0 += 2 * NGW) {
        f32x4 x[2][4]; float s2[2];
#pragma unroll
        for (int k = 0; k < 2; ++k) { const int r = (r0 + k * NGW < NEXP) ? r0 + k * NGW : r0; const GAS f32x4* p = (const GAS f32x4*)(src + (size_t)r * D + 16 * lane);
            x[k][0] = p[0]; x[k][1] = p[1]; x[k][2] = p[2]; x[k][3] = p[3]; }
#pragma unroll
        for (int k = 0; k < 2; ++k) { float t = 0.f;
#pragma unroll
            for (int i = 0; i < 4; ++i) t += (x[k][i].x * x[k][i].x + x[k][i].y * x[k][i].y) + (x[k][i].z * x[k][i].z + x[k][i].w * x[k][i].w);
            s2[k] = t; }
        s2[0] = wave_sum(s2[0]); s2[1] = wave_sum(s2[1]);
#pragma unroll
        for (int k = 0; k < 2; ++k) { const int r = r0 + k * NGW; if (r < NEXP) {
            const f32x4 a = x[k][0], b = x[k][1], c = x[k][2], d = x[k][3];
            const float step = 0.3352f * sqrtf(s2[k] * (1.f / D)), is = (step > 0.f) ? 1.f / step : 0.f;
#define Q4_(x) ((unsigned)(int)fminf(fmaxf(floorf((x) * is), -8.f), 7.f))
#define Q4B_(h, l) (((Q4_(h) & 15u) << 4) | ((Q4_(l) + 8u) & 15u))
#define Q4N_(lo, hi) ((Q4_(lo) & 15u) | ((Q4_(hi) & 15u) << 4))
            v2u o;
            if (vtab) { o.x = Q4B_(a.x, a.y) | (Q4B_(a.z, a.w) << 8) | (Q4B_(b.x, b.y) << 16) | (Q4B_(b.z, b.w) << 24); o.y = Q4B_(c.x, c.y) | (Q4B_(c.z, c.w) << 8) | (Q4B_(d.x, d.y) << 16) | (Q4B_(d.z, d.w) << 24); }
            else      { o.x = Q4N_(a.x, a.y) | (Q4N_(a.z, a.w) << 8) | (Q4N_(b.x, b.y) << 16) | (Q4N_(b.z, b.w) << 24); o.y = Q4N_(c.x, c.y) | (Q4N_(c.z, c.w) << 8) | (Q4N_(d.x, d.y) << 16) | (Q4N_(d.z, d.w) << 24); }
#undef Q4N_
#undef Q4B_
#undef Q4_
            *(GAS v2u*)(dst + (size_t)(lane >> 4) * ((size_t)NEXP * 128) + (size_t)r * 128 + 8 * (lane & 15)) = o;
            if (lane == 0) inv_scale[r] = step; } }
    }
}
__device__ __forceinline__ void mrq_load(const bf16* xlo, const bf16* xhi, int lane, v2u (&xw)[4]) {
    const GAS v2u* xr0 = (const GAS v2u*)xlo + lane; const GAS v2u* xr1 = (const GAS v2u*)xhi + lane;
    xw[0] = xr0[0]; xw[1] = xr0[64]; xw[2] = xr1[0]; xw[3] = xr1[64];
}
__device__ __forceinline__ void mrq_finish(const v2u (&xw)[4], bf16* orow, unsigned char* qrow, float* qscale, float* qsum, const float* g, const float* shift, const float* scale, int lane) {
    f32x4 v[4]; float s2 = 0.f;
#pragma unroll
    for (int j = 0; j < 4; ++j) { v[j] = (f32x4){bflo(xw[j].x), bfhi(xw[j].x), bflo(xw[j].y), bfhi(xw[j].y)}; s2 += (v[j].x * v[j].x + v[j].y * v[j].y) + (v[j].z * v[j].z + v[j].w * v[j].w); }
    const float rstd = 1.f / sqrtf(wave_sum(s2) * (1.f / D) + EPS);
    GAS v2u* o8 = (GAS v2u*)orow + lane; float m = 0.f;
#pragma unroll
    for (int j = 0; j < 4; ++j) {
        const f32x4 gg = ((const GAS f32x4*)g)[lane + 64 * j], sh = ((const GAS f32x4*)shift)[lane + 64 * j], sc = ((const GAS f32x4*)scale)[lane + 64 * j];
        v[j] = (v[j] * rstd) * gg * (sc + 1.0f) + sh;
        v2u o; o.x = pk2(v[j].x, v[j].y); o.y = pk2(v[j].z, v[j].w); pg8::st_wt8((void*)(o8 + 64 * j), o);
        m = fmaxf(m, fmaxf(fmaxf(fabsf(v[j].x), fabsf(v[j].y)), fmaxf(fabsf(v[j].z), fabsf(v[j].w)))); }
    m = wave_max(m);
    const float qs = (m > 0.f) ? 119.f / m : 1.f;
    int hs = 0;
#pragma unroll
    for (int j = 0; j < 4; ++j) {
        const int q_[4] = {(int)rintf(v[j].x * qs), (int)rintf(v[j].y * qs), (int)rintf(v[j].z * qs), (int)rintf(v[j].w * qs)};
        unsigned A16 = 0u, B16 = 0u;
#pragma unroll
        for (int k = 0; k < 4; ++k) { const int b_ = ((q_[k] + 8) & 15) - 8, a_ = (q_[k] - b_) >> 4; A16 |= ((unsigned)a_ & 15u) << (4 * k); B16 |= ((unsigned)b_ & 15u) << (4 * k); hs += q_[k]; }
        const unsigned nA = (unsigned)__builtin_amdgcn_mov_dpp((int)A16, 0xb1, 0xf, 0xf, true), nB = (unsigned)__builtin_amdgcn_mov_dpp((int)B16, 0xb1, 0xf, 0xf, true);
        const unsigned dw = (lane & 1) ? (nB | (B16 << 16)) : (A16 | (nA << 16));
        *(GAS unsigned*)(qrow + j * 256 + (lane >> 3) * 32 + (lane & 1) * 16 + ((lane & 7) >> 1) * 4) = dw; }
    const float hsum = wave_sum((float)hs);
    if (lane == 0) { *qscale = (m > 0.f) ? m * (1.f / 119.f) : 1.f; *qsum = hsum; }
}

#define SORT16_DESC(v) do { float hi_, lo_; \
    hi_ = fmaxf(v[0], v[1]); lo_ = fminf(v[0], v[1]); v[0] = hi_; v[1] = lo_; \
    hi_ = fmaxf(v[2], v[3]); lo_ = fminf(v[2], v[3]); v[2] = hi_; v[3] = lo_; \
    hi_ = fmaxf(v[0], v[2]); lo_ = fminf(v[0], v[2]); v[0] = hi_; v[2] = lo_; \
    hi_ = fmaxf(v[1], v[3]); lo_ = fminf(v[1], v[3]); v[1] = hi_; v[3] = lo_; \
    hi_ = fmaxf(v[1], v[2]); lo_ = fminf(v[1], v[2]); v[1] = hi_; v[2] = lo_; \
    hi_ = fmaxf(v[4], v[5]); lo_ = fminf(v[4], v[5]); v[4] = hi_; v[5] = lo_; \
    hi_ = fmaxf(v[6], v[7]); lo_ = fminf(v[6], v[7]); v[6] = hi_; v[7] = lo_; \
    hi_ = fmaxf(v[4], v[6]); lo_ = fminf(v[4], v[6]); v[4] = hi_; v[6] = lo_; \
    hi_ = fmaxf(v[5], v[7]); lo_ = fminf(v[5], v[7]); v[5] = hi_; v[7] = lo_; \
    hi_ = fmaxf(v[5], v[6]); lo_ = fminf(v[5], v[6]); v[5] = hi_; v[6] = lo_; \
    hi_ = fmaxf(v[0], v[4]); lo_ = fminf(v[0], v[4]); v[0] = hi_; v[4] = lo_; \
    hi_ = fmaxf(v[2], v[6]); lo_ = fminf(v[2], v[6]); v[2] = hi_; v[6] = lo_; \
    hi_ = fmaxf(v[2], v[4]); lo_ = fminf(v[2], v[4]); v[2] = hi_; v[4] = lo_; \
    hi_ = fmaxf(v[1], v[5]); lo_ = fminf(v[1], v[5]); v[1] = hi_; v[5] = lo_; \
    hi_ = fmaxf(v[3], v[7]); lo_ = fminf(v[3], v[7]); v[3] = hi_; v[7] = lo_; \
    hi_ = fmaxf(v[3], v[5]); lo_ = fminf(v[3], v[5]); v[3] = hi_; v[5] = lo_; \
    hi_ = fmaxf(v[1], v[2]); lo_ = fminf(v[1], v[2]); v[1] = hi_; v[2] = lo_; \
    hi_ = fmaxf(v[3], v[4]); lo_ = fminf(v[3], v[4]); v[3] = hi_; v[4] = lo_; \
    hi_ = fmaxf(v[5], v[6]); lo_ = fminf(v[5], v[6]); v[5] = hi_; v[6] = lo_; \
    hi_ = fmaxf(v[8], v[9]); lo_ = fminf(v[8], v[9]); v[8] = hi_; v[9] = lo_; \
    hi_ = fmaxf(v[10], v[11]); lo_ = fminf(v[10], v[11]); v[10] = hi_; v[11] = lo_; \
    hi_ = fmaxf(v[8], v[10]); lo_ = fminf(v[8], v[10]); v[8] = hi_; v[10] = lo_; \
    hi_ = fmaxf(v[9], v[11]); lo_ = fminf(v[9], v[11]); v[9] = hi_; v[11] = lo_; \
    hi_ = fmaxf(v[9], v[10]); lo_ = fminf(v[9], v[10]); v[9] = hi_; v[10] = lo_; \
    hi_ = fmaxf(v[12], v[13]); lo_ = fminf(v[12], v[13]); v[12] = hi_; v[13] = lo_; \
    hi_ = fmaxf(v[14], v[15]); lo_ = fminf(v[14], v[15]); v[14] = hi_; v[15] = lo_; \
    hi_ = fmaxf(v[12], v[14]); lo_ = fminf(v[12], v[14]); v[12] = hi_; v[14] = lo_; \
    hi_ = fmaxf(v[13], v[15]); lo_ = fminf(v[13], v[15]); v[13] = hi_; v[15] = lo_; \
    hi_ = fmaxf(v[13], v[14]); lo_ = fminf(v[13], v[14]); v[13] = hi_; v[14] = lo_; \
    hi_ = fmaxf(v[8], v[12]); lo_ = fminf(v[8], v[12]); v[8] = hi_; v[12] = lo_; \
    hi_ = fmaxf(v[10], v[14]); lo_ = fminf(v[10], v[14]); v[10] = hi_; v[14] = lo_; \
    hi_ = fmaxf(v[10], v[12]); lo_ = fminf(v[10], v[12]); v[10] = hi_; v[12] = lo_; \
    hi_ = fmaxf(v[9], v[13]); lo_ = fminf(v[9], v[13]); v[9] = hi_; v[13] = lo_; \
    hi_ = fmaxf(v[11], v[15]); lo_ = fminf(v[11], v[15]); v[11] = hi_; v[15] = lo_; \
    hi_ = fmaxf(v[11], v[13]); lo_ = fminf(v[11], v[13]); v[11] = hi_; v[13] = lo_; \
    hi_ = fmaxf(v[9], v[10]); lo_ = fminf(v[9], v[10]); v[9] = hi_; v[10] = lo_; \
    hi_ = fmaxf(v[11], v[12]); lo_ = fminf(v[11], v[12]); v[11] = hi_; v[12] = lo_; \
    hi_ = fmaxf(v[13], v[14]); lo_ = fminf(v[13], v[14]); v[13] = hi_; v[14] = lo_; \
    hi_ = fmaxf(v[0], v[8]); lo_ = fminf(v[0], v[8]); v[0] = hi_; v[8] = lo_; \
    hi_ = fmaxf(v[4], v[12]); lo_ = fminf(v[4], v[12]); v[4] = hi_; v[12] = lo_; \
    hi_ = fmaxf(v[4], v[8]); lo_ = fminf(v[4], v[8]); v[4] = hi_; v[8] = lo_; \
    hi_ = fmaxf(v[2], v[10]); lo_ = fminf(v[2], v[10]); v[2] = hi_; v[10] = lo_; \
    hi_ = fmaxf(v[6], v[14]); lo_ = fminf(v[6], v[14]); v[6] = hi_; v[14] = lo_; \
    hi_ = fmaxf(v[6], v[10]); lo_ = fminf(v[6], v[10]); v[6] = hi_; v[10] = lo_; \
    hi_ = fmaxf(v[2], v[4]); lo_ = fminf(v[2], v[4]); v[2] = hi_; v[4] = lo_; \
    hi_ = fmaxf(v[6], v[8]); lo_ = fminf(v[6], v[8]); v[6] = hi_; v[8] = lo_; \
    hi_ = fmaxf(v[10], v[12]); lo_ = fminf(v[10], v[12]); v[10] = hi_; v[12] = lo_; \
    hi_ = fmaxf(v[1], v[9]); lo_ = fminf(v[1], v[9]); v[1] = hi_; v[9] = lo_; \
    hi_ = fmaxf(v[5], v[13]); lo_ = fminf(v[5], v[13]); v[5] = hi_; v[13] = lo_; \
    hi_ = fmaxf(v[5], v[9]); lo_ = fminf(v[5], v[9]); v[5] = hi_; v[9] = lo_; \
    hi_ = fmaxf(v[3], v[11]); lo_ = fminf(v[3], v[11]); v[3] = hi_; v[11] = lo_; \
    hi_ = fmaxf(v[7], v[15]); lo_ = fminf(v[7], v[15]); v[7] = hi_; v[15] = lo_; \
    hi_ = fmaxf(v[7], v[11]); lo_ = fminf(v[7], v[11]); v[7] = hi_; v[11] = lo_; \
    hi_ = fmaxf(v[3], v[5]); lo_ = fminf(v[3], v[5]); v[3] = hi_; v[5] = lo_; \
    hi_ = fmaxf(v[7], v[9]); lo_ = fminf(v[7], v[9]); v[7] = hi_; v[9] = lo_; \
    hi_ = fmaxf(v[11], v[13]); lo_ = fminf(v[11], v[13]); v[11] = hi_; v[13] = lo_; \
    hi_ = fmaxf(v[1], v[2]); lo_ = fminf(v[1], v[2]); v[1] = hi_; v[2] = lo_; \
    hi_ = fmaxf(v[3], v[4]); lo_ = fminf(v[3], v[4]); v[3] = hi_; v[4] = lo_; \
    hi_ = fmaxf(v[5], v[6]); lo_ = fminf(v[5], v[6]); v[5] = hi_; v[6] = lo_; \
    hi_ = fmaxf(v[7], v[8]); lo_ = fminf(v[7], v[8]); v[7] = hi_; v[8] = lo_; \
    hi_ = fmaxf(v[9], v[10]); lo_ = fminf(v[9], v[10]); v[9] = hi_; v[10] = lo_; \
    hi_ = fmaxf(v[11], v[12]); lo_ = fminf(v[11], v[12]); v[11] = hi_; v[12] = lo_; \
    hi_ = fmaxf(v[13], v[14]); lo_ = fminf(v[13], v[14]); v[13] = hi_; v[14] = lo_; \
    } while (0)
#define MERGE16_TOP(a, b) do { _Pragma("unroll") for (int i_ = 0; i_ < 16; ++i_) a[i_] = fmaxf(a[i_], b[15 - i_]); \
    _Pragma("unroll") for (int j_ = 8; j_ > 0; j_ >>= 1) _Pragma("unroll") for (int i_ = 0; i_ < 16; ++i_) { const int l_ = i_ ^ j_; \
    if (l_ > i_) { const float hi_ = fmaxf(a[i_], a[l_]), lo_ = fminf(a[i_], a[l_]); a[i_] = hi_; a[l_] = lo_; } } } while (0)
constexpr int TK_S = 0, TK_SSTR = 136, TK_L = 139264;
__device__ __forceinline__ void topk_select(LAS unsigned char* L, int tid, size_t tok_base, int h, unsigned short* eidx, float* gate) {
    {
        const int row = tid >> 1, hf = tid & 1;
        float a[16];
        const LAS f32x4* sp = (const LAS f32x4*)((LAS float*)(L + TK_S) + row * TK_SSTR) + hf;
#pragma unroll
        for (int blk = 0; blk < 4; ++blk) {
            float v[16];
#pragma unroll
            for (int c4 = 0; c4 < 4; ++c4) { const int i = 4 * blk + c4; const f32x4 x4 = sp[2 * i]; const float ve[4] = {x4.x, x4.y, x4.z, x4.w};
#pragma unroll
                for (int e = 0; e < 4; ++e) v[4 * c4 + e] = __builtin_bit_cast(float, (__builtin_bit_cast(unsigned, ve[e]) & ~127u) | (unsigned)(8 * i + 4 * hf + e)); }
            SORT16_DESC(v);
            if (blk == 0) {
#pragma unroll
                for (int j = 0; j < 16; ++j) a[j] = v[j];
            } else { MERGE16_TOP(a, v); }
        }
        { float pb[16];
#pragma unroll
          for (int j = 0; j < 16; ++j) pb[j] = WDPP_(a[j], 0xb1);
          MERGE16_TOP(a, pb); }
        if (hf == 0) { LAS v4u* tp = (LAS v4u*)(L + TK_L + row * 64);
#pragma unroll
            for (int i = 0; i < 4; ++i) tp[i] = (v4u){__builtin_bit_cast(unsigned, a[4 * i]), __builtin_bit_cast(unsigned, a[4 * i + 1]), __builtin_bit_cast(unsigned, a[4 * i + 2]), __builtin_bit_cast(unsigned, a[4 * i + 3])}; }
    }
    LBAR();
    if (tid < 128) {
        const int t = tid, r0 = t, r1 = 128 + t;
        const LAS unsigned* t0 = (const LAS unsigned*)(L + TK_L + r0 * 64); const LAS unsigned* t1 = (const LAS unsigned*)(L + TK_L + r1 * 64);
        float v1[16], v2[16];
#pragma unroll
        for (int i = 0; i < 4; ++i) { const v4u x = ((const LAS v4u*)t0)[i], y = ((const LAS v4u*)t1)[i];
            v1[4 * i] = __builtin_bit_cast(float, x.x & ~127u); v1[4 * i + 1] = __builtin_bit_cast(float, x.y & ~127u); v1[4 * i + 2] = __builtin_bit_cast(float, x.z & ~127u); v1[4 * i + 3] = __builtin_bit_cast(float, x.w & ~127u);
            v2[4 * i] = __builtin_bit_cast(float, y.x & ~127u); v2[4 * i + 1] = __builtin_bit_cast(float, y.y & ~127u); v2[4 * i + 2] = __builtin_bit_cast(float, y.z & ~127u); v2[4 * i + 3] = __builtin_bit_cast(float, y.w & ~127u); }
        float c[16];
#pragma unroll
        for (int blk = 0; blk < 4; ++blk) {
            float v[16];
#pragma unroll
            for (int j = 0; j < 16; ++j) v[j] = -3.0e38f;
            { int n = 0, slot = 0;
#pragma unroll
              for (int ia = 0; ia < 16; ++ia)
#pragma unroll
                  for (int ib = 0; ib < 16; ++ib) if ((ia + 1) * (ib + 1) <= 16) { if ((n >> 4) == blk) { v[slot] = __builtin_bit_cast(float, (__builtin_bit_cast(unsigned, v1[ia] + v2[ib]) & ~255u) | (unsigned)(ia * 16 + ib)); ++slot; } ++n; } }
            SORT16_DESC(v);
            if (blk == 0) {
#pragma unroll
                for (int j = 0; j < 16; ++j) c[j] = v[j];
            } else { MERGE16_TOP(c, v); }
        }
        float ex[16], sum = 0.f; const float mx = __builtin_bit_cast(float, __builtin_bit_cast(unsigned, c[0]) & ~255u);
#pragma unroll
        for (int k = 0; k < 16; ++k) { ex[k] = fast_exp(__builtin_bit_cast(float, __builtin_bit_cast(unsigned, c[k]) & ~255u) - mx); sum += ex[k]; }
        const float inv = 1.f / sum; const size_t ob = (tok_base + t) * 128 + h * 16;
        unsigned ee[16];
#pragma unroll
        for (int k = 0; k < 16; ++k) { const unsigned code = __builtin_bit_cast(unsigned, c[k]) & 255u;
            const unsigned i1 = t0[code >> 4] & 127u, i2 = t1[code & 15u] & 127u; ee[k] = i1 * 128u + i2; }
        { GAS v4u* ep = (GAS v4u*)(eidx + ob); ep[0] = (v4u){ee[0] | (ee[1] << 16), ee[2] | (ee[3] << 16), ee[4] | (ee[5] << 16), ee[6] | (ee[7] << 16)};
          ep[1] = (v4u){ee[8] | (ee[9] << 16), ee[10] | (ee[11] << 16), ee[12] | (ee[13] << 16), ee[14] | (ee[15] << 16)};
          GAS f32x4* gp = (GAS f32x4*)(gate + ob);
#pragma unroll
          for (int k4 = 0; k4 < 4; ++k4) gp[k4] = (f32x4){ex[4 * k4] * inv, ex[4 * k4 + 1] * inv, ex[4 * k4 + 2] * inv, ex[4 * k4 + 3] * inv}; }
    }
}
struct EpiTopk {
    static constexpr bool PERM = false, AFTER_DRAIN = true;
    unsigned short* eidx; float* gate;
    __device__ __forceinline__ void operator()(pg8::f32x4 (&)[2][2][4][2], const Unit&, int, int, int, int) const {}
    __device__ __forceinline__ void fused(pg8::f32x4 (&acc)[2][2][4][2], const Unit& u, int wr, int wc, int fr, int fq, PG8_LAS unsigned char* lds) const {
        const int tid = threadIdx.x; LAS unsigned char* L = (LAS unsigned char*)lds;
#pragma unroll
        for (int ai = 0; ai < 2; ++ai) {
#pragma unroll
            for (int bj = 0; bj < 2; ++bj)
#pragma unroll
                for (int m = 0; m < 4; ++m)
#pragma unroll
                    for (int n = 0; n < 2; ++n) *(LAS f32x4*)((LAS float*)(L + TK_S) + (bj * 128 + wr * 64 + m * 16 + fr) * TK_SSTR + wc * 32 + n * 16 + 4 * fq) = acc[ai][bj][m][n];
            LBAR();
            topk_select(L, tid, (size_t)u.pm * 256 + 128 * ai, u.pn, eidx, gate);
        }
        __syncthreads();
    }
};

#define TRED3(d, lane, m0, m1, m2) do { \
    _Pragma("unroll") for (int _i = 0; _i < 8; ++_i) { const bool _h = ((lane) & (m0)) != 0; const float _k = _h ? d[_i + 8] : d[_i], _s = _h ? d[_i] : d[_i + 8]; d[_i] = _k + __shfl_xor(_s, (m0)); } \
    _Pragma("unroll") for (int _i = 0; _i < 4; ++_i) { const bool _h = ((lane) & (m1)) != 0; const float _k = _h ? d[_i + 4] : d[_i], _s = _h ? d[_i] : d[_i + 4]; d[_i] = _k + __shfl_xor(_s, (m1)); } \
    _Pragma("unroll") for (int _i = 0; _i < 2; ++_i) { const bool _h = ((lane) & (m2)) != 0; const float _k = _h ? d[_i + 2] : d[_i], _s = _h ? d[_i] : d[_i + 2]; d[_i] = _k + __shfl_xor(_s, (m2)); } } while (0)
typedef int i32x4 __attribute__((ext_vector_type(4)));
#define PX_LOAD_E(ev, tok) do { const GAS v4u* ep_ = (const GAS v4u*)(eidx + (size_t)(tok) * 128 + 16 * pg); ev[0] = ep_[0]; ev[1] = ep_[1]; } while (0)
#define PX_LOAD_ROWS8(rows, ea, base) do { const unsigned e_[8] = {ea.x & 0xffffu, ea.x >> 16, ea.y & 0xffffu, ea.y >> 16, ea.z & 0xffffu, ea.z >> 16, ea.w & 0xffffu, ea.w >> 16}; \
    _Pragma("unroll") for (int i_ = 0; i_ < 8; ++i_) rows[i_] = *(const GAS v4u*)((base) + (e_[i_] * 128u + cgo)); } while (0)
#define TRED3I(d, lane, m0, m1, m2) do { \
    _Pragma("unroll") for (int _i = 0; _i < 8; ++_i) { const bool _h = ((lane) & (m0)) != 0; const int _k = _h ? d[_i + 8] : d[_i], _s = _h ? d[_i] : d[_i + 8]; d[_i] = _k + __shfl_xor(_s, (m0)); } \
    _Pragma("unroll") for (int _i = 0; _i < 4; ++_i) { const bool _h = ((lane) & (m1)) != 0; const int _k = _h ? d[_i + 4] : d[_i], _s = _h ? d[_i] : d[_i + 4]; d[_i] = _k + __shfl_xor(_s, (m1)); } \
    _Pragma("unroll") for (int _i = 0; _i < 2; ++_i) { const bool _h = ((lane) & (m2)) != 0; const int _k = _h ? d[_i + 2] : d[_i], _s = _h ? d[_i] : d[_i + 2]; d[_i] = _k + __shfl_xor(_s, (m2)); } } while (0)
typedef int i32x2 __attribute__((ext_vector_type(2)));
typedef unsigned u32x2_t __attribute__((ext_vector_type(2)));
#define PU4_LOAD_H(ha, hb, tok) do { const GAS v4u* hp_ = (const GAS v4u*)(H8 + (size_t)(tok) * D + 256 * slice + 32 * cg); ha = hp_[0]; hb = hp_[1]; } while (0)
#define QDPP_(x, ctrl) __builtin_amdgcn_mov_dpp((x), (ctrl), 0xf, 0xf, true)
#define PU4_DOT8(rows, dd, off) do { \
    _Pragma("unroll") for (int i_ = 0; i_ < 8; ++i_) { const unsigned w_[4] = {rows[i_].x, rows[i_].y, rows[i_].z, rows[i_].w}; int sa_ = 0, sb_ = 0; \
        _Pragma("unroll") for (int q_ = 0; q_ < 4; ++q_) { sa_ = __builtin_amdgcn_sdot8((int)w_[q_], ha_[q_], sa_, false); sb_ = __builtin_amdgcn_sdot8((int)w_[q_], hb_[q_], sb_, false); } \
        dd[(off) + i_] = (sa_ << 4) + sb_; } } while (0)
__device__ __forceinline__ void peer_u_slice(unsigned char* ws_, const unsigned char* H8, int slice, int rank, int nrank) {
    const int lane = threadIdx.x & 63, wave = __builtin_amdgcn_readfirstlane(threadIdx.x >> 6);
    const int pg = lane >> 3, cg = lane & 7, wi = rank * NWAVES + wave, nw = nrank * NWAVES;
    const unsigned char* Us = ws_ + WS_U8 + (size_t)slice * ((size_t)NEXP * 128); const unsigned cgo = 16u * cg;
    const unsigned short* eidx = (const unsigned short*)(ws_ + WS_EIDX); bf16* part = (bf16*)(ws_ + WS_PART) + (size_t)slice * ML * 128;
    v4u eC[2], eN[2]; v4u r0[8], r1[8]; v4u hC0, hC1, hN0, hN1;
    PX_LOAD_E(eC, wi); PU4_LOAD_H(hC0, hC1, wi); PX_LOAD_ROWS8(r0, eC[0], Us);
#pragma unroll 1
    for (int t = wi; t < ML; t += nw) {
        const int tn = (t + nw < ML) ? t + nw : t;
        PX_LOAD_ROWS8(r1, eC[1], Us); PX_LOAD_E(eN, tn); PU4_LOAD_H(hN0, hN1, tn);
        __builtin_amdgcn_sched_barrier(0);
        const int ha_[4] = {(int)hC0.x, (int)hC0.y, (int)hC0.z, (int)hC0.w}, hb_[4] = {(int)hC1.x, (int)hC1.y, (int)hC1.z, (int)hC1.w};
        int d[16];
        PU4_DOT8(r0, d, 0);
        PX_LOAD_ROWS8(r0, eN[0], Us);
        __builtin_amdgcn_sched_barrier(0);
        PU4_DOT8(r1, d, 8);
#pragma unroll
        for (int i_ = 0; i_ < 8; ++i_) { const int a_ = d[i_] + QDPP_(d[i_], 0x12c), b_ = d[i_ + 8] + QDPP_(d[i_ + 8], 0x124); d[i_] = (lane & 4) ? b_ : a_; }
#pragma unroll
        for (int i_ = 0; i_ < 4; ++i_) { const bool h_ = (lane & 2) != 0; const int k_ = h_ ? d[i_ + 4] : d[i_], s_ = h_ ? d[i_] : d[i_ + 4]; d[i_] = k_ + QDPP_(s_, 0x4e); }
#pragma unroll
        for (int i_ = 0; i_ < 2; ++i_) { const bool h_ = (lane & 1) != 0; const int k_ = h_ ? d[i_ + 2] : d[i_], s_ = h_ ? d[i_] : d[i_ + 2]; d[i_] = k_ + QDPP_(s_, 0xb1); }
        *(GAS unsigned*)(part + (size_t)t * 128 + 2 * lane) = pk2((float)d[0], (float)d[1]);
        eC[0] = eN[0]; eC[1] = eN[1]; hC0 = hN0; hC1 = hN1;
    }
}
typedef _Float16 h16x2 __attribute__((ext_vector_type(2)));
__device__ __forceinline__ void peer_reduce(Frame& F) {
    const bf16* part = (const bf16*)(F.ws + WS_PART); const float* sh = (const float*)(F.ws + WS_SH); const unsigned short* eidx = (const unsigned short*)(F.ws + WS_EIDX); const float* gate = (const float*)(F.ws + WS_GATE);
    const float* su = (const float*)(F.ws + WS_SU); const float* sv = (const float*)(F.ws + WS_SV); unsigned* wq = (unsigned*)(F.ws + WS_WGT); float* wsc = (float*)(F.ws + WS_WGT + 4 * MiB);
    for (size_t i4 = (size_t)F.bid * NTHREADS + F.tid; i4 < (size_t)ML * 32; i4 += (size_t)F.G * NTHREADS) {
        const size_t i = 4 * i4;
        f32x4 s = (f32x4){0.f, 0.f, 0.f, 0.f};
#pragma unroll
        for (int x = 0; x < 4; ++x) { const v2u pv = *(const GAS v2u*)(part + (size_t)x * ML * 128 + i); s += (f32x4){bflo(pv.x), bfhi(pv.x), bflo(pv.y), bfhi(pv.y)}; }
        const v2u ev = *(const GAS v2u*)(eidx + i); const f32x4 gv = *(const GAS f32x4*)(gate + i); const float sht = sh[i >> 7];
        { const float hh = 0.5f * sh[ML + (i >> 7)]; s.x += hh; s.y += hh; s.z += hh; s.w += hh; }
        const unsigned e[4] = {ev.x & 0xffffu, ev.x >> 16, ev.y & 0xffffu, ev.y >> 16}; const float sv4[4] = {s.x, s.y, s.z, s.w}; const float g4[4] = {gv.x, gv.y, gv.z, gv.w};
        float w[4];
#pragma unroll
        for (int k = 0; k < 4; ++k) { const float z = sv4[k] * su[e[k]] * sht; w[k] = g4[k] * (0.5f * z * (1.f + erff(z * 0.70710678118f))) * sv[e[k]]; }
        float m = fmaxf(fmaxf(fabsf(w[0]), fabsf(w[1])), fmaxf(fabsf(w[2]), fabsf(w[3])));
        m = fmaxf(m, WDPP_(m, 0xb1)); m = fmaxf(m, WDPP_(m, 0x4e)); m = fmaxf(m, WDPP_(m, 0x141)); m = fmaxf(m, WDPP_(m, 0x140)); WSWAP_(m, 16, fmaxf);
        const float qs = (m > 0.f) ? 127.f / m : 1.f;
        const float q0 = rintf(w[0] * qs), q1 = rintf(w[1] * qs), q2 = rintf(w[2] * qs), q3 = rintf(w[3] * qs);
        wq[i4] = pack_i8x4(q0, q1, q2, q3);
        float qsum = (q0 + q1) + (q2 + q3);
        qsum += WDPP_(qsum, 0xb1); qsum += WDPP_(qsum, 0x4e); qsum += WDPP_(qsum, 0x141); qsum += WDPP_(qsum, 0x140); WSWAP_(qsum, 16, WADD_);
        if ((i4 & 31) == 0) { const float st = (m > 0.f) ? m * (1.f / 127.f) : 0.f; wsc[i >> 7] = st * (1.f / 16.f); wsc[ML + (i >> 7)] = st * 0.5f * qsum; wsc[2 * ML + (i >> 7)] = st * 8.f * qsum; }
    }
}
#define PV_LOAD_W(wv, tok) do { wv = *(const GAS v4u*)(wq + (size_t)(tok) * 128 + 16 * pg); } while (0)
#define PV4_ACC4(ra, rb, rc, rd, wd) do { const unsigned a_[4] = {ra.x, ra.y, ra.z, ra.w}, b_[4] = {rb.x, rb.y, rb.z, rb.w}, c_[4] = {rc.x, rc.y, rc.z, rc.w}, d_[4] = {rd.x, rd.y, rd.z, rd.w}; \
    _Pragma("unroll") for (int q_ = 0; q_ < 4; ++q_) { \
        const unsigned t0_ = __builtin_amdgcn_perm(b_[q_], a_[q_], 0x05010400u), t1_ = __builtin_amdgcn_perm(b_[q_], a_[q_], 0x07030602u); \
        const unsigned t2_ = __builtin_amdgcn_perm(d_[q_], c_[q_], 0x05010400u), t3_ = __builtin_amdgcn_perm(d_[q_], c_[q_], 0x07030602u); \
        const unsigned T_[4] = {__builtin_amdgcn_perm(t2_, t0_, 0x05040100u), __builtin_amdgcn_perm(t2_, t0_, 0x07060302u), __builtin_amdgcn_perm(t3_, t1_, 0x05040100u), __builtin_amdgcn_perm(t3_, t1_, 0x07060302u)}; \
        _Pragma("unroll") for (int k_ = 0; k_ < 4; ++k_) { \
            acc[8 * q_ + 2 * k_]     = __builtin_amdgcn_sdot4((int)T_[k_], (int)(wd), acc[8 * q_ + 2 * k_], false); \
            acc[8 * q_ + 2 * k_ + 1] = __builtin_amdgcn_sdot4((int)(T_[k_] & 0x0f0f0f0fu), (int)(wd), acc[8 * q_ + 2 * k_ + 1], false); } } } while (0)
__device__ __forceinline__ void peer_v_slice(unsigned char* ws_, bf16* po_, int slice, int rank, int nrank) {
    const int lane = threadIdx.x & 63, wave = __builtin_amdgcn_readfirstlane(threadIdx.x >> 6);
    const int pg = lane >> 3, cg = lane & 7, wi = rank * NWAVES + wave, nw = nrank * NWAVES;
    const unsigned char* Vs = ws_ + WS_V8 + (size_t)slice * ((size_t)NEXP * 128); const unsigned cgo = 16u * cg;
    const unsigned short* eidx = (const unsigned short*)(ws_ + WS_EIDX); const unsigned char* wq = ws_ + WS_WGT; const float* wsc = (const float*)(ws_ + WS_WGT + 4 * MiB);
    const int col = 256 * slice + 32 * cg + 4 * pg;
    v4u eC[2], eN[2]; v4u r0[8], r1[8]; v4u wC, wN; float sC, sN, oC, oN, pC, pN;
    PX_LOAD_E(eC, wi); PV_LOAD_W(wC, wi); sC = wsc[wi]; oC = wsc[ML + wi]; pC = wsc[2 * ML + wi]; PX_LOAD_ROWS8(r0, eC[0], Vs);
#pragma unroll 1
    for (int t = wi; t < ML; t += nw) {
        const int tn = (t + nw < ML) ? t + nw : t;
        PX_LOAD_ROWS8(r1, eC[1], Vs); PX_LOAD_E(eN, tn); PV_LOAD_W(wN, tn); sN = wsc[tn]; oN = wsc[ML + tn]; pN = wsc[2 * ML + tn];
        __builtin_amdgcn_sched_barrier(0);
        int acc[32];
#pragma unroll
        for (int k = 0; k < 32; ++k) acc[k] = 0;
        PV4_ACC4(r0[0], r0[1], r0[2], r0[3], wC.x); __builtin_amdgcn_sched_barrier(0);
        PV4_ACC4(r0[4], r0[5], r0[6], r0[7], wC.y);
        PX_LOAD_ROWS8(r0, eN[0], Vs);
        __builtin_amdgcn_sched_barrier(0);
        PV4_ACC4(r1[0], r1[1], r1[2], r1[3], wC.z); __builtin_amdgcn_sched_barrier(0);
        PV4_ACC4(r1[4], r1[5], r1[6], r1[7], wC.w);
#pragma unroll
        for (int i_ = 0; i_ < 16; ++i_) { const u32x2_t r_ = __builtin_amdgcn_permlane32_swap((unsigned)acc[i_], (unsigned)acc[i_ + 16], false, false); acc[i_] = (int)(r_.x + r_.y); }
#pragma unroll
        for (int i_ = 0; i_ < 8; ++i_) { const u32x2_t r_ = __builtin_amdgcn_permlane16_swap((unsigned)acc[i_], (unsigned)acc[i_ + 8], false, false); acc[i_] = (int)(r_.x + r_.y); }
#pragma unroll
        for (int i_ = 0; i_ < 4; ++i_) { const int a_ = acc[i_] + QDPP_(acc[i_], 0x128), b_ = acc[i_ + 4] + QDPP_(acc[i_ + 4], 0x128); acc[i_] = (lane & 8) ? b_ : a_; }
        v2u ov; ov.x = pk2((float)(acc[0] - acc[1]) * sC + oC, (float)acc[1] * (16.f * sC) - pC + oC); ov.y = pk2((float)(acc[2] - acc[3]) * sC + oC, (float)acc[3] * (16.f * sC) - pC + oC);
        *(GAS v2u*)(po_ + (size_t)t * D + col) = ov;
        eC[0] = eN[0]; eC[1] = eN[1]; wC = wN; sC = sN; oC = oN; pC = pN;
    }
}
__device__ __forceinline__ void final_norm(Frame& F) {
    const bf16* po = (const bf16*)(F.ws + WS_PO); const float* mod = (const float*)(F.ws + WS_MOD); const int lane = F.lane, gw = F.bid * NWAVES + F.wave, NGW = F.G * NWAVES;
    for (int t0 = gw; t0 < ML; t0 += 2 * NGW) {
        f32x4 xv[2][4]; float s2[2] = {0.f, 0.f};
#pragma unroll
        for (int r = 0; r < 2; ++r) { const int t = (t0 + r * NGW < ML) ? t0 + r * NGW : t0;
            const GAS v2u* orow0 = (const GAS v2u*)((const bf16*)(F.ws + WS_YHG) + (size_t)t * 512) + lane; const GAS v2u* orow1 = (const GAS v2u*)((const bf16*)(F.ws + WS_YPOOL) + (size_t)t * 512) + lane; const GAS v2u* prow = (const GAS v2u*)(po + (size_t)t * D) + lane;
            const GAS f32x4* g2 = (const GAS f32x4*)(mod + (size_t)(t >> 12) * 6144 + 5 * 1024) + lane;
#pragma unroll
            for (int j = 0; j < 4; ++j) { const v2u xw = (j < 2) ? orow0[64 * j] : orow1[64 * (j - 2)]; const f32x4 x1 = (f32x4){bflo(xw.x), bfhi(xw.x), bflo(xw.y), bfhi(xw.y)}, gg = g2[64 * j]; const v2u pv = prow[64 * j];
                xv[r][j] = x1 + gg * (f32x4){bflo(pv.x), bfhi(pv.x), bflo(pv.y), bfhi(pv.y)};
                s2[r] += (xv[r][j].x * xv[r][j].x + xv[r][j].y * xv[r][j].y) + (xv[r][j].z * xv[r][j].z + xv[r][j].w * xv[r][j].w); } }
#pragma unroll
        for (int r = 0; r < 2; ++r) { const int t = t0 + r * NGW; if (t < ML) {
            const float rstd = 1.f / sqrtf(wave_sum(s2[r]) * (1.f / D) + EPS); GAS f32x4* orow = (GAS f32x4*)(F.out + (size_t)t * D) + lane;
#pragma unroll
            for (int j = 0; j < 4; ++j) { const f32x4 fg = ((const GAS f32x4*)F.final_g)[lane + 64 * j]; f32x4 ov = xv[r][j] * rstd * fg;
                orow[64 * j] = ov; } } }
    }
}

constexpr int N_PHASES = 15;
__global__ void __launch_bounds__(NTHREADS, 2) fwd_kernel(Args args) {
    extern __shared__ __attribute__((aligned(16))) unsigned char lds[];
    Frame F;
    F.lds = (LAS unsigned char*)lds;
    F.tid = threadIdx.x; F.lane = F.tid & 63; F.wave = __builtin_amdgcn_readfirstlane(F.tid >> 6); F.G = gridDim.x; F.bid = blockIdx.x;
    F.x = args.in[0]; F.c = args.in[1]; F.ctx = args.in[2]; F.c_ctx = args.in[3]; F.w_mod = args.in[4]; F.b_mod = args.in[5]; F.n1g = args.in[6]; F.n2g = args.in[7];
    F.w_in = args.in[8]; F.pool_w = args.in[9]; F.pool_scale = args.in[10]; F.lb_logits = args.in[11]; F.hg_norm_g = args.in[12]; F.w_a = args.in[13]; F.w_b = args.in[14];
    F.w_o = args.in[15]; F.wq = args.in[16]; F.keys = args.in[17]; F.pu = args.in[18]; F.pv = args.in[19]; F.final_g = args.in[20];
    F.out = args.out; F.ws = args.ws;
    volatile LAS unsigned* MISC = (volatile LAS unsigned*)(F.lds + MISC_OFF);
    if (F.tid < 64) MISC[F.tid] = 0u;
    __syncthreads();
    unsigned* barw = (unsigned*)(F.ws + WS_CTL) + CW_BAR;
    XcdBarrier bar; bar.bar = barw; bar.x = 0; bar.st = nullptr;
    if (ONE_LAUNCH) bar = xcd_barrier_post(barw, MISC + 8);
    const int lo = args.ph_lo, hi = args.ph_hi;
#ifndef PH_MASK
#define PH_MASK 0x7fff
#endif
#define IN(k) (((PH_MASK >> (k)) & 1) && lo <= (k) && (k) < hi)
#define SEAM(k) do { if (IN(k) && IN((k) + 1)) xcd_barrier(bar); } while (0)

#ifndef REPP
#define REPP (-1)
#endif
#define RUNP(k, ...) do { if (IN(k)) { __VA_ARGS__ if (REPP == (k)) { __syncthreads(); __VA_ARGS__ } } } while (0)
    RUNP(0, p0_prologue(F););
    { __syncthreads(); if (F.tid == 0) { unsigned* c_ = (unsigned*)(F.ws + WS_CTL) + CW_MODCNT; XB_SPIN(xb_ld(c_) < 192u, barw); __builtin_amdgcn_fence(__ATOMIC_ACQUIRE, "agent"); asm volatile("s_waitcnt vmcnt(0)" ::: "memory"); } __syncthreads(); }
    RUNP(1, p1_modulate(F);); SEAM(1);
    RUNP(2, {
        SchedIn S{(const char*)(F.ws + WS_H), (const char*)(F.ws + WS_WIN), F.G, F.bid};
        EpiZ E{(bf16*)(F.ws + WS_ZA), (bf16*)(F.ws + WS_ZB), (bf16*)(F.ws + WS_ZC), (bf16*)(F.ws + WS_ZC2)};
        pg8::gemm_phase<EpiZ, SchedIn, true, true>(F.lds, D, S, E);
    }); SEAM(2);
    RUNP(3, {
        for (int u = F.bid; u < NSCAN; u += F.G) scan_unit(F, u);
        for (int u = F.bid; u < NB * 64; u += F.G) pool_unit(F, u);
    }); if (IN(3) && IN(14)) xcd_barrier(bar);
    RUNP(14, { for (int u = F.bid; u < 256; u += F.G) prefix_unit(F, u); }); if (IN(14) && IN(4)) xcd_barrier(bar);
    int pm = 0, pn = 0; pg8::tile_of(F.bid, 64, 4, pm, pn);
    unsigned* pcnt = (unsigned*)(F.ws + WS_CTL) + CW_PANEL + pm * 16;
#define PANEL_SYNC(seam) do { asm volatile("s_waitcnt vmcnt(0)" ::: "memory"); __syncthreads(); \
        if (F.tid == 0) { unsigned* c_ = pcnt + (seam) * 1024; xb_add(c_, 1u); XB_SPIN(xb_ld(c_) < 4u, barw); __builtin_amdgcn_fence(__ATOMIC_ACQUIRE, "agent"); asm volatile("s_waitcnt vmcnt(0)" ::: "memory"); } \
        __syncthreads(); } while (0)
#define P7B_TABLES() do { const int gw = F.bid * NWAVES + F.wave, NGW = F.G * NWAVES; \
          i4_rows(F.pu, F.ws + WS_U8, (float*)(F.ws + WS_SU), gw, NGW, F.lane, false); \
          i4_rows(F.pv, F.ws + WS_V8, (float*)(F.ws + WS_SV), gw, NGW, F.lane, true); } while (0)
    if (F.bid & 1) { P7B_TABLES(); __syncthreads(); }
    RUNP(4, { fix_unit(F, pm >> 4, pn, (pm >> 1) & 7, pm & 1); });
    PANEL_SYNC(0);
    RUNP(5, {
        SchedMerge S{(const char*)(F.ws + WS_YPOOL), (const char*)(F.ws + WS_YHG), (const char*)(F.ws + WS_WPA), (const char*)(F.ws + WS_WB), F.G, F.bid};
        EpiMerge E{(const bf16*)(F.ws + WS_ZB), (bf16*)(F.ws + WS_M)};
        pg8::gemm_phase<EpiMerge, SchedMerge, true, true>(F.lds, 512, S, E);
    });
    PANEL_SYNC(1);
    RUNP(6, {
        SchedTile S{(const char*)(F.ws + WS_M), (const char*)(F.ws + WS_WO), D, pm, pn};
        EpiRes E{F.x, (const float*)(F.ws + WS_MOD), (bf16*)(F.ws + WS_YHG), (bf16*)(F.ws + WS_YPOOL)};
        pg8::gemm_phase<EpiRes, SchedTile, true, true>(F.lds, D, S, E);
    });
    PANEL_SYNC(2);
    RUNP(7, {
        const float* mod = (const float*)(F.ws + WS_MOD) + (pm >> 4) * 6144; bf16* H2 = (bf16*)(F.ws + WS_M);
        const bf16* X0 = (const bf16*)(F.ws + WS_YHG); const bf16* X1 = (const bf16*)(F.ws + WS_YPOOL); unsigned char* H8 = (unsigned char*)F.out + OUT_QSEG;
        const size_t m0 = (size_t)pm * 256 + pn * 64 + F.wave * 8;
        v2u xc[4]; mrq_load(X0 + m0 * 512, X1 + m0 * 512, F.lane, xc);
        _Pragma("unroll 1") for (int i = 0; i < 8; ++i) { const size_t m = m0 + i, mn = m0 + (i < 7 ? i + 1 : i);
            v2u xn[4]; mrq_load(X0 + mn * 512, X1 + mn * 512, F.lane, xn);
            mrq_finish(xc, H2 + m * D, H8 + m * D, (float*)(F.ws + WS_SH) + m, (float*)(F.ws + WS_SH) + ML + m, F.n2g, mod + 3 * 1024, mod + 4 * 1024, F.lane);
            xc[0] = xn[0]; xc[1] = xn[1]; xc[2] = xn[2]; xc[3] = xn[3]; }
    });
    PANEL_SYNC(3);
    RUNP(8, {
        EpiTopk E{(unsigned short*)(F.ws + WS_EIDX), (float*)(F.ws + WS_GATE)};
        { SchedTile S{(const char*)(F.ws + WS_M), (const char*)(F.ws + WS_WQ), D, pm, pn};
          pg8::gemm_phase<EpiTopk, SchedTile, true, true>(F.lds, D, S, E); }
        __syncthreads();
        { SchedTile S{(const char*)(F.ws + WS_M), (const char*)(F.ws + WS_WQ), D, pm, pn + 4};
          pg8::gemm_phase<EpiTopk, SchedTile, true, true>(F.lds, D, S, E); }
    });
    if (!(F.bid & 1)) { __syncthreads(); P7B_TABLES(); }
    xcd_barrier(bar);
    int pslice = F.bid & 7, prank = F.bid >> 3; const int pnrank = F.G >> 3;
    if (ONE_LAUNCH && (IN(10) || IN(12))) {
        bool okc = (F.G == 256) && (bar.x < 8u);
#pragma unroll
        for (int j = 0; j < 8; ++j) okc = okc && (xb_ld(&barw[XB_XCNT(j)]) == 32u);
        if (okc) { pslice = (int)bar.x; prank = (int)MISC[10]; }
    }
    RUNP(10, peer_u_slice(F.ws, (const unsigned char*)F.out + OUT_QSEG, pslice & 3, (pslice >> 2) * pnrank + prank, 2 * pnrank);); SEAM(10);
    RUNP(11, peer_reduce(F);); SEAM(11);
    RUNP(12, peer_v_slice(F.ws, (bf16*)(F.ws + WS_PO), pslice & 3, (pslice >> 2) * pnrank + prank, 2 * pnrank);); SEAM(12);
    RUNP(13, final_norm(F););
#undef RUNP
#undef IN
#undef SEAM
}

extern "C" void kernel_launch(void* const* d_in, const int* in_sizes, int n_in, void* d_out, int out_size, void* d_ws, size_t ws_size, hipStream_t stream) {
    static int grid = 0;
    if (grid == 0) {
        if (n_in != 21 || out_size != ML * D || ws_size < WS_END) { fprintf(stderr, "kernel_launch: unexpected problem (n_in %d, out %d, ws %zu)\n", n_in, out_size, ws_size); grid = -1; return; }
        int dev = 0, cus = 0;
        if (hipGetDevice(&dev) != hipSuccess || hipDeviceGetAttribute(&cus, hipDeviceAttributeMultiprocessorCount, dev) != hipSuccess) { grid = -1; return; }
        if (hipFuncSetAttribute((const void*)fwd_kernel, hipFuncAttributeMaxDynamicSharedMemorySize, LDS_BYTES) != hipSuccess) { fprintf(stderr, "kernel_launch: hipFuncSetAttribute failed\n"); grid = -1; return; }
        int per_cu = 0;
        if (hipOccupancyMaxActiveBlocksPerMultiprocessor(&per_cu, (const void*)fwd_kernel, NTHREADS, LDS_BYTES) != hipSuccess || per_cu < 1) fprintf(stderr, "kernel_launch: occupancy query says %d\n", per_cu);
        (void)hipGetLastError();
        if (cus != 256) { fprintf(stderr, "kernel_launch: the row-panel chain is laid out for 256 workgroups (one per CU), found %d CUs\n", cus); grid = -1; return; }
        grid = cus;
    }
    if (grid < 0) return;
    (void)hipMemsetAsync((char*)d_ws + WS_CTL, 0, CTL_ZERO_BYTES, stream);
    Args a{};
    for (int i = 0; i < 21; ++i) a.in[i] = (const float*)d_in[i];
    a.out = (float*)d_out; a.ws = (unsigned char*)d_ws;
#if ONE_LAUNCH
    a.ph_lo = 0; a.ph_hi = N_PHASES;
    hipLaunchKernelGGL(fwd_kernel, dim3(grid), dim3(NTHREADS), LDS_BYTES, stream, a);
#else
    static const int order[N_PHASES - 1] = {0, 1, 2, 3, 14, 4, 5, 6, 7, 8, 10, 11, 12, 13};
    for (int pi = 0; pi < N_PHASES - 1; ++pi) { const int p = order[pi]; a.ph_lo = p; a.ph_hi = p + 1; hipLaunchKernelGGL(fwd_kernel, dim3(grid), dim3(NTHREADS), LDS_BYTES, stream, a); }
#endif
}
```

```cpp
#define ONE_LAUNCH 1
#include <hip/hip_runtime.h>
#include <cstdio>
#include <cstdint>

#ifndef ONE_LAUNCH
#define ONE_LAUNCH 1
#endif

namespace pg8 {
#define PG8_LAS __attribute__((address_space(3)))
typedef unsigned short bf16_t;
typedef short bf16x8 __attribute__((ext_vector_type(8)));
typedef float f32x4 __attribute__((ext_vector_type(4)));
typedef float f32x2 __attribute__((ext_vector_type(2)));
typedef unsigned u32x4 __attribute__((ext_vector_type(4)));
typedef unsigned u32x2 __attribute__((ext_vector_type(2)));
constexpr int BM = 256, BK = 64, HALF = 128, HTB = HALF * BK * 2, STAGE_BYTES = 8 * HTB, NXCD = 8, WGM = 8;

__host__ __device__ __forceinline__ int lds_byte(int r, int c) { const int st = (r >> 4) * 2 + (c >> 5), rr = r & 15, cc = c & 31, ob = rr * 64 + cc * 2; return st * 1024 + (ob ^ (((ob >> 9) & 1) << 5)); }
__host__ __device__ __forceinline__ void stage_rc(int b, int& R, int& C) { const int st = b / 1024, sb = b % 1024, swz = sb ^ (((sb >> 9) & 1) << 5); R = (st >> 1) * 16 + swz / 64; C = (st & 1) * 32 + (swz % 64) / 2; }
__host__ __device__ __forceinline__ int perm32(int rho) { const int n = rho >> 4, i = rho & 15; return 8 * (i >> 2) + 4 * n + (i & 3); }

struct Unit { int pm, pn, seg; };

__host__ __device__ __forceinline__ void tile_of(int wgid, int nM, int nN, int& pm, int& pn) {
    const int nwg = nM * nN;
    { const int q = nwg / NXCD, r = nwg % NXCD, xcd = wgid % NXCD, off = wgid / NXCD; wgid = (xcd < r ? xcd * (q + 1) : r * (q + 1) + (xcd - r) * q) + off; }
    const int nig = WGM * nN, gid = wgid / nig, fm = gid * WGM, gsz = (nM - fm) < WGM ? (nM - fm) : WGM;
    pm = fm + ((wgid % nig) % gsz); pn = (wgid % nig) / gsz;
}

typedef __bf16 bf16x2_t __attribute__((ext_vector_type(2)));
__device__ __forceinline__ unsigned cvt_pk_bf16(float lo, float hi) { bf16x2_t v; v.x = (__bf16)lo; v.y = (__bf16)hi; return __builtin_bit_cast(unsigned, v); }
__device__ __forceinline__ void st_wt16(void* p, u32x4 v) { asm volatile("global_store_dwordx4 %0, %1, off sc1\n\ts_nop 1" :: "v"(p), "v"(v)); }

template <class Epi, class Sched, bool ALIGN_EPI = false, bool SP2 = false>
__device__ __forceinline__ void gemm_phase(PG8_LAS unsigned char* lds, const int ld, const Sched& S, const Epi& E) {
    const int tid = threadIdx.x, wid = __builtin_amdgcn_readfirstlane(tid >> 6), lane = tid & 63, wr = wid >> 2, wc = wid & 3, fr = lane & 15, fq = lane >> 4;
    unsigned voffA[2], voffB[2];
#pragma unroll
    for (int i = 0; i < 2; ++i) { int R, C; stage_rc(tid * 16 + i * 8192, R, C); const int Rb = Epi::PERM ? ((R & ~31) + perm32(R & 31)) : R;
        voffA[i] = (unsigned)(R * ld + C) * 2u; voffB[i] = (unsigned)(Rb * ld + C) * 2u; }
    const size_t kstep = (size_t)(BK * 2);
    const size_t hstep = (size_t)HALF * ld * 2;
    const unsigned ldsw = (unsigned)wid * 1024u;
    const int aoff = lds_byte(wr * 64 + fr, fq * 8), boff = lds_byte(wc * 32 + fr, fq * 8);
#define PG8_SA(b, h) (((b) * 2 + (h)) * HTB)
#define PG8_SB(b, h) ((4 + (b) * 2 + (h)) * HTB)
#define PG8_STAGE(bufoff, gbase, voff) do { _Pragma("unroll") for (int _i = 0; _i < 2; ++_i) \
        __builtin_amdgcn_global_load_lds((const unsigned*)((const char*)(gbase) + (voff)[_i]), (PG8_LAS unsigned*)(lds + (bufoff) + ldsw + _i * 8192), 16, 0, 0); } while (0)
#define PG8_LDA(dst, b, h) do { _Pragma("unroll") for (int m = 0; m < 4; ++m) _Pragma("unroll") for (int k = 0; k < 2; ++k) dst[m][k] = *(const PG8_LAS bf16x8*)(lds + PG8_SA(b, h) + aoff + m * 2048 + k * 1024); } while (0)
#define PG8_LDB(dst, b, h) do { _Pragma("unroll") for (int n = 0; n < 2; ++n) _Pragma("unroll") for (int k = 0; k < 2; ++k) dst[n][k] = *(const PG8_LAS bf16x8*)(lds + PG8_SB(b, h) + boff + n * 2048 + k * 1024); } while (0)
#define PG8_MMA(ai, bj, At, Bt) do { __builtin_amdgcn_s_setprio(1); _Pragma("unroll") for (int m = 0; m < 4; ++m) _Pragma("unroll") for (int n = 0; n < 2; ++n) _Pragma("unroll") for (int k = 0; k < 2; ++k) \
        acc[ai][bj][m][n] = __builtin_amdgcn_mfma_f32_16x16x32_bf16(Bt[n][k], At[m][k], acc[ai][bj][m][n], 0, 0, 0); __builtin_amdgcn_s_setprio(0); } while (0)
#define PG8_WAIT_V(n) asm volatile("s_waitcnt vmcnt(" #n ")" ::: "memory")
#define PG8_WAIT_L(n) asm volatile("s_waitcnt lgkmcnt(" #n ")" ::: "memory")
#define PG8_BAR __builtin_amdgcn_s_barrier()
#define PG8_SCHED __builtin_amdgcn_sched_barrier(0)
    Unit cur, nxt; int ui = 0;
    if (!S.next(0, cur)) return;
    f32x4 acc[2][2][4][2];
#pragma unroll
    for (int a = 0; a < 2; ++a)
#pragma unroll
        for (int b = 0; b < 2; ++b)
#pragma unroll
            for (int m = 0; m < 4; ++m)
#pragma unroll
                for (int n = 0; n < 2; ++n) acc[a][b][m][n] = (f32x4){0.f, 0.f, 0.f, 0.f};
    bf16x8 At[4][2], B0[2][2], B1[2][2];
    const char* cA = S.A(cur); const char* cB = S.B(cur);
    if constexpr (SP2) {
        PG8_STAGE(PG8_SB(0, 0), cB, voffB); PG8_STAGE(PG8_SB(0, 1), cB + hstep, voffB); PG8_STAGE(PG8_SA(0, 0), cA, voffA); PG8_STAGE(PG8_SA(0, 1), cA + hstep, voffA);
        if (wr == 1) PG8_BAR;
        PG8_WAIT_V(2); PG8_BAR;
        PG8_STAGE(PG8_SB(1, 0), cB + kstep, voffB); PG8_STAGE(PG8_SA(1, 0), cA + kstep, voffA); PG8_STAGE(PG8_SB(1, 1), cB + hstep + kstep, voffB);
        PG8_WAIT_V(6); PG8_BAR;
    } else {
        PG8_STAGE(PG8_SB(0, 0), cB, voffB); PG8_STAGE(PG8_SA(0, 0), cA, voffA); PG8_STAGE(PG8_SB(0, 1), cB + hstep, voffB); PG8_STAGE(PG8_SA(0, 1), cA + hstep, voffA);
        if (wr == 1) PG8_BAR;
        PG8_WAIT_V(4); PG8_BAR;
        PG8_STAGE(PG8_SB(1, 0), cB + kstep, voffB); PG8_STAGE(PG8_SA(1, 0), cA + kstep, voffA); PG8_STAGE(PG8_SB(1, 1), cB + hstep + kstep, voffB);
        PG8_WAIT_V(6); PG8_BAR;
    }
    for (;;) {
        const bool has_next = S.next(ui + 1, nxt); const int nt = S.nt(cur);
        const char* nA = has_next ? S.A(nxt) : cA; const char* nB = has_next ? S.B(nxt) : cB;
        for (int t = 0; t < nt; t += 2) {
            const bool last = (t == nt - 2);
            const char* a1 = cA + (size_t)(t + 1) * kstep;
            const char* a2 = last ? nA : cA + (size_t)(t + 2) * kstep; const char* b2 = last ? nB : cB + (size_t)(t + 2) * kstep;
            const char* a3 = a2 + kstep; const char* b3 = b2 + kstep;
            if constexpr (SP2) {
            PG8_LDB(B0, 0, 0); PG8_LDB(B1, 0, 1); PG8_SCHED; PG8_LDA(At, 0, 0); PG8_STAGE(PG8_SA(1, 1), a1 + hstep, voffA);
            PG8_WAIT_V(8); PG8_WAIT_L(0); PG8_BAR; PG8_MMA(0, 0, At, B0); PG8_MMA(0, 1, At, B1); PG8_BAR; PG8_SCHED;
            PG8_LDA(At, 0, 1); PG8_STAGE(PG8_SB(0, 0), b2, voffB); PG8_STAGE(PG8_SB(0, 1), b2 + hstep, voffB); PG8_STAGE(PG8_SA(0, 0), a2, voffA);
            PG8_WAIT_V(8); PG8_WAIT_L(0); PG8_BAR; PG8_MMA(1, 0, At, B0); PG8_MMA(1, 1, At, B1); PG8_BAR; PG8_SCHED;
            PG8_LDB(B0, 1, 0); PG8_LDB(B1, 1, 1); PG8_SCHED; PG8_LDA(At, 1, 0); PG8_STAGE(PG8_SA(0, 1), a2 + hstep, voffA);
            PG8_WAIT_V(8); PG8_WAIT_L(0); PG8_BAR; PG8_MMA(0, 0, At, B0); PG8_MMA(0, 1, At, B1); PG8_BAR; PG8_SCHED;
            PG8_LDA(At, 1, 1); PG8_STAGE(PG8_SB(1, 0), b3, voffB); PG8_STAGE(PG8_SB(1, 1), b3 + hstep, voffB); PG8_STAGE(PG8_SA(1, 0), a3, voffA);
            PG8_WAIT_V(8); PG8_WAIT_L(0); PG8_BAR; PG8_MMA(1, 0, At, B0); PG8_MMA(1, 1, At, B1); PG8_BAR; PG8_SCHED;
            } else {
            PG8_LDB(B0, 0, 0); PG8_SCHED; PG8_LDA(At, 0, 0); PG8_STAGE(PG8_SA(1, 1), a1 + hstep, voffA);
            PG8_WAIT_L(8); PG8_BAR; PG8_WAIT_L(0); PG8_MMA(0, 0, At, B0); PG8_BAR; PG8_SCHED;
            PG8_LDB(B1, 0, 1); PG8_STAGE(PG8_SB(0, 0), b2, voffB);
            PG8_BAR; PG8_WAIT_L(0); PG8_MMA(0, 1, At, B1); PG8_BAR;
            PG8_LDA(At, 0, 1); PG8_STAGE(PG8_SA(0, 0), a2, voffA);
            PG8_BAR; PG8_WAIT_L(0); PG8_MMA(1, 0, At, B0); PG8_BAR; PG8_SCHED;
            PG8_STAGE(PG8_SB(0, 1), b2 + hstep, voffB);
            PG8_WAIT_V(6); PG8_BAR; PG8_MMA(1, 1, At, B1); PG8_BAR;
            PG8_LDB(B0, 1, 0); PG8_SCHED; PG8_LDA(At, 1, 0); PG8_STAGE(PG8_SA(0, 1), a2 + hstep, voffA);
            PG8_WAIT_L(8); PG8_BAR; PG8_WAIT_L(0); PG8_MMA(0, 0, At, B0); PG8_BAR; PG8_SCHED;
            PG8_LDB(B1, 1, 1); PG8_STAGE(PG8_SB(1, 0), b3, voffB);
            PG8_BAR; PG8_WAIT_L(0); PG8_MMA(0, 1, At, B1); PG8_BAR;
            PG8_LDA(At, 1, 1); PG8_STAGE(PG8_SA(1, 0), a3, voffA);
            PG8_BAR; PG8_WAIT_L(0); PG8_MMA(1, 0, At, B0); PG8_BAR; PG8_SCHED;
            PG8_STAGE(PG8_SB(1, 1), b3 + hstep, voffB);
            PG8_WAIT_V(6); PG8_BAR; PG8_MMA(1, 1, At, B1); PG8_BAR;
            }
        }
        if constexpr (ALIGN_EPI) { if (wr == 0) PG8_BAR; }
        if constexpr (!Epi::AFTER_DRAIN) E(acc, cur, wr, wc, fr, fq);
        if (!has_next) break;
        if (!S.keep(cur)) {
#pragma unroll
        for (int a = 0; a < 2; ++a)
#pragma unroll
            for (int b = 0; b < 2; ++b)
#pragma unroll
                for (int m = 0; m < 4; ++m)
#pragma unroll
                    for (int n = 0; n < 2; ++n) acc[a][b][m][n] = (f32x4){0.f, 0.f, 0.f, 0.f};
        }
        cur = nxt; cA = nA; cB = nB; ++ui;
        if constexpr (ALIGN_EPI) { if (wr == 1) PG8_BAR; }
    }
    PG8_WAIT_V(0);
    if constexpr (!ALIGN_EPI) { if (wr == 0) PG8_BAR; }
    PG8_BAR;
    if constexpr (Epi::AFTER_DRAIN) E.fused(acc, cur, wr, wc, fr, fq, lds);
#undef PG8_SA
#undef PG8_SB
#undef PG8_STAGE
#undef PG8_LDA
#undef PG8_LDB
#undef PG8_MMA
#undef PG8_WAIT_V
#undef PG8_WAIT_L
#undef PG8_BAR
#undef PG8_SCHED
}
}

constexpr int D = 1024, NB = 4, SEQ = 4096, CTXL = 256;
constexpr int ML = NB * SEQ;
constexpr int MC = NB * CTXL;
constexpr int MH = ML + MC;
constexpr int INW = 5120;
constexpr int ZC_W = 1536;
constexpr int NEXP = 16384, NHEAD_P = 8, TOPK = 16;
constexpr float EPS = 1e-6f;
constexpr int NWAVES = 8, NTHREADS = 512;
constexpr int SEGT = 512, NSEG = SEQ / SEGT;
constexpr int CHT = 32;
constexpr int NSCAN_L = NB * 4 * 2 * NSEG;
constexpr int NCSEG = 4;
constexpr int NSCAN = NSCAN_L + NB * 4 * 2 * NCSEG;

constexpr size_t MiB = 1u << 20;
constexpr size_t WS_CTL = 0, CTL_ZERO_BYTES = 64 * 1024;
constexpr size_t WS_MOD = 1 * MiB;
constexpr size_t WS_LBT = WS_MOD + 128 * 1024;
constexpr size_t WS_ASEG = WS_LBT + 8 * 1024;
constexpr size_t WS_SU = WS_ASEG + 200 * 1024;
constexpr size_t WS_SV = WS_SU + 64 * 1024;
constexpr size_t WS_WIN = 2 * MiB;
constexpr size_t WS_WA = 12 * MiB, WS_WB = 13 * MiB, WS_WO = 14 * MiB, WS_WQ = 16 * MiB;
constexpr size_t WS_WPA = 20 * MiB;
constexpr size_t WS_ZC = 21 * MiB;
constexpr size_t WS_Z = 24 * MiB;
constexpr size_t WS_EIDX = 88 * MiB;
constexpr size_t WS_GATE = 96 * MiB;
constexpr size_t WS_U8 = 112 * MiB, WS_V8 = 128 * MiB;
constexpr size_t WS_PART = 24 * MiB;
constexpr size_t WS_WGT = 104 * MiB;
constexpr size_t WS_SH = WS_ASEG;
constexpr size_t WS_PO = 144 * MiB;
constexpr size_t WS_SSQ = 21 * MiB;
constexpr size_t WS_H = 184 * MiB;
constexpr size_t WS_YHG = 184 * MiB, WS_YPOOL = 200 * MiB;
constexpr size_t WS_USEG = 218 * MiB;
constexpr size_t WS_PFX = 2 * MiB;
constexpr size_t WS_M = 218 * MiB;
constexpr size_t WS_ZC2 = 252 * MiB;
constexpr size_t WS_END = 255 * MiB;
static_assert(WS_Z + (size_t)ML * INW * 2 <= WS_H && WS_H + (size_t)MH * D * 2 <= WS_USEG && WS_USEG + (size_t)NSCAN * 128 * 128 * 4 <= WS_END && WS_M + (size_t)ML * D * 2 <= WS_END && WS_USEG + (size_t)NSCAN * 128 * 128 * 4 <= WS_ZC2 && WS_PFX + 8 * MiB <= WS_WA, "ws map");
static_assert(WS_V8 + (size_t)NEXP * D <= WS_H, "ws map 2");
constexpr size_t OUT_OLOC = 0, OUT_QSEG = 32 * MiB;
constexpr int CW_BAR = 1024;
constexpr int CW_MODCNT = 12288;
constexpr int CW_PANEL = 8192;

constexpr int LDS_BYTES = 163840;
constexpr int MISC_OFF = LDS_BYTES - 256;

#define GAS __attribute__((address_space(1)))
#define LAS __attribute__((address_space(3)))
typedef unsigned short bf16;
typedef unsigned v4u __attribute__((ext_vector_type(4)));
typedef unsigned v2u __attribute__((ext_vector_type(2)));
typedef float f32x4 __attribute__((ext_vector_type(4)));
typedef float f32x2 __attribute__((ext_vector_type(2)));
typedef short bf16x8 __attribute__((ext_vector_type(8)));
typedef short s16x4 __attribute__((ext_vector_type(4)));
#define LDS_WAIT() asm volatile("s_waitcnt lgkmcnt(0)" ::: "memory")
#define VM_WAIT() asm volatile("s_waitcnt vmcnt(0)" ::: "memory")
#define LBAR() do { asm volatile("s_waitcnt lgkmcnt(0)" ::: "memory"); __builtin_amdgcn_s_barrier(); asm volatile("" ::: "memory"); } while (0)
__device__ __forceinline__ unsigned f2bf(float f) { unsigned u = __builtin_bit_cast(unsigned, f); return (u + 0x7fffu + ((u >> 16) & 1u)) >> 16; }
__device__ __forceinline__ unsigned pk2(float lo, float hi) { return pg8::cvt_pk_bf16(lo, hi); }
__device__ __forceinline__ float bflo(unsigned w) { return __builtin_bit_cast(float, w << 16); }
__device__ __forceinline__ float bfhi(unsigned w) { return __builtin_bit_cast(float, w & 0xffff0000u); }
__device__ __forceinline__ float fast_exp(float x) { return __builtin_amdgcn_exp2f(x * 1.4426950408889634f); }
__device__ __forceinline__ float fast_rcp(float x) { return __builtin_amdgcn_rcpf(x); }
__device__ __forceinline__ float sigmoidf_(float x) { return fast_rcp(1.f + fast_exp(-x)); }
__device__ __forceinline__ unsigned pack_i8x4(float a, float b, float c, float d) {
    const int ia = (int)rintf(a), ib = (int)rintf(b), ic = (int)rintf(c), id = (int)rintf(d);
    return ((unsigned)ia & 255u) | (((unsigned)ib & 255u) << 8) | (((unsigned)ic & 255u) << 16) | (((unsigned)id & 255u) << 24);
}
#define WDPP_(v, ctrl) __builtin_bit_cast(float, __builtin_amdgcn_mov_dpp(__builtin_bit_cast(int, (v)), (ctrl), 0xf, 0xf, true))
typedef unsigned wr_u2 __attribute__((ext_vector_type(2)));
#define WSWAP_(v, which, OP) do { unsigned w_ = __builtin_bit_cast(unsigned, (v)); asm volatile("" : "+v"(w_)); \
    const wr_u2 r_ = __builtin_amdgcn_permlane##which##_swap(__builtin_bit_cast(unsigned, (v)), w_, false, false); const unsigned ra_ = r_.x, rb_ = r_.y; (v) = OP(__builtin_bit_cast(float, ra_), __builtin_bit_cast(float, rb_)); } while (0)
#define WADD_(a, b) ((a) + (b))
__device__ __forceinline__ float wave_sum(float v) {
    v += WDPP_(v, 0xb1); v += WDPP_(v, 0x4e); v += WDPP_(v, 0x141); v += WDPP_(v, 0x140);
    WSWAP_(v, 16, WADD_); WSWAP_(v, 32, WADD_);
    return v;
}
__device__ __forceinline__ float wave_max(float v) {
    v = fmaxf(v, WDPP_(v, 0xb1)); v = fmaxf(v, WDPP_(v, 0x4e)); v = fmaxf(v, WDPP_(v, 0x141)); v = fmaxf(v, WDPP_(v, 0x140));
    WSWAP_(v, 16, fmaxf); WSWAP_(v, 32, fmaxf);
    return v;
}

#define XB_TMO      128
#define XB_XCNT(j)  (256  + 64 * (j))
#define XB_XSUB(j)  (1280 + 64 * (j))
#define XB_XGEN(j)  (2304 + 64 * (j))
#define XB_TOP      3328
#define XB_TOPGEN   3392
#define XCD_BAR_WORDS 3456
#define XB_SPIN_CAP (1u << 18)
__device__ __forceinline__ unsigned xb_ld(unsigned* p)              { return __hip_atomic_load(p, __ATOMIC_RELAXED, __HIP_MEMORY_SCOPE_AGENT); }
__device__ __forceinline__ unsigned xb_add(unsigned* p, unsigned v) { return __hip_atomic_fetch_add(p, v, __ATOMIC_RELAXED, __HIP_MEMORY_SCOPE_AGENT); }
__device__ __forceinline__ unsigned xb_xcc_id() { return (unsigned)__builtin_amdgcn_s_getreg((3 << 11) | 20) & 0xFu; }
#define XB_SPIN(cond, bar) do { unsigned _sp = 0; while (cond) { __builtin_amdgcn_s_sleep(1); \
    if ((++_sp & 255u) == 0u) { if (xb_ld(&(bar)[XB_TMO])) break; if (_sp > XB_SPIN_CAP) { atomicAdd(&(bar)[XB_TMO], 1u); break; } } } } while (0)
struct XcdBarrier { unsigned* bar; unsigned x; volatile LAS unsigned* st; };
__device__ __forceinline__ XcdBarrier xcd_barrier_post(unsigned* bar, volatile LAS unsigned* st) {
    XcdBarrier b; b.bar = bar; b.x = xb_xcc_id(); b.st = st;
    if (threadIdx.x == 0) st[2] = xb_add(&bar[XB_XCNT(b.x)], 1u);
    return b;
}
__device__ __forceinline__ void xcd_barrier_complete(unsigned* bar, unsigned x, unsigned& nloc, unsigned& nx) {
    const unsigned G = gridDim.x * gridDim.y * gridDim.z;
    unsigned sum, cnt, mine, sp = 0u;
    for (;;) {
        sum = 0u; cnt = 0u; mine = 0u;
#pragma unroll
        for (unsigned j = 0; j < 16; ++j) { const unsigned c = xb_ld(&bar[XB_XCNT(j)]); sum += c; cnt += (c > 0u) ? 1u : 0u; mine = (j == x) ? c : mine; }
        if (sum == G) break;
        __builtin_amdgcn_s_sleep(1);
        if ((++sp & 255u) == 0u) { if (xb_ld(&bar[XB_TMO])) break; if (sp > XB_SPIN_CAP) { atomicAdd(&bar[XB_TMO], 1u); break; } }
    }
    nloc = mine > 0u ? mine : 1u; nx = cnt > 0u ? cnt : 1u;
}
__device__ __forceinline__ void xcd_barrier(const XcdBarrier& b) {
    asm volatile("s_waitcnt vmcnt(0)" ::: "memory");
    __syncthreads();
    if (threadIdx.x == 0) {
        unsigned* bar = b.bar;
        __builtin_amdgcn_s_waitcnt(0);
        unsigned nloc = b.st[0], nx = b.st[1];
        if (nloc == 0u) { xcd_barrier_complete(bar, b.x, nloc, nx); b.st[0] = nloc; b.st[1] = nx; }
        const unsigned old = xb_add(&bar[XB_XSUB(b.x)], 1u);
        const unsigned gen = old / nloc;
        if (old + 1u == (gen + 1u) * nloc) {
            __builtin_amdgcn_fence(__ATOMIC_RELEASE, "agent");
            asm volatile("s_waitcnt vmcnt(0)" ::: "memory");
            const unsigned og = xb_add(&bar[XB_TOP], 1u);
            const unsigned tg = og / nx;
            if (og + 1u == (tg + 1u) * nx) xb_add(&bar[XB_TOPGEN], 1u);
            else XB_SPIN(xb_ld(&bar[XB_TOPGEN]) == tg, bar);
            __builtin_amdgcn_fence(__ATOMIC_ACQUIRE, "agent");
            xb_add(&bar[XB_XGEN(b.x)], 1u);
            asm volatile("s_waitcnt vmcnt(0)" ::: "memory");
        } else {
            XB_SPIN(xb_ld(&bar[XB_XGEN(b.x)]) == gen, bar);
            __builtin_amdgcn_fence(__ATOMIC_ACQUIRE, "agent");
            asm volatile("s_waitcnt vmcnt(0)" ::: "memory");
        }
    }
    __syncthreads();
}

struct Args { const float* in[21]; float* out; unsigned char* ws; int ph_lo, ph_hi; };

struct Frame {
    LAS unsigned char* lds; int tid, lane, wave, G, bid;
    const float *x, *c, *ctx, *c_ctx, *w_mod, *b_mod, *n1g, *n2g, *w_in, *pool_w, *pool_scale, *lb_logits, *hg_norm_g, *w_a, *w_b, *w_o, *wq, *keys, *pu, *pv, *final_g;
    float* out; unsigned char* ws;
};

__device__ __forceinline__ void p0_transpose_item(const float* W, int K, int N, bf16* WT, LAS float* scr, int item, int lane) {
    const int nblk = N / 32, kb = item / nblk, nb = item % nblk, k0 = 64 * kb, n0 = 32 * nb;
#pragma unroll 8
    for (int i = 0; i < 32; ++i) { const int kk = 2 * i + (lane >> 5); scr[kk * 33 + (lane & 31)] = W[(size_t)(k0 + kk) * N + n0 + (lane & 31)]; }
    LDS_WAIT(); asm volatile("" ::: "memory");
    const int c = lane & 7;
#pragma unroll
    for (int j = 0; j < 4; ++j) { const int n = (lane >> 3) + 8 * j; const LAS float* s = scr + (8 * c) * 33 + n;
        v4u o; o.x = pk2(s[0 * 33], s[1 * 33]); o.y = pk2(s[2 * 33], s[3 * 33]); o.z = pk2(s[4 * 33], s[5 * 33]); o.w = pk2(s[6 * 33], s[7 * 33]);
        *(GAS v4u*)(WT + (size_t)(n0 + n) * K + k0 + 8 * c) = o; }
    LDS_WAIT(); asm volatile("" ::: "memory");
}

__device__ __forceinline__ void p0_prologue(Frame& F) {
    float* mod = (float*)(F.ws + WS_MOD);
    if (F.bid < 192) {
        LAS float* sl = (LAS float*)(F.lds + 81920);
        LAS float* red = (LAS float*)(F.lds + 81920 + 20480);
        for (int i = F.tid; i < 5 * 1024; i += NTHREADS) { const float cv = (i < 4096) ? F.c[i] : F.c_ctx[i - 4096]; sl[i] = cv * sigmoidf_(cv); }
        __syncthreads();
        const int col = F.tid & 31, kg = F.tid >> 5, col0 = 32 * F.bid;
        float a0 = 0.f, a1 = 0.f, a2 = 0.f, a3 = 0.f, a4 = 0.f;
        const float* wp = F.w_mod + (size_t)(kg * 64) * 6144 + col0 + col;
#pragma unroll 8
        for (int r = 0; r < 64; ++r) { const float w = wp[(size_t)r * 6144]; const int k = kg * 64 + r;
            a0 += w * sl[k]; a1 += w * sl[1024 + k]; a2 += w * sl[2048 + k]; a3 += w * sl[3072 + k]; a4 += w * sl[4096 + k]; }
        red[(kg * 5 + 0) * 32 + col] = a0; red[(kg * 5 + 1) * 32 + col] = a1; red[(kg * 5 + 2) * 32 + col] = a2; red[(kg * 5 + 3) * 32 + col] = a3; red[(kg * 5 + 4) * 32 + col] = a4;
        __syncthreads();
        if (F.tid < 160) { const int v = F.tid >> 5, cc = F.tid & 31; float s = 0.f;
#pragma unroll
            for (int g = 0; g < 16; ++g) s += red[(g * 5 + v) * 32 + cc];
            __hip_atomic_store(&mod[v * 6144 + col0 + cc], s + F.b_mod[col0 + cc], __ATOMIC_RELAXED, __HIP_MEMORY_SCOPE_AGENT); }
        asm volatile("s_waitcnt vmcnt(0)" ::: "memory");
        __syncthreads();
        if (F.tid == 0) xb_add((unsigned*)(F.ws + WS_CTL) + CW_MODCNT, 1u);
    }
    LAS float* scr = (LAS float*)(F.lds + F.wave * 8448);
    const int gw = F.bid * NWAVES + F.wave, NGW = F.G * NWAVES;
    constexpr int I_IN = (D / 64) * (INW / 32), I_A = (512 / 64) * (D / 32), I_O = (D / 64) * (D / 32);
    constexpr int NITEMS = I_IN + 2 * I_A + I_O;
    for (int it = gw; it < NITEMS; it += NGW) {
        int r = it;
        if (r < I_IN) { p0_transpose_item(F.w_in, D, INW, (bf16*)(F.ws + WS_WIN), scr, r, F.lane); continue; } r -= I_IN;
        if (r < I_A) { p0_transpose_item(F.w_a, 512, D, (bf16*)(F.ws + WS_WA), scr, r, F.lane); continue; } r -= I_A;
        if (r < I_A) { p0_transpose_item(F.w_b, 512, D, (bf16*)(F.ws + WS_WB), scr, r, F.lane); continue; } r -= I_A;
        p0_transpose_item(F.w_o, D, D, (bf16*)(F.ws + WS_WO), scr, r, F.lane);
    }
    for (int it = gw; it < 16 * 64 * 2; it += NGW) {
        const int kh = it & 1, dt = (it >> 1) & 63, hp = it >> 7, lane = F.lane, q = lane >> 4;
        bf16x8 Aw[4];
#pragma unroll
        for (int sk = 0; sk < 4; ++sk) { const GAS f32x4* p = (const GAS f32x4*)(F.wq + (size_t)(16 * dt + (lane & 15)) * 2048 + hp * 128 + 32 * sk + 8 * q); const f32x4 a = p[0], b = p[1];
            v4u w; w.x = pk2(a.x, a.y); w.y = pk2(a.z, a.w); w.z = pk2(b.x, b.y); w.w = pk2(b.z, b.w); Aw[sk] = __builtin_bit_cast(bf16x8, w); }
        bf16* wc = (bf16*)(F.ws + WS_WQ);
        f32x4 kf[4][4][2];
#pragma unroll
        for (int k4 = 0; k4 < 4; ++k4)
#pragma unroll
            for (int sk = 0; sk < 4; ++sk) { const GAS f32x4* p = (const GAS f32x4*)(F.keys + (size_t)(hp * 128 + 16 * (4 * kh + k4) + (lane & 15)) * 128 + 32 * sk + 8 * q); kf[k4][sk][0] = p[0]; kf[k4][sk][1] = p[1]; }
#pragma unroll
        for (int k4 = 0; k4 < 4; ++k4) { const int kt = 4 * kh + k4;
            f32x4 acc = (f32x4){0.f, 0.f, 0.f, 0.f};
#pragma unroll
            for (int sk = 0; sk < 4; ++sk) { const f32x4 a = kf[k4][sk][0], b = kf[k4][sk][1];
                v4u w; w.x = pk2(a.x, a.y); w.y = pk2(a.z, a.w); w.z = pk2(b.x, b.y); w.w = pk2(b.z, b.w);
                acc = __builtin_amdgcn_mfma_f32_16x16x32_bf16(Aw[sk], __builtin_bit_cast(bf16x8, w), acc, 0, 0, 0); }
            v2u o; o.x = pk2(acc[0], acc[1]); o.y = pk2(acc[2], acc[3]);
            *(GAS v2u*)(wc + (size_t)(hp * 128 + 16 * kt + (lane & 15)) * D + 16 * dt + 4 * q) = o;
        }
    }
    for (int it = gw; it < 4 * 64 * 8; it += NGW) {
        const int ct = it & 7, ntile = (it >> 3) & 63, g = it >> 9, lane = F.lane, q = lane >> 4;
        f32x4 acc = (f32x4){0.f, 0.f, 0.f, 0.f};
#pragma unroll
        for (int sk = 0; sk < 4; ++sk) {
            const GAS f32x4* p = (const GAS f32x4*)(F.pool_w + ((size_t)g * 128 + 16 * ct + (lane & 15)) * 128 + 32 * sk + 8 * q); const GAS f32x4* sp = (const GAS f32x4*)(F.pool_scale + g * 128 + 32 * sk + 8 * q);
            const f32x4 a = p[0] * sp[0], b = p[1] * sp[1];
            v4u wa_; wa_.x = pk2(a.x, a.y); wa_.y = pk2(a.z, a.w); wa_.z = pk2(b.x, b.y); wa_.w = pk2(b.z, b.w);
            const float* wcol = F.w_a + (size_t)(g * 128 + 32 * sk + 8 * q) * D + 16 * ntile + (lane & 15);
            v4u wb_; wb_.x = pk2(wcol[0], wcol[D]); wb_.y = pk2(wcol[2 * D], wcol[3 * D]); wb_.z = pk2(wcol[4 * D], wcol[5 * D]); wb_.w = pk2(wcol[6 * D], wcol[7 * D]);
            acc = __builtin_amdgcn_mfma_f32_16x16x32_bf16(__builtin_bit_cast(bf16x8, wa_), __builtin_bit_cast(bf16x8, wb_), acc, 0, 0, 0); }
        v2u o; o.x = pk2(acc[0], acc[1]); o.y = pk2(acc[2], acc[3]);
        *(GAS v2u*)((bf16*)(F.ws + WS_WPA) + (size_t)(16 * ntile + (lane & 15)) * 512 + g * 128 + 16 * ct + 4 * q) = o;
    }
    { const int gt = F.bid * NTHREADS + F.tid; float* lbt = (float*)(F.ws + WS_LBT);
      if (gt < 1024) { const int dir = gt >> 9, cc = gt & 511; const float l0 = F.lb_logits[(dir * 2 + 0) * 512 + cc], l1 = F.lb_logits[(dir * 2 + 1) * 512 + cc];
          lbt[gt] = 1.f / (1.f + expf(l1 - l0)); } }
}

__device__ __forceinline__ void modulate_row_fin(const f32x4 (&xin)[4], bf16* orow, const float* g, const float* shift, const float* scale, int lane) {
    f32x4 v[4]; float s2 = 0.f;
#pragma unroll
    for (int j = 0; j < 4; ++j) { v[j] = xin[j]; s2 += (v[j].x * v[j].x + v[j].y * v[j].y) + (v[j].z * v[j].z + v[j].w * v[j].w); }
    const float rstd = 1.f / sqrtf(wave_sum(s2) * (1.f / D) + EPS);
    GAS v2u* o8 = (GAS v2u*)orow + lane;
#pragma unroll
    for (int j = 0; j < 4; ++j) {
        const f32x4 gg = ((const GAS f32x4*)g)[lane + 64 * j], sh = ((const GAS f32x4*)shift)[lane + 64 * j], sc = ((const GAS f32x4*)scale)[lane + 64 * j];
        const f32x4 y = (v[j] * rstd) * gg * (sc + 1.0f) + sh;
        v2u o; o.x = pk2(y.x, y.y); o.y = pk2(y.z, y.w); o8[64 * j] = o; }
}
__device__ __forceinline__ void p1_modulate(Frame& F) {
    const float* mod = (const float*)(F.ws + WS_MOD); bf16* H = (bf16*)(F.ws + WS_H);
    const int gw = F.bid * NWAVES + F.wave, NGW = F.G * NWAVES;
#define P1_XROW(m_) ((const GAS f32x4*)(((m_) < ML) ? F.x + (size_t)(m_) * D : F.ctx + (size_t)((m_) - ML) * D) + F.lane)
    f32x4 xc[4];
    { const GAS f32x4* xr = P1_XROW(gw); xc[0] = xr[0]; xc[1] = xr[64]; xc[2] = xr[128]; xc[3] = xr[192]; }
#pragma unroll 1
    for (int m = gw; m < MH; m += NGW) {
        const int mn = (m + NGW < MH) ? m + NGW : m;
        f32x4 xn[4];
        { const GAS f32x4* xr = P1_XROW(mn); xn[0] = xr[0]; xn[1] = xr[64]; xn[2] = xr[128]; xn[3] = xr[192]; }
        const int v = (m < ML) ? (m >> 12) : 4;
        modulate_row_fin(xc, H + (size_t)m * D, F.n1g, mod + v * 6144 + 0, mod + v * 6144 + 1024, F.lane);
        xc[0] = xn[0]; xc[1] = xn[1]; xc[2] = xn[2]; xc[3] = xn[3];
    }
#undef P1_XROW
}

using pg8::Unit;
struct SchedPlain {
    const char* Ab; const char* Bb; int nM, nN, K, G, c;
    __device__ __forceinline__ bool next(int i, Unit& u) const { const int L = i * G + c; if (L >= nM * nN) return false; pg8::tile_of(L, nM, nN, u.pm, u.pn); u.seg = 0; return true; }
    __device__ __forceinline__ const char* A(const Unit& u) const { return Ab + (size_t)u.pm * 256 * K * 2; }
    __device__ __forceinline__ const char* B(const Unit& u) const { return Bb + (size_t)u.pn * 256 * K * 2; }
    __device__ __forceinline__ bool keep(const Unit&) const { return false; }
    __device__ __forceinline__ int nt(const Unit&) const { return K / 64; }
};
struct SchedOnce {
    const char* Ab; const char* Bb; int nM, nN, K, base, c;
    __device__ __forceinline__ bool next(int i, Unit& u) const { const int L = base + c; if (i != 0 || L >= nM * nN) return false; pg8::tile_of(L, nM, nN, u.pm, u.pn); u.seg = 0; return true; }
    __device__ __forceinline__ const char* A(const Unit& u) const { return Ab + (size_t)u.pm * 256 * K * 2; }
    __device__ __forceinline__ const char* B(const Unit& u) const { return Bb + (size_t)u.pn * 256 * K * 2; }
    __device__ __forceinline__ bool keep(const Unit&) const { return false; }
    __device__ __forceinline__ int nt(const Unit&) const { return K / 64; }
};
struct SchedTile {
    const char* Ab; const char* Bb; int K, pm, pn;
    __device__ __forceinline__ bool next(int i, Unit& u) const { if (i != 0) return false; u.pm = pm; u.pn = pn; u.seg = 0; return true; }
    __device__ __forceinline__ const char* A(const Unit& u) const { return Ab + (size_t)u.pm * 256 * K * 2; }
    __device__ __forceinline__ const char* B(const Unit& u) const { return Bb + (size_t)u.pn * 256 * K * 2; }
    __device__ __forceinline__ bool keep(const Unit&) const { return false; }
    __device__ __forceinline__ int nt(const Unit&) const { return K / 64; }
};
struct SchedIn {
    const char* Ab; const char* Bb; int G, c;
    __device__ __forceinline__ bool next(int i, Unit& u) const { const int L = i * G + c; u.seg = 0;
        if (L < 1280) { pg8::tile_of(L, 64, 20, u.pm, u.pn); return true; }
        if (L < 1328) { const int l = L - 1280, l2 = l >> 1; u.seg = l & 1; u.pm = 64 + (l2 & 3); u.pn = 4 + (l2 >> 2); return true; }
        return false; }
    __device__ __forceinline__ const char* A(const Unit& u) const { return Ab + (size_t)u.pm * 256 * D * 2 + ((u.pm >= 64 && u.seg) ? 1024 : 0); }
    __device__ __forceinline__ const char* B(const Unit& u) const { return Bb + (size_t)u.pn * 256 * D * 2 + ((u.pm >= 64 && u.seg) ? 1024 : 0); }
    __device__ __forceinline__ bool keep(const Unit&) const { return false; }
    __device__ __forceinline__ int nt(const Unit& u) const { return u.pm >= 64 ? 8 : 16; }
};
struct SchedMerge {
    const char *A0, *A1, *B0, *B1; int G, c;
    __device__ __forceinline__ bool next(int i, Unit& u) const { const int tile = (i >> 1) * G + c; if (tile >= 256) return false; pg8::tile_of(tile, 64, 4, u.pm, u.pn); u.seg = i & 1; return true; }
    __device__ __forceinline__ const char* A(const Unit& u) const { return (u.seg ? A1 : A0) + (size_t)u.pm * 256 * 512 * 2; }
    __device__ __forceinline__ const char* B(const Unit& u) const { return (u.seg ? B1 : B0) + (size_t)u.pn * 256 * 512 * 2; }
    __device__ __forceinline__ bool keep(const Unit& u) const { return u.seg == 0; }
    __device__ __forceinline__ int nt(const Unit&) const { return 8; }
};

struct EpiZ {
    static constexpr bool PERM = true, AFTER_DRAIN = false;
    bf16* Z; bf16* ZC; bf16* ZC2;
    __device__ __forceinline__ void operator()(pg8::f32x4 (&acc)[2][2][4][2], const Unit& u, int wr, int wc, int fr, int fq) const {
        int row0 = u.pm * 256 + wr * 64 + fr, col0 = u.pn * 256 + wc * 32 + 8 * fq, ldc = INW; bf16* base = Z;
        if (u.pm >= 64) { base = u.seg ? ZC2 : ZC; row0 -= ML; col0 -= 1024; ldc = ZC_W; }
        const bool sg = u.pn >= 12;
#pragma unroll
        for (int ai = 0; ai < 2; ++ai)
#pragma unroll
            for (int m = 0; m < 4; ++m) { bf16* rowp = base + (size_t)(row0 + ai * 128 + m * 16) * ldc + col0;
#pragma unroll
                for (int bj = 0; bj < 2; ++bj) { pg8::f32x4 v0 = acc[ai][bj][m][0], v1 = acc[ai][bj][m][1];
                    if (sg) {
#pragma unroll
                        for (int j = 0; j < 4; ++j) { v0[j] = sigmoidf_(v0[j]); v1[j] = sigmoidf_(v1[j]); } }
                    v4u w; w.x = pk2(v0[0], v0[1]); w.y = pk2(v0[2], v0[3]); w.z = pk2(v1[0], v1[1]); w.w = pk2(v1[2], v1[3]);
                    *(GAS v4u*)(rowp + bj * 128) = w; } }
    }
};
struct EpiPlain {
    static constexpr bool PERM = true, AFTER_DRAIN = false;
    bf16* O; int ldc;
    __device__ __forceinline__ void operator()(pg8::f32x4 (&acc)[2][2][4][2], const Unit& u, int wr, int wc, int fr, int fq) const {
        const int row0 = u.pm * 256 + wr * 64 + fr, col0 = u.pn * 256 + wc * 32 + 8 * fq;
#pragma unroll
        for (int ai = 0; ai < 2; ++ai)
#pragma unroll
            for (int m = 0; m < 4; ++m) { bf16* rowp = O + (size_t)(row0 + ai * 128 + m * 16) * ldc + col0;
#pragma unroll
                for (int bj = 0; bj < 2; ++bj) { const pg8::f32x4 v0 = acc[ai][bj][m][0], v1 = acc[ai][bj][m][1];
                    v4u w; w.x = pk2(v0[0], v0[1]); w.y = pk2(v0[2], v0[3]); w.z = pk2(v1[0], v1[1]); w.w = pk2(v1[2], v1[3]);
                    *(GAS v4u*)(rowp + bj * 128) = w; } }
    }
};
struct EpiMerge {
    static constexpr bool PERM = true, AFTER_DRAIN = false;
    const bf16* Z; bf16* Mo;
    __device__ __forceinline__ void operator()(pg8::f32x4 (&acc)[2][2][4][2], const Unit& u, int wr, int wc, int fr, int fq) const {
        const int row0 = u.pm * 256 + wr * 64 + fr, col0 = u.pn * 256 + wc * 32 + 8 * fq;
#pragma unroll
        for (int ai = 0; ai < 2; ++ai)
#pragma unroll
            for (int m = 0; m < 4; ++m) { const size_t r = (size_t)(row0 + ai * 128 + m * 16);
#pragma unroll
                for (int bj = 0; bj < 2; ++bj) { const int c = col0 + bj * 128;
                    const v4u gh = *(const GAS v4u*)(Z + r * INW + 4096 + c);
                    float h[8] = {bflo(gh.x), bfhi(gh.x), bflo(gh.y), bfhi(gh.y), bflo(gh.z), bfhi(gh.z), bflo(gh.w), bfhi(gh.w)};
                    if (u.seg == 0) {
                        const v4u gp = *(const GAS v4u*)(Z + r * INW + 3072 + c);
                        float p[8] = {bflo(gp.x), bfhi(gp.x), bflo(gp.y), bfhi(gp.y), bflo(gp.z), bfhi(gp.z), bflo(gp.w), bfhi(gp.w)};
#pragma unroll
                        for (int j = 0; j < 4; ++j) { acc[ai][bj][m][0][j] *= p[j] * fast_rcp(fmaxf(h[j], 1e-30f)); acc[ai][bj][m][1][j] *= p[4 + j] * fast_rcp(fmaxf(h[4 + j], 1e-30f)); }
                    } else {
                        pg8::f32x4 v0 = acc[ai][bj][m][0], v1 = acc[ai][bj][m][1];
#pragma unroll
                        for (int j = 0; j < 4; ++j) { v0[j] *= h[j]; v1[j] *= h[4 + j]; }
                        v4u w; w.x = pk2(v0[0], v0[1]); w.y = pk2(v0[2], v0[3]); w.z = pk2(v1[0], v1[1]); w.w = pk2(v1[2], v1[3]);
                        pg8::st_wt16(Mo + r * D + c, w); } } }
    }
};
struct EpiRes {
    static constexpr bool PERM = true, AFTER_DRAIN = false;
    const float* X; const float* mod; bf16* O0; bf16* O1;
    __device__ __forceinline__ void operator()(pg8::f32x4 (&acc)[2][2][4][2], const Unit& u, int wr, int wc, int fr, int fq) const {
        const int row0 = u.pm * 256 + wr * 64 + fr, col0 = u.pn * 256 + wc * 32 + 8 * fq;
        const float* g1 = mod + (size_t)(u.pm >> 4) * 6144 + 2048;
        bf16* Ob = ((u.pn & 2) ? O1 : O0) + (u.pn & 1) * 256 + wc * 32 + 8 * fq;
        pg8::f32x4 gv[2][2];
#pragma unroll
        for (int bj = 0; bj < 2; ++bj)
#pragma unroll
            for (int n = 0; n < 2; ++n) gv[bj][n] = *(const GAS pg8::f32x4*)(g1 + col0 + bj * 128 + n * 4);
#pragma unroll
        for (int ai = 0; ai < 2; ++ai)
#pragma unroll
            for (int m = 0; m < 4; ++m) { const size_t row = (size_t)(row0 + ai * 128 + m * 16), off = row * D + col0;
#pragma unroll
                for (int bj = 0; bj < 2; ++bj) { const pg8::f32x4 x0 = *(const GAS pg8::f32x4*)(X + off + bj * 128), x1 = *(const GAS pg8::f32x4*)(X + off + bj * 128 + 4);
                    const pg8::f32x4 v0 = x0 + gv[bj][0] * acc[ai][bj][m][0], v1 = x1 + gv[bj][1] * acc[ai][bj][m][1];
                    v4u w; w.x = pk2(v0[0], v0[1]); w.y = pk2(v0[2], v0[3]); w.z = pk2(v1[0], v1[1]); w.w = pk2(v1[2], v1[3]);
                    pg8::st_wt16(Ob + row * 512 + bj * 128, w); }
                asm volatile("" ::: "memory"); }
    }
};

__device__ __forceinline__ unsigned off_b(unsigned row, unsigned ch) { return 256u * row + 16u * (ch ^ (((row & 3) << 2) | ((row >> 2) & 3))); }
__device__ __forceinline__ unsigned row_addr16(unsigned lane, unsigned rb, unsigned s) { return off_b((lane & 15) + 16 * rb, 4 * s + (lane >> 4)); }
__device__ __forceinline__ unsigned tr_addr16(unsigned lane, unsigned c, unsigned t) { const unsigned g = lane >> 4, q = (lane & 15) >> 2, p = lane & 3; return off_b(8 * g + 4 * t + q, 2 * c + (p >> 1)) + 8 * (p & 1); }
__device__ __forceinline__ bf16x8 tr_frag(LAS unsigned char* tile, unsigned lane, unsigned c) {
    const s16x4 lo = __builtin_amdgcn_ds_read_tr16_b64_v4i16((LAS s16x4*)(tile + tr_addr16(lane, c, 0)));
    const s16x4 hi = __builtin_amdgcn_ds_read_tr16_b64_v4i16((LAS s16x4*)(tile + tr_addr16(lane, c, 1)));
    return __builtin_shufflevector(lo, hi, 0, 1, 2, 3, 4, 5, 6, 7);
}
#define MFMA16(a, b, c) __builtin_amdgcn_mfma_f32_16x16x32_bf16((a), (b), (c), 0, 0, 0)

__device__ __forceinline__ v4u add_bf16x8(const v4u a, const v4u b) {
    v4u r; r.x = pk2(bflo(a.x) + bflo(b.x), bfhi(a.x) + bfhi(b.x)); r.y = pk2(bflo(a.y) + bflo(b.y), bfhi(a.y) + bfhi(b.y));
    r.z = pk2(bflo(a.z) + bflo(b.z), bfhi(a.z) + bfhi(b.z)); r.w = pk2(bflo(a.w) + bflo(b.w), bfhi(a.w) + bfhi(b.w)); return r; }
constexpr int SC_QT = 0, SC_KT = 8192, SC_KD = 16384, SC_VT = 24576, SC_ATT = 32768, SC_EL = 35328, SC_WT = 35840;

__device__ __forceinline__ void scan_unit(Frame& F, int u) {
    const int tid = F.tid, lane = F.lane, w = F.wave, q = lane >> 4;
    const bool isctx = u >= NSCAN_L;
    int b, h, dir, rowbase, nch; const bf16* src; int ld, cq, ci, cf;
    if (!isctx) { const int j = u & 7; dir = (u >> 3) & 1; h = (u >> 4) & 3; b = u >> 6; const int tb = dir ? 7 - j : j;
        rowbase = b * SEQ + tb * SEGT; nch = SEGT / CHT; src = (const bf16*)(F.ws + WS_Z); ld = INW; cq = 512 + h * 128; ci = 1024 + h * 128; cf = (dir ? 2048 : 1536) + h * 128; }
    else { const int v = u - NSCAN_L, cs = v & (NCSEG - 1); dir = (v >> 2) & 1; h = (v >> 3) & 3; b = v >> 5;
        rowbase = b * CTXL + (dir ? NCSEG - 1 - cs : cs) * (CTXL / NCSEG); nch = CTXL / NCSEG / CHT; src = (const bf16*)(F.ws + WS_ZC); ld = ZC_W; ci = h * 128; cq = ci; cf = (dir ? 1024 : 512) + h * 128; }
    const int t = tid >> 4, k8 = tid & 15;
    const int pl = dir ? 3 - q : q;
    const float* lbt = (const float*)(F.ws + WS_LBT) + dir * 512 + h * 128 + 8 * k8;
    float lb[8], om_[8], ecum[8];
#pragma unroll
    for (int i = 0; i < 8; ++i) { lb[i] = lbt[i]; om_[i] = 1.f - lbt[i]; ecum[i] = 1.f; }
    f32x4 S[8];
#pragma unroll
    for (int i = 0; i < 8; ++i) S[i] = (f32x4){0.f, 0.f, 0.f, 0.f};
    LAS unsigned char* L = F.lds;
    bf16* qseg = (bf16*)((unsigned char*)F.out + OUT_QSEG) + (size_t)dir * ML * 512;
    bf16* oloc = (bf16*)((unsigned char*)F.out + OUT_OLOC);
    v4u qv, vv, fv;
    { const int tc = dir ? nch - 1 : 0; const bf16* rp = src + (size_t)(rowbase + tc * CHT + t) * ld + 8 * k8;
      qv = *(const GAS v4u*)(rp + cq); vv = *(const GAS v4u*)(rp + ci); fv = *(const GAS v4u*)(rp + cf);
      if (isctx) { const bf16* r2 = rp + (WS_ZC2 - WS_ZC) / 2; vv = add_bf16x8(vv, *(const GAS v4u*)(r2 + ci)); fv = add_bf16x8(fv, *(const GAS v4u*)(r2 + cf)); qv = vv; } }
    for (int pc = 0; pc < nch; ++pc) {
        const int tc = dir ? nch - 1 - pc : pc;
        const v4u q0 = qv, v0 = vv, f0 = fv;
        if (pc + 1 < nch) { const int tn = dir ? tc - 1 : tc + 1; const bf16* rp = src + (size_t)(rowbase + tn * CHT + t) * ld + 8 * k8;
            qv = *(const GAS v4u*)(rp + cq); vv = *(const GAS v4u*)(rp + ci); fv = *(const GAS v4u*)(rp + cf);
            if (isctx) { const bf16* r2 = rp + (WS_ZC2 - WS_ZC) / 2; vv = add_bf16x8(vv, *(const GAS v4u*)(r2 + ci)); fv = add_bf16x8(fv, *(const GAS v4u*)(r2 + cf)); qv = vv; } }
        float fr_[8] = {bflo(f0.x), bfhi(f0.x), bflo(f0.y), bfhi(f0.y), bflo(f0.z), bfhi(f0.z), bflo(f0.w), bfhi(f0.w)};
        float e[8], kk[8];
#pragma unroll
        for (int i = 0; i < 8; ++i) { const float s = fast_rcp(1.f + fast_exp(-fr_[i])); e[i] = lb[i] + om_[i] * s; kk[i] = om_[i] - om_[i] * s; }
        { const int s1 = dir ? lane + 16 : lane - 16, s2 = dir ? lane + 32 : lane - 32;
#pragma unroll
          for (int i = 0; i < 8; ++i) { const float o = __shfl(e[i], s1 & 63); e[i] = (pl >= 1) ? e[i] * o : e[i]; }
#pragma unroll
          for (int i = 0; i < 8; ++i) { const float o = __shfl(e[i], s2 & 63); e[i] = (pl >= 2) ? e[i] * o : e[i]; } }
        if (pl == 3) { LAS f32x4* wt = (LAS f32x4*)(L + SC_WT + (w * 128 + 8 * k8) * 4); wt[0] = (f32x4){e[0], e[1], e[2], e[3]}; wt[1] = (f32x4){e[4], e[5], e[6], e[7]}; }
        LBAR();
        float etot[8];
        { float pre[8], run[8];
#pragma unroll
          for (int i = 0; i < 8; ++i) { pre[i] = 1.f; run[i] = 1.f; }
#pragma unroll
          for (int sidx = 0; sidx < 8; ++sidx) { const int ww = dir ? 7 - sidx : sidx;
              const LAS f32x4* wt = (const LAS f32x4*)(L + SC_WT + (ww * 128 + 8 * k8) * 4); const f32x4 a = wt[0], c = wt[1];
              if (ww == w) {
#pragma unroll
                  for (int i = 0; i < 8; ++i) pre[i] = run[i]; }
              run[0] *= a.x; run[1] *= a.y; run[2] *= a.z; run[3] *= a.w; run[4] *= c.x; run[5] *= c.y; run[6] *= c.z; run[7] *= c.w; }
#pragma unroll
          for (int i = 0; i < 8; ++i) { etot[i] = run[i]; e[i] *= pre[i]; } }
        {
            const float qf[8] = {bflo(q0.x), bfhi(q0.x), bflo(q0.y), bfhi(q0.y), bflo(q0.z), bfhi(q0.z), bflo(q0.w), bfhi(q0.w)};
            float qt[8], kt[8], kd[8];
#pragma unroll
            for (int i = 0; i < 8; ++i) { qt[i] = qf[i] * e[i]; kt[i] = kk[i] * fast_rcp(e[i]); kd[i] = kt[i] * etot[i]; }
            const unsigned ob = off_b((unsigned)t, (unsigned)k8);
            v4u o; o.x = pk2(qt[0], qt[1]); o.y = pk2(qt[2], qt[3]); o.z = pk2(qt[4], qt[5]); o.w = pk2(qt[6], qt[7]); *(LAS v4u*)(L + SC_QT + ob) = o;
            o.x = pk2(kt[0], kt[1]); o.y = pk2(kt[2], kt[3]); o.z = pk2(kt[4], kt[5]); o.w = pk2(kt[6], kt[7]); *(LAS v4u*)(L + SC_KT + ob) = o;
            o.x = pk2(kd[0], kd[1]); o.y = pk2(kd[2], kd[3]); o.z = pk2(kd[4], kd[5]); o.w = pk2(kd[6], kd[7]); *(LAS v4u*)(L + SC_KD + ob) = o;
            *(LAS v4u*)(L + SC_VT + ob) = v0;
            if (!isctx) { o.x = pk2(qt[0] * ecum[0], qt[1] * ecum[1]); o.y = pk2(qt[2] * ecum[2], qt[3] * ecum[3]); o.z = pk2(qt[4] * ecum[4], qt[5] * ecum[5]); o.w = pk2(qt[6] * ecum[6], qt[7] * ecum[7]);
                *(GAS v4u*)(qseg + (size_t)(rowbase + tc * CHT + t) * 512 + h * 128 + 8 * k8) = o; }
            if (t == 0) { LAS f32x4* el = (LAS f32x4*)(L + SC_EL + 32 * k8); el[0] = (f32x4){etot[0], etot[1], etot[2], etot[3]}; el[1] = (f32x4){etot[4], etot[5], etot[6], etot[7]}; }
#pragma unroll
            for (int i = 0; i < 8; ++i) ecum[i] *= etot[i];
        }
        LBAR();
        if (w < 4 && !isctx) {
            const int tt = dir ? (w >> 1) : ((w + 1) >> 1), st = dir ? ((w + 1) >> 1) : (w >> 1);
            const int tz = dir ? 1 : 0, sz = dir ? 0 : 1;
            f32x4 a = (f32x4){0.f, 0.f, 0.f, 0.f};
            if (w < 3) {
#pragma unroll
                for (int s = 0; s < 4; ++s) { const bf16x8 A = *(const LAS bf16x8*)(L + SC_QT + row_addr16(lane, tt, s)); const bf16x8 B = *(const LAS bf16x8*)(L + SC_KT + row_addr16(lane, st, s)); a = MFMA16(A, B, a); }
            }
            const int tr = (w < 3 ? tt : tz) * 16 + 4 * q, sc = (w < 3 ? st : sz) * 16 + (lane & 15);
#pragma unroll
            for (int j = 0; j < 4; ++j) { const int ti = tr + j; const bool ok = (w < 3) && (dir ? (sc >= ti) : (sc <= ti));
                *(LAS unsigned short*)(L + SC_ATT + ti * 80 + sc * 2) = (unsigned short)f2bf(ok ? a[j] : 0.f); }
        }
        LBAR();
        {
            const bf16x8 Bv = tr_frag(L + SC_VT, lane, w);
            if (!isctx) {
                v4u sb[4];
#pragma unroll
                for (int s = 0; s < 4; ++s) { sb[s].x = pk2(S[2 * s][0], S[2 * s][1]); sb[s].y = pk2(S[2 * s][2], S[2 * s][3]); sb[s].z = pk2(S[2 * s + 1][0], S[2 * s + 1][1]); sb[s].w = pk2(S[2 * s + 1][2], S[2 * s + 1][3]); }
#pragma unroll 1
                for (int tt = 0; tt < 2; ++tt) {
                    f32x4 o = (f32x4){0.f, 0.f, 0.f, 0.f};
                    const unsigned row = 16 * tt + (lane & 15);
#pragma unroll
                    for (int s = 0; s < 4; ++s) {
                        const v2u alo = *(const LAS v2u*)(L + SC_QT + off_b(row, 4 * s + (q >> 1)) + 8 * (q & 1));
                        const v2u ahi = *(const LAS v2u*)(L + SC_QT + off_b(row, 4 * s + 2 + (q >> 1)) + 8 * (q & 1));
                        const v4u av = (v4u){alo.x, alo.y, ahi.x, ahi.y};
                        o = MFMA16(__builtin_bit_cast(bf16x8, av), __builtin_bit_cast(bf16x8, sb[s]), o);
                    }
                    const bf16x8 At = *(const LAS bf16x8*)(L + SC_ATT + row * 80 + 16 * q);
                    o = MFMA16(At, Bv, o);
                    const int ttg = (rowbase + tc * CHT + 16 * tt) >> 4;
                    v2u ov; ov.x = pk2(o[0], o[1]); ov.y = pk2(o[2], o[3]);
                    *(GAS v2u*)(oloc + ((((size_t)(dir * 1024 + ttg) * 4 + h) * 8 + w) * 64 + lane) * 4) = ov;
                }
            }
#pragma unroll
            for (int kt = 0; kt < 8; ++kt) {
                const bf16x8 A = tr_frag(L + SC_KD, lane, kt);
                const f32x4 a4 = *(const LAS f32x4*)(L + SC_EL + (16 * kt + 4 * q) * 4);
                S[kt] = MFMA16(A, Bv, S[kt] * a4);
            }
        }
    }
    { float* us = (float*)(F.ws + WS_USEG) + (size_t)u * 128 * 128 + (4 * q) * 128 + 16 * w + (lane & 15);
#pragma unroll
      for (int kt = 0; kt < 8; ++kt) {
#pragma unroll
          for (int j = 0; j < 4; ++j) us[j * 128] = S[kt][j];
          us += 16 * 128; asm volatile("" : "+v"(us)); }
      if (t == 0) { float* as = (float*)(F.ws + WS_ASEG) + (size_t)u * 128 + 8 * k8;
#pragma unroll
          for (int i = 0; i < 8; ++i) as[i] = ecum[i]; } }
    __syncthreads();
}


constexpr int PL_VSTR = 132, PL_VBYTES = 64 * PL_VSTR * 4;
#define PL_LOAD8(ra, rd, g_, r0b_, rhi_) do { _Pragma("unroll") for (int u8 = 0; u8 < 8; ++u8) { const int rr_ = min((r0b_) + u8, (rhi_)); \
    const bf16* p_ = Z + (size_t)(b * SEQ + rr_ * 64 + c) * INW + (g_) * 128 + 16 * ch16; ra[u8] = *(const GAS v4u*)p_; rd[u8] = *(const GAS v4u*)(p_ + 8); } } while (0)
#define PL_CONSUME8(ra, rd, r0b_, rhi_) do { _Pragma("unroll") for (int u8 = 0; u8 < 8; ++u8) { const int rr_ = (r0b_) + u8; if (rr_ <= (rhi_)) { const v4u a_ = ra[u8], d_ = rd[u8]; \
    const float x_[16] = {bflo(a_.x), bfhi(a_.x), bflo(a_.y), bfhi(a_.y), bflo(a_.z), bfhi(a_.z), bflo(a_.w), bfhi(a_.w), bflo(d_.x), bfhi(d_.x), bflo(d_.y), bfhi(d_.y), bflo(d_.z), bfhi(d_.z), bflo(d_.w), bfhi(d_.w)}; \
    _Pragma("unroll") for (int i_ = 0; i_ < 16; ++i_) vs[i_] += x_[i_]; \
    if (rr_ == r) { _Pragma("unroll") for (int i_ = 0; i_ < 16; ++i_) pc[i_] = x_[i_]; } } } } while (0)
__device__ __forceinline__ void pool_unit(Frame& F, int u) {
    const int b = u >> 6, r = u & 63, tid = F.tid;
    const int c = tid >> 3, ch16 = tid & 7;
    const bf16* Z = (const bf16*)(F.ws + WS_Z); bf16* YP = (bf16*)(F.ws + WS_YPOOL);
    v4u ra[8], rd[8];
    PL_LOAD8(ra, rd, 0, max(0, r - 1), r);
#pragma unroll 1
    for (int g = 0; g < 4; ++g) {
        LAS unsigned char* L = F.lds + (g & 1) * PL_VBYTES;
        const int half = 1 << g;
        const int r_lo = max(0, r - half), r_hi = min(63, r + half - 1), c_lo = max(0, c - half), c_hi = min(63, c + half - 1);
        float vs[16], pc[16];
#pragma unroll
        for (int i = 0; i < 16; ++i) { vs[i] = 0.f; pc[i] = 0.f; }
        PL_CONSUME8(ra, rd, r_lo, r_hi);
        if (g == 3) { PL_LOAD8(ra, rd, 3, r_lo + 8, r_hi); PL_CONSUME8(ra, rd, r_lo + 8, r_hi); }
        else { const int h2 = 2 * half; PL_LOAD8(ra, rd, g + 1, max(0, r - h2), min(63, r + h2 - 1)); }
        { LAS f32x4* vp = (LAS f32x4*)(L + (c * PL_VSTR + 16 * ch16) * 4);
#pragma unroll
          for (int i = 0; i < 4; ++i) vp[i] = (f32x4){vs[4 * i], vs[4 * i + 1], vs[4 * i + 2], vs[4 * i + 3]}; }
        LBAR();
        float hs[16];
#pragma unroll
        for (int i = 0; i < 16; ++i) hs[i] = 0.f;
        for (int cc = c_lo; cc <= c_hi; ++cc) { const LAS f32x4* vp = (const LAS f32x4*)(L + (cc * PL_VSTR + 16 * ch16) * 4);
#pragma unroll
            for (int i = 0; i < 4; ++i) { const f32x4 x = vp[i]; hs[4 * i] += x.x; hs[4 * i + 1] += x.y; hs[4 * i + 2] += x.z; hs[4 * i + 3] += x.w; } }
        { const float inv = 1.f / (float)((r_hi - r_lo + 1) * (c_hi - c_lo + 1));
          v4u o0, o1;
          o0.x = pk2(hs[0] * inv - pc[0], hs[1] * inv - pc[1]); o0.y = pk2(hs[2] * inv - pc[2], hs[3] * inv - pc[3]); o0.z = pk2(hs[4] * inv - pc[4], hs[5] * inv - pc[5]); o0.w = pk2(hs[6] * inv - pc[6], hs[7] * inv - pc[7]);
          o1.x = pk2(hs[8] * inv - pc[8], hs[9] * inv - pc[9]); o1.y = pk2(hs[10] * inv - pc[10], hs[11] * inv - pc[11]); o1.z = pk2(hs[12] * inv - pc[12], hs[13] * inv - pc[13]); o1.w = pk2(hs[14] * inv - pc[14], hs[15] * inv - pc[15]);
          GAS v4u* dp = (GAS v4u*)(YP + (size_t)(b * SEQ + r * 64 + c) * 512 + g * 128 + 16 * ch16); dp[0] = o0; dp[1] = o1; }
    }
    __syncthreads();
}

constexpr int FX_SF = 0, FX_SB = 32768, FX_SCR = 65536, FX_SCRSTR = 132;
__device__ __forceinline__ void prefix_unit(Frame& F, int u) {
    const int chain = u >> 3, rb = u & 7, tid = F.tid, k = 16 * rb + (tid >> 5), v = 4 * (tid & 31);
    const float* US = (const float*)(F.ws + WS_USEG); const float* AS = (const float*)(F.ws + WS_ASEG);
    unsigned char* P = F.ws + WS_PFX + (size_t)chain * 8 * 32768;
    constexpr int NU = NCSEG + 7;
    f32x4 uu[NU]; float aa[NU];
#pragma unroll
    for (int i = 0; i < NU; ++i) { const int un = (i < NCSEG) ? NSCAN_L + chain * NCSEG + i : chain * 8 + (i - NCSEG);
        uu[i] = *(const GAS f32x4*)(US + ((size_t)un * 128 + k) * 128 + v); aa[i] = AS[un * 128 + k]; }
    f32x4 s = uu[0];
#pragma unroll
    for (int i = 1; i < NCSEG; ++i) s = s * aa[i] + uu[i];
    const unsigned ob = (unsigned)(k >> 5) * 8192u + off_b((unsigned)(k & 31), (unsigned)(v >> 3)) + (unsigned)(v & 7) * 2u;
#pragma unroll
    for (int j = 0; j < 8; ++j) {
        v2u o; o.x = pk2(s.x, s.y); o.y = pk2(s.z, s.w);
        *(GAS v2u*)(P + (size_t)j * 32768 + ob) = o;
        if (j < 7) s = s * aa[NCSEG + j] + uu[NCSEG + j];
    }
}
__device__ __forceinline__ void fix_load_state(Frame& F, int chain, int seg, int soff) {
    const GAS v4u* src = (const GAS v4u*)(F.ws + WS_PFX + ((size_t)chain * 8 + seg) * 32768) + F.tid;
#pragma unroll
    for (int i = 0; i < 4; ++i) *(LAS v4u*)(F.lds + soff + (F.tid + 512 * i) * 16) = src[512 * i];
}
__device__ __forceinline__ void fix_unit(Frame& F, int b, int h, int tb, int half) {
    const int lane = F.lane, w = F.wave, q = lane >> 4;
    LAS unsigned char* L = F.lds;
    fix_load_state(F, (b * 4 + h) * 2 + 0, tb, FX_SF);
    fix_load_state(F, (b * 4 + h) * 2 + 1, 7 - tb, FX_SB);
    __syncthreads();
    const bf16* Z = (const bf16*)(F.ws + WS_Z); bf16* YH = (bf16*)(F.ws + WS_YHG);
    const bf16* qseg = (const bf16*)((const unsigned char*)F.out + OUT_QSEG); const bf16* oloc = (const bf16*)((const unsigned char*)F.out + OUT_OLOC);
    LAS float* scr = (LAS float*)(L + FX_SCR + w * (16 * FX_SCRSTR * 4));
    const int row0 = b * SEQ + tb * SEGT;
#pragma unroll 1
    for (int ti = 0; ti < 2; ++ti) {
        const int tt = 16 * half + 2 * w + ti, rowt = row0 + 16 * tt;
        f32x4 acc[8];
#pragma unroll
        for (int c = 0; c < 8; ++c) acc[c] = (f32x4){0.f, 0.f, 0.f, 0.f};
        bf16x8 A[2][4]; v2u ol[2][8]; v4u ogv[4];
        const int tl = lane >> 2, v0 = 8 * (lane & 3);
#pragma unroll
        for (int dir = 0; dir < 2; ++dir)
#pragma unroll
            for (int s = 0; s < 4; ++s) A[dir][s] = *(const GAS bf16x8*)(qseg + ((size_t)dir * ML + rowt + (lane & 15)) * 512 + h * 128 + 32 * s + 8 * q);
#pragma unroll
        for (int dir = 0; dir < 2; ++dir)
#pragma unroll
            for (int c = 0; c < 8; ++c) ol[dir][c] = *(const GAS v2u*)(oloc + ((((size_t)(dir * 1024 + (rowt >> 4)) * 4 + h) * 8 + c) * 64 + lane) * 4);
#pragma unroll
        for (int i = 0; i < 4; ++i) ogv[i] = *(const GAS v4u*)(Z + (size_t)(rowt + tl) * INW + 2560 + h * 128 + v0 + 32 * i);
#pragma unroll
        for (int dir = 0; dir < 2; ++dir) {
#pragma unroll
            for (int s = 0; s < 4; ++s)
#pragma unroll
                for (int c = 0; c < 8; ++c) { const bf16x8 B = tr_frag(L + (dir ? FX_SB : FX_SF) + s * 8192, lane, c); acc[c] = MFMA16(A[dir][s], B, acc[c]); }
        }
#pragma unroll
        for (int dir = 0; dir < 2; ++dir)
#pragma unroll
            for (int c = 0; c < 8; ++c) { const v2u ov = ol[dir][c];
                acc[c][0] += bflo(ov.x); acc[c][1] += bfhi(ov.x); acc[c][2] += bflo(ov.y); acc[c][3] += bfhi(ov.y); }
        float ss[4];
#pragma unroll
        for (int j = 0; j < 4; ++j) { float s = 0.f;
#pragma unroll
            for (int c = 0; c < 8; ++c) s += acc[c][j] * acc[c][j];
            s += WDPP_(s, 0xb1); s += WDPP_(s, 0x4e); s += WDPP_(s, 0x141); s += WDPP_(s, 0x140);
            ss[j] = 1.f / sqrtf(s * (1.f / 128.f) + EPS); }
#pragma unroll
        for (int c = 0; c < 8; ++c)
#pragma unroll
            for (int j = 0; j < 4; ++j) scr[(4 * q + j) * FX_SCRSTR + 16 * c + (lane & 15)] = acc[c][j] * ss[j];
        LDS_WAIT();
        { const size_t row = (size_t)(rowt + tl);
          bf16* yo = YH + row * 512 + h * 128 + v0;
#pragma unroll
          for (int i = 0; i < 4; ++i) {
              const f32x4 a = *(const LAS f32x4*)(scr + tl * FX_SCRSTR + v0 + 32 * i), c2 = *(const LAS f32x4*)(scr + tl * FX_SCRSTR + v0 + 32 * i + 4);
              const v4u g = ogv[i];
              const f32x4 n0 = *(const GAS f32x4*)(F.hg_norm_g + v0 + 32 * i), n1 = *(const GAS f32x4*)(F.hg_norm_g + v0 + 32 * i + 4);
              const float gg[8] = {bflo(g.x), bfhi(g.x), bflo(g.y), bfhi(g.y), bflo(g.z), bfhi(g.z), bflo(g.w), bfhi(g.w)};
              const float yv[8] = {a.x * n0.x, a.y * n0.y, a.z * n0.z, a.w * n0.w, c2.x * n1.x, c2.y * n1.y, c2.z * n1.z, c2.w * n1.w};
              float o[8];
#pragma unroll
              for (int e = 0; e < 8; ++e) o[e] = yv[e] * gg[e] * sigmoidf_(gg[e]);
              v4u ov; ov.x = pk2(o[0], o[1]); ov.y = pk2(o[2], o[3]); ov.z = pk2(o[4], o[5]); ov.w = pk2(o[6], o[7]);
              pg8::st_wt16(yo + 32 * i, ov); } }
        LDS_WAIT();
    }
    __syncthreads();
}


__device__ __forceinline__ void i8_rows(const float* src, unsigned char* dst, float* inv_scale, int gw, int NGW, int lane, unsigned bias, int rend = NEXP) {
    for (int r = gw; r < rend; r += NGW) {
        const GAS f32x4* p = (const GAS f32x4*)(src + (size_t)r * D + 16 * lane);
        const f32x4 a = p[0], b = p[1], c = p[2], d = p[3];
        float m = fmaxf(fmaxf(fmaxf(fabsf(a.x), fabsf(a.y)), fmaxf(fabsf(a.z), fabsf(a.w))), fmaxf(fmaxf(fabsf(b.x), fabsf(b.y)), fmaxf(fabsf(b.z), fabsf(b.w))));
        m = fmaxf(m, fmaxf(fmaxf(fmaxf(fabsf(c.x), fabsf(c.y)), fmaxf(fabsf(c.z), fabsf(c.w))), fmaxf(fmaxf(fabsf(d.x), fabsf(d.y)), fmaxf(fabsf(d.z), fabsf(d.w)))));
        m = wave_max(m);
        const float sc = (m > 0.f) ? 127.f / m : 1.f;
        v4u o; o.x = pack_i8x4(a.x * sc, a.y * sc, a.z * sc, a.w * sc); o.y = pack_i8x4(b.x * sc, b.y * sc, b.z * sc, b.w * sc);
        o.z = pack_i8x4(c.x * sc, c.y * sc, c.z * sc, c.w * sc); o.w = pack_i8x4(d.x * sc, d.y * sc, d.z * sc, d.w * sc);
        o.x ^= bias; o.y ^= bias; o.z ^= bias; o.w ^= bias;
        *(GAS v4u*)(dst + (size_t)(lane >> 3) * ((size_t)NEXP * 128) + (size_t)r * 128 + 16 * (lane & 7)) = o;
        if (lane == 0) inv_scale[r] = (m > 0.f) ? m * (1.f / 127.f) : 1.f;
    }
}
__device__ __forceinline__ void i4_rows(const float* src, unsigned char* dst, float* inv_scale, int gw, int NGW, int lane, const bool vtab) {
    for (int r0 = gw; r0 < NEXP; r0 += 2 * NGW) {
        f32x4 x[2][4]; float s2[2];
#pragma unroll
        for (int k = 0; k < 2; ++k) { const int r = (r0 + k * NGW < NEXP) ? r0 + k * NGW : r0; const GAS f32x4* p = (const GAS f32x4*)(src + (size_t)r * D + 16 * lane);
            x[k][0] = p[0]; x[k][1] = p[1]; x[k][2] = p[2]; x[k][3] = p[3]; }
#pragma unroll
        for (int k = 0; k < 2; ++k) { float t = 0.f;
#pragma unroll
            for (int i = 0; i < 4; ++i) t += (x[k][i].x * x[k][i].x + x[k][i].y * x[k][i].y) + (x[k][i].z * x[k][i].z + x[k][i].w * x[k][i].w);
            s2[k] = t; }
        s2[0] = wave_sum(s2[0]); s2[1] = wave_sum(s2[1]);
#pragma unroll
        for (int k = 0; k < 2; ++k) { const int r = r0 + k * NGW; if (r < NEXP) {
            const f32x4 a = x[k][0], b = x[k][1], c = x[k][2], d = x[k][3];
            const float step = 0.3352f * sqrtf(s2[k] * (1.f / D)), is = (step > 0.f) ? 1.f / step : 0.f;
#define Q4_(x) ((unsigned)(int)fminf(fmaxf(floorf((x) * is), -8.f), 7.f))
#define Q4B_(h, l) (((Q4_(h) & 15u) << 4) | ((Q4_(l) + 8u) & 15u))
#define Q4N_(lo, hi) ((Q4_(lo) & 15u) | ((Q4_(hi) & 15u) << 4))
            v2u o;
            if (vtab) { o.x = Q4B_(a.x, a.y) | (Q4B_(a.z, a.w) << 8) | (Q4B_(b.x, b.y) << 16) | (Q4B_(b.z, b.w) << 24); o.y = Q4B_(c.x, c.y) | (Q4B_(c.z, c.w) << 8) | (Q4B_(d.x, d.y) << 16) | (Q4B_(d.z, d.w) << 24); }
            else      { o.x = Q4N_(a.x, a.y) | (Q4N_(a.z, a.w) << 8) | (Q4N_(b.x, b.y) << 16) | (Q4N_(b.z, b.w) << 24); o.y = Q4N_(c.x, c.y) | (Q4N_(c.z, c.w) << 8) | (Q4N_(d.x, d.y) << 16) | (Q4N_(d.z, d.w) << 24); }
#undef Q4N_
#undef Q4B_
#undef Q4_
            *(GAS v2u*)(dst + (size_t)(lane >> 4) * ((size_t)NEXP * 128) + (size_t)r * 128 + 8 * (lane & 15)) = o;
            if (lane == 0) inv_scale[r] = step; } }
    }
}
__device__ __forceinline__ void mrq_load(const bf16* xlo, const bf16* xhi, int lane, v2u (&xw)[4]) {
    const GAS v2u* xr0 = (const GAS v2u*)xlo + lane; const GAS v2u* xr1 = (const GAS v2u*)xhi + lane;
    xw[0] = xr0[0]; xw[1] = xr0[64]; xw[2] = xr1[0]; xw[3] = xr1[64];
}
__device__ __forceinline__ void mrq_finish(const v2u (&xw)[4], bf16* orow, unsigned char* qrow, float* qscale, float* qsum, const float* g, const float* shift, const float* scale, int lane) {
    f32x4 v[4]; float s2 = 0.f;
#pragma unroll
    for (int j = 0; j < 4; ++j) { v[j] = (f32x4){bflo(xw[j].x), bfhi(xw[j].x), bflo(xw[j].y), bfhi(xw[j].y)}; s2 += (v[j].x * v[j].x + v[j].y * v[j].y) + (v[j].z * v[j].z + v[j].w * v[j].w); }
    const float rstd = 1.f / sqrtf(wave_sum(s2) * (1.f / D) + EPS);
    GAS v2u* o8 = (GAS v2u*)orow + lane; float m = 0.f;
#pragma unroll
    for (int j = 0; j < 4; ++j) {
        const f32x4 gg = ((const GAS f32x4*)g)[lane + 64 * j], sh = ((const GAS f32x4*)shift)[lane + 64 * j], sc = ((const GAS f32x4*)scale)[lane + 64 * j];
        v[j] = (v[j] * rstd) * gg * (sc + 1.0f) + sh;
        v2u o; o.x = pk2(v[j].x, v[j].y); o.y = pk2(v[j].z, v[j].w); o8[64 * j] = o;
        m = fmaxf(m, fmaxf(fmaxf(fabsf(v[j].x), fabsf(v[j].y)), fmaxf(fabsf(v[j].z), fabsf(v[j].w)))); }
    m = wave_max(m);
    const float qs = (m > 0.f) ? 119.f / m : 1.f;
    int hs = 0;
#pragma unroll
    for (int j = 0; j < 4; ++j) {
        const int q_[4] = {(int)rintf(v[j].x * qs), (int)rintf(v[j].y * qs), (int)rintf(v[j].z * qs), (int)rintf(v[j].w * qs)};
        unsigned A16 = 0u, B16 = 0u;
#pragma unroll
        for (int k = 0; k < 4; ++k) { const int b_ = ((q_[k] + 8) & 15) - 8, a_ = (q_[k] - b_) >> 4; A16 |= ((unsigned)a_ & 15u) << (4 * k); B16 |= ((unsigned)b_ & 15u) << (4 * k); hs += q_[k]; }
        const unsigned nA = (unsigned)__builtin_amdgcn_mov_dpp((int)A16, 0xb1, 0xf, 0xf, true), nB = (unsigned)__builtin_amdgcn_mov_dpp((int)B16, 0xb1, 0xf, 0xf, true);
        const unsigned dw = (lane & 1) ? (nB | (B16 << 16)) : (A16 | (nA << 16));
        *(GAS unsigned*)(qrow + j * 256 + (lane >> 3) * 32 + (lane & 1) * 16 + ((lane & 7) >> 1) * 4) = dw; }
    const float hsum = wave_sum((float)hs);
    if (lane == 0) { *qscale = (m > 0.f) ? m * (1.f / 119.f) : 1.f; *qsum = hsum; }
}

#define SORT16_DESC(v) do { float hi_, lo_; \
    hi_ = fmaxf(v[0], v[1]); lo_ = fminf(v[0], v[1]); v[0] = hi_; v[1] = lo_; \
    hi_ = fmaxf(v[2], v[3]); lo_ = fminf(v[2], v[3]); v[2] = hi_; v[3] = lo_; \
    hi_ = fmaxf(v[0], v[2]); lo_ = fminf(v[0], v[2]); v[0] = hi_; v[2] = lo_; \
    hi_ = fmaxf(v[1], v[3]); lo_ = fminf(v[1], v[3]); v[1] = hi_; v[3] = lo_; \
    hi_ = fmaxf(v[1], v[2]); lo_ = fminf(v[1], v[2]); v[1] = hi_; v[2] = lo_; \
    hi_ = fmaxf(v[4], v[5]); lo_ = fminf(v[4], v[5]); v[4] = hi_; v[5] = lo_; \
    hi_ = fmaxf(v[6], v[7]); lo_ = fminf(v[6], v[7]); v[6] = hi_; v[7] = lo_; \
    hi_ = fmaxf(v[4], v[6]); lo_ = fminf(v[4], v[6]); v[4] = hi_; v[6] = lo_; \
    hi_ = fmaxf(v[5], v[7]); lo_ = fminf(v[5], v[7]); v[5] = hi_; v[7] = lo_; \
    hi_ = fmaxf(v[5], v[6]); lo_ = fminf(v[5], v[6]); v[5] = hi_; v[6] = lo_; \
    hi_ = fmaxf(v[0], v[4]); lo_ = fminf(v[0], v[4]); v[0] = hi_; v[4] = lo_; \
    hi_ = fmaxf(v[2], v[6]); lo_ = fminf(v[2], v[6]); v[2] = hi_; v[6] = lo_; \
    hi_ = fmaxf(v[2], v[4]); lo_ = fminf(v[2], v[4]); v[2] = hi_; v[4] = lo_; \
    hi_ = fmaxf(v[1], v[5]); lo_ = fminf(v[1], v[5]); v[1] = hi_; v[5] = lo_; \
    hi_ = fmaxf(v[3], v[7]); lo_ = fminf(v[3], v[7]); v[3] = hi_; v[7] = lo_; \
    hi_ = fmaxf(v[3], v[5]); lo_ = fminf(v[3], v[5]); v[3] = hi_; v[5] = lo_; \
    hi_ = fmaxf(v[1], v[2]); lo_ = fminf(v[1], v[2]); v[1] = hi_; v[2] = lo_; \
    hi_ = fmaxf(v[3], v[4]); lo_ = fminf(v[3], v[4]); v[3] = hi_; v[4] = lo_; \
    hi_ = fmaxf(v[5], v[6]); lo_ = fminf(v[5], v[6]); v[5] = hi_; v[6] = lo_; \
    hi_ = fmaxf(v[8], v[9]); lo_ = fminf(v[8], v[9]); v[8] = hi_; v[9] = lo_; \
    hi_ = fmaxf(v[10], v[11]); lo_ = fminf(v[10], v[11]); v[10] = hi_; v[11] = lo_; \
    hi_ = fmaxf(v[8], v[10]); lo_ = fminf(v[8], v[10]); v[8] = hi_; v[10] = lo_; \
    hi_ = fmaxf(v[9], v[11]); lo_ = fminf(v[9], v[11]); v[9] = hi_; v[11] = lo_; \
    hi_ = fmaxf(v[9], v[10]); lo_ = fminf(v[9], v[10]); v[9] = hi_; v[10] = lo_; \
    hi_ = fmaxf(v[12], v[13]); lo_ = fminf(v[12], v[13]); v[12] = hi_; v[13] = lo_; \
    hi_ = fmaxf(v[14], v[15]); lo_ = fminf(v[14], v[15]); v[14] = hi_; v[15] = lo_; \
    hi_ = fmaxf(v[12], v[14]); lo_ = fminf(v[12], v[14]); v[12] = hi_; v[14] = lo_; \
    hi_ = fmaxf(v[13], v[15]); lo_ = fminf(v[13], v[15]); v[13] = hi_; v[15] = lo_; \
    hi_ = fmaxf(v[13], v[14]); lo_ = fminf(v[13], v[14]); v[13] = hi_; v[14] = lo_; \
    hi_ = fmaxf(v[8], v[12]); lo_ = fminf(v[8], v[12]); v[8] = hi_; v[12] = lo_; \
    hi_ = fmaxf(v[10], v[14]); lo_ = fminf(v[10], v[14]); v[10] = hi_; v[14] = lo_; \
    hi_ = fmaxf(v[10], v[12]); lo_ = fminf(v[10], v[12]); v[10] = hi_; v[12] = lo_; \
    hi_ = fmaxf(v[9], v[13]); lo_ = fminf(v[9], v[13]); v[9] = hi_; v[13] = lo_; \
    hi_ = fmaxf(v[11], v[15]); lo_ = fminf(v[11], v[15]); v[11] = hi_; v[15] = lo_; \
    hi_ = fmaxf(v[11], v[13]); lo_ = fminf(v[11], v[13]); v[11] = hi_; v[13] = lo_; \
    hi_ = fmaxf(v[9], v[10]); lo_ = fminf(v[9], v[10]); v[9] = hi_; v[10] = lo_; \
    hi_ = fmaxf(v[11], v[12]); lo_ = fminf(v[11], v[12]); v[11] = hi_; v[12] = lo_; \
    hi_ = fmaxf(v[13], v[14]); lo_ = fminf(v[13], v[14]); v[13] = hi_; v[14] = lo_; \
    hi_ = fmaxf(v[0], v[8]); lo_ = fminf(v[0], v[8]); v[0] = hi_; v[8] = lo_; \
    hi_ = fmaxf(v[4], v[12]); lo_ = fminf(v[4], v[12]); v[4] = hi_; v[12] = lo_; \
    hi_ = fmaxf(v[4], v[8]); lo_ = fminf(v[4], v[8]); v[4] = hi_; v[8] = lo_; \
    hi_ = fmaxf(v[2], v[10]); lo_ = fminf(v[2], v[10]); v[2] = hi_; v[10] = lo_; \
    hi_ = fmaxf(v[6], v[14]); lo_ = fminf(v[6], v[14]); v[6] = hi_; v[14] = lo_; \
    hi_ = fmaxf(v[6], v[10]); lo_ = fminf(v[6], v[10]); v[6] = hi_; v[10] = lo_; \
    hi_ = fmaxf(v[2], v[4]); lo_ = fminf(v[2], v[4]); v[2] = hi_; v[4] = lo_; \
    hi_ = fmaxf(v[6], v[8]); lo_ = fminf(v[6], v[8]); v[6] = hi_; v[8] = lo_; \
    hi_ = fmaxf(v[10], v[12]); lo_ = fminf(v[10], v[12]); v[10] = hi_; v[12] = lo_; \
    hi_ = fmaxf(v[1], v[9]); lo_ = fminf(v[1], v[9]); v[1] = hi_; v[9] = lo_; \
    hi_ = fmaxf(v[5], v[13]); lo_ = fminf(v[5], v[13]); v[5] = hi_; v[13] = lo_; \
    hi_ = fmaxf(v[5], v[9]); lo_ = fminf(v[5], v[9]); v[5] = hi_; v[9] = lo_; \
    hi_ = fmaxf(v[3], v[11]); lo_ = fminf(v[3], v[11]); v[3] = hi_; v[11] = lo_; \
    hi_ = fmaxf(v[7], v[15]); lo_ = fminf(v[7], v[15]); v[7] = hi_; v[15] = lo_; \
    hi_ = fmaxf(v[7], v[11]); lo_ = fminf(v[7], v[11]); v[7] = hi_; v[11] = lo_; \
    hi_ = fmaxf(v[3], v[5]); lo_ = fminf(v[3], v[5]); v[3] = hi_; v[5] = lo_; \
    hi_ = fmaxf(v[7], v[9]); lo_ = fminf(v[7], v[9]); v[7] = hi_; v[9] = lo_; \
    hi_ = fmaxf(v[11], v[13]); lo_ = fminf(v[11], v[13]); v[11] = hi_; v[13] = lo_; \
    hi_ = fmaxf(v[1], v[2]); lo_ = fminf(v[1], v[2]); v[1] = hi_; v[2] = lo_; \
    hi_ = fmaxf(v[3], v[4]); lo_ = fminf(v[3], v[4]); v[3] = hi_; v[4] = lo_; \
    hi_ = fmaxf(v[5], v[6]); lo_ = fminf(v[5], v[6]); v[5] = hi_; v[6] = lo_; \
    hi_ = fmaxf(v[7], v[8]); lo_ = fminf(v[7], v[8]); v[7] = hi_; v[8] = lo_; \
    hi_ = fmaxf(v[9], v[10]); lo_ = fminf(v[9], v[10]); v[9] = hi_; v[10] = lo_; \
    hi_ = fmaxf(v[11], v[12]); lo_ = fminf(v[11], v[12]); v[11] = hi_; v[12] = lo_; \
    hi_ = fmaxf(v[13], v[14]); lo_ = fminf(v[13], v[14]); v[13] = hi_; v[14] = lo_; \
    } while (0)
#define MERGE16_TOP(a, b) do { _Pragma("unroll") for (int i_ = 0; i_ < 16; ++i_) a[i_] = fmaxf(a[i_], b[15 - i_]); \
    _Pragma("unroll") for (int j_ = 8; j_ > 0; j_ >>= 1) _Pragma("unroll") for (int i_ = 0; i_ < 16; ++i_) { const int l_ = i_ ^ j_; \
    if (l_ > i_) { const float hi_ = fmaxf(a[i_], a[l_]), lo_ = fminf(a[i_], a[l_]); a[i_] = hi_; a[l_] = lo_; } } } while (0)
constexpr int TK_S = 0, TK_SSTR = 136, TK_L = 139264;
__device__ __forceinline__ void topk_select(LAS unsigned char* L, int tid, size_t tok_base, int h, unsigned short* eidx, float* gate) {
    {
        const int row = tid >> 1, hf = tid & 1;
        float a[16];
        const LAS f32x4* sp = (const LAS f32x4*)((LAS float*)(L + TK_S) + row * TK_SSTR) + hf;
#pragma unroll
        for (int blk = 0; blk < 4; ++blk) {
            float v[16];
#pragma unroll
            for (int c4 = 0; c4 < 4; ++c4) { const int i = 4 * blk + c4; const f32x4 x4 = sp[2 * i]; const float ve[4] = {x4.x, x4.y, x4.z, x4.w};
#pragma unroll
                for (int e = 0; e < 4; ++e) v[4 * c4 + e] = __builtin_bit_cast(float, (__builtin_bit_cast(unsigned, ve[e]) & ~127u) | (unsigned)(8 * i + 4 * hf + e)); }
            SORT16_DESC(v);
            if (blk == 0) {
#pragma unroll
                for (int j = 0; j < 16; ++j) a[j] = v[j];
            } else { MERGE16_TOP(a, v); }
        }
        { float pb[16];
#pragma unroll
          for (int j = 0; j < 16; ++j) pb[j] = WDPP_(a[j], 0xb1);
          MERGE16_TOP(a, pb); }
        if (hf == 0) { LAS v4u* tp = (LAS v4u*)(L + TK_L + row * 64);
#pragma unroll
            for (int i = 0; i < 4; ++i) tp[i] = (v4u){__builtin_bit_cast(unsigned, a[4 * i]), __builtin_bit_cast(unsigned, a[4 * i + 1]), __builtin_bit_cast(unsigned, a[4 * i + 2]), __builtin_bit_cast(unsigned, a[4 * i + 3])}; }
    }
    LBAR();
    if (tid < 128) {
        const int t = tid, r0 = t, r1 = 128 + t;
        const LAS unsigned* t0 = (const LAS unsigned*)(L + TK_L + r0 * 64); const LAS unsigned* t1 = (const LAS unsigned*)(L + TK_L + r1 * 64);
        float v1[16], v2[16];
#pragma unroll
        for (int i = 0; i < 4; ++i) { const v4u x = ((const LAS v4u*)t0)[i], y = ((const LAS v4u*)t1)[i];
            v1[4 * i] = __builtin_bit_cast(float, x.x & ~127u); v1[4 * i + 1] = __builtin_bit_cast(float, x.y & ~127u); v1[4 * i + 2] = __builtin_bit_cast(float, x.z & ~127u); v1[4 * i + 3] = __builtin_bit_cast(float, x.w & ~127u);
            v2[4 * i] = __builtin_bit_cast(float, y.x & ~127u); v2[4 * i + 1] = __builtin_bit_cast(float, y.y & ~127u); v2[4 * i + 2] = __builtin_bit_cast(float, y.z & ~127u); v2[4 * i + 3] = __builtin_bit_cast(float, y.w & ~127u); }
        float c[16];
#pragma unroll
        for (int blk = 0; blk < 4; ++blk) {
            float v[16];
#pragma unroll
            for (int j = 0; j < 16; ++j) v[j] = -3.0e38f;
            { int n = 0, slot = 0;
#pragma unroll
              for (int ia = 0; ia < 16; ++ia)
#pragma unroll
                  for (int ib = 0; ib < 16; ++ib) if ((ia + 1) * (ib + 1) <= 16) { if ((n >> 4) == blk) { v[slot] = __builtin_bit_cast(float, (__builtin_bit_cast(unsigned, v1[ia] + v2[ib]) & ~255u) | (unsigned)(ia * 16 + ib)); ++slot; } ++n; } }
            SORT16_DESC(v);
            if (blk == 0) {
#pragma unroll
                for (int j = 0; j < 16; ++j) c[j] = v[j];
            } else { MERGE16_TOP(c, v); }
        }
        float ex[16], sum = 0.f; const float mx = __builtin_bit_cast(float, __builtin_bit_cast(unsigned, c[0]) & ~255u);
#pragma unroll
        for (int k = 0; k < 16; ++k) { ex[k] = fast_exp(__builtin_bit_cast(float, __builtin_bit_cast(unsigned, c[k]) & ~255u) - mx); sum += ex[k]; }
        const float inv = 1.f / sum; const size_t ob = (tok_base + t) * 128 + h * 16;
        unsigned ee[16];
#pragma unroll
        for (int k = 0; k < 16; ++k) { const unsigned code = __builtin_bit_cast(unsigned, c[k]) & 255u;
            const unsigned i1 = t0[code >> 4] & 127u, i2 = t1[code & 15u] & 127u; ee[k] = i1 * 128u + i2; }
        { GAS v4u* ep = (GAS v4u*)(eidx + ob); ep[0] = (v4u){ee[0] | (ee[1] << 16), ee[2] | (ee[3] << 16), ee[4] | (ee[5] << 16), ee[6] | (ee[7] << 16)};
          ep[1] = (v4u){ee[8] | (ee[9] << 16), ee[10] | (ee[11] << 16), ee[12] | (ee[13] << 16), ee[14] | (ee[15] << 16)};
          GAS f32x4* gp = (GAS f32x4*)(gate + ob);
#pragma unroll
          for (int k4 = 0; k4 < 4; ++k4) gp[k4] = (f32x4){ex[4 * k4] * inv, ex[4 * k4 + 1] * inv, ex[4 * k4 + 2] * inv, ex[4 * k4 + 3] * inv}; }
    }
}
struct EpiTopk {
    static constexpr bool PERM = false, AFTER_DRAIN = true;
    unsigned short* eidx; float* gate;
    __device__ __forceinline__ void operator()(pg8::f32x4 (&)[2][2][4][2], const Unit&, int, int, int, int) const {}
    __device__ __forceinline__ void fused(pg8::f32x4 (&acc)[2][2][4][2], const Unit& u, int wr, int wc, int fr, int fq, PG8_LAS unsigned char* lds) const {
        const int tid = threadIdx.x; LAS unsigned char* L = (LAS unsigned char*)lds;
#pragma unroll
        for (int ai = 0; ai < 2; ++ai) {
#pragma unroll
            for (int bj = 0; bj < 2; ++bj)
#pragma unroll
                for (int m = 0; m < 4; ++m)
#pragma unroll
                    for (int n = 0; n < 2; ++n) *(LAS f32x4*)((LAS float*)(L + TK_S) + (bj * 128 + wr * 64 + m * 16 + fr) * TK_SSTR + wc * 32 + n * 16 + 4 * fq) = acc[ai][bj][m][n];
            LBAR();
            topk_select(L, tid, (size_t)u.pm * 256 + 128 * ai, u.pn, eidx, gate);
        }
        __syncthreads();
    }
};

#define TRED3(d, lane, m0, m1, m2) do { \
    _Pragma("unroll") for (int _i = 0; _i < 8; ++_i) { const bool _h = ((lane) & (m0)) != 0; const float _k = _h ? d[_i + 8] : d[_i], _s = _h ? d[_i] : d[_i + 8]; d[_i] = _k + __shfl_xor(_s, (m0)); } \
    _Pragma("unroll") for (int _i = 0; _i < 4; ++_i) { const bool _h = ((lane) & (m1)) != 0; const float _k = _h ? d[_i + 4] : d[_i], _s = _h ? d[_i] : d[_i + 4]; d[_i] = _k + __shfl_xor(_s, (m1)); } \
    _Pragma("unroll") for (int _i = 0; _i < 2; ++_i) { const bool _h = ((lane) & (m2)) != 0; const float _k = _h ? d[_i + 2] : d[_i], _s = _h ? d[_i] : d[_i + 2]; d[_i] = _k + __shfl_xor(_s, (m2)); } } while (0)
typedef int i32x4 __attribute__((ext_vector_type(4)));
#define PX_LOAD_E(ev, tok) do { const GAS v4u* ep_ = (const GAS v4u*)(eidx + (size_t)(tok) * 128 + 16 * pg); ev[0] = ep_[0]; ev[1] = ep_[1]; } while (0)
#define PX_LOAD_ROWS8(rows, ea, base) do { const unsigned e_[8] = {ea.x & 0xffffu, ea.x >> 16, ea.y & 0xffffu, ea.y >> 16, ea.z & 0xffffu, ea.z >> 16, ea.w & 0xffffu, ea.w >> 16}; \
    _Pragma("unroll") for (int i_ = 0; i_ < 8; ++i_) rows[i_] = *(const GAS v4u*)((base) + (e_[i_] * 128u + cgo)); } while (0)
#define TRED3I(d, lane, m0, m1, m2) do { \
    _Pragma("unroll") for (int _i = 0; _i < 8; ++_i) { const bool _h = ((lane) & (m0)) != 0; const int _k = _h ? d[_i + 8] : d[_i], _s = _h ? d[_i] : d[_i + 8]; d[_i] = _k + __shfl_xor(_s, (m0)); } \
    _Pragma("unroll") for (int _i = 0; _i < 4; ++_i) { const bool _h = ((lane) & (m1)) != 0; const int _k = _h ? d[_i + 4] : d[_i], _s = _h ? d[_i] : d[_i + 4]; d[_i] = _k + __shfl_xor(_s, (m1)); } \
    _Pragma("unroll") for (int _i = 0; _i < 2; ++_i) { const bool _h = ((lane) & (m2)) != 0; const int _k = _h ? d[_i + 2] : d[_i], _s = _h ? d[_i] : d[_i + 2]; d[_i] = _k + __shfl_xor(_s, (m2)); } } while (0)
typedef int i32x2 __attribute__((ext_vector_type(2)));
typedef unsigned u32x2_t __attribute__((ext_vector_type(2)));
#define PU4_LOAD_H(ha, hb, tok) do { const GAS v4u* hp_ = (const GAS v4u*)(H8 + (size_t)(tok) * D + 256 * slice + 32 * cg); ha = hp_[0]; hb = hp_[1]; } while (0)
#define QDPP_(x, ctrl) __builtin_amdgcn_mov_dpp((x), (ctrl), 0xf, 0xf, true)
#define PU4_DOT8(rows, dd, off) do { \
    _Pragma("unroll") for (int i_ = 0; i_ < 8; ++i_) { const unsigned w_[4] = {rows[i_].x, rows[i_].y, rows[i_].z, rows[i_].w}; int sa_ = 0, sb_ = 0; \
        _Pragma("unroll") for (int q_ = 0; q_ < 4; ++q_) { sa_ = __builtin_amdgcn_sdot8((int)w_[q_], ha_[q_], sa_, false); sb_ = __builtin_amdgcn_sdot8((int)w_[q_], hb_[q_], sb_, false); } \
        dd[(off) + i_] = (sa_ << 4) + sb_; } } while (0)
__device__ __forceinline__ void peer_u_slice(unsigned char* ws_, const unsigned char* H8, int slice, int rank, int nrank) {
    const int lane = threadIdx.x & 63, wave = __builtin_amdgcn_readfirstlane(threadIdx.x >> 6);
    const int pg = lane >> 3, cg = lane & 7, wi = rank * NWAVES + wave, nw = nrank * NWAVES;
    const unsigned char* Us = ws_ + WS_U8 + (size_t)slice * ((size_t)NEXP * 128); const unsigned cgo = 16u * cg;
    const unsigned short* eidx = (const unsigned short*)(ws_ + WS_EIDX); bf16* part = (bf16*)(ws_ + WS_PART) + (size_t)slice * ML * 128;
    v4u eC[2], eN[2]; v4u r0[8], r1[8]; v4u hC0, hC1, hN0, hN1;
    PX_LOAD_E(eC, wi); PU4_LOAD_H(hC0, hC1, wi); PX_LOAD_ROWS8(r0, eC[0], Us);
#pragma unroll 1
    for (int t = wi; t < ML; t += nw) {
        const int tn = (t + nw < ML) ? t + nw : t;
        PX_LOAD_ROWS8(r1, eC[1], Us); PX_LOAD_E(eN, tn); PU4_LOAD_H(hN0, hN1, tn);
        __builtin_amdgcn_sched_barrier(0);
        const int ha_[4] = {(int)hC0.x, (int)hC0.y, (int)hC0.z, (int)hC0.w}, hb_[4] = {(int)hC1.x, (int)hC1.y, (int)hC1.z, (int)hC1.w};
        int d[16];
        PU4_DOT8(r0, d, 0);
        PX_LOAD_ROWS8(r0, eN[0], Us);
        __builtin_amdgcn_sched_barrier(0);
        PU4_DOT8(r1, d, 8);
#pragma unroll
        for (int i_ = 0; i_ < 8; ++i_) { const int a_ = d[i_] + QDPP_(d[i_], 0x12c), b_ = d[i_ + 8] + QDPP_(d[i_ + 8], 0x124); d[i_] = (lane & 4) ? b_ : a_; }
#pragma unroll
        for (int i_ = 0; i_ < 4; ++i_) { const bool h_ = (lane & 2) != 0; const int k_ = h_ ? d[i_ + 4] : d[i_], s_ = h_ ? d[i_] : d[i_ + 4]; d[i_] = k_ + QDPP_(s_, 0x4e); }
#pragma unroll
        for (int i_ = 0; i_ < 2; ++i_) { const bool h_ = (lane & 1) != 0; const int k_ = h_ ? d[i_ + 2] : d[i_], s_ = h_ ? d[i_] : d[i_ + 2]; d[i_] = k_ + QDPP_(s_, 0xb1); }
        *(GAS unsigned*)(part + (size_t)t * 128 + 2 * lane) = pk2((float)d[0], (float)d[1]);
        eC[0] = eN[0]; eC[1] = eN[1]; hC0 = hN0; hC1 = hN1;
    }
}
typedef _Float16 h16x2 __attribute__((ext_vector_type(2)));
__device__ __forceinline__ void peer_reduce(Frame& F) {
    const bf16* part = (const bf16*)(F.ws + WS_PART); const float* sh = (const float*)(F.ws + WS_SH); const unsigned short* eidx = (const unsigned short*)(F.ws + WS_EIDX); const float* gate = (const float*)(F.ws + WS_GATE);
    const float* su = (const float*)(F.ws + WS_SU); const float* sv = (const float*)(F.ws + WS_SV); unsigned* wq = (unsigned*)(F.ws + WS_WGT); float* wsc = (float*)(F.ws + WS_WGT + 4 * MiB);
    for (size_t i4 = (size_t)F.bid * NTHREADS + F.tid; i4 < (size_t)ML * 32; i4 += (size_t)F.G * NTHREADS) {
        const size_t i = 4 * i4;
        f32x4 s = (f32x4){0.f, 0.f, 0.f, 0.f};
#pragma unroll
        for (int x = 0; x < 4; ++x) { const v2u pv = *(const GAS v2u*)(part + (size_t)x * ML * 128 + i); s += (f32x4){bflo(pv.x), bfhi(pv.x), bflo(pv.y), bfhi(pv.y)}; }
        const v2u ev = *(const GAS v2u*)(eidx + i); const f32x4 gv = *(const GAS f32x4*)(gate + i); const float sht = sh[i >> 7];
        { const float hh = 0.5f * sh[ML + (i >> 7)]; s.x += hh; s.y += hh; s.z += hh; s.w += hh; }
        const unsigned e[4] = {ev.x & 0xffffu, ev.x >> 16, ev.y & 0xffffu, ev.y >> 16}; const float sv4[4] = {s.x, s.y, s.z, s.w}; const float g4[4] = {gv.x, gv.y, gv.z, gv.w};
        float w[4];
#pragma unroll
        for (int k = 0; k < 4; ++k) { const float z = sv4[k] * su[e[k]] * sht; w[k] = g4[k] * (0.5f * z * (1.f + erff(z * 0.70710678118f))) * sv[e[k]]; }
        float m = fmaxf(fmaxf(fabsf(w[0]), fabsf(w[1])), fmaxf(fabsf(w[2]), fabsf(w[3])));
        m = fmaxf(m, WDPP_(m, 0xb1)); m = fmaxf(m, WDPP_(m, 0x4e)); m = fmaxf(m, WDPP_(m, 0x141)); m = fmaxf(m, WDPP_(m, 0x140)); WSWAP_(m, 16, fmaxf);
        const float qs = (m > 0.f) ? 127.f / m : 1.f;
        const float q0 = rintf(w[0] * qs), q1 = rintf(w[1] * qs), q2 = rintf(w[2] * qs), q3 = rintf(w[3] * qs);
        wq[i4] = pack_i8x4(q0, q1, q2, q3);
        float qsum = (q0 + q1) + (q2 + q3);
        qsum += WDPP_(qsum, 0xb1); qsum += WDPP_(qsum, 0x4e); qsum += WDPP_(qsum, 0x141); qsum += WDPP_(qsum, 0x140); WSWAP_(qsum, 16, WADD_);
        if ((i4 & 31) == 0) { const float st = (m > 0.f) ? m * (1.f / 127.f) : 0.f; wsc[i >> 7] = st * (1.f / 16.f); wsc[ML + (i >> 7)] = st * 0.5f * qsum; wsc[2 * ML + (i >> 7)] = st * 8.f * qsum; }
    }
}
#define PV_LOAD_W(wv, tok) do { wv = *(const GAS v4u*)(wq + (size_t)(tok) * 128 + 16 * pg); } while (0)
#define PV4_ACC4(ra, rb, rc, rd, wd) do { const unsigned a_[4] = {ra.x, ra.y, ra.z, ra.w}, b_[4] = {rb.x, rb.y, rb.z, rb.w}, c_[4] = {rc.x, rc.y, rc.z, rc.w}, d_[4] = {rd.x, rd.y, rd.z, rd.w}; \
    _Pragma("unroll") for (int q_ = 0; q_ < 4; ++q_) { \
        const unsigned t0_ = __builtin_amdgcn_perm(b_[q_], a_[q_], 0x05010400u), t1_ = __builtin_amdgcn_perm(b_[q_], a_[q_], 0x07030602u); \
        const unsigned t2_ = __builtin_amdgcn_perm(d_[q_], c_[q_], 0x05010400u), t3_ = __builtin_amdgcn_perm(d_[q_], c_[q_], 0x07030602u); \
        const unsigned T_[4] = {__builtin_amdgcn_perm(t2_, t0_, 0x05040100u), __builtin_amdgcn_perm(t2_, t0_, 0x07060302u), __builtin_amdgcn_perm(t3_, t1_, 0x05040100u), __builtin_amdgcn_perm(t3_, t1_, 0x07060302u)}; \
        _Pragma("unroll") for (int k_ = 0; k_ < 4; ++k_) { \
            acc[8 * q_ + 2 * k_]     = __builtin_amdgcn_sdot4((int)T_[k_], (int)(wd), acc[8 * q_ + 2 * k_], false); \
            acc[8 * q_ + 2 * k_ + 1] = __builtin_amdgcn_sdot4((int)(T_[k_] & 0x0f0f0f0fu), (int)(wd), acc[8 * q_ + 2 * k_ + 1], false); } } } while (0)
__device__ __forceinline__ void peer_v_slice(unsigned char* ws_, bf16* po_, int slice, int rank, int nrank) {
    const int lane = threadIdx.x & 63, wave = __builtin_amdgcn_readfirstlane(threadIdx.x >> 6);
    const int pg = lane >> 3, cg = lane & 7, wi = rank * NWAVES + wave, nw = nrank * NWAVES;
    const unsigned char* Vs = ws_ + WS_V8 + (size_t)slice * ((size_t)NEXP * 128); const unsigned cgo = 16u * cg;
    const unsigned short* eidx = (const unsigned short*)(ws_ + WS_EIDX); const unsigned char* wq = ws_ + WS_WGT; const float* wsc = (const float*)(ws_ + WS_WGT + 4 * MiB);
    const int col = 256 * slice + 32 * cg + 4 * pg;
    v4u eC[2], eN[2]; v4u r0[8], r1[8]; v4u wC, wN; float sC, sN, oC, oN, pC, pN;
    PX_LOAD_E(eC, wi); PV_LOAD_W(wC, wi); sC = wsc[wi]; oC = wsc[ML + wi]; pC = wsc[2 * ML + wi]; PX_LOAD_ROWS8(r0, eC[0], Vs);
#pragma unroll 1
    for (int t = wi; t < ML; t += nw) {
        const int tn = (t + nw < ML) ? t + nw : t;
        PX_LOAD_ROWS8(r1, eC[1], Vs); PX_LOAD_E(eN, tn); PV_LOAD_W(wN, tn); sN = wsc[tn]; oN = wsc[ML + tn]; pN = wsc[2 * ML + tn];
        __builtin_amdgcn_sched_barrier(0);
        int acc[32];
#pragma unroll
        for (int k = 0; k < 32; ++k) acc[k] = 0;
        PV4_ACC4(r0[0], r0[1], r0[2], r0[3], wC.x); __builtin_amdgcn_sched_barrier(0);
        PV4_ACC4(r0[4], r0[5], r0[6], r0[7], wC.y);
        PX_LOAD_ROWS8(r0, eN[0], Vs);
        __builtin_amdgcn_sched_barrier(0);
        PV4_ACC4(r1[0], r1[1], r1[2], r1[3], wC.z); __builtin_amdgcn_sched_barrier(0);
        PV4_ACC4(r1[4], r1[5], r1[6], r1[7], wC.w);
#pragma unroll
        for (int i_ = 0; i_ < 16; ++i_) { const u32x2_t r_ = __builtin_amdgcn_permlane32_swap((unsigned)acc[i_], (unsigned)acc[i_ + 16], false, false); acc[i_] = (int)(r_.x + r_.y); }
#pragma unroll
        for (int i_ = 0; i_ < 8; ++i_) { const u32x2_t r_ = __builtin_amdgcn_permlane16_swap((unsigned)acc[i_], (unsigned)acc[i_ + 8], false, false); acc[i_] = (int)(r_.x + r_.y); }
#pragma unroll
        for (int i_ = 0; i_ < 4; ++i_) { const int a_ = acc[i_] + QDPP_(acc[i_], 0x128), b_ = acc[i_ + 4] + QDPP_(acc[i_ + 4], 0x128); acc[i_] = (lane & 8) ? b_ : a_; }
        v2u ov; ov.x = pk2((float)(acc[0] - acc[1]) * sC + oC, (float)acc[1] * (16.f * sC) - pC + oC); ov.y = pk2((float)(acc[2] - acc[3]) * sC + oC, (float)acc[3] * (16.f * sC) - pC + oC);
        *(GAS v2u*)(po_ + (size_t)t * D + col) = ov;
        eC[0] = eN[0]; eC[1] = eN[1]; wC = wN; sC = sN; oC = oN; pC = pN;
    }
}
__device__ __forceinline__ void final_norm(Frame& F) {
    const bf16* po = (const bf16*)(F.ws + WS_PO); const float* mod = (const float*)(F.ws + WS_MOD); const int lane = F.lane, gw = F.bid * NWAVES + F.wave, NGW = F.G * NWAVES;
    for (int t0 = gw; t0 < ML; t0 += 2 * NGW) {
        f32x4 xv[2][4]; float s2[2] = {0.f, 0.f};
#pragma unroll
        for (int r = 0; r < 2; ++r) { const int t = (t0 + r * NGW < ML) ? t0 + r * NGW : t0;
            const GAS v2u* orow0 = (const GAS v2u*)((const bf16*)(F.ws + WS_YHG) + (size_t)t * 512) + lane; const GAS v2u* orow1 = (const GAS v2u*)((const bf16*)(F.ws + WS_YPOOL) + (size_t)t * 512) + lane; const GAS v2u* prow = (const GAS v2u*)(po + (size_t)t * D) + lane;
            const GAS f32x4* g2 = (const GAS f32x4*)(mod + (size_t)(t >> 12) * 6144 + 5 * 1024) + lane;
#pragma unroll
            for (int j = 0; j < 4; ++j) { const v2u xw = (j < 2) ? orow0[64 * j] : orow1[64 * (j - 2)]; const f32x4 x1 = (f32x4){bflo(xw.x), bfhi(xw.x), bflo(xw.y), bfhi(xw.y)}, gg = g2[64 * j]; const v2u pv = prow[64 * j];
                xv[r][j] = x1 + gg * (f32x4){bflo(pv.x), bfhi(pv.x), bflo(pv.y), bfhi(pv.y)};
                s2[r] += (xv[r][j].x * xv[r][j].x + xv[r][j].y * xv[r][j].y) + (xv[r][j].z * xv[r][j].z + xv[r][j].w * xv[r][j].w); } }
#pragma unroll
        for (int r = 0; r < 2; ++r) { const int t = t0 + r * NGW; if (t < ML) {
            const float rstd = 1.f / sqrtf(wave_sum(s2[r]) * (1.f / D) + EPS); GAS f32x4* orow = (GAS f32x4*)(F.out + (size_t)t * D) + lane;
#pragma unroll
            for (int j = 0; j < 4; ++j) { const f32x4 fg = ((const GAS f32x4*)F.final_g)[lane + 64 * j]; f32x4 ov = xv[r][j] * rstd * fg;
                orow[64 * j] = ov; } } }
    }
}

constexpr int N_PHASES = 15;
__global__ void __launch_bounds__(NTHREADS, 2) fwd_kernel(Args args) {
    extern __shared__ __attribute__((aligned(16))) unsigned char lds[];
    Frame F;
    F.lds = (LAS unsigned char*)lds;
    F.tid = threadIdx.x; F.lane = F.tid & 63; F.wave = __builtin_amdgcn_readfirstlane(F.tid >> 6); F.G = gridDim.x; F.bid = blockIdx.x;
    F.x = args.in[0]; F.c = args.in[1]; F.ctx = args.in[2]; F.c_ctx = args.in[3]; F.w_mod = args.in[4]; F.b_mod = args.in[5]; F.n1g = args.in[6]; F.n2g = args.in[7];
    F.w_in = args.in[8]; F.pool_w = args.in[9]; F.pool_scale = args.in[10]; F.lb_logits = args.in[11]; F.hg_norm_g = args.in[12]; F.w_a = args.in[13]; F.w_b = args.in[14];
    F.w_o = args.in[15]; F.wq = args.in[16]; F.keys = args.in[17]; F.pu = args.in[18]; F.pv = args.in[19]; F.final_g = args.in[20];
    F.out = args.out; F.ws = args.ws;
    volatile LAS unsigned* MISC = (volatile LAS unsigned*)(F.lds + MISC_OFF);
    if (F.tid < 64) MISC[F.tid] = 0u;
    __syncthreads();
    unsigned* barw = (unsigned*)(F.ws + WS_CTL) + CW_BAR;
    XcdBarrier bar; bar.bar = barw; bar.x = 0; bar.st = nullptr;
    if (ONE_LAUNCH) bar = xcd_barrier_post(barw, MISC + 8);
    const int lo = args.ph_lo, hi = args.ph_hi;
#ifndef PH_MASK
#define PH_MASK 0x7fff
#endif
#define IN(k) (((PH_MASK >> (k)) & 1) && lo <= (k) && (k) < hi)
#define SEAM(k) do { if (IN(k) && IN((k) + 1)) xcd_barrier(bar); } while (0)

#ifndef REPP
#define REPP (-1)
#endif
#define RUNP(k, ...) do { if (IN(k)) { __VA_ARGS__ if (REPP == (k)) { __syncthreads(); __VA_ARGS__ } } } while (0)
    RUNP(0, p0_prologue(F););
    { __syncthreads(); if (F.tid == 0) { unsigned* c_ = (unsigned*)(F.ws + WS_CTL) + CW_MODCNT; XB_SPIN(xb_ld(c_) < 192u, barw); __builtin_amdgcn_fence(__ATOMIC_ACQUIRE, "agent"); asm volatile("s_waitcnt vmcnt(0)" ::: "memory"); } __syncthreads(); }
    RUNP(1, p1_modulate(F);); SEAM(1);
    RUNP(2, {
        SchedIn S{(const char*)(F.ws + WS_H), (const char*)(F.ws + WS_WIN), F.G, F.bid};
        EpiZ E{(bf16*)(F.ws + WS_Z), (bf16*)(F.ws + WS_ZC), (bf16*)(F.ws + WS_ZC2)};
        pg8::gemm_phase<EpiZ, SchedIn, true, true>(F.lds, D, S, E);
    }); SEAM(2);
    RUNP(3, {
        for (int u = F.bid; u < NSCAN; u += F.G) scan_unit(F, u);
        for (int u = F.bid; u < NB * 64; u += F.G) pool_unit(F, u);
    }); if (IN(3) && IN(14)) xcd_barrier(bar);
    RUNP(14, { for (int u = F.bid; u < 256; u += F.G) prefix_unit(F, u); }); if (IN(14) && IN(4)) xcd_barrier(bar);
    int pm = 0, pn = 0; pg8::tile_of(F.bid, 64, 4, pm, pn);
    unsigned* pcnt = (unsigned*)(F.ws + WS_CTL) + CW_PANEL + pm * 16;
#define PANEL_SYNC(seam) do { asm volatile("s_waitcnt vmcnt(0)" ::: "memory"); __syncthreads(); \
        if (F.tid == 0) { unsigned* c_ = pcnt + (seam) * 1024; xb_add(c_, 1u); XB_SPIN(xb_ld(c_) < 4u, barw); __builtin_amdgcn_fence(__ATOMIC_ACQUIRE, "agent"); asm volatile("s_waitcnt vmcnt(0)" ::: "memory"); } \
        __syncthreads(); } while (0)
    RUNP(4, { fix_unit(F, pm >> 4, pn, (pm >> 1) & 7, pm & 1); });
    PANEL_SYNC(0);
    RUNP(5, {
        SchedMerge S{(const char*)(F.ws + WS_YPOOL), (const char*)(F.ws + WS_YHG), (const char*)(F.ws + WS_WPA), (const char*)(F.ws + WS_WB), F.G, F.bid};
        EpiMerge E{(const bf16*)(F.ws + WS_Z), (bf16*)(F.ws + WS_M)};
        pg8::gemm_phase<EpiMerge, SchedMerge, true, true>(F.lds, 512, S, E);
    });
    PANEL_SYNC(1);
    RUNP(6, {
        SchedTile S{(const char*)(F.ws + WS_M), (const char*)(F.ws + WS_WO), D, pm, pn};
        EpiRes E{F.x, (const float*)(F.ws + WS_MOD), (bf16*)(F.ws + WS_YHG), (bf16*)(F.ws + WS_YPOOL)};
        pg8::gemm_phase<EpiRes, SchedTile, true, true>(F.lds, D, S, E);
    });
    PANEL_SYNC(2);
    RUNP(7, {
        const float* mod = (const float*)(F.ws + WS_MOD) + (pm >> 4) * 6144; bf16* H2 = (bf16*)(F.ws + WS_M);
        const bf16* X0 = (const bf16*)(F.ws + WS_YHG); const bf16* X1 = (const bf16*)(F.ws + WS_YPOOL); unsigned char* H8 = (unsigned char*)F.out + OUT_QSEG;
        const size_t m0 = (size_t)pm * 256 + pn * 64 + F.wave * 8;
        v2u xc[4]; mrq_load(X0 + m0 * 512, X1 + m0 * 512, F.lane, xc);
        _Pragma("unroll 1") for (int i = 0; i < 8; ++i) { const size_t m = m0 + i, mn = m0 + (i < 7 ? i + 1 : i);
            v2u xn[4]; mrq_load(X0 + mn * 512, X1 + mn * 512, F.lane, xn);
            mrq_finish(xc, H2 + m * D, H8 + m * D, (float*)(F.ws + WS_SH) + m, (float*)(F.ws + WS_SH) + ML + m, F.n2g, mod + 3 * 1024, mod + 4 * 1024, F.lane);
            xc[0] = xn[0]; xc[1] = xn[1]; xc[2] = xn[2]; xc[3] = xn[3]; }
    }); xcd_barrier(bar);
    RUNP(8, {
#define P7B_TABLES() do { const int gw = F.bid * NWAVES + F.wave, NGW = F.G * NWAVES; \
          i4_rows(F.pu, F.ws + WS_U8, (float*)(F.ws + WS_SU), gw, NGW, F.lane, false); \
          i4_rows(F.pv, F.ws + WS_V8, (float*)(F.ws + WS_SV), gw, NGW, F.lane, true); } while (0)
        if (F.bid & 1) { P7B_TABLES(); __syncthreads(); }
        EpiTopk E{(unsigned short*)(F.ws + WS_EIDX), (float*)(F.ws + WS_GATE)};
        { SchedTile S{(const char*)(F.ws + WS_M), (const char*)(F.ws + WS_WQ), D, pm, pn};
          pg8::gemm_phase<EpiTopk, SchedTile, true, true>(F.lds, D, S, E); }
        __syncthreads();
        { SchedTile S{(const char*)(F.ws + WS_M), (const char*)(F.ws + WS_WQ), D, pm, pn + 4};
          pg8::gemm_phase<EpiTopk, SchedTile, true, true>(F.lds, D, S, E); }
        if (!(F.bid & 1)) { __syncthreads(); P7B_TABLES(); }
    }); xcd_barrier(bar);
    int pslice = F.bid & 7, prank = F.bid >> 3; const int pnrank = F.G >> 3;
    if (ONE_LAUNCH && (IN(10) || IN(12))) {
        bool okc = (F.G == 256) && (bar.x < 8u);
#pragma unroll
        for (int j = 0; j < 8; ++j) okc = okc && (xb_ld(&barw[XB_XCNT(j)]) == 32u);
        if (okc) { pslice = (int)bar.x; prank = (int)MISC[10]; }
    }
    RUNP(10, peer_u_slice(F.ws, (const unsigned char*)F.out + OUT_QSEG, pslice & 3, (pslice >> 2) * pnrank + prank, 2 * pnrank);); SEAM(10);
    RUNP(11, peer_reduce(F);); SEAM(11);
    RUNP(12, peer_v_slice(F.ws, (bf16*)(F.ws + WS_PO), pslice & 3, (pslice >> 2) * pnrank + prank, 2 * pnrank);); SEAM(12);
    RUNP(13, final_norm(F););
#undef RUNP
#undef IN
#undef SEAM
}

extern "C" void kernel_launch(void* const* d_in, const int* in_sizes, int n_in, void* d_out, int out_size, void* d_ws, size_t ws_size, hipStream_t stream) {
    static int grid = 0;
    if (grid == 0) {
        if (n_in != 21 || out_size != ML * D || ws_size < WS_END) { fprintf(stderr, "kernel_launch: unexpected problem (n_in %d, out %d, ws %zu)\n", n_in, out_size, ws_size); grid = -1; return; }
        int dev = 0, cus = 0;
        if (hipGetDevice(&dev) != hipSuccess || hipDeviceGetAttribute(&cus, hipDeviceAttributeMultiprocessorCount, dev) != hipSuccess) { grid = -1; return; }
        if (hipFuncSetAttribute((const void*)fwd_kernel, hipFuncAttributeMaxDynamicSharedMemorySize, LDS_BYTES) != hipSuccess) { fprintf(stderr, "kernel_launch: hipFuncSetAttribute failed\n"); grid = -1; return; }
        int per_cu = 0;
        if (hipOccupancyMaxActiveBlocksPerMultiprocessor(&per_cu, (const void*)fwd_kernel, NTHREADS, LDS_BYTES) != hipSuccess || per_cu < 1) fprintf(stderr, "kernel_launch: occupancy query says %d\n", per_cu);
        (void)hipGetLastError();
        if (cus != 256) { fprintf(stderr, "kernel_launch: the row-panel chain is laid out for 256 workgroups (one per CU), found %d CUs\n", cus); grid = -1; return; }
        grid = cus;
    }
    if (grid < 0) return;
    (void)hipMemsetAsync((char*)d_ws + WS_CTL, 0, CTL_ZERO_BYTES, stream);
    Args a{};
    for (int i = 0; i < 21; ++i) a.in[i] = (const float*)d_in[i];
    a.out = (float*)d_out; a.ws = (unsigned char*)d_ws;
#if ONE_LAUNCH
    a.ph_lo = 0; a.ph_hi = N_PHASES;
    hipLaunchKernelGGL(fwd_kernel, dim3(grid), dim3(NTHREADS), LDS_BYTES, stream, a);
#else
    static const int order[N_PHASES - 1] = {0, 1, 2, 3, 14, 4, 5, 6, 7, 8, 10, 11, 12, 13};
    for (int pi = 0; pi < N_PHASES - 1; ++pi) { const int p = order[pi]; a.ph_lo = p; a.ph_hi = p + 1; hipLaunchKernelGGL(fwd_kernel, dim3(grid), dim3(NTHREADS), LDS_BYTES, stream, a); }
#endif
}
```

```cpp
#define ONE_LAUNCH 1
#include <hip/hip_runtime.h>
#include <cstdio>
#include <cstdint>

#ifndef ONE_LAUNCH
#define ONE_LAUNCH 1
#endif

namespace pg8 {
#define PG8_LAS __attribute__((address_space(3)))
typedef unsigned short bf16_t;
typedef short bf16x8 __attribute__((ext_vector_type(8)));
typedef float f32x4 __attribute__((ext_vector_type(4)));
typedef float f32x2 __attribute__((ext_vector_type(2)));
typedef unsigned u32x4 __attribute__((ext_vector_type(4)));
typedef unsigned u32x2 __attribute__((ext_vector_type(2)));
constexpr int BM = 256, BK = 64, HALF = 128, HTB = HALF * BK * 2, STAGE_BYTES = 8 * HTB, NXCD = 8, WGM = 8;

__host__ __device__ __forceinline__ int lds_byte(int r, int c) { const int st = (r >> 4) * 2 + (c >> 5), rr = r & 15, cc = c & 31, ob = rr * 64 + cc * 2; return st * 1024 + (ob ^ (((ob >> 9) & 1) << 5)); }
__host__ __device__ __forceinline__ void stage_rc(int b, int& R, int& C) { const int st = b / 1024, sb = b % 1024, swz = sb ^ (((sb >> 9) & 1) << 5); R = (st >> 1) * 16 + swz / 64; C = (st & 1) * 32 + (swz % 64) / 2; }
__host__ __device__ __forceinline__ int perm32(int rho) { const int n = rho >> 4, i = rho & 15; return 8 * (i >> 2) + 4 * n + (i & 3); }

struct Unit { int pm, pn, seg; };

__host__ __device__ __forceinline__ void tile_of(int wgid, int nM, int nN, int& pm, int& pn) {
    const int nwg = nM * nN;
    { const int q = nwg / NXCD, r = nwg % NXCD, xcd = wgid % NXCD, off = wgid / NXCD; wgid = (xcd < r ? xcd * (q + 1) : r * (q + 1) + (xcd - r) * q) + off; }
    const int nig = WGM * nN, gid = wgid / nig, fm = gid * WGM, gsz = (nM - fm) < WGM ? (nM - fm) : WGM;
    pm = fm + ((wgid % nig) % gsz); pn = (wgid % nig) / gsz;
}

typedef int i32x4 __attribute__((ext_vector_type(4)));
template <bool I8> struct AccOf { typedef f32x4 T; };
template <> struct AccOf<true> { typedef i32x4 T; };
typedef __bf16 bf16x2_t __attribute__((ext_vector_type(2)));
__device__ __forceinline__ unsigned cvt_pk_bf16(float lo, float hi) { bf16x2_t v; v.x = (__bf16)lo; v.y = (__bf16)hi; return __builtin_bit_cast(unsigned, v); }
__device__ __forceinline__ void st_wt16(void* p, u32x4 v) { asm volatile("global_store_dwordx4 %0, %1, off sc1\n\ts_nop 1" :: "v"(p), "v"(v)); }

template <class Epi, class Sched, bool ALIGN_EPI = false, bool SP2 = false, bool I8 = false>
__device__ __forceinline__ void gemm_phase(PG8_LAS unsigned char* lds, const int ld, const Sched& S, const Epi& E) {
    const int tid = threadIdx.x, wid = __builtin_amdgcn_readfirstlane(tid >> 6), lane = tid & 63, wr = wid >> 2, wc = wid & 3, fr = lane & 15, fq = lane >> 4;
    unsigned voffA[2], voffB[2];
#pragma unroll
    for (int i = 0; i < 2; ++i) { int R, C; stage_rc(tid * 16 + i * 8192, R, C); const int Rb = Epi::PERM ? ((R & ~31) + perm32(R & 31)) : R;
        voffA[i] = (unsigned)(R * ld + C) * 2u; voffB[i] = (unsigned)(Rb * ld + C) * 2u; }
    const size_t kstep = (size_t)(BK * 2);
    const size_t hstep = (size_t)HALF * ld * 2;
    const unsigned ldsw = (unsigned)wid * 1024u;
    const int aoff = lds_byte(wr * 64 + fr, fq * 8), boff = lds_byte(wc * 32 + fr, fq * 8);
#define PG8_SA(b, h) (((b) * 2 + (h)) * HTB)
#define PG8_SB(b, h) ((4 + (b) * 2 + (h)) * HTB)
#define PG8_STAGE(bufoff, gbase, voff) do { _Pragma("unroll") for (int _i = 0; _i < 2; ++_i) \
        __builtin_amdgcn_global_load_lds((const unsigned*)((const char*)(gbase) + (voff)[_i]), (PG8_LAS unsigned*)(lds + (bufoff) + ldsw + _i * 8192), 16, 0, 0); } while (0)
#define PG8_LDA(dst, b, h) do { _Pragma("unroll") for (int m = 0; m < 4; ++m) _Pragma("unroll") for (int k = 0; k < 2; ++k) dst[m][k] = *(const PG8_LAS bf16x8*)(lds + PG8_SA(b, h) + aoff + m * 2048 + k * 1024); } while (0)
#define PG8_LDB(dst, b, h) do { _Pragma("unroll") for (int n = 0; n < 2; ++n) _Pragma("unroll") for (int k = 0; k < 2; ++k) dst[n][k] = *(const PG8_LAS bf16x8*)(lds + PG8_SB(b, h) + boff + n * 2048 + k * 1024); } while (0)
#define PG8_MMA(ai, bj, At, Bt) do { __builtin_amdgcn_s_setprio(1); _Pragma("unroll") for (int m = 0; m < 4; ++m) _Pragma("unroll") for (int n = 0; n < 2; ++n) _Pragma("unroll") for (int k = 0; k < 2; ++k) \
        { if constexpr (I8) acc[ai][bj][m][n] = __builtin_amdgcn_mfma_i32_16x16x64_i8(__builtin_bit_cast(i32x4, Bt[n][k]), __builtin_bit_cast(i32x4, At[m][k]), acc[ai][bj][m][n], 0, 0, 0); \
          else acc[ai][bj][m][n] = __builtin_amdgcn_mfma_f32_16x16x32_bf16(Bt[n][k], At[m][k], acc[ai][bj][m][n], 0, 0, 0); } __builtin_amdgcn_s_setprio(0); } while (0)
#define PG8_WAIT_V(n) asm volatile("s_waitcnt vmcnt(" #n ")" ::: "memory")
#define PG8_WAIT_L(n) asm volatile("s_waitcnt lgkmcnt(" #n ")" ::: "memory")
#define PG8_BAR __builtin_amdgcn_s_barrier()
#define PG8_SCHED __builtin_amdgcn_sched_barrier(0)
    Unit cur, nxt; int ui = 0;
    if (!S.next(0, cur)) return;
    typedef typename AccOf<I8>::T acc_t; const acc_t azero = {0, 0, 0, 0};
    acc_t acc[2][2][4][2];
#pragma unroll
    for (int a = 0; a < 2; ++a)
#pragma unroll
        for (int b = 0; b < 2; ++b)
#pragma unroll
            for (int m = 0; m < 4; ++m)
#pragma unroll
                for (int n = 0; n < 2; ++n) acc[a][b][m][n] = azero;
    bf16x8 At[4][2], B0[2][2], B1[2][2];
    const char* cA = S.A(cur); const char* cB = S.B(cur);
    if constexpr (SP2) {
        PG8_STAGE(PG8_SB(0, 0), cB, voffB); PG8_STAGE(PG8_SB(0, 1), cB + hstep, voffB); PG8_STAGE(PG8_SA(0, 0), cA, voffA); PG8_STAGE(PG8_SA(0, 1), cA + hstep, voffA);
        if (wr == 1) PG8_BAR;
        PG8_WAIT_V(2); PG8_BAR;
        PG8_STAGE(PG8_SB(1, 0), cB + kstep, voffB); PG8_STAGE(PG8_SA(1, 0), cA + kstep, voffA); PG8_STAGE(PG8_SB(1, 1), cB + hstep + kstep, voffB);
        PG8_WAIT_V(6); PG8_BAR;
    } else {
        PG8_STAGE(PG8_SB(0, 0), cB, voffB); PG8_STAGE(PG8_SA(0, 0), cA, voffA); PG8_STAGE(PG8_SB(0, 1), cB + hstep, voffB); PG8_STAGE(PG8_SA(0, 1), cA + hstep, voffA);
        if (wr == 1) PG8_BAR;
        PG8_WAIT_V(4); PG8_BAR;
        PG8_STAGE(PG8_SB(1, 0), cB + kstep, voffB); PG8_STAGE(PG8_SA(1, 0), cA + kstep, voffA); PG8_STAGE(PG8_SB(1, 1), cB + hstep + kstep, voffB);
        PG8_WAIT_V(6); PG8_BAR;
    }
    for (;;) {
        const bool has_next = S.next(ui + 1, nxt); const int nt = S.nt(cur);
        const char* nA = has_next ? S.A(nxt) : cA; const char* nB = has_next ? S.B(nxt) : cB;
        for (int t = 0; t < nt; t += 2) {
            const bool last = (t == nt - 2);
            const char* a1 = cA + (size_t)(t + 1) * kstep;
            const char* a2 = last ? nA : cA + (size_t)(t + 2) * kstep; const char* b2 = last ? nB : cB + (size_t)(t + 2) * kstep;
            const char* a3 = a2 + kstep; const char* b3 = b2 + kstep;
            if constexpr (SP2) {
            PG8_LDB(B0, 0, 0); PG8_LDB(B1, 0, 1); PG8_SCHED; PG8_LDA(At, 0, 0); PG8_STAGE(PG8_SA(1, 1), a1 + hstep, voffA);
            PG8_WAIT_V(8); PG8_WAIT_L(0); PG8_BAR; PG8_MMA(0, 0, At, B0); PG8_MMA(0, 1, At, B1); PG8_BAR; PG8_SCHED;
            PG8_LDA(At, 0, 1); PG8_STAGE(PG8_SB(0, 0), b2, voffB); PG8_STAGE(PG8_SB(0, 1), b2 + hstep, voffB); PG8_STAGE(PG8_SA(0, 0), a2, voffA);
            PG8_WAIT_V(8); PG8_WAIT_L(0); PG8_BAR; PG8_MMA(1, 0, At, B0); PG8_MMA(1, 1, At, B1); PG8_BAR; PG8_SCHED;
            PG8_LDB(B0, 1, 0); PG8_LDB(B1, 1, 1); PG8_SCHED; PG8_LDA(At, 1, 0); PG8_STAGE(PG8_SA(0, 1), a2 + hstep, voffA);
            PG8_WAIT_V(8); PG8_WAIT_L(0); PG8_BAR; PG8_MMA(0, 0, At, B0); PG8_MMA(0, 1, At, B1); PG8_BAR; PG8_SCHED;
            PG8_LDA(At, 1, 1); PG8_STAGE(PG8_SB(1, 0), b3, voffB); PG8_STAGE(PG8_SB(1, 1), b3 + hstep, voffB); PG8_STAGE(PG8_SA(1, 0), a3, voffA);
            PG8_WAIT_V(8); PG8_WAIT_L(0); PG8_BAR; PG8_MMA(1, 0, At, B0); PG8_MMA(1, 1, At, B1); PG8_BAR; PG8_SCHED;
            } else {
            PG8_LDB(B0, 0, 0); PG8_SCHED; PG8_LDA(At, 0, 0); PG8_STAGE(PG8_SA(1, 1), a1 + hstep, voffA);
            PG8_WAIT_L(8); PG8_BAR; PG8_WAIT_L(0); PG8_MMA(0, 0, At, B0); PG8_BAR; PG8_SCHED;
            PG8_LDB(B1, 0, 1); PG8_STAGE(PG8_SB(0, 0), b2, voffB);
            PG8_BAR; PG8_WAIT_L(0); PG8_MMA(0, 1, At, B1); PG8_BAR;
            PG8_LDA(At, 0, 1); PG8_STAGE(PG8_SA(0, 0), a2, voffA);
            PG8_BAR; PG8_WAIT_L(0); PG8_MMA(1, 0, At, B0); PG8_BAR; PG8_SCHED;
            PG8_STAGE(PG8_SB(0, 1), b2 + hstep, voffB);
            PG8_WAIT_V(6); PG8_BAR; PG8_MMA(1, 1, At, B1); PG8_BAR;
            PG8_LDB(B0, 1, 0); PG8_SCHED; PG8_LDA(At, 1, 0); PG8_STAGE(PG8_SA(0, 1), a2 + hstep, voffA);
            PG8_WAIT_L(8); PG8_BAR; PG8_WAIT_L(0); PG8_MMA(0, 0, At, B0); PG8_BAR; PG8_SCHED;
            PG8_LDB(B1, 1, 1); PG8_STAGE(PG8_SB(1, 0), b3, voffB);
            PG8_BAR; PG8_WAIT_L(0); PG8_MMA(0, 1, At, B1); PG8_BAR;
            PG8_LDA(At, 1, 1); PG8_STAGE(PG8_SA(1, 0), a3, voffA);
            PG8_BAR; PG8_WAIT_L(0); PG8_MMA(1, 0, At, B0); PG8_BAR; PG8_SCHED;
            PG8_STAGE(PG8_SB(1, 1), b3 + hstep, voffB);
            PG8_WAIT_V(6); PG8_BAR; PG8_MMA(1, 1, At, B1); PG8_BAR;
            }
        }
        if constexpr (ALIGN_EPI) { if (wr == 0) PG8_BAR; }
        if constexpr (!Epi::AFTER_DRAIN) E(acc, cur, wr, wc, fr, fq);
        if (!has_next) break;
        if (!S.keep(cur)) {
#pragma unroll
        for (int a = 0; a < 2; ++a)
#pragma unroll
            for (int b = 0; b < 2; ++b)
#pragma unroll
                for (int m = 0; m < 4; ++m)
#pragma unroll
                    for (int n = 0; n < 2; ++n) acc[a][b][m][n] = azero;
        }
        cur = nxt; cA = nA; cB = nB; ++ui;
        if constexpr (ALIGN_EPI) { if (wr == 1) PG8_BAR; }
    }
    PG8_WAIT_V(0);
    if constexpr (!ALIGN_EPI) { if (wr == 0) PG8_BAR; }
    PG8_BAR;
    if constexpr (Epi::AFTER_DRAIN) E.fused(acc, cur, wr, wc, fr, fq, lds);
#undef PG8_SA
#undef PG8_SB
#undef PG8_STAGE
#undef PG8_LDA
#undef PG8_LDB
#undef PG8_MMA
#undef PG8_WAIT_V
#undef PG8_WAIT_L
#undef PG8_BAR
#undef PG8_SCHED
}
}

constexpr int D = 1024, NB = 4, SEQ = 4096, CTXL = 256;
constexpr int ML = NB * SEQ;
constexpr int MC = NB * CTXL;
constexpr int MH = ML + MC;
constexpr int INW = 5120;
constexpr int ZC_W = 1536;
constexpr int NEXP = 16384, NHEAD_P = 8, TOPK = 16;
constexpr float EPS = 1e-6f;
constexpr int NWAVES = 8, NTHREADS = 512;
constexpr int SEGT = 512, NSEG = SEQ / SEGT;
constexpr int CHT = 32;
constexpr int NSCAN_L = NB * 4 * 2 * NSEG;
constexpr int NCSEG = 4;
constexpr int NSCAN = NSCAN_L + NB * 4 * 2 * NCSEG;

constexpr size_t MiB = 1u << 20;
constexpr size_t WS_CTL = 0, CTL_ZERO_BYTES = 64 * 1024;
constexpr size_t WS_MOD = 1 * MiB;
constexpr size_t WS_LBT = WS_MOD + 128 * 1024;
constexpr size_t WS_ASEG = WS_LBT + 8 * 1024;
constexpr size_t WS_SU = WS_ASEG + 200 * 1024;
constexpr size_t WS_SV = WS_SU + 64 * 1024;
constexpr size_t WS_SA1 = WS_SV + 72 * 1024;
constexpr size_t WS_SBW = WS_SA1 + 72 * 1024;
constexpr size_t WS_WIN8 = 242 * MiB;
constexpr size_t WS_SB = WS_SV + 64 * 1024;
constexpr size_t WS_WC8 = 10 * MiB;
constexpr size_t WS_WIN = 2 * MiB;
constexpr size_t WS_WA = 12 * MiB, WS_WB = 13 * MiB, WS_WO = 14 * MiB, WS_WQ = 16 * MiB;
constexpr size_t WS_WPA = 20 * MiB;
constexpr size_t WS_ZC = 21 * MiB;
constexpr int ZLD = 3072;
constexpr size_t WS_Z = 24 * MiB;
constexpr size_t WS_G8 = 120 * MiB;
constexpr size_t WS_EIDX = 88 * MiB;
constexpr size_t WS_GATE = 96 * MiB;
constexpr size_t WS_U8 = 112 * MiB, WS_V8 = 128 * MiB;
constexpr size_t WS_PART = 24 * MiB;
constexpr size_t WS_WGT = 104 * MiB;
constexpr size_t WS_H8P = 152 * MiB;
constexpr size_t WS_SH = WS_ASEG;
constexpr size_t WS_PO = 144 * MiB;
constexpr size_t WS_SSQ = 21 * MiB;
constexpr size_t WS_H = 184 * MiB;
constexpr size_t WS_HC = 216 * MiB;
constexpr size_t WS_YHG = 184 * MiB, WS_YPOOL = 200 * MiB;
constexpr size_t WS_USEG = 218 * MiB;
constexpr size_t WS_PFX = 2 * MiB;
constexpr size_t WS_M = 218 * MiB;
constexpr size_t WS_ZC2 = 252 * MiB;
constexpr size_t WS_END = 255 * MiB;
static_assert(WS_Z + (size_t)ML * ZLD * 2 <= WS_G8 && WS_G8 + (size_t)ML * 2048 <= WS_H && WS_H + (size_t)MH * D * 2 <= WS_USEG && WS_USEG + (size_t)NSCAN * 128 * 128 * 4 <= WS_END && WS_M + (size_t)ML * D * 2 <= WS_END && WS_USEG + (size_t)NSCAN * 128 * 128 * 4 <= WS_ZC2 && WS_PFX + 8 * MiB <= WS_WA, "ws map");
static_assert(WS_V8 + (size_t)NEXP * D <= WS_H, "ws map 2");
constexpr size_t OUT_OLOC = 0, OUT_QSEG = 32 * MiB;
constexpr int CW_BAR = 1024;
constexpr int CW_WINB = 13824;
constexpr int CW_CTXCNT = 12800;
constexpr int CW_MODCNT = 12288;
constexpr int CW_PANEL = 8192;

constexpr int LDS_BYTES = 163840;
constexpr int MISC_OFF = LDS_BYTES - 256;

#define GAS __attribute__((address_space(1)))
#define LAS __attribute__((address_space(3)))
typedef unsigned short bf16;
typedef unsigned v4u __attribute__((ext_vector_type(4)));
typedef unsigned v2u __attribute__((ext_vector_type(2)));
typedef float f32x4 __attribute__((ext_vector_type(4)));
typedef float f32x2 __attribute__((ext_vector_type(2)));
typedef short bf16x8 __attribute__((ext_vector_type(8)));
typedef short s16x4 __attribute__((ext_vector_type(4)));
#define LDS_WAIT() asm volatile("s_waitcnt lgkmcnt(0)" ::: "memory")
#define VM_WAIT() asm volatile("s_waitcnt vmcnt(0)" ::: "memory")
#define LBAR() do { asm volatile("s_waitcnt lgkmcnt(0)" ::: "memory"); __builtin_amdgcn_s_barrier(); asm volatile("" ::: "memory"); } while (0)
__device__ __forceinline__ unsigned f2bf(float f) { unsigned u = __builtin_bit_cast(unsigned, f); return (u + 0x7fffu + ((u >> 16) & 1u)) >> 16; }
__device__ __forceinline__ unsigned pk2(float lo, float hi) { return pg8::cvt_pk_bf16(lo, hi); }
__device__ __forceinline__ float bflo(unsigned w) { return __builtin_bit_cast(float, w << 16); }
__device__ __forceinline__ float bfhi(unsigned w) { return __builtin_bit_cast(float, w & 0xffff0000u); }
__device__ __forceinline__ float fast_exp(float x) { return __builtin_amdgcn_exp2f(x * 1.4426950408889634f); }
__device__ __forceinline__ float fast_rcp(float x) { return __builtin_amdgcn_rcpf(x); }
__device__ __forceinline__ float sigmoidf_(float x) { return fast_rcp(1.f + fast_exp(-x)); }
__device__ __forceinline__ unsigned pack_i8x4(float a, float b, float c, float d) {
    const int ia = (int)rintf(a), ib = (int)rintf(b), ic = (int)rintf(c), id = (int)rintf(d);
    return ((unsigned)ia & 255u) | (((unsigned)ib & 255u) << 8) | (((unsigned)ic & 255u) << 16) | (((unsigned)id & 255u) << 24);
}
#define WDPP_(v, ctrl) __builtin_bit_cast(float, __builtin_amdgcn_mov_dpp(__builtin_bit_cast(int, (v)), (ctrl), 0xf, 0xf, true))
typedef unsigned wr_u2 __attribute__((ext_vector_type(2)));
#define WSWAP_(v, which, OP) do { unsigned w_ = __builtin_bit_cast(unsigned, (v)); asm volatile("" : "+v"(w_)); \
    const wr_u2 r_ = __builtin_amdgcn_permlane##which##_swap(__builtin_bit_cast(unsigned, (v)), w_, false, false); const unsigned ra_ = r_.x, rb_ = r_.y; (v) = OP(__builtin_bit_cast(float, ra_), __builtin_bit_cast(float, rb_)); } while (0)
#define WADD_(a, b) ((a) + (b))
__device__ __forceinline__ float wave_sum(float v) {
    v += WDPP_(v, 0xb1); v += WDPP_(v, 0x4e); v += WDPP_(v, 0x141); v += WDPP_(v, 0x140);
    WSWAP_(v, 16, WADD_); WSWAP_(v, 32, WADD_);
    return v;
}
__device__ __forceinline__ float wave_max(float v) {
    v = fmaxf(v, WDPP_(v, 0xb1)); v = fmaxf(v, WDPP_(v, 0x4e)); v = fmaxf(v, WDPP_(v, 0x141)); v = fmaxf(v, WDPP_(v, 0x140));
    WSWAP_(v, 16, fmaxf); WSWAP_(v, 32, fmaxf);
    return v;
}

#define XB_TMO      128
#define XB_XCNT(j)  (256  + 64 * (j))
#define XB_XSUB(j)  (1280 + 64 * (j))
#define XB_XGEN(j)  (2304 + 64 * (j))
#define XB_TOP      3328
#define XB_TOPGEN   3392
#define XCD_BAR_WORDS 3456
#define XB_SPIN_CAP (1u << 18)
__device__ __forceinline__ unsigned xb_ld(unsigned* p)              { return __hip_atomic_load(p, __ATOMIC_RELAXED, __HIP_MEMORY_SCOPE_AGENT); }
__device__ __forceinline__ unsigned xb_add(unsigned* p, unsigned v) { return __hip_atomic_fetch_add(p, v, __ATOMIC_RELAXED, __HIP_MEMORY_SCOPE_AGENT); }
__device__ __forceinline__ unsigned xb_xcc_id() { return (unsigned)__builtin_amdgcn_s_getreg((3 << 11) | 20) & 0xFu; }
#define XB_SPIN(cond, bar) do { unsigned _sp = 0; while (cond) { __builtin_amdgcn_s_sleep(1); \
    if ((++_sp & 255u) == 0u) { if (xb_ld(&(bar)[XB_TMO])) break; if (_sp > XB_SPIN_CAP) { atomicAdd(&(bar)[XB_TMO], 1u); break; } } } } while (0)
struct XcdBarrier { unsigned* bar; unsigned x; volatile LAS unsigned* st; };
__device__ __forceinline__ XcdBarrier xcd_barrier_post(unsigned* bar, volatile LAS unsigned* st) {
    XcdBarrier b; b.bar = bar; b.x = xb_xcc_id(); b.st = st;
    if (threadIdx.x == 0) st[2] = xb_add(&bar[XB_XCNT(b.x)], 1u);
    return b;
}
__device__ __forceinline__ void xcd_barrier_complete(unsigned* bar, unsigned x, unsigned& nloc, unsigned& nx) {
    const unsigned G = gridDim.x * gridDim.y * gridDim.z;
    unsigned sum, cnt, mine, sp = 0u;
    for (;;) {
        sum = 0u; cnt = 0u; mine = 0u;
#pragma unroll
        for (unsigned j = 0; j < 16; ++j) { const unsigned c = xb_ld(&bar[XB_XCNT(j)]); sum += c; cnt += (c > 0u) ? 1u : 0u; mine = (j == x) ? c : mine; }
        if (sum == G) break;
        __builtin_amdgcn_s_sleep(1);
        if ((++sp & 255u) == 0u) { if (xb_ld(&bar[XB_TMO])) break; if (sp > XB_SPIN_CAP) { atomicAdd(&bar[XB_TMO], 1u); break; } }
    }
    nloc = mine > 0u ? mine : 1u; nx = cnt > 0u ? cnt : 1u;
}
__device__ __forceinline__ void xcd_barrier(const XcdBarrier& b) {
    asm volatile("s_waitcnt vmcnt(0)" ::: "memory");
    __syncthreads();
    if (threadIdx.x == 0) {
        unsigned* bar = b.bar;
        __builtin_amdgcn_s_waitcnt(0);
        unsigned nloc = b.st[0], nx = b.st[1];
        if (nloc == 0u) { xcd_barrier_complete(bar, b.x, nloc, nx); b.st[0] = nloc; b.st[1] = nx; }
        const unsigned old = xb_add(&bar[XB_XSUB(b.x)], 1u);
        const unsigned gen = old / nloc;
        if (old + 1u == (gen + 1u) * nloc) {
            __builtin_amdgcn_fence(__ATOMIC_RELEASE, "agent");
            asm volatile("s_waitcnt vmcnt(0)" ::: "memory");
            const unsigned og = xb_add(&bar[XB_TOP], 1u);
            const unsigned tg = og / nx;
            if (og + 1u == (tg + 1u) * nx) xb_add(&bar[XB_TOPGEN], 1u);
            else XB_SPIN(xb_ld(&bar[XB_TOPGEN]) == tg, bar);
            __builtin_amdgcn_fence(__ATOMIC_ACQUIRE, "agent");
            xb_add(&bar[XB_XGEN(b.x)], 1u);
            asm volatile("s_waitcnt vmcnt(0)" ::: "memory");
        } else {
            XB_SPIN(xb_ld(&bar[XB_XGEN(b.x)]) == gen, bar);
            __builtin_amdgcn_fence(__ATOMIC_ACQUIRE, "agent");
            asm volatile("s_waitcnt vmcnt(0)" ::: "memory");
        }
    }
    __syncthreads();
}

struct Args { const float* in[21]; float* out; unsigned char* ws; int ph_lo, ph_hi; };

struct Frame {
    LAS unsigned char* lds; int tid, lane, wave, G, bid;
    const float *x, *c, *ctx, *c_ctx, *w_mod, *b_mod, *n1g, *n2g, *w_in, *pool_w, *pool_scale, *lb_logits, *hg_norm_g, *w_a, *w_b, *w_o, *wq, *keys, *pu, *pv, *final_g;
    float* out; unsigned char* ws;
};

__device__ __forceinline__ void p0_transpose_item(const float* W, int K, int N, bf16* WT, LAS float* scr, int item, int lane) {
    const int nblk = N / 32, kb = item / nblk, nb = item % nblk, k0 = 64 * kb, n0 = 32 * nb;
#pragma unroll 8
    for (int i = 0; i < 32; ++i) { const int kk = 2 * i + (lane >> 5); scr[kk * 33 + (lane & 31)] = W[(size_t)(k0 + kk) * N + n0 + (lane & 31)]; }
    LDS_WAIT(); asm volatile("" ::: "memory");
    const int c = lane & 7;
#pragma unroll
    for (int j = 0; j < 4; ++j) { const int n = (lane >> 3) + 8 * j; const LAS float* s = scr + (8 * c) * 33 + n;
        v4u o; o.x = pk2(s[0 * 33], s[1 * 33]); o.y = pk2(s[2 * 33], s[3 * 33]); o.z = pk2(s[4 * 33], s[5 * 33]); o.w = pk2(s[6 * 33], s[7 * 33]);
        pg8::st_wt16((void*)(WT + (size_t)(n0 + n) * K + k0 + 8 * c), o); }
    LDS_WAIT(); asm volatile("" ::: "memory");
}

__device__ __forceinline__ void p0_prologue(Frame& F) {
    float* mod = (float*)(F.ws + WS_MOD);
    if (F.bid < 192) {
        LAS float* sl = (LAS float*)(F.lds + 81920);
        LAS float* red = (LAS float*)(F.lds + 81920 + 20480);
        for (int i = F.tid; i < 5 * 1024; i += NTHREADS) { const float cv = (i < 4096) ? F.c[i] : F.c_ctx[i - 4096]; sl[i] = cv * sigmoidf_(cv); }
        __syncthreads();
        const int col = F.tid & 31, kg = F.tid >> 5, col0 = 32 * F.bid;
        float a0 = 0.f, a1 = 0.f, a2 = 0.f, a3 = 0.f, a4 = 0.f;
        const float* wp = F.w_mod + (size_t)(kg * 64) * 6144 + col0 + col;
        float wv_[64];
#pragma unroll
        for (int r = 0; r < 64; ++r) wv_[r] = wp[(size_t)r * 6144];
#pragma unroll
        for (int r = 0; r < 64; ++r) { const float w = wv_[r]; const int k = kg * 64 + r;
            a0 += w * sl[k]; a1 += w * sl[1024 + k]; a2 += w * sl[2048 + k]; a3 += w * sl[3072 + k]; a4 += w * sl[4096 + k]; }
        red[(kg * 5 + 0) * 32 + col] = a0; red[(kg * 5 + 1) * 32 + col] = a1; red[(kg * 5 + 2) * 32 + col] = a2; red[(kg * 5 + 3) * 32 + col] = a3; red[(kg * 5 + 4) * 32 + col] = a4;
        __syncthreads();
        if (F.tid < 160) { const int v = F.tid >> 5, cc = F.tid & 31; float s = 0.f;
#pragma unroll
            for (int g = 0; g < 16; ++g) s += red[(g * 5 + v) * 32 + cc];
            __hip_atomic_store(&mod[v * 6144 + col0 + cc], s + F.b_mod[col0 + cc], __ATOMIC_RELAXED, __HIP_MEMORY_SCOPE_AGENT); }
        asm volatile("s_waitcnt vmcnt(0)" ::: "memory");
        __syncthreads();
        if (F.tid == 0) xb_add((unsigned*)(F.ws + WS_CTL) + CW_MODCNT, 1u);
    }
    LAS float* scr = (LAS float*)(F.lds + F.wave * 8448);
    const int gw = F.bid * NWAVES + F.wave, NGW = F.G * NWAVES;
    constexpr int I_IN = (D / 64) * (INW / 32), I_A = (512 / 64) * (D / 32), I_O = (D / 64) * (D / 32);
    constexpr int NITEMS = I_IN + 2 * I_A + I_O;
    for (int it = gw; it < NITEMS; it += NGW) {
        int r = it;
        if (r < I_IN) { p0_transpose_item(F.w_in, D, INW, (bf16*)(F.ws + WS_WIN), scr, r, F.lane);
            asm volatile("s_waitcnt vmcnt(0)" ::: "memory");
            if (F.lane == 0) xb_add((unsigned*)(F.ws + WS_CTL) + CW_WINB + (r % (INW / 32)) * 16, 1u);
            continue; } r -= I_IN;
        if (r < I_A) { p0_transpose_item(F.w_a, 512, D, (bf16*)(F.ws + WS_WA), scr, r, F.lane); continue; } r -= I_A;
        if (r < I_A) { p0_transpose_item(F.w_b, 512, D, (bf16*)(F.ws + WS_WB), scr, r, F.lane); continue; } r -= I_A;
        p0_transpose_item(F.w_o, D, D, (bf16*)(F.ws + WS_WO), scr, r, F.lane);
    }
    for (int it = gw; it < 16 * 64 * 2; it += NGW) {
        const int kh = it & 1, dt = (it >> 1) & 63, hp = it >> 7, lane = F.lane, q = lane >> 4;
        bf16x8 Aw[4];
#pragma unroll
        for (int sk = 0; sk < 4; ++sk) { const GAS f32x4* p = (const GAS f32x4*)(F.wq + (size_t)(16 * dt + (lane & 15)) * 2048 + hp * 128 + 32 * sk + 8 * q); const f32x4 a = p[0], b = p[1];
            v4u w; w.x = pk2(a.x, a.y); w.y = pk2(a.z, a.w); w.z = pk2(b.x, b.y); w.w = pk2(b.z, b.w); Aw[sk] = __builtin_bit_cast(bf16x8, w); }
        bf16* wc = (bf16*)(F.ws + WS_WQ);
        f32x4 kf[4][4][2];
#pragma unroll
        for (int k4 = 0; k4 < 4; ++k4)
#pragma unroll
            for (int sk = 0; sk < 4; ++sk) { const GAS f32x4* p = (const GAS f32x4*)(F.keys + (size_t)(hp * 128 + 16 * (4 * kh + k4) + (lane & 15)) * 128 + 32 * sk + 8 * q); kf[k4][sk][0] = p[0]; kf[k4][sk][1] = p[1]; }
#pragma unroll
        for (int k4 = 0; k4 < 4; ++k4) { const int kt = 4 * kh + k4;
            f32x4 acc = (f32x4){0.f, 0.f, 0.f, 0.f};
#pragma unroll
            for (int sk = 0; sk < 4; ++sk) { const f32x4 a = kf[k4][sk][0], b = kf[k4][sk][1];
                v4u w; w.x = pk2(a.x, a.y); w.y = pk2(a.z, a.w); w.z = pk2(b.x, b.y); w.w = pk2(b.z, b.w);
                acc = __builtin_amdgcn_mfma_f32_16x16x32_bf16(Aw[sk], __builtin_bit_cast(bf16x8, w), acc, 0, 0, 0); }
            v2u o; o.x = pk2(acc[0], acc[1]); o.y = pk2(acc[2], acc[3]);
            *(GAS v2u*)(wc + (size_t)(hp * 128 + 16 * kt + (lane & 15)) * D + 16 * dt + 4 * q) = o;
        }
    }
    for (int it = gw; it < 4 * 64 * 8; it += NGW) {
        const int ct = it & 7, ntile = (it >> 3) & 63, g = it >> 9, lane = F.lane, q = lane >> 4;
        f32x4 acc = (f32x4){0.f, 0.f, 0.f, 0.f};
#pragma unroll
        for (int sk = 0; sk < 4; ++sk) {
            const GAS f32x4* p = (const GAS f32x4*)(F.pool_w + ((size_t)g * 128 + 16 * ct + (lane & 15)) * 128 + 32 * sk + 8 * q); const GAS f32x4* sp = (const GAS f32x4*)(F.pool_scale + g * 128 + 32 * sk + 8 * q);
            const f32x4 a = p[0] * sp[0], b = p[1] * sp[1];
            v4u wa_; wa_.x = pk2(a.x, a.y); wa_.y = pk2(a.z, a.w); wa_.z = pk2(b.x, b.y); wa_.w = pk2(b.z, b.w);
            const float* wcol = F.w_a + (size_t)(g * 128 + 32 * sk + 8 * q) * D + 16 * ntile + (lane & 15);
            v4u wb_; wb_.x = pk2(wcol[0], wcol[D]); wb_.y = pk2(wcol[2 * D], wcol[3 * D]); wb_.z = pk2(wcol[4 * D], wcol[5 * D]); wb_.w = pk2(wcol[6 * D], wcol[7 * D]);
            acc = __builtin_amdgcn_mfma_f32_16x16x32_bf16(__builtin_bit_cast(bf16x8, wa_), __builtin_bit_cast(bf16x8, wb_), acc, 0, 0, 0); }
        v2u o; o.x = pk2(acc[0], acc[1]); o.y = pk2(acc[2], acc[3]);
        *(GAS v2u*)((bf16*)(F.ws + WS_WPA) + (size_t)(16 * ntile + (lane & 15)) * 512 + g * 128 + 16 * ct + 4 * q) = o;
    }
    { const int gt = F.bid * NTHREADS + F.tid; float* lbt = (float*)(F.ws + WS_LBT);
      if (gt < 1024) { const int dir = gt >> 9, cc = gt & 511; const float l0 = F.lb_logits[(dir * 2 + 0) * 512 + cc], l1 = F.lb_logits[(dir * 2 + 1) * 512 + cc];
          lbt[gt] = 1.f / (1.f + expf(l1 - l0)); } }
}

__device__ __forceinline__ void rows_bf16_to_i8(const bf16* src, unsigned char* dst, float* scl, int nrows, int gw, int NGW, int lane) {
    for (int r = gw; r < nrows; r += NGW) {
        const GAS v4u* p = (const GAS v4u*)(src + (size_t)r * D + 16 * lane); const v4u a = p[0], b = p[1];
        const float x[16] = {bflo(a.x), bfhi(a.x), bflo(a.y), bfhi(a.y), bflo(a.z), bfhi(a.z), bflo(a.w), bfhi(a.w), bflo(b.x), bfhi(b.x), bflo(b.y), bfhi(b.y), bflo(b.z), bfhi(b.z), bflo(b.w), bfhi(b.w)};
        float m = 0.f;
#pragma unroll
        for (int i = 0; i < 16; ++i) m = fmaxf(m, fabsf(x[i]));
        m = wave_max(m);
        const float qs = (m > 0.f) ? 127.f / m : 1.f;
        v4u o; o.x = pack_i8x4(x[0] * qs, x[1] * qs, x[2] * qs, x[3] * qs); o.y = pack_i8x4(x[4] * qs, x[5] * qs, x[6] * qs, x[7] * qs); o.z = pack_i8x4(x[8] * qs, x[9] * qs, x[10] * qs, x[11] * qs); o.w = pack_i8x4(x[12] * qs, x[13] * qs, x[14] * qs, x[15] * qs);
        *(GAS v4u*)(dst + (size_t)r * D + 16 * lane) = o;
        if (lane == 0) scl[r] = (m > 0.f) ? m * (1.f / 127.f) : 1.f;
    }
}
__device__ __forceinline__ void modulate_row_fin(const f32x4 (&xin)[4], unsigned char* orow, float* oscale, const float* g, const float* shift, const float* scale, int lane) {
    f32x4 v[4]; float s2 = 0.f;
#pragma unroll
    for (int j = 0; j < 4; ++j) { v[j] = xin[j]; s2 += (v[j].x * v[j].x + v[j].y * v[j].y) + (v[j].z * v[j].z + v[j].w * v[j].w); }
    const float rstd = 1.f / sqrtf(wave_sum(s2) * (1.f / D) + EPS);
    float m = 0.f;
#pragma unroll
    for (int j = 0; j < 4; ++j) {
        const f32x4 gg = ((const GAS f32x4*)g)[lane + 64 * j], sh = ((const GAS f32x4*)shift)[lane + 64 * j], sc = ((const GAS f32x4*)scale)[lane + 64 * j];
        v[j] = (v[j] * rstd) * gg * (sc + 1.0f) + sh;
        m = fmaxf(m, fmaxf(fmaxf(fabsf(v[j].x), fabsf(v[j].y)), fmaxf(fabsf(v[j].z), fabsf(v[j].w)))); }
    m = wave_max(m);
    const float qs = (m > 0.f) ? 127.f / m : 1.f;
#pragma unroll
    for (int j = 0; j < 4; ++j) ((GAS unsigned*)orow)[lane + 64 * j] = pack_i8x4(v[j].x * qs, v[j].y * qs, v[j].z * qs, v[j].w * qs);
    if (lane == 0) *oscale = (m > 0.f) ? m * (1.f / 127.f) : 1.f;
}
__device__ __forceinline__ void p1_modulate(Frame& F) {
    const float* mod = (const float*)(F.ws + WS_MOD); unsigned char* H = F.ws + WS_H; unsigned char* HC = F.ws + WS_HC; float* SA = (float*)(F.ws + WS_SA1);
    const int gw = F.bid * NWAVES + F.wave, NGW = F.G * NWAVES;
#define P1_XROW(m_) ((const GAS f32x4*)(((m_) < ML) ? F.x + (size_t)(m_) * D : F.ctx + (size_t)((m_) - ML) * D) + F.lane)
#define P1_LOAD(XX, m_) do { const GAS f32x4* xr_ = P1_XROW(m_); XX[0] = xr_[0]; XX[1] = xr_[64]; XX[2] = xr_[128]; XX[3] = xr_[192]; } while (0)
    f32x4 xa[4], xb[4];
    { const int mb = (gw + NGW < MH) ? gw + NGW : gw; P1_LOAD(xa, gw); P1_LOAD(xb, mb); }
#pragma unroll 1
    for (int m = gw; m < MH; m += 2 * NGW) {
        const int m1 = m + NGW, mn0 = (m + 2 * NGW < MH) ? m + 2 * NGW : m, mn1 = (m + 3 * NGW < MH) ? m + 3 * NGW : m;
        f32x4 na[4], nb[4];
        P1_LOAD(na, mn0); P1_LOAD(nb, mn1);
        { const int v = (m < ML) ? (m >> 12) : 4; modulate_row_fin(xa, ((m < ML) ? H + (size_t)m * D : HC + (size_t)(m - ML) * D), SA + m, F.n1g, mod + v * 6144 + 0, mod + v * 6144 + 1024, F.lane); }
        if (m1 < MH) { const int v = (m1 < ML) ? (m1 >> 12) : 4; modulate_row_fin(xb, ((m1 < ML) ? H + (size_t)m1 * D : HC + (size_t)(m1 - ML) * D), SA + m1, F.n1g, mod + v * 6144 + 0, mod + v * 6144 + 1024, F.lane); }
#pragma unroll
        for (int j = 0; j < 4; ++j) { xa[j] = na[j]; xb[j] = nb[j]; }
    }
#undef P1_LOAD
#undef P1_XROW
}
__device__ __forceinline__ void p1_win8_poll(Frame& F) {
    const int gw = F.bid * NWAVES + F.wave, NGW = F.G * NWAVES; unsigned* tmo = (unsigned*)(F.ws + WS_CTL) + CW_BAR;
    if (F.lane == 0) { for (int r = gw; r < INW; r += NGW) { unsigned* c_ = (unsigned*)(F.ws + WS_CTL) + CW_WINB + (r >> 5) * 16; XB_SPIN(xb_ld(c_) < 16u, tmo); } }
}
__device__ __forceinline__ void p1_win8_convert(Frame& F) {
    rows_bf16_to_i8((const bf16*)(F.ws + WS_WIN), F.ws + WS_WIN8, (float*)(F.ws + WS_SBW), INW, F.bid * NWAVES + F.wave, F.G * NWAVES, F.lane);
}

using pg8::Unit;
struct SchedPlain {
    const char* Ab; const char* Bb; int nM, nN, K, G, c;
    __device__ __forceinline__ bool next(int i, Unit& u) const { const int L = i * G + c; if (L >= nM * nN) return false; pg8::tile_of(L, nM, nN, u.pm, u.pn); u.seg = 0; return true; }
    __device__ __forceinline__ const char* A(const Unit& u) const { return Ab + (size_t)u.pm * 256 * K * 2; }
    __device__ __forceinline__ const char* B(const Unit& u) const { return Bb + (size_t)u.pn * 256 * K * 2; }
    __device__ __forceinline__ bool keep(const Unit&) const { return false; }
    __device__ __forceinline__ int nt(const Unit&) const { return K / 64; }
};
struct SchedOnce {
    const char* Ab; const char* Bb; int nM, nN, K, base, c;
    __device__ __forceinline__ bool next(int i, Unit& u) const { const int L = base + c; if (i != 0 || L >= nM * nN) return false; pg8::tile_of(L, nM, nN, u.pm, u.pn); u.seg = 0; return true; }
    __device__ __forceinline__ const char* A(const Unit& u) const { return Ab + (size_t)u.pm * 256 * K * 2; }
    __device__ __forceinline__ const char* B(const Unit& u) const { return Bb + (size_t)u.pn * 256 * K * 2; }
    __device__ __forceinline__ bool keep(const Unit&) const { return false; }
    __device__ __forceinline__ int nt(const Unit&) const { return K / 64; }
};
struct SchedTile {
    const char* Ab; const char* Bb; int K, pm, pn;
    __device__ __forceinline__ bool next(int i, Unit& u) const { if (i != 0) return false; u.pm = pm; u.pn = pn; u.seg = 0; return true; }
    __device__ __forceinline__ const char* A(const Unit& u) const { return Ab + (size_t)u.pm * 256 * K * 2; }
    __device__ __forceinline__ const char* B(const Unit& u) const { return Bb + (size_t)u.pn * 256 * K * 2; }
    __device__ __forceinline__ bool keep(const Unit&) const { return false; }
    __device__ __forceinline__ int nt(const Unit&) const { return K / 64; }
};
struct SchedIn {
    const char* Ab; const char* Bb; int G, c;
    __device__ __forceinline__ bool next(int i, Unit& u) const { const int L = i * G + c; u.seg = 0;
        if (L < 1280) { pg8::tile_of(L, 64, 20, u.pm, u.pn); return true; }
        return false; }
    __device__ __forceinline__ const char* A(const Unit& u) const { return Ab + (size_t)u.pm * 256 * D; }
    __device__ __forceinline__ const char* B(const Unit& u) const { return Bb + (size_t)u.pn * 256 * D; }
    __device__ __forceinline__ bool keep(const Unit&) const { return false; }
    __device__ __forceinline__ int nt(const Unit&) const { return 8; }
};
struct SchedCtx {
    const char* Ab; const char* Bb; int l;
    __device__ __forceinline__ bool next(int i, Unit& u) const { if (i != 0) return false; const int l2 = l >> 1; u.seg = l & 1; u.pm = 64 + (l2 & 3); u.pn = 4 + (l2 >> 2); return true; }
    __device__ __forceinline__ const char* A(const Unit& u) const { return Ab + (size_t)(u.pm - 64) * 256 * D + (u.seg ? 512 : 0); }
    __device__ __forceinline__ const char* B(const Unit& u) const { return Bb + (size_t)u.pn * 256 * D + (u.seg ? 512 : 0); }
    __device__ __forceinline__ bool keep(const Unit&) const { return false; }
    __device__ __forceinline__ int nt(const Unit&) const { return 4; }
};
struct SchedMerge {
    const char *A0, *A1, *B0, *B1; int G, c;
    __device__ __forceinline__ bool next(int i, Unit& u) const { const int tile = (i >> 1) * G + c; if (tile >= 256) return false; pg8::tile_of(tile, 64, 4, u.pm, u.pn); u.seg = i & 1; return true; }
    __device__ __forceinline__ const char* A(const Unit& u) const { return (u.seg ? A1 : A0) + (size_t)u.pm * 256 * 512 * 2; }
    __device__ __forceinline__ const char* B(const Unit& u) const { return (u.seg ? B1 : B0) + (size_t)u.pn * 256 * 512 * 2; }
    __device__ __forceinline__ bool keep(const Unit& u) const { return u.seg == 0; }
    __device__ __forceinline__ int nt(const Unit&) const { return 8; }
};

struct EpiZ {
    static constexpr bool PERM = true, AFTER_DRAIN = false;
    bf16* Z; unsigned char* G8; bf16* ZC; bf16* ZC2; const float* sa; const float* sb;
    __device__ __forceinline__ void operator()(pg8::i32x4 (&acc)[2][2][4][2], const Unit& u, int wr, int wc, int fr, int fq) const {
        const int grow0 = u.pm * 256 + wr * 64 + fr, gcol0 = u.pn * 256 + wc * 32 + 8 * fq;
        int row0 = grow0, col0 = gcol0, ldc = ZLD; bf16* base = Z;
        if (u.pm >= 64) { base = u.seg ? ZC2 : ZC; row0 -= ML; col0 -= 1024; ldc = ZC_W; }
        const bool sg = u.pn >= 12;
        pg8::f32x4 cs[2][2];
#pragma unroll
        for (int bj = 0; bj < 2; ++bj)
#pragma unroll
            for (int n = 0; n < 2; ++n) cs[bj][n] = *(const GAS pg8::f32x4*)(sb + gcol0 + bj * 128 + n * 4);
        float rsv[2][4];
#pragma unroll
        for (int ai = 0; ai < 2; ++ai)
#pragma unroll
            for (int m = 0; m < 4; ++m) rsv[ai][m] = sa[grow0 + ai * 128 + m * 16];
#pragma unroll
        for (int ai = 0; ai < 2; ++ai)
#pragma unroll
            for (int m = 0; m < 4; ++m) { bf16* rowp = base + (size_t)(row0 + ai * 128 + m * 16) * ldc + col0; const float rs = rsv[ai][m];
#pragma unroll
                for (int bj = 0; bj < 2; ++bj) { const pg8::i32x4 a0 = acc[ai][bj][m][0], a1 = acc[ai][bj][m][1];
                    pg8::f32x4 v0 = (pg8::f32x4){(float)a0.x, (float)a0.y, (float)a0.z, (float)a0.w} * cs[bj][0] * rs, v1 = (pg8::f32x4){(float)a1.x, (float)a1.y, (float)a1.z, (float)a1.w} * cs[bj][1] * rs;
                    if (sg) {
                        unsigned q[8];
#pragma unroll
                        for (int j = 0; j < 4; ++j) { q[j] = (unsigned)__builtin_amdgcn_fmed3f(v0[j] * 16.f + 128.5f, 0.f, 255.f); q[4 + j] = (unsigned)__builtin_amdgcn_fmed3f(v1[j] * 16.f + 128.5f, 0.f, 255.f); }
                        v2u w8; w8.x = q[0] | (q[1] << 8) | (q[2] << 16) | (q[3] << 24); w8.y = q[4] | (q[5] << 8) | (q[6] << 16) | (q[7] << 24);
                        *(GAS v2u*)(G8 + (size_t)(grow0 + ai * 128 + m * 16) * 2048 + (gcol0 - 3072) + bj * 128) = w8;
                    } else {
                    v4u w; w.x = pk2(v0[0], v0[1]); w.y = pk2(v0[2], v0[3]); w.z = pk2(v1[0], v1[1]); w.w = pk2(v1[2], v1[3]);
                    pg8::st_wt16((void*)(rowp + bj * 128), w); } } }
    }
};
struct EpiPlain {
    static constexpr bool PERM = true, AFTER_DRAIN = false;
    bf16* O; int ldc;
    __device__ __forceinline__ void operator()(pg8::f32x4 (&acc)[2][2][4][2], const Unit& u, int wr, int wc, int fr, int fq) const {
        const int row0 = u.pm * 256 + wr * 64 + fr, col0 = u.pn * 256 + wc * 32 + 8 * fq;
#pragma unroll
        for (int ai = 0; ai < 2; ++ai)
#pragma unroll
            for (int m = 0; m < 4; ++m) { bf16* rowp = O + (size_t)(row0 + ai * 128 + m * 16) * ldc + col0;
#pragma unroll
                for (int bj = 0; bj < 2; ++bj) { const pg8::f32x4 v0 = acc[ai][bj][m][0], v1 = acc[ai][bj][m][1];
                    v4u w; w.x = pk2(v0[0], v0[1]); w.y = pk2(v0[2], v0[3]); w.z = pk2(v1[0], v1[1]); w.w = pk2(v1[2], v1[3]);
                    *(GAS v4u*)(rowp + bj * 128) = w; } }
    }
};
struct EpiMerge {
    static constexpr bool PERM = true, AFTER_DRAIN = false;
    const unsigned char* G8; bf16* Mo;
    __device__ __forceinline__ void operator()(pg8::f32x4 (&acc)[2][2][4][2], const Unit& u, int wr, int wc, int fr, int fq) const {
        const int row0 = u.pm * 256 + wr * 64 + fr, col0 = u.pn * 256 + wc * 32 + 8 * fq;
        const bool s0 = u.seg == 0;
        v2u gh[2], gp[2], ghn[2], gpn[2];
#define EM_LOAD(GH, GP, it_) do { const size_t r_ = (size_t)(row0 + ((it_) >> 2) * 128 + ((it_) & 3) * 16); \
        _Pragma("unroll") for (int bj = 0; bj < 2; ++bj) { GH[bj] = *(const GAS v2u*)(G8 + r_ * 2048 + 1024 + col0 + bj * 128); if (s0) GP[bj] = *(const GAS v2u*)(G8 + r_ * 2048 + col0 + bj * 128); } } while (0)
#define EM_U8(w_, k_) ((float)(((w_) >> (8 * (k_))) & 255u))
        EM_LOAD(gh, gp, 0);
#pragma unroll
        for (int it = 0; it < 8; ++it) { const int ai = it >> 2, m = it & 3; const size_t r = (size_t)(row0 + ai * 128 + m * 16);
            if (it < 7) EM_LOAD(ghn, gpn, it + 1);
#pragma unroll
            for (int bj = 0; bj < 2; ++bj) { const int c = col0 + bj * 128;
                const v2u g = gh[bj];
                float eh[8];
                { const float b_[8] = {EM_U8(g.x, 0), EM_U8(g.x, 1), EM_U8(g.x, 2), EM_U8(g.x, 3), EM_U8(g.y, 0), EM_U8(g.y, 1), EM_U8(g.y, 2), EM_U8(g.y, 3)};
#pragma unroll
                  for (int j = 0; j < 8; ++j) eh[j] = fast_exp(8.f - b_[j] * (1.f / 16.f)); }
                if (s0) {
                    const v2u q = gp[bj];
                    const float b_[8] = {EM_U8(q.x, 0), EM_U8(q.x, 1), EM_U8(q.x, 2), EM_U8(q.x, 3), EM_U8(q.y, 0), EM_U8(q.y, 1), EM_U8(q.y, 2), EM_U8(q.y, 3)};
#pragma unroll
                    for (int j = 0; j < 4; ++j) { acc[ai][bj][m][0][j] *= (1.f + eh[j]) * fast_rcp(1.f + fast_exp(8.f - b_[j] * (1.f / 16.f))); acc[ai][bj][m][1][j] *= (1.f + eh[4 + j]) * fast_rcp(1.f + fast_exp(8.f - b_[4 + j] * (1.f / 16.f))); }
                } else {
                    pg8::f32x4 v0 = acc[ai][bj][m][0], v1 = acc[ai][bj][m][1];
#pragma unroll
                    for (int j = 0; j < 4; ++j) { v0[j] *= fast_rcp(1.f + eh[j]); v1[j] *= fast_rcp(1.f + eh[4 + j]); }
                    v4u w; w.x = pk2(v0[0], v0[1]); w.y = pk2(v0[2], v0[3]); w.z = pk2(v1[0], v1[1]); w.w = pk2(v1[2], v1[3]);
                    pg8::st_wt16(Mo + r * D + c, w); } }
            gh[0] = ghn[0]; gh[1] = ghn[1]; gp[0] = gpn[0]; gp[1] = gpn[1]; }
#undef EM_U8
#undef EM_LOAD
    }
};
struct EpiRes {
    static constexpr bool PERM = true, AFTER_DRAIN = false;
    const float* X; const float* mod; bf16* O0; bf16* O1;
    __device__ __forceinline__ void operator()(pg8::f32x4 (&acc)[2][2][4][2], const Unit& u, int wr, int wc, int fr, int fq) const {
        const int row0 = u.pm * 256 + wr * 64 + fr, col0 = u.pn * 256 + wc * 32 + 8 * fq;
        const float* g1 = mod + (size_t)(u.pm >> 4) * 6144 + 2048;
        bf16* Ob = ((u.pn & 2) ? O1 : O0) + (u.pn & 1) * 256 + wc * 32 + 8 * fq;
        pg8::f32x4 gv[2][2];
#pragma unroll
        for (int bj = 0; bj < 2; ++bj)
#pragma unroll
            for (int n = 0; n < 2; ++n) gv[bj][n] = *(const GAS pg8::f32x4*)(g1 + col0 + bj * 128 + n * 4);
#pragma unroll
        for (int ai = 0; ai < 2; ++ai)
#pragma unroll
            for (int m = 0; m < 4; ++m) { const size_t row = (size_t)(row0 + ai * 128 + m * 16), off = row * D + col0;
#pragma unroll
                for (int bj = 0; bj < 2; ++bj) { const pg8::f32x4 x0 = *(const GAS pg8::f32x4*)(X + off + bj * 128), x1 = *(const GAS pg8::f32x4*)(X + off + bj * 128 + 4);
                    const pg8::f32x4 v0 = x0 + gv[bj][0] * acc[ai][bj][m][0], v1 = x1 + gv[bj][1] * acc[ai][bj][m][1];
                    v4u w; w.x = pk2(v0[0], v0[1]); w.y = pk2(v0[2], v0[3]); w.z = pk2(v1[0], v1[1]); w.w = pk2(v1[2], v1[3]);
                    pg8::st_wt16(Ob + row * 512 + bj * 128, w); }
                asm volatile("" ::: "memory"); }
    }
};

__device__ __forceinline__ unsigned off_b(unsigned row, unsigned ch) { return 256u * row + 16u * (ch ^ (((row & 3) << 2) | ((row >> 2) & 3))); }
__device__ __forceinline__ unsigned row_addr16(unsigned lane, unsigned rb, unsigned s) { return off_b((lane & 15) + 16 * rb, 4 * s + (lane >> 4)); }
__device__ __forceinline__ unsigned tr_addr16(unsigned lane, unsigned c, unsigned t) { const unsigned g = lane >> 4, q = (lane & 15) >> 2, p = lane & 3; return off_b(8 * g + 4 * t + q, 2 * c + (p >> 1)) + 8 * (p & 1); }
__device__ __forceinline__ bf16x8 tr_frag(LAS unsigned char* tile, unsigned lane, unsigned c) {
    const s16x4 lo = __builtin_amdgcn_ds_read_tr16_b64_v4i16((LAS s16x4*)(tile + tr_addr16(lane, c, 0)));
    const s16x4 hi = __builtin_amdgcn_ds_read_tr16_b64_v4i16((LAS s16x4*)(tile + tr_addr16(lane, c, 1)));
    return __builtin_shufflevector(lo, hi, 0, 1, 2, 3, 4, 5, 6, 7);
}
#define MFMA16(a, b, c) __builtin_amdgcn_mfma_f32_16x16x32_bf16((a), (b), (c), 0, 0, 0)

__device__ __forceinline__ v4u add_bf16x8(const v4u a, const v4u b) {
    v4u r; r.x = pk2(bflo(a.x) + bflo(b.x), bfhi(a.x) + bfhi(b.x)); r.y = pk2(bflo(a.y) + bflo(b.y), bfhi(a.y) + bfhi(b.y));
    r.z = pk2(bflo(a.z) + bflo(b.z), bfhi(a.z) + bfhi(b.z)); r.w = pk2(bflo(a.w) + bflo(b.w), bfhi(a.w) + bfhi(b.w)); return r; }
constexpr int S6_QT = 0, S6_KT = 16384, S6_KD = 32768, S6_VT = 49152, S6_ATT = 65536, S6_ATTSTR = 144, S6_EL = 65536 + 64 * 144, S6_WT = S6_EL + 512;
constexpr int CH6 = 64;
__device__ __forceinline__ void scan_unit(Frame& F, int u) {
    const int tid = F.tid, lane = F.lane, w = F.wave, q = lane >> 4;
    const bool isctx = u >= NSCAN_L;
    int b, h, dir, rowbase, nch; const bf16* src; int ld, cq, ci, cf;
    if (!isctx) { const int j = u & 7; dir = (u >> 3) & 1; h = (u >> 4) & 3; b = u >> 6; const int tb = dir ? 7 - j : j;
        rowbase = b * SEQ + tb * SEGT; nch = SEGT / CH6; src = (const bf16*)(F.ws + WS_Z); ld = ZLD; cq = 512 + h * 128; ci = 1024 + h * 128; cf = (dir ? 2048 : 1536) + h * 128; }
    else { const int v = u - NSCAN_L, cs = v & (NCSEG - 1); dir = (v >> 2) & 1; h = (v >> 3) & 3; b = v >> 5;
        rowbase = b * CTXL + (dir ? NCSEG - 1 - cs : cs) * (CTXL / NCSEG); nch = CTXL / NCSEG / CH6; src = (const bf16*)(F.ws + WS_ZC); ld = ZC_W; ci = h * 128; cq = ci; cf = (dir ? 1024 : 512) + h * 128; }
    const int t = tid >> 4, k8 = tid & 15;
    const int pl = dir ? 3 - q : q;
    const float* lbt = (const float*)(F.ws + WS_LBT) + dir * 512 + h * 128 + 8 * k8;
    float lb[8], om_[8], ecum[8];
#pragma unroll
    for (int i = 0; i < 8; ++i) { lb[i] = lbt[i]; om_[i] = 1.f - lbt[i]; ecum[i] = 1.f; }
    f32x4 S[8];
#pragma unroll
    for (int i = 0; i < 8; ++i) S[i] = (f32x4){0.f, 0.f, 0.f, 0.f};
    LAS unsigned char* L = F.lds;
    bf16* qseg = (bf16*)((unsigned char*)F.out + OUT_QSEG) + (size_t)dir * ML * 512;
    bf16* oloc = (bf16*)((unsigned char*)F.out + OUT_OLOC);
    v4u qv[2], vv[2], fv[2];
#define S6_LOAD(tc_) do { _Pragma("unroll") for (int r_ = 0; r_ < 2; ++r_) { const bf16* rp = src + (size_t)(rowbase + (tc_) * CH6 + 2 * t + r_) * ld + 8 * k8; \
        qv[r_] = *(const GAS v4u*)(rp + cq); vv[r_] = *(const GAS v4u*)(rp + ci); fv[r_] = *(const GAS v4u*)(rp + cf); \
        if (isctx) { const bf16* r2 = rp + (WS_ZC2 - WS_ZC) / 2; vv[r_] = add_bf16x8(vv[r_], *(const GAS v4u*)(r2 + ci)); fv[r_] = add_bf16x8(fv[r_], *(const GAS v4u*)(r2 + cf)); qv[r_] = vv[r_]; } } } while (0)
    S6_LOAD(dir ? nch - 1 : 0);
    for (int pc = 0; pc < nch; ++pc) {
        const int tc = dir ? nch - 1 - pc : pc;
        const v4u q0[2] = {qv[0], qv[1]}, v0[2] = {vv[0], vv[1]}, f0[2] = {fv[0], fv[1]};
        if (pc + 1 < nch) { S6_LOAD(dir ? tc - 1 : tc + 1); }
        float e[2][8], kk[2][8];
#pragma unroll
        for (int r = 0; r < 2; ++r) { const float fr_[8] = {bflo(f0[r].x), bfhi(f0[r].x), bflo(f0[r].y), bfhi(f0[r].y), bflo(f0[r].z), bfhi(f0[r].z), bflo(f0[r].w), bfhi(f0[r].w)};
#pragma unroll
            for (int i = 0; i < 8; ++i) { const float s = fast_rcp(1.f + fast_exp(-fr_[i])); e[r][i] = lb[i] + om_[i] * s; kk[r][i] = om_[i] - om_[i] * s; } }
        float pin[8], pex[8];
        { const int s1 = dir ? lane + 16 : lane - 16, s2 = dir ? lane + 32 : lane - 32;
#pragma unroll
          for (int i = 0; i < 8; ++i) pin[i] = e[0][i] * e[1][i];
#pragma unroll
          for (int i = 0; i < 8; ++i) { const float o = __shfl(pin[i], s1 & 63); pin[i] = (pl >= 1) ? pin[i] * o : pin[i]; }
#pragma unroll
          for (int i = 0; i < 8; ++i) { const float o = __shfl(pin[i], s2 & 63); pin[i] = (pl >= 2) ? pin[i] * o : pin[i]; }
#pragma unroll
          for (int i = 0; i < 8; ++i) { const float o = __shfl(pin[i], s1 & 63); pex[i] = (pl >= 1) ? o : 1.f; } }
        if (pl == 3) { LAS f32x4* wt = (LAS f32x4*)(L + S6_WT + (w * 128 + 8 * k8) * 4); wt[0] = (f32x4){pin[0], pin[1], pin[2], pin[3]}; wt[1] = (f32x4){pin[4], pin[5], pin[6], pin[7]}; }
        LBAR();
        float etot[8];
        { float pre[8], run[8];
#pragma unroll
          for (int i = 0; i < 8; ++i) { pre[i] = 1.f; run[i] = 1.f; }
#pragma unroll
          for (int sidx = 0; sidx < 8; ++sidx) { const int ww = dir ? 7 - sidx : sidx;
              const LAS f32x4* wt = (const LAS f32x4*)(L + S6_WT + (ww * 128 + 8 * k8) * 4); const f32x4 a = wt[0], c = wt[1];
              if (ww == w) {
#pragma unroll
                  for (int i = 0; i < 8; ++i) pre[i] = run[i]; }
              run[0] *= a.x; run[1] *= a.y; run[2] *= a.z; run[3] *= a.w; run[4] *= c.x; run[5] *= c.y; run[6] *= c.z; run[7] *= c.w; }
#pragma unroll
          for (int i = 0; i < 8; ++i) { etot[i] = run[i]; pex[i] *= pre[i]; } }
        {
#pragma unroll
            for (int r = 0; r < 2; ++r) {
                const float qf[8] = {bflo(q0[r].x), bfhi(q0[r].x), bflo(q0[r].y), bfhi(q0[r].y), bflo(q0[r].z), bfhi(q0[r].z), bflo(q0[r].w), bfhi(q0[r].w)};
                float qt[8], kt[8], kd[8];
#pragma unroll
                for (int i = 0; i < 8; ++i) { const float x0 = pex[i] * e[0][i], x1 = pex[i] * e[1][i], z = x0 * e[1][i];
                    const float E = (r == 0) ? (dir ? z : x0) : (dir ? x1 : z);
                    qt[i] = qf[i] * E; kt[i] = kk[r][i] * fast_rcp(E); kd[i] = kt[i] * etot[i]; }
                const unsigned tau = 2u * (unsigned)t + (unsigned)r;
                const unsigned ob = (tau >> 5) * 8192u + off_b(tau & 31u, (unsigned)k8);
                v4u o; o.x = pk2(qt[0], qt[1]); o.y = pk2(qt[2], qt[3]); o.z = pk2(qt[4], qt[5]); o.w = pk2(qt[6], qt[7]); *(LAS v4u*)(L + S6_QT + ob) = o;
                o.x = pk2(kt[0], kt[1]); o.y = pk2(kt[2], kt[3]); o.z = pk2(kt[4], kt[5]); o.w = pk2(kt[6], kt[7]); *(LAS v4u*)(L + S6_KT + ob) = o;
                o.x = pk2(kd[0], kd[1]); o.y = pk2(kd[2], kd[3]); o.z = pk2(kd[4], kd[5]); o.w = pk2(kd[6], kd[7]); *(LAS v4u*)(L + S6_KD + ob) = o;
                *(LAS v4u*)(L + S6_VT + ob) = v0[r];
                if (!isctx) { o.x = pk2(qt[0] * ecum[0], qt[1] * ecum[1]); o.y = pk2(qt[2] * ecum[2], qt[3] * ecum[3]); o.z = pk2(qt[4] * ecum[4], qt[5] * ecum[5]); o.w = pk2(qt[6] * ecum[6], qt[7] * ecum[7]);
                    pg8::st_wt16((void*)(qseg + (size_t)(rowbase + tc * CH6 + (int)tau) * 512 + h * 128 + 8 * k8), o); }
            }
            if (t == 0) { LAS f32x4* el = (LAS f32x4*)(L + S6_EL + 32 * k8); el[0] = (f32x4){etot[0], etot[1], etot[2], etot[3]}; el[1] = (f32x4){etot[4], etot[5], etot[6], etot[7]}; }
#pragma unroll
            for (int i = 0; i < 8; ++i) ecum[i] *= etot[i];
        }
        LBAR();
        if (!isctx) {
#pragma unroll 1
            for (int rep = 0; rep < 2; ++rep) {
                const int n = w + 8 * rep;
                if (n < 10) {
                    const int a_ = (n >= 6) ? 3 : (n >= 3) ? 2 : (n >= 1) ? 1 : 0, b_ = n - ((a_ * (a_ + 1)) >> 1);
                    const int tt = dir ? 3 - a_ : a_, st = dir ? 3 - b_ : b_;
                    f32x4 a = (f32x4){0.f, 0.f, 0.f, 0.f};
#pragma unroll
                    for (int s = 0; s < 4; ++s) { const bf16x8 A = *(const LAS bf16x8*)(L + S6_QT + (tt >> 1) * 8192 + row_addr16(lane, tt & 1, s)); const bf16x8 B = *(const LAS bf16x8*)(L + S6_KT + (st >> 1) * 8192 + row_addr16(lane, st & 1, s)); a = MFMA16(A, B, a); }
                    const int tr = tt * 16 + 4 * q, sc = st * 16 + (lane & 15);
#pragma unroll
                    for (int j = 0; j < 4; ++j) { const int ti = tr + j; const bool ok = dir ? (sc >= ti) : (sc <= ti);
                        *(LAS unsigned short*)(L + S6_ATT + ti * S6_ATTSTR + sc * 2) = (unsigned short)f2bf(ok ? a[j] : 0.f); }
                } else if (rep == 1 && (w == 2 || w == 3)) {
                    const int zt = dir ? (w == 2 ? 3 : 1) : (w == 2 ? 0 : 2), zs = dir ? (w == 2 ? 2 : 0) : (w == 2 ? 1 : 3);
                    const int tr = zt * 16 + 4 * q, sc = zs * 16 + (lane & 15);
#pragma unroll
                    for (int j = 0; j < 4; ++j) *(LAS unsigned short*)(L + S6_ATT + (tr + j) * S6_ATTSTR + sc * 2) = (unsigned short)0;
                }
            }
        }
        LBAR();
        {
            const bf16x8 Bv0 = tr_frag(L + S6_VT, lane, w), Bv1 = tr_frag(L + S6_VT + 8192, lane, w);
            if (!isctx) {
                v4u sb[4];
#pragma unroll
                for (int s = 0; s < 4; ++s) { sb[s].x = pk2(S[2 * s][0], S[2 * s][1]); sb[s].y = pk2(S[2 * s][2], S[2 * s][3]); sb[s].z = pk2(S[2 * s + 1][0], S[2 * s + 1][1]); sb[s].w = pk2(S[2 * s + 1][2], S[2 * s + 1][3]); }
#pragma unroll 1
                for (int tt = 0; tt < 4; ++tt) {
                    f32x4 o = (f32x4){0.f, 0.f, 0.f, 0.f};
                    const unsigned row = 16 * (tt & 1) + (lane & 15); LAS unsigned char* QI = L + S6_QT + (tt >> 1) * 8192;
#pragma unroll
                    for (int s = 0; s < 4; ++s) {
                        const v2u alo = *(const LAS v2u*)(QI + off_b(row, 4 * s + (q >> 1)) + 8 * (q & 1));
                        const v2u ahi = *(const LAS v2u*)(QI + off_b(row, 4 * s + 2 + (q >> 1)) + 8 * (q & 1));
                        const v4u av = (v4u){alo.x, alo.y, ahi.x, ahi.y};
                        o = MFMA16(__builtin_bit_cast(bf16x8, av), __builtin_bit_cast(bf16x8, sb[s]), o);
                    }
                    const LAS unsigned char* ar = L + S6_ATT + (16 * tt + (lane & 15)) * S6_ATTSTR + 16 * q;
                    if (dir ? (tt <= 1) : true) { const bf16x8 At = *(const LAS bf16x8*)(ar); o = MFMA16(At, Bv0, o); }
                    if (dir ? true : (tt >= 2)) { const bf16x8 At = *(const LAS bf16x8*)(ar + 64); o = MFMA16(At, Bv1, o); }
                    const int ttg = (rowbase + tc * CH6 + 16 * tt) >> 4;
                    v2u ov; ov.x = pk2(o[0], o[1]); ov.y = pk2(o[2], o[3]);
                    *(GAS v2u*)(oloc + ((((size_t)(dir * 1024 + ttg) * 4 + h) * 8 + w) * 64 + lane) * 4) = ov;
                }
            }
#pragma unroll
            for (int kt = 0; kt < 8; ++kt) {
                const bf16x8 A0 = tr_frag(L + S6_KD, lane, kt), A1 = tr_frag(L + S6_KD + 8192, lane, kt);
                const f32x4 a4 = *(const LAS f32x4*)(L + S6_EL + (16 * kt + 4 * q) * 4);
                S[kt] = MFMA16(A1, Bv1, MFMA16(A0, Bv0, S[kt] * a4));
            }
        }
    }
#undef S6_LOAD
    { float* us = (float*)(F.ws + WS_USEG) + (size_t)u * 128 * 128 + (4 * q) * 128 + 16 * w + (lane & 15);
#pragma unroll
      for (int kt = 0; kt < 8; ++kt) {
#pragma unroll
          for (int j = 0; j < 4; ++j) us[j * 128] = S[kt][j];
          us += 16 * 128; asm volatile("" : "+v"(us)); }
      if (t == 0) { float* as = (float*)(F.ws + WS_ASEG) + (size_t)u * 128 + 8 * k8;
#pragma unroll
          for (int i = 0; i < 8; ++i) as[i] = ecum[i]; } }
    __syncthreads();
}


constexpr int PL_VSTR = 132, PL_VBYTES = 64 * PL_VSTR * 4;
#define PL_LOAD8(ra, rd, g_, r0b_, rhi_) do { _Pragma("unroll") for (int u8 = 0; u8 < 8; ++u8) { const int rr_ = min((r0b_) + u8, (rhi_)); \
    const bf16* p_ = Z + (size_t)(b * SEQ + rr_ * 64 + c) * ZLD + (g_) * 128 + 16 * ch16; ra[u8] = *(const GAS v4u*)p_; rd[u8] = *(const GAS v4u*)(p_ + 8); } } while (0)
#define PL_CONSUME8(ra, rd, r0b_, rhi_) do { _Pragma("unroll") for (int u8 = 0; u8 < 8; ++u8) { const int rr_ = (r0b_) + u8; if (rr_ <= (rhi_)) { const v4u a_ = ra[u8], d_ = rd[u8]; \
    const float x_[16] = {bflo(a_.x), bfhi(a_.x), bflo(a_.y), bfhi(a_.y), bflo(a_.z), bfhi(a_.z), bflo(a_.w), bfhi(a_.w), bflo(d_.x), bfhi(d_.x), bflo(d_.y), bfhi(d_.y), bflo(d_.z), bfhi(d_.z), bflo(d_.w), bfhi(d_.w)}; \
    _Pragma("unroll") for (int i_ = 0; i_ < 16; ++i_) vs[i_] += x_[i_]; \
    if (rr_ == r) { _Pragma("unroll") for (int i_ = 0; i_ < 16; ++i_) pc[i_] = x_[i_]; } } } } while (0)
__device__ __forceinline__ void pool_unit(Frame& F, int u) {
    const int b = u >> 6, r = u & 63, tid = F.tid;
    const int c = tid >> 3, ch16 = tid & 7;
    const bf16* Z = (const bf16*)(F.ws + WS_Z); bf16* YP = (bf16*)(F.ws + WS_YPOOL);
    v4u ra[8], rd[8];
    PL_LOAD8(ra, rd, 0, max(0, r - 1), r);
#pragma unroll 1
    for (int g = 0; g < 4; ++g) {
        LAS unsigned char* L = F.lds + (g & 1) * PL_VBYTES;
        const int half = 1 << g;
        const int r_lo = max(0, r - half), r_hi = min(63, r + half - 1), c_lo = max(0, c - half), c_hi = min(63, c + half - 1);
        float vs[16], pc[16];
#pragma unroll
        for (int i = 0; i < 16; ++i) { vs[i] = 0.f; pc[i] = 0.f; }
        PL_CONSUME8(ra, rd, r_lo, r_hi);
        if (g == 3) { PL_LOAD8(ra, rd, 3, r_lo + 8, r_hi); PL_CONSUME8(ra, rd, r_lo + 8, r_hi); }
        else { const int h2 = 2 * half; PL_LOAD8(ra, rd, g + 1, max(0, r - h2), min(63, r + h2 - 1)); }
        { LAS f32x4* vp = (LAS f32x4*)(L + (c * PL_VSTR + 16 * ch16) * 4);
#pragma unroll
          for (int i = 0; i < 4; ++i) vp[i] = (f32x4){vs[4 * i], vs[4 * i + 1], vs[4 * i + 2], vs[4 * i + 3]}; }
        LBAR();
        float hs[16];
#pragma unroll
        for (int i = 0; i < 16; ++i) hs[i] = 0.f;
        for (int cc = c_lo; cc <= c_hi; ++cc) { const LAS f32x4* vp = (const LAS f32x4*)(L + (cc * PL_VSTR + 16 * ch16) * 4);
#pragma unroll
            for (int i = 0; i < 4; ++i) { const f32x4 x = vp[i]; hs[4 * i] += x.x; hs[4 * i + 1] += x.y; hs[4 * i + 2] += x.z; hs[4 * i + 3] += x.w; } }
        { const float inv = 1.f / (float)((r_hi - r_lo + 1) * (c_hi - c_lo + 1));
          v4u o0, o1;
          o0.x = pk2(hs[0] * inv - pc[0], hs[1] * inv - pc[1]); o0.y = pk2(hs[2] * inv - pc[2], hs[3] * inv - pc[3]); o0.z = pk2(hs[4] * inv - pc[4], hs[5] * inv - pc[5]); o0.w = pk2(hs[6] * inv - pc[6], hs[7] * inv - pc[7]);
          o1.x = pk2(hs[8] * inv - pc[8], hs[9] * inv - pc[9]); o1.y = pk2(hs[10] * inv - pc[10], hs[11] * inv - pc[11]); o1.z = pk2(hs[12] * inv - pc[12], hs[13] * inv - pc[13]); o1.w = pk2(hs[14] * inv - pc[14], hs[15] * inv - pc[15]);
          GAS v4u* dp = (GAS v4u*)(YP + (size_t)(b * SEQ + r * 64 + c) * 512 + g * 128 + 16 * ch16); pg8::st_wt16((void*)dp, o0); pg8::st_wt16((void*)(dp + 1), o1); }
    }
    __syncthreads();
}

constexpr int FX_SF = 0, FX_SB = 32768, FX_SCR = 65536, FX_SCRSTR = 132;
__device__ __forceinline__ void prefix_unit(Frame& F, int u) {
    const int chain = u >> 3, rb = u & 7, tid = F.tid, k = 16 * rb + (tid >> 5), v = 4 * (tid & 31);
    const float* US = (const float*)(F.ws + WS_USEG); const float* AS = (const float*)(F.ws + WS_ASEG);
    unsigned char* P = F.ws + WS_PFX + (size_t)chain * 8 * 32768;
    constexpr int NU = NCSEG + 7;
    f32x4 uu[NU]; float aa[NU];
#pragma unroll
    for (int i = 0; i < NU; ++i) { const int un = (i < NCSEG) ? NSCAN_L + chain * NCSEG + i : chain * 8 + (i - NCSEG);
        uu[i] = *(const GAS f32x4*)(US + ((size_t)un * 128 + k) * 128 + v); aa[i] = AS[un * 128 + k]; }
    f32x4 s = uu[0];
#pragma unroll
    for (int i = 1; i < NCSEG; ++i) s = s * aa[i] + uu[i];
    const unsigned ob = (unsigned)(k >> 5) * 8192u + off_b((unsigned)(k & 31), (unsigned)(v >> 3)) + (unsigned)(v & 7) * 2u;
#pragma unroll
    for (int j = 0; j < 8; ++j) {
        v2u o; o.x = pk2(s.x, s.y); o.y = pk2(s.z, s.w);
        *(GAS v2u*)(P + (size_t)j * 32768 + ob) = o;
        if (j < 7) s = s * aa[NCSEG + j] + uu[NCSEG + j];
    }
}
__device__ __forceinline__ void fix_load_state(Frame& F, int chain, int seg, int soff) {
    const GAS v4u* src = (const GAS v4u*)(F.ws + WS_PFX + ((size_t)chain * 8 + seg) * 32768) + F.tid;
#pragma unroll
    for (int i = 0; i < 4; ++i) *(LAS v4u*)(F.lds + soff + (F.tid + 512 * i) * 16) = src[512 * i];
}
__device__ __forceinline__ void fix_unit(Frame& F, int b, int h, int tb, int half) {
    const int lane = F.lane, w = F.wave, q = lane >> 4;
    LAS unsigned char* L = F.lds;
    fix_load_state(F, (b * 4 + h) * 2 + 0, tb, FX_SF);
    fix_load_state(F, (b * 4 + h) * 2 + 1, 7 - tb, FX_SB);
    __syncthreads();
    const bf16* Z = (const bf16*)(F.ws + WS_Z); bf16* YH = (bf16*)(F.ws + WS_YHG);
    const bf16* qseg = (const bf16*)((const unsigned char*)F.out + OUT_QSEG); const bf16* oloc = (const bf16*)((const unsigned char*)F.out + OUT_OLOC);
    LAS float* scr = (LAS float*)(L + FX_SCR + w * (16 * FX_SCRSTR * 4));
    const int row0 = b * SEQ + tb * SEGT;
#pragma unroll 1
    for (int ti = 0; ti < 2; ++ti) {
        const int tt = 16 * half + 2 * w + ti, rowt = row0 + 16 * tt;
        f32x4 acc[8];
#pragma unroll
        for (int c = 0; c < 8; ++c) acc[c] = (f32x4){0.f, 0.f, 0.f, 0.f};
        bf16x8 A[2][4]; v2u ol[2][8]; v4u ogv[4];
        const int tl = lane >> 2, v0 = 8 * (lane & 3);
#pragma unroll
        for (int dir = 0; dir < 2; ++dir)
#pragma unroll
            for (int s = 0; s < 4; ++s) A[dir][s] = *(const GAS bf16x8*)(qseg + ((size_t)dir * ML + rowt + (lane & 15)) * 512 + h * 128 + 32 * s + 8 * q);
#pragma unroll
        for (int dir = 0; dir < 2; ++dir)
#pragma unroll
            for (int c = 0; c < 8; ++c) ol[dir][c] = *(const GAS v2u*)(oloc + ((((size_t)(dir * 1024 + (rowt >> 4)) * 4 + h) * 8 + c) * 64 + lane) * 4);
#pragma unroll
        for (int i = 0; i < 4; ++i) ogv[i] = *(const GAS v4u*)(Z + (size_t)(rowt + tl) * ZLD + 2560 + h * 128 + v0 + 32 * i);
#pragma unroll
        for (int dir = 0; dir < 2; ++dir) {
#pragma unroll
            for (int s = 0; s < 4; ++s)
#pragma unroll
                for (int c = 0; c < 8; ++c) { const bf16x8 B = tr_frag(L + (dir ? FX_SB : FX_SF) + s * 8192, lane, c); acc[c] = MFMA16(A[dir][s], B, acc[c]); }
        }
#pragma unroll
        for (int dir = 0; dir < 2; ++dir)
#pragma unroll
            for (int c = 0; c < 8; ++c) { const v2u ov = ol[dir][c];
                acc[c][0] += bflo(ov.x); acc[c][1] += bfhi(ov.x); acc[c][2] += bflo(ov.y); acc[c][3] += bfhi(ov.y); }
        float ss[4];
#pragma unroll
        for (int j = 0; j < 4; ++j) { float s = 0.f;
#pragma unroll
            for (int c = 0; c < 8; ++c) s += acc[c][j] * acc[c][j];
            s += WDPP_(s, 0xb1); s += WDPP_(s, 0x4e); s += WDPP_(s, 0x141); s += WDPP_(s, 0x140);
            ss[j] = 1.f / sqrtf(s * (1.f / 128.f) + EPS); }
#pragma unroll
        for (int c = 0; c < 8; ++c)
#pragma unroll
            for (int j = 0; j < 4; ++j) scr[(4 * q + j) * FX_SCRSTR + 16 * c + (lane & 15)] = acc[c][j] * ss[j];
        LDS_WAIT();
        { const size_t row = (size_t)(rowt + tl);
          bf16* yo = YH + row * 512 + h * 128 + v0;
#pragma unroll
          for (int i = 0; i < 4; ++i) {
              const f32x4 a = *(const LAS f32x4*)(scr + tl * FX_SCRSTR + v0 + 32 * i), c2 = *(const LAS f32x4*)(scr + tl * FX_SCRSTR + v0 + 32 * i + 4);
              const v4u g = ogv[i];
              const f32x4 n0 = *(const GAS f32x4*)(F.hg_norm_g + v0 + 32 * i), n1 = *(const GAS f32x4*)(F.hg_norm_g + v0 + 32 * i + 4);
              const float gg[8] = {bflo(g.x), bfhi(g.x), bflo(g.y), bfhi(g.y), bflo(g.z), bfhi(g.z), bflo(g.w), bfhi(g.w)};
              const float yv[8] = {a.x * n0.x, a.y * n0.y, a.z * n0.z, a.w * n0.w, c2.x * n1.x, c2.y * n1.y, c2.z * n1.z, c2.w * n1.w};
              float o[8];
#pragma unroll
              for (int e = 0; e < 8; ++e) o[e] = yv[e] * gg[e] * sigmoidf_(gg[e]);
              v4u ov; ov.x = pk2(o[0], o[1]); ov.y = pk2(o[2], o[3]); ov.z = pk2(o[4], o[5]); ov.w = pk2(o[6], o[7]);
              pg8::st_wt16(yo + 32 * i, ov); } }
        LDS_WAIT();
    }
    __syncthreads();
}


__device__ __forceinline__ void i8_rows(const float* src, unsigned char* dst, float* inv_scale, int gw, int NGW, int lane, unsigned bias, int rend = NEXP) {
    for (int r = gw; r < rend; r += NGW) {
        const GAS f32x4* p = (const GAS f32x4*)(src + (size_t)r * D + 16 * lane);
        const f32x4 a = p[0], b = p[1], c = p[2], d = p[3];
        float m = fmaxf(fmaxf(fmaxf(fabsf(a.x), fabsf(a.y)), fmaxf(fabsf(a.z), fabsf(a.w))), fmaxf(fmaxf(fabsf(b.x), fabsf(b.y)), fmaxf(fabsf(b.z), fabsf(b.w))));
        m = fmaxf(m, fmaxf(fmaxf(fmaxf(fabsf(c.x), fabsf(c.y)), fmaxf(fabsf(c.z), fabsf(c.w))), fmaxf(fmaxf(fabsf(d.x), fabsf(d.y)), fmaxf(fabsf(d.z), fabsf(d.w)))));
        m = wave_max(m);
        const float sc = (m > 0.f) ? 127.f / m : 1.f;
        v4u o; o.x = pack_i8x4(a.x * sc, a.y * sc, a.z * sc, a.w * sc); o.y = pack_i8x4(b.x * sc, b.y * sc, b.z * sc, b.w * sc);
        o.z = pack_i8x4(c.x * sc, c.y * sc, c.z * sc, c.w * sc); o.w = pack_i8x4(d.x * sc, d.y * sc, d.z * sc, d.w * sc);
        o.x ^= bias; o.y ^= bias; o.z ^= bias; o.w ^= bias;
        *(GAS v4u*)(dst + (size_t)(lane >> 3) * ((size_t)NEXP * 128) + (size_t)r * 128 + 16 * (lane & 7)) = o;
        if (lane == 0) inv_scale[r] = (m > 0.f) ? m * (1.f / 127.f) : 1.f;
    }
}
__device__ __forceinline__ void i4_rows(const float* src, unsigned char* dst, float* inv_scale, int gw, int NGW, int lane, const bool vtab) {
    for (int r0 = gw; r0 < NEXP; r0 += 4 * NGW) {
        f32x4 x[4][4]; float s2[4];
#pragma unroll
        for (int k = 0; k < 4; ++k) { const int r = (r0 + k * NGW < NEXP) ? r0 + k * NGW : r0; const GAS f32x4* p = (const GAS f32x4*)(src + (size_t)r * D + 16 * lane);
            x[k][0] = p[0]; x[k][1] = p[1]; x[k][2] = p[2]; x[k][3] = p[3]; }
#pragma unroll
        for (int k = 0; k < 4; ++k) { float t = 0.f;
#pragma unroll
            for (int i = 0; i < 4; ++i) t += (x[k][i].x * x[k][i].x + x[k][i].y * x[k][i].y) + (x[k][i].z * x[k][i].z + x[k][i].w * x[k][i].w);
            s2[k] = t; }
        s2[0] = wave_sum(s2[0]); s2[1] = wave_sum(s2[1]); s2[2] = wave_sum(s2[2]); s2[3] = wave_sum(s2[3]);
#pragma unroll
        for (int k = 0; k < 4; ++k) { const int r = r0 + k * NGW; if (r < NEXP) {
            const f32x4 a = x[k][0], b = x[k][1], c = x[k][2], d = x[k][3];
            const float step = 0.3352f * sqrtf(s2[k] * (1.f / D)), is = (step > 0.f) ? 1.f / step : 0.f;
#define Q4_(x) ((unsigned)(int)fminf(fmaxf(floorf((x) * is), -8.f), 7.f))
#define Q4B_(h, l) (((Q4_(h) & 15u) << 4) | ((Q4_(l) + 8u) & 15u))
#define Q4N_(lo, hi) ((Q4_(lo) & 15u) | ((Q4_(hi) & 15u) << 4))
            v2u o;
            if (vtab) { o.x = Q4B_(a.x, a.y) | (Q4B_(a.z, a.w) << 8) | (Q4B_(b.x, b.y) << 16) | (Q4B_(b.z, b.w) << 24); o.y = Q4B_(c.x, c.y) | (Q4B_(c.z, c.w) << 8) | (Q4B_(d.x, d.y) << 16) | (Q4B_(d.z, d.w) << 24); }
            else      { o.x = Q4N_(a.x, a.y) | (Q4N_(a.z, a.w) << 8) | (Q4N_(b.x, b.y) << 16) | (Q4N_(b.z, b.w) << 24); o.y = Q4N_(c.x, c.y) | (Q4N_(c.z, c.w) << 8) | (Q4N_(d.x, d.y) << 16) | (Q4N_(d.z, d.w) << 24); }
#undef Q4N_
#undef Q4B_
#undef Q4_
            *(GAS v2u*)(dst + (size_t)(lane >> 4) * ((size_t)NEXP * 128) + (size_t)r * 128 + 8 * (lane & 15)) = o;
            if (lane == 0) inv_scale[r] = step; } }
    }
}
__device__ __forceinline__ void mrq_load(const bf16* xlo, const bf16* xhi, int lane, v2u (&xw)[4]) {
    const GAS v2u* xr0 = (const GAS v2u*)xlo + lane; const GAS v2u* xr1 = (const GAS v2u*)xhi + lane;
    xw[0] = xr0[0]; xw[1] = xr0[64]; xw[2] = xr1[0]; xw[3] = xr1[64];
}
__device__ __forceinline__ void mrq_finish(const v2u (&xw)[4], unsigned char* orow, unsigned char* qrow, float* qscale, float* qsum, const f32x4 (&gm)[4], const f32x4 (&shv)[4], int lane) {
    f32x4 v[4]; float s2 = 0.f;
#pragma unroll
    for (int j = 0; j < 4; ++j) { v[j] = (f32x4){bflo(xw[j].x), bfhi(xw[j].x), bflo(xw[j].y), bfhi(xw[j].y)}; s2 += (v[j].x * v[j].x + v[j].y * v[j].y) + (v[j].z * v[j].z + v[j].w * v[j].w); }
    const float rstd = 1.f / sqrtf(wave_sum(s2) * (1.f / D) + EPS);
    float m = 0.f;
#pragma unroll
    for (int j = 0; j < 4; ++j) {
        v[j] = (v[j] * rstd) * gm[j] + shv[j];
        m = fmaxf(m, fmaxf(fmaxf(fabsf(v[j].x), fabsf(v[j].y)), fmaxf(fabsf(v[j].z), fabsf(v[j].w)))); }
    m = wave_max(m);
    { const float q8 = (m > 0.f) ? 127.f / m : 1.f;
#pragma unroll
      for (int j = 0; j < 4; ++j) ((GAS unsigned*)orow)[lane + 64 * j] = pack_i8x4(v[j].x * q8, v[j].y * q8, v[j].z * q8, v[j].w * q8); }
    const float qs = (m > 0.f) ? 119.f / m : 1.f;
    int hs = 0;
#pragma unroll
    for (int j = 0; j < 4; ++j) {
        const int q_[4] = {(int)rintf(v[j].x * qs), (int)rintf(v[j].y * qs), (int)rintf(v[j].z * qs), (int)rintf(v[j].w * qs)};
        unsigned A16 = 0u, B16 = 0u;
#pragma unroll
        for (int k = 0; k < 4; ++k) { const int b_ = ((q_[k] + 8) & 15) - 8, a_ = (q_[k] - b_) >> 4; A16 |= ((unsigned)a_ & 15u) << (4 * k); B16 |= ((unsigned)b_ & 15u) << (4 * k); hs += q_[k]; }
        const unsigned nA = (unsigned)__builtin_amdgcn_mov_dpp((int)A16, 0xb1, 0xf, 0xf, true), nB = (unsigned)__builtin_amdgcn_mov_dpp((int)B16, 0xb1, 0xf, 0xf, true);
        const unsigned dw = (lane & 1) ? (nB | (B16 << 16)) : (A16 | (nA << 16));
        *(GAS unsigned*)(qrow + j * 256 + (lane >> 3) * 32 + (lane & 1) * 16 + ((lane & 7) >> 1) * 4) = dw; }
    const float hsum = wave_sum((float)hs);
    if (lane == 0) { *qscale = (m > 0.f) ? m * (1.f / 119.f) : 1.f; *qsum = hsum; qscale[2 * ML] = (m > 0.f) ? m * (1.f / 127.f) : 1.f; }
}

#define SORT16_DESC(v) do { float hi_, lo_; \
    hi_ = fmaxf(v[0], v[1]); lo_ = fminf(v[0], v[1]); v[0] = hi_; v[1] = lo_; \
    hi_ = fmaxf(v[2], v[3]); lo_ = fminf(v[2], v[3]); v[2] = hi_; v[3] = lo_; \
    hi_ = fmaxf(v[0], v[2]); lo_ = fminf(v[0], v[2]); v[0] = hi_; v[2] = lo_; \
    hi_ = fmaxf(v[1], v[3]); lo_ = fminf(v[1], v[3]); v[1] = hi_; v[3] = lo_; \
    hi_ = fmaxf(v[1], v[2]); lo_ = fminf(v[1], v[2]); v[1] = hi_; v[2] = lo_; \
    hi_ = fmaxf(v[4], v[5]); lo_ = fminf(v[4], v[5]); v[4] = hi_; v[5] = lo_; \
    hi_ = fmaxf(v[6], v[7]); lo_ = fminf(v[6], v[7]); v[6] = hi_; v[7] = lo_; \
    hi_ = fmaxf(v[4], v[6]); lo_ = fminf(v[4], v[6]); v[4] = hi_; v[6] = lo_; \
    hi_ = fmaxf(v[5], v[7]); lo_ = fminf(v[5], v[7]); v[5] = hi_; v[7] = lo_; \
    hi_ = fmaxf(v[5], v[6]); lo_ = fminf(v[5], v[6]); v[5] = hi_; v[6] = lo_; \
    hi_ = fmaxf(v[0], v[4]); lo_ = fminf(v[0], v[4]); v[0] = hi_; v[4] = lo_; \
    hi_ = fmaxf(v[2], v[6]); lo_ = fminf(v[2], v[6]); v[2] = hi_; v[6] = lo_; \
    hi_ = fmaxf(v[2], v[4]); lo_ = fminf(v[2], v[4]); v[2] = hi_; v[4] = lo_; \
    hi_ = fmaxf(v[1], v[5]); lo_ = fminf(v[1], v[5]); v[1] = hi_; v[5] = lo_; \
    hi_ = fmaxf(v[3], v[7]); lo_ = fminf(v[3], v[7]); v[3] = hi_; v[7] = lo_; \
    hi_ = fmaxf(v[3], v[5]); lo_ = fminf(v[3], v[5]); v[3] = hi_; v[5] = lo_; \
    hi_ = fmaxf(v[1], v[2]); lo_ = fminf(v[1], v[2]); v[1] = hi_; v[2] = lo_; \
    hi_ = fmaxf(v[3], v[4]); lo_ = fminf(v[3], v[4]); v[3] = hi_; v[4] = lo_; \
    hi_ = fmaxf(v[5], v[6]); lo_ = fminf(v[5], v[6]); v[5] = hi_; v[6] = lo_; \
    hi_ = fmaxf(v[8], v[9]); lo_ = fminf(v[8], v[9]); v[8] = hi_; v[9] = lo_; \
    hi_ = fmaxf(v[10], v[11]); lo_ = fminf(v[10], v[11]); v[10] = hi_; v[11] = lo_; \
    hi_ = fmaxf(v[8], v[10]); lo_ = fminf(v[8], v[10]); v[8] = hi_; v[10] = lo_; \
    hi_ = fmaxf(v[9], v[11]); lo_ = fminf(v[9], v[11]); v[9] = hi_; v[11] = lo_; \
    hi_ = fmaxf(v[9], v[10]); lo_ = fminf(v[9], v[10]); v[9] = hi_; v[10] = lo_; \
    hi_ = fmaxf(v[12], v[13]); lo_ = fminf(v[12], v[13]); v[12] = hi_; v[13] = lo_; \
    hi_ = fmaxf(v[14], v[15]); lo_ = fminf(v[14], v[15]); v[14] = hi_; v[15] = lo_; \
    hi_ = fmaxf(v[12], v[14]); lo_ = fminf(v[12], v[14]); v[12] = hi_; v[14] = lo_; \
    hi_ = fmaxf(v[13], v[15]); lo_ = fminf(v[13], v[15]); v[13] = hi_; v[15] = lo_; \
    hi_ = fmaxf(v[13], v[14]); lo_ = fminf(v[13], v[14]); v[13] = hi_; v[14] = lo_; \
    hi_ = fmaxf(v[8], v[12]); lo_ = fminf(v[8], v[12]); v[8] = hi_; v[12] = lo_; \
    hi_ = fmaxf(v[10], v[14]); lo_ = fminf(v[10], v[14]); v[10] = hi_; v[14] = lo_; \
    hi_ = fmaxf(v[10], v[12]); lo_ = fminf(v[10], v[12]); v[10] = hi_; v[12] = lo_; \
    hi_ = fmaxf(v[9], v[13]); lo_ = fminf(v[9], v[13]); v[9] = hi_; v[13] = lo_; \
    hi_ = fmaxf(v[11], v[15]); lo_ = fminf(v[11], v[15]); v[11] = hi_; v[15] = lo_; \
    hi_ = fmaxf(v[11], v[13]); lo_ = fminf(v[11], v[13]); v[11] = hi_; v[13] = lo_; \
    hi_ = fmaxf(v[9], v[10]); lo_ = fminf(v[9], v[10]); v[9] = hi_; v[10] = lo_; \
    hi_ = fmaxf(v[11], v[12]); lo_ = fminf(v[11], v[12]); v[11] = hi_; v[12] = lo_; \
    hi_ = fmaxf(v[13], v[14]); lo_ = fminf(v[13], v[14]); v[13] = hi_; v[14] = lo_; \
    hi_ = fmaxf(v[0], v[8]); lo_ = fminf(v[0], v[8]); v[0] = hi_; v[8] = lo_; \
    hi_ = fmaxf(v[4], v[12]); lo_ = fminf(v[4], v[12]); v[4] = hi_; v[12] = lo_; \
    hi_ = fmaxf(v[4], v[8]); lo_ = fminf(v[4], v[8]); v[4] = hi_; v[8] = lo_; \
    hi_ = fmaxf(v[2], v[10]); lo_ = fminf(v[2], v[10]); v[2] = hi_; v[10] = lo_; \
    hi_ = fmaxf(v[6], v[14]); lo_ = fminf(v[6], v[14]); v[6] = hi_; v[14] = lo_; \
    hi_ = fmaxf(v[6], v[10]); lo_ = fminf(v[6], v[10]); v[6] = hi_; v[10] = lo_; \
    hi_ = fmaxf(v[2], v[4]); lo_ = fminf(v[2], v[4]); v[2] = hi_; v[4] = lo_; \
    hi_ = fmaxf(v[6], v[8]); lo_ = fminf(v[6], v[8]); v[6] = hi_; v[8] = lo_; \
    hi_ = fmaxf(v[10], v[12]); lo_ = fminf(v[10], v[12]); v[10] = hi_; v[12] = lo_; \
    hi_ = fmaxf(v[1], v[9]); lo_ = fminf(v[1], v[9]); v[1] = hi_; v[9] = lo_; \
    hi_ = fmaxf(v[5], v[13]); lo_ = fminf(v[5], v[13]); v[5] = hi_; v[13] = lo_; \
    hi_ = fmaxf(v[5], v[9]); lo_ = fminf(v[5], v[9]); v[5] = hi_; v[9] = lo_; \
    hi_ = fmaxf(v[3], v[11]); lo_ = fminf(v[3], v[11]); v[3] = hi_; v[11] = lo_; \
    hi_ = fmaxf(v[7], v[15]); lo_ = fminf(v[7], v[15]); v[7] = hi_; v[15] = lo_; \
    hi_ = fmaxf(v[7], v[11]); lo_ = fminf(v[7], v[11]); v[7] = hi_; v[11] = lo_; \
    hi_ = fmaxf(v[3], v[5]); lo_ = fminf(v[3], v[5]); v[3] = hi_; v[5] = lo_; \
    hi_ = fmaxf(v[7], v[9]); lo_ = fminf(v[7], v[9]); v[7] = hi_; v[9] = lo_; \
    hi_ = fmaxf(v[11], v[13]); lo_ = fminf(v[11], v[13]); v[11] = hi_; v[13] = lo_; \
    hi_ = fmaxf(v[1], v[2]); lo_ = fminf(v[1], v[2]); v[1] = hi_; v[2] = lo_; \
    hi_ = fmaxf(v[3], v[4]); lo_ = fminf(v[3], v[4]); v[3] = hi_; v[4] = lo_; \
    hi_ = fmaxf(v[5], v[6]); lo_ = fminf(v[5], v[6]); v[5] = hi_; v[6] = lo_; \
    hi_ = fmaxf(v[7], v[8]); lo_ = fminf(v[7], v[8]); v[7] = hi_; v[8] = lo_; \
    hi_ = fmaxf(v[9], v[10]); lo_ = fminf(v[9], v[10]); v[9] = hi_; v[10] = lo_; \
    hi_ = fmaxf(v[11], v[12]); lo_ = fminf(v[11], v[12]); v[11] = hi_; v[12] = lo_; \
    hi_ = fmaxf(v[13], v[14]); lo_ = fminf(v[13], v[14]); v[13] = hi_; v[14] = lo_; \
    } while (0)
#define MERGE16_TOP(a, b) do { _Pragma("unroll") for (int i_ = 0; i_ < 16; ++i_) a[i_] = fmaxf(a[i_], b[15 - i_]); \
    _Pragma("unroll") for (int j_ = 8; j_ > 0; j_ >>= 1) _Pragma("unroll") for (int i_ = 0; i_ < 16; ++i_) { const int l_ = i_ ^ j_; \
    if (l_ > i_) { const float hi_ = fmaxf(a[i_], a[l_]), lo_ = fminf(a[i_], a[l_]); a[i_] = hi_; a[l_] = lo_; } } } while (0)
constexpr int TK_S = 0, TK_SSTR = 136, TK_L = 139264;
__device__ __forceinline__ void topk_select(LAS unsigned char* L, int tid, size_t tok_base, int h, unsigned short* eidx, float* gate) {
    {
        const int row = tid >> 1, hf = tid & 1;
        float a[16];
        const LAS f32x4* sp = (const LAS f32x4*)((LAS float*)(L + TK_S) + row * TK_SSTR) + hf;
#pragma unroll
        for (int blk = 0; blk < 4; ++blk) {
            float v[16];
#pragma unroll
            for (int c4 = 0; c4 < 4; ++c4) { const int i = 4 * blk + c4; const f32x4 x4 = sp[2 * i]; const float ve[4] = {x4.x, x4.y, x4.z, x4.w};
#pragma unroll
                for (int e = 0; e < 4; ++e) v[4 * c4 + e] = __builtin_bit_cast(float, (__builtin_bit_cast(unsigned, ve[e]) & ~127u) | (unsigned)(8 * i + 4 * hf + e)); }
            SORT16_DESC(v);
            if (blk == 0) {
#pragma unroll
                for (int j = 0; j < 16; ++j) a[j] = v[j];
            } else { MERGE16_TOP(a, v); }
        }
        { float pb[16];
#pragma unroll
          for (int j = 0; j < 16; ++j) pb[j] = WDPP_(a[j], 0xb1);
          MERGE16_TOP(a, pb); }
        if (hf == 0) { LAS v4u* tp = (LAS v4u*)(L + TK_L + row * 64);
#pragma unroll
            for (int i = 0; i < 4; ++i) tp[i] = (v4u){__builtin_bit_cast(unsigned, a[4 * i]), __builtin_bit_cast(unsigned, a[4 * i + 1]), __builtin_bit_cast(unsigned, a[4 * i + 2]), __builtin_bit_cast(unsigned, a[4 * i + 3])}; }
    }
    LBAR();
    if (tid < 128) {
        const int t = tid, r0 = t, r1 = 128 + t;
        const LAS unsigned* t0 = (const LAS unsigned*)(L + TK_L + r0 * 64); const LAS unsigned* t1 = (const LAS unsigned*)(L + TK_L + r1 * 64);
        float v1[16], v2[16];
#pragma unroll
        for (int i = 0; i < 4; ++i) { const v4u x = ((const LAS v4u*)t0)[i], y = ((const LAS v4u*)t1)[i];
            v1[4 * i] = __builtin_bit_cast(float, x.x & ~127u); v1[4 * i + 1] = __builtin_bit_cast(float, x.y & ~127u); v1[4 * i + 2] = __builtin_bit_cast(float, x.z & ~127u); v1[4 * i + 3] = __builtin_bit_cast(float, x.w & ~127u);
            v2[4 * i] = __builtin_bit_cast(float, y.x & ~127u); v2[4 * i + 1] = __builtin_bit_cast(float, y.y & ~127u); v2[4 * i + 2] = __builtin_bit_cast(float, y.z & ~127u); v2[4 * i + 3] = __builtin_bit_cast(float, y.w & ~127u); }
        float c[16];
#pragma unroll
        for (int blk = 0; blk < 4; ++blk) {
            float v[16];
#pragma unroll
            for (int j = 0; j < 16; ++j) v[j] = -3.0e38f;
            { int n = 0, slot = 0;
#pragma unroll
              for (int ia = 0; ia < 16; ++ia)
#pragma unroll
                  for (int ib = 0; ib < 16; ++ib) if ((ia + 1) * (ib + 1) <= 16) { if ((n >> 4) == blk) { v[slot] = __builtin_bit_cast(float, (__builtin_bit_cast(unsigned, v1[ia] + v2[ib]) & ~255u) | (unsigned)(ia * 16 + ib)); ++slot; } ++n; } }
            SORT16_DESC(v);
            if (blk == 0) {
#pragma unroll
                for (int j = 0; j < 16; ++j) c[j] = v[j];
            } else { MERGE16_TOP(c, v); }
        }
        float ex[16], sum = 0.f; const float mx = __builtin_bit_cast(float, __builtin_bit_cast(unsigned, c[0]) & ~255u);
#pragma unroll
        for (int k = 0; k < 16; ++k) { ex[k] = fast_exp(__builtin_bit_cast(float, __builtin_bit_cast(unsigned, c[k]) & ~255u) - mx); sum += ex[k]; }
        const float inv = 1.f / sum; const size_t ob = (tok_base + t) * 128 + h * 16;
        unsigned ee[16];
#pragma unroll
        for (int k = 0; k < 16; ++k) { const unsigned code = __builtin_bit_cast(unsigned, c[k]) & 255u;
            const unsigned i1 = t0[code >> 4] & 127u, i2 = t1[code & 15u] & 127u; ee[k] = i1 * 128u + i2; }
        { GAS v4u* ep = (GAS v4u*)(eidx + ob); ep[0] = (v4u){ee[0] | (ee[1] << 16), ee[2] | (ee[3] << 16), ee[4] | (ee[5] << 16), ee[6] | (ee[7] << 16)};
          ep[1] = (v4u){ee[8] | (ee[9] << 16), ee[10] | (ee[11] << 16), ee[12] | (ee[13] << 16), ee[14] | (ee[15] << 16)};
          GAS f32x4* gp = (GAS f32x4*)(gate + ob);
#pragma unroll
          for (int k4 = 0; k4 < 4; ++k4) gp[k4] = (f32x4){ex[4 * k4] * inv, ex[4 * k4 + 1] * inv, ex[4 * k4 + 2] * inv, ex[4 * k4 + 3] * inv}; }
    }
}
struct EpiTopk8 {
    static constexpr bool PERM = false, AFTER_DRAIN = true;
    unsigned short* eidx; float* gate; const float* sa; const float* sb;
    __device__ __forceinline__ void operator()(pg8::i32x4 (&)[2][2][4][2], const Unit&, int, int, int, int) const {}
    __device__ __forceinline__ void fused(pg8::i32x4 (&acc)[2][2][4][2], const Unit& u, int wr, int wc, int fr, int fq, PG8_LAS unsigned char* lds) const {
        const int tid = threadIdx.x; LAS unsigned char* L = (LAS unsigned char*)lds;
        f32x4 kb[2][2];
#pragma unroll
        for (int bj = 0; bj < 2; ++bj)
#pragma unroll
            for (int n = 0; n < 2; ++n) kb[bj][n] = *(const GAS f32x4*)(sb + u.pn * 256 + bj * 128 + wc * 32 + n * 16 + 4 * fq);
#pragma unroll
        for (int ai = 0; ai < 2; ++ai) {
            float ta[4];
#pragma unroll
            for (int m = 0; m < 4; ++m) ta[m] = sa[(size_t)u.pm * 256 + ai * 128 + wr * 64 + m * 16 + fr];
#pragma unroll
            for (int bj = 0; bj < 2; ++bj)
#pragma unroll
                for (int m = 0; m < 4; ++m)
#pragma unroll
                    for (int n = 0; n < 2; ++n) { const pg8::i32x4 a = acc[ai][bj][m][n];
                        *(LAS f32x4*)((LAS float*)(L + TK_S) + (bj * 128 + wr * 64 + m * 16 + fr) * TK_SSTR + wc * 32 + n * 16 + 4 * fq) = (f32x4){(float)a.x, (float)a.y, (float)a.z, (float)a.w} * kb[bj][n] * ta[m]; }
            LBAR();
            topk_select(L, tid, (size_t)u.pm * 256 + 128 * ai, u.pn, eidx, gate);
        }
        __syncthreads();
    }
};
struct EpiTopk {
    static constexpr bool PERM = false, AFTER_DRAIN = true;
    unsigned short* eidx; float* gate;
    __device__ __forceinline__ void operator()(pg8::f32x4 (&)[2][2][4][2], const Unit&, int, int, int, int) const {}
    __device__ __forceinline__ void fused(pg8::f32x4 (&acc)[2][2][4][2], const Unit& u, int wr, int wc, int fr, int fq, PG8_LAS unsigned char* lds) const {
        const int tid = threadIdx.x; LAS unsigned char* L = (LAS unsigned char*)lds;
#pragma unroll
        for (int ai = 0; ai < 2; ++ai) {
#pragma unroll
            for (int bj = 0; bj < 2; ++bj)
#pragma unroll
                for (int m = 0; m < 4; ++m)
#pragma unroll
                    for (int n = 0; n < 2; ++n) *(LAS f32x4*)((LAS float*)(L + TK_S) + (bj * 128 + wr * 64 + m * 16 + fr) * TK_SSTR + wc * 32 + n * 16 + 4 * fq) = acc[ai][bj][m][n];
            LBAR();
            topk_select(L, tid, (size_t)u.pm * 256 + 128 * ai, u.pn, eidx, gate);
        }
        __syncthreads();
    }
};

#define TRED3(d, lane, m0, m1, m2) do { \
    _Pragma("unroll") for (int _i = 0; _i < 8; ++_i) { const bool _h = ((lane) & (m0)) != 0; const float _k = _h ? d[_i + 8] : d[_i], _s = _h ? d[_i] : d[_i + 8]; d[_i] = _k + __shfl_xor(_s, (m0)); } \
    _Pragma("unroll") for (int _i = 0; _i < 4; ++_i) { const bool _h = ((lane) & (m1)) != 0; const float _k = _h ? d[_i + 4] : d[_i], _s = _h ? d[_i] : d[_i + 4]; d[_i] = _k + __shfl_xor(_s, (m1)); } \
    _Pragma("unroll") for (int _i = 0; _i < 2; ++_i) { const bool _h = ((lane) & (m2)) != 0; const float _k = _h ? d[_i + 2] : d[_i], _s = _h ? d[_i] : d[_i + 2]; d[_i] = _k + __shfl_xor(_s, (m2)); } } while (0)
typedef int i32x4 __attribute__((ext_vector_type(4)));
#define PX_LOAD_E(ev, tok) do { const GAS v4u* ep_ = (const GAS v4u*)(eidx + (size_t)(tok) * 128 + 16 * pg); ev[0] = ep_[0]; ev[1] = ep_[1]; } while (0)
#define PX_LOAD_ROWS8(rows, ea, base) do { const unsigned e_[8] = {ea.x & 0xffffu, ea.x >> 16, ea.y & 0xffffu, ea.y >> 16, ea.z & 0xffffu, ea.z >> 16, ea.w & 0xffffu, ea.w >> 16}; \
    _Pragma("unroll") for (int i_ = 0; i_ < 8; ++i_) rows[i_] = *(const GAS v4u*)((base) + (e_[i_] * 128u + cgo)); } while (0)
#define TRED3I(d, lane, m0, m1, m2) do { \
    _Pragma("unroll") for (int _i = 0; _i < 8; ++_i) { const bool _h = ((lane) & (m0)) != 0; const int _k = _h ? d[_i + 8] : d[_i], _s = _h ? d[_i] : d[_i + 8]; d[_i] = _k + __shfl_xor(_s, (m0)); } \
    _Pragma("unroll") for (int _i = 0; _i < 4; ++_i) { const bool _h = ((lane) & (m1)) != 0; const int _k = _h ? d[_i + 4] : d[_i], _s = _h ? d[_i] : d[_i + 4]; d[_i] = _k + __shfl_xor(_s, (m1)); } \
    _Pragma("unroll") for (int _i = 0; _i < 2; ++_i) { const bool _h = ((lane) & (m2)) != 0; const int _k = _h ? d[_i + 2] : d[_i], _s = _h ? d[_i] : d[_i + 2]; d[_i] = _k + __shfl_xor(_s, (m2)); } } while (0)
typedef int i32x2 __attribute__((ext_vector_type(2)));
typedef unsigned u32x2_t __attribute__((ext_vector_type(2)));
#define PU4_LOAD_H(ha, hb, tok) do { const GAS v4u* hp_ = (const GAS v4u*)(H8 + (size_t)(tok) * D + 256 * slice + 32 * cg); ha = hp_[0]; hb = hp_[1]; } while (0)
#define QDPP_(x, ctrl) __builtin_amdgcn_mov_dpp((x), (ctrl), 0xf, 0xf, true)
#define PU4_DOT8(rows, dd, off) do { \
    _Pragma("unroll") for (int i_ = 0; i_ < 8; ++i_) { const unsigned w_[4] = {rows[i_].x, rows[i_].y, rows[i_].z, rows[i_].w}; int sa_ = 0, sb_ = 0; \
        _Pragma("unroll") for (int q_ = 0; q_ < 4; ++q_) { sa_ = __builtin_amdgcn_sdot8((int)w_[q_], ha_[q_], sa_, false); sb_ = __builtin_amdgcn_sdot8((int)w_[q_], hb_[q_], sb_, false); } \
        dd[(off) + i_] = (sa_ << 4) + sb_; } } while (0)
__device__ __forceinline__ void peer_u_slice(unsigned char* ws_, const unsigned char* H8, int slice, int rank, int nrank) {
    const int lane = threadIdx.x & 63, wave = __builtin_amdgcn_readfirstlane(threadIdx.x >> 6);
    const int pg = lane >> 3, cg = lane & 7, wi = rank * NWAVES + wave, nw = nrank * NWAVES;
    const unsigned char* Us = ws_ + WS_U8 + (size_t)slice * ((size_t)NEXP * 128); const unsigned cgo = 16u * cg;
    const unsigned short* eidx = (const unsigned short*)(ws_ + WS_EIDX); bf16* part = (bf16*)(ws_ + WS_PART) + (size_t)slice * ML * 128;
    v4u eC[2], eN[2]; v4u r0[8], r1[8]; v4u hC0, hC1, hN0, hN1;
    PX_LOAD_E(eC, wi); PU4_LOAD_H(hC0, hC1, wi); PX_LOAD_ROWS8(r0, eC[0], Us);
#pragma unroll 1
    for (int t = wi; t < ML; t += nw) {
        const int tn = (t + nw < ML) ? t + nw : t;
        PX_LOAD_ROWS8(r1, eC[1], Us); PX_LOAD_E(eN, tn); PU4_LOAD_H(hN0, hN1, tn);
        __builtin_amdgcn_sched_barrier(0);
        const int ha_[4] = {(int)hC0.x, (int)hC0.y, (int)hC0.z, (int)hC0.w}, hb_[4] = {(int)hC1.x, (int)hC1.y, (int)hC1.z, (int)hC1.w};
        int d[16];
        PU4_DOT8(r0, d, 0);
        PX_LOAD_ROWS8(r0, eN[0], Us);
        __builtin_amdgcn_sched_barrier(0);
        PU4_DOT8(r1, d, 8);
#pragma unroll
        for (int i_ = 0; i_ < 8; ++i_) { const int a_ = d[i_] + QDPP_(d[i_], 0x12c), b_ = d[i_ + 8] + QDPP_(d[i_ + 8], 0x124); d[i_] = (lane & 4) ? b_ : a_; }
#pragma unroll
        for (int i_ = 0; i_ < 4; ++i_) { const bool h_ = (lane & 2) != 0; const int k_ = h_ ? d[i_ + 4] : d[i_], s_ = h_ ? d[i_] : d[i_ + 4]; d[i_] = k_ + QDPP_(s_, 0x4e); }
#pragma unroll
        for (int i_ = 0; i_ < 2; ++i_) { const bool h_ = (lane & 1) != 0; const int k_ = h_ ? d[i_ + 2] : d[i_], s_ = h_ ? d[i_] : d[i_ + 2]; d[i_] = k_ + QDPP_(s_, 0xb1); }
        *(GAS unsigned*)(part + (size_t)t * 128 + 2 * lane) = pk2((float)d[0], (float)d[1]);
        eC[0] = eN[0]; eC[1] = eN[1]; hC0 = hN0; hC1 = hN1;
    }
}
typedef _Float16 h16x2 __attribute__((ext_vector_type(2)));
__device__ __forceinline__ void peer_reduce(Frame& F) {
    const bf16* part = (const bf16*)(F.ws + WS_PART); const float* sh = (const float*)(F.ws + WS_SH); const unsigned short* eidx = (const unsigned short*)(F.ws + WS_EIDX); const float* gate = (const float*)(F.ws + WS_GATE);
    unsigned* wq = (unsigned*)(F.ws + WS_WGT); float* wsc = (float*)(F.ws + WS_WGT + 4 * MiB);
    { const GAS f32x4* src = (const GAS f32x4*)(F.ws + WS_SU); LAS f32x4* dst = (LAS f32x4*)F.lds;
#pragma unroll
      for (int i = 0; i < 16; ++i) dst[F.tid + 512 * i] = src[F.tid + 512 * i];
      __syncthreads(); }
    const LAS float* su = (const LAS float*)F.lds; const LAS float* sv = su + NEXP;
    for (size_t i4 = (size_t)F.bid * NTHREADS + F.tid; i4 < (size_t)ML * 32; i4 += (size_t)F.G * NTHREADS) {
        const size_t i = 4 * i4;
        f32x4 s = (f32x4){0.f, 0.f, 0.f, 0.f};
#pragma unroll
        for (int x = 0; x < 4; ++x) { const v2u pv = *(const GAS v2u*)(part + (size_t)x * ML * 128 + i); s += (f32x4){bflo(pv.x), bfhi(pv.x), bflo(pv.y), bfhi(pv.y)}; }
        const v2u ev = *(const GAS v2u*)(eidx + i); const f32x4 gv = *(const GAS f32x4*)(gate + i); const float sht = sh[i >> 7];
        { const float hh = 0.5f * sh[ML + (i >> 7)]; s.x += hh; s.y += hh; s.z += hh; s.w += hh; }
        const unsigned e[4] = {ev.x & 0xffffu, ev.x >> 16, ev.y & 0xffffu, ev.y >> 16}; const float sv4[4] = {s.x, s.y, s.z, s.w}; const float g4[4] = {gv.x, gv.y, gv.z, gv.w};
        float w[4];
#pragma unroll
        for (int k = 0; k < 4; ++k) { const float z = sv4[k] * su[e[k]] * sht; w[k] = g4[k] * (0.5f * z * (1.f + erff(z * 0.70710678118f))) * sv[e[k]]; }
        float m = fmaxf(fmaxf(fabsf(w[0]), fabsf(w[1])), fmaxf(fabsf(w[2]), fabsf(w[3])));
        m = fmaxf(m, WDPP_(m, 0xb1)); m = fmaxf(m, WDPP_(m, 0x4e)); m = fmaxf(m, WDPP_(m, 0x141)); m = fmaxf(m, WDPP_(m, 0x140)); WSWAP_(m, 16, fmaxf);
        const float qs = (m > 0.f) ? 127.f / m : 1.f;
        const float q0 = rintf(w[0] * qs), q1 = rintf(w[1] * qs), q2 = rintf(w[2] * qs), q3 = rintf(w[3] * qs);
        wq[i4] = pack_i8x4(q0, q1, q2, q3);
        float qsum = (q0 + q1) + (q2 + q3);
        qsum += WDPP_(qsum, 0xb1); qsum += WDPP_(qsum, 0x4e); qsum += WDPP_(qsum, 0x141); qsum += WDPP_(qsum, 0x140); WSWAP_(qsum, 16, WADD_);
        if ((i4 & 31) == 0) { const float st = (m > 0.f) ? m * (1.f / 127.f) : 0.f; wsc[i >> 7] = st * (1.f / 16.f); wsc[ML + (i >> 7)] = st * 0.5f * qsum; wsc[2 * ML + (i >> 7)] = st * 8.f * qsum; }
    }
    __syncthreads();
}
#define PV_LOAD_W(wv, tok) do { wv = *(const GAS v4u*)(wq + (size_t)(tok) * 128 + 16 * pg); } while (0)
#define PV4_ACC4(ra, rb, rc, rd, wd) do { const unsigned a_[4] = {ra.x, ra.y, ra.z, ra.w}, b_[4] = {rb.x, rb.y, rb.z, rb.w}, c_[4] = {rc.x, rc.y, rc.z, rc.w}, d_[4] = {rd.x, rd.y, rd.z, rd.w}; \
    _Pragma("unroll") for (int q_ = 0; q_ < 4; ++q_) { \
        const unsigned t0_ = __builtin_amdgcn_perm(b_[q_], a_[q_], 0x05010400u), t1_ = __builtin_amdgcn_perm(b_[q_], a_[q_], 0x07030602u); \
        const unsigned t2_ = __builtin_amdgcn_perm(d_[q_], c_[q_], 0x05010400u), t3_ = __builtin_amdgcn_perm(d_[q_], c_[q_], 0x07030602u); \
        const unsigned T_[4] = {__builtin_amdgcn_perm(t2_, t0_, 0x05040100u), __builtin_amdgcn_perm(t2_, t0_, 0x07060302u), __builtin_amdgcn_perm(t3_, t1_, 0x05040100u), __builtin_amdgcn_perm(t3_, t1_, 0x07060302u)}; \
        _Pragma("unroll") for (int k_ = 0; k_ < 4; ++k_) { \
            acc[8 * q_ + 2 * k_]     = __builtin_amdgcn_sdot4((int)T_[k_], (int)(wd), acc[8 * q_ + 2 * k_], false); \
            acc[8 * q_ + 2 * k_ + 1] = __builtin_amdgcn_sdot4((int)(T_[k_] & 0x0f0f0f0fu), (int)(wd), acc[8 * q_ + 2 * k_ + 1], false); } } } while (0)
__device__ __forceinline__ void peer_u_reduce(Frame& F, int rank) {
    unsigned char* ws_ = F.ws;
    const int lane = threadIdx.x & 63, wave = __builtin_amdgcn_readfirstlane(threadIdx.x >> 6), tid = threadIdx.x;
    const int pg = lane >> 3, cg = lane & 7, tw = rank * NWAVES + wave;
    const unsigned cgo = 16u * cg;
    const unsigned char* H8 = ws_ + WS_H8P;
    const unsigned short* eidx = (const unsigned short*)(ws_ + WS_EIDX);
    LAS unsigned short* tab = (LAS unsigned short*)F.lds;
    LAS int* accL = (LAS int*)(F.lds + 65536) + wave * 1024;
    { const GAS f32x4* src = (const GAS f32x4*)(ws_ + WS_SU);
#pragma unroll
      for (int i = 0; i < 16; ++i) { const f32x4 v = src[tid + 512 * i]; *(LAS v2u*)(F.lds + (size_t)(tid + 512 * i) * 8) = (v2u){pk2(v.x, v.y), pk2(v.z, v.w)}; }
#pragma unroll
      for (int i = 0; i < 16; ++i) ((LAS int*)(F.lds + 65536))[tid + 512 * i] = 0; }
    __syncthreads();
#define PUR_TOK(j_) (tw + 2048 * ((j_) & 7))
#define PUR_US(j_) (ws_ + WS_U8 + (size_t)((j_) >> 3) * ((size_t)NEXP * 128))
#define PUR_LOAD_H(ha, hb, tok, sl) do { const GAS v4u* hp_ = (const GAS v4u*)(H8 + (size_t)(tok) * D + 256 * (sl) + 32 * cg); ha = hp_[0]; hb = hp_[1]; } while (0)
    v4u eC[2], eN[2]; v4u r0[8], r1[8]; v4u hC0, hC1, hN0, hN1;
    LAS unsigned char* idsL = F.lds + 135168 + wave * 2048;
#pragma unroll
    for (int k = 0; k < 2; ++k) { const int i = (lane >> 4) + 4 * k; *(LAS v4u*)(idsL + i * 256 + 16 * (lane & 15)) = *(const GAS v4u*)(eidx + (size_t)(tw + 2048 * i) * 128 + 8 * (lane & 15)); }
    asm volatile("s_waitcnt vmcnt(0) lgkmcnt(0)" ::: "memory");
#define PE_LDS(ev, i_) do { const LAS v4u* ep_ = (const LAS v4u*)(idsL + (i_) * 256 + 32 * pg); ev[0] = ep_[0]; ev[1] = ep_[1]; } while (0)
    { const int t0 = PUR_TOK(0); PE_LDS(eC, 0); PUR_LOAD_H(hC0, hC1, t0, 0); PX_LOAD_ROWS8(r0, eC[0], PUR_US(0)); }
#pragma unroll 1
    for (int j = 0; j < 32; ++j) {
        const int jn = (j + 1 < 32) ? j + 1 : j, tn = PUR_TOK(jn);
        const unsigned char* Us = PUR_US(j); const unsigned char* Un = PUR_US(jn);
        PX_LOAD_ROWS8(r1, eC[1], Us); PE_LDS(eN, jn & 7); PUR_LOAD_H(hN0, hN1, tn, jn >> 3);
        __builtin_amdgcn_sched_barrier(0);
        const int ha_[4] = {(int)hC0.x, (int)hC0.y, (int)hC0.z, (int)hC0.w}, hb_[4] = {(int)hC1.x, (int)hC1.y, (int)hC1.z, (int)hC1.w};
        int d[16];
        PU4_DOT8(r0, d, 0);
        PX_LOAD_ROWS8(r0, eN[0], Un);
        __builtin_amdgcn_sched_barrier(0);
        PU4_DOT8(r1, d, 8);
#pragma unroll
        for (int i_ = 0; i_ < 8; ++i_) { const int a_ = d[i_] + QDPP_(d[i_], 0x12c), b_ = d[i_ + 8] + QDPP_(d[i_ + 8], 0x124); d[i_] = (lane & 4) ? b_ : a_; }
#pragma unroll
        for (int i_ = 0; i_ < 4; ++i_) { const bool h_ = (lane & 2) != 0; const int k_ = h_ ? d[i_ + 4] : d[i_], s_ = h_ ? d[i_] : d[i_ + 4]; d[i_] = k_ + QDPP_(s_, 0x4e); }
#pragma unroll
        for (int i_ = 0; i_ < 2; ++i_) { const bool h_ = (lane & 1) != 0; const int k_ = h_ ? d[i_ + 2] : d[i_], s_ = h_ ? d[i_] : d[i_ + 2]; d[i_] = k_ + QDPP_(s_, 0xb1); }
        { LAS i32x2* ap = (LAS i32x2*)(accL + (j & 7) * 128 + 2 * lane); i32x2 v = *ap; v.x += d[0]; v.y += d[1]; *ap = v; }
        eC[0] = eN[0]; eC[1] = eN[1]; hC0 = hN0; hC1 = hN1;
    }
#undef PUR_LOAD_H
#undef PUR_US
#undef PUR_TOK
    asm volatile("s_waitcnt lgkmcnt(0)" ::: "memory");
    const float* sh = (const float*)(ws_ + WS_SH); const float* gate = (const float*)(ws_ + WS_GATE); unsigned char* wq = ws_ + WS_WGT; float* wsc = (float*)(ws_ + WS_WGT + 4 * MiB);
#pragma unroll
    for (int i = 0; i < 8; ++i) { const int t = tw + 2048 * i;
        const i32x2 sv_ = *(const LAS i32x2*)(accL + i * 128 + 2 * lane);
        const unsigned ev = *(const GAS unsigned*)(eidx + (size_t)t * 128 + 2 * lane); const f32x2 gv = *(const GAS f32x2*)(gate + (size_t)t * 128 + 2 * lane);
        const float sht = sh[t], hh = 0.5f * sh[ML + t];
        const unsigned e0 = ev & 0xffffu, e1 = ev >> 16;
        const float su0 = __builtin_bit_cast(float, (unsigned)tab[e0] << 16), su1 = __builtin_bit_cast(float, (unsigned)tab[e1] << 16), sv0 = __builtin_bit_cast(float, (unsigned)tab[NEXP + e0] << 16), sv1 = __builtin_bit_cast(float, (unsigned)tab[NEXP + e1] << 16);
        const float z0 = ((float)sv_.x + hh) * su0 * sht, z1 = ((float)sv_.y + hh) * su1 * sht;
        const float w0 = gv.x * (0.5f * z0 * (1.f + erff(z0 * 0.70710678118f))) * sv0, w1 = gv.y * (0.5f * z1 * (1.f + erff(z1 * 0.70710678118f))) * sv1;
        const float m = wave_max(fmaxf(fabsf(w0), fabsf(w1)));
        const float qs = (m > 0.f) ? 127.f / m : 1.f;
        const float q0 = rintf(w0 * qs), q1 = rintf(w1 * qs);
        const float qsum = wave_sum(q0 + q1);
        *(GAS unsigned short*)(wq + (size_t)t * 128 + 2 * lane) = (unsigned short)(((unsigned)(int)q0 & 255u) | (((unsigned)(int)q1 & 255u) << 8));
        if (lane == 0) { const float st = (m > 0.f) ? m * (1.f / 127.f) : 0.f; wsc[t] = st * (1.f / 16.f); wsc[ML + t] = st * 0.5f * qsum; wsc[2 * ML + t] = st * 8.f * qsum; } }
    __syncthreads();
}
__device__ __forceinline__ void peer_v_final(Frame& F, int rank) {
    unsigned char* ws_ = F.ws;
    const int lane = threadIdx.x & 63, wave = __builtin_amdgcn_readfirstlane(threadIdx.x >> 6);
    const int pg = lane >> 3, cg = lane & 7, tw = rank * NWAVES + wave;
    const unsigned cgo = 16u * cg;
    const unsigned short* eidx = (const unsigned short*)(ws_ + WS_EIDX); const unsigned char* wq = ws_ + WS_WGT; const float* wsc = (const float*)(ws_ + WS_WGT + 4 * MiB);
    const float* mod = (const float*)(ws_ + WS_MOD);
    LAS float* ssq = (LAS float*)F.lds + wave * 8;
    LAS unsigned char* xb = F.lds + 1024 + wave * 16384;
    if (lane < 8) ssq[lane] = 0.f;
#define PVF_TOK(j_) (tw + 2048 * ((j_) & 7))
#define PVF_VS(j_) (ws_ + WS_V8 + (size_t)((j_) >> 3) * ((size_t)NEXP * 128))
    v4u eC[2], eN[2]; v4u r0[8], r1[8]; v4u wC, wN; float sC, sN, oC, oN, pC, pN;
    const LAS unsigned char* idsL = F.lds + 135168 + wave * 2048;
    { const int t0 = PVF_TOK(0); PE_LDS(eC, 0); PV_LOAD_W(wC, t0); sC = wsc[t0]; oC = wsc[ML + t0]; pC = wsc[2 * ML + t0]; PX_LOAD_ROWS8(r0, eC[0], PVF_VS(0)); }
#pragma unroll 1
    for (int j = 0; j < 32; ++j) {
        const int t = PVF_TOK(j), slice = j >> 3, jn = (j + 1 < 32) ? j + 1 : j, tn = PVF_TOK(jn);
        const unsigned char* Vs = PVF_VS(j); const unsigned char* Vn = PVF_VS(jn);
        PX_LOAD_ROWS8(r1, eC[1], Vs); PE_LDS(eN, jn & 7); PV_LOAD_W(wN, tn); sN = wsc[tn]; oN = wsc[ML + tn]; pN = wsc[2 * ML + tn];
        const int col = 256 * slice + 32 * cg + 4 * pg;
        const v2u xw = *(const GAS v2u*)((const bf16*)(ws_ + ((slice & 2) ? WS_YPOOL : WS_YHG)) + (size_t)t * 512 + 256 * (slice & 1) + 32 * cg + 4 * pg);
        const f32x4 gg = *(const GAS f32x4*)(mod + (size_t)(t >> 12) * 6144 + 5 * 1024 + col);
        __builtin_amdgcn_sched_barrier(0);
        int acc[32];
#pragma unroll
        for (int k = 0; k < 32; ++k) acc[k] = 0;
        PV4_ACC4(r0[0], r0[1], r0[2], r0[3], wC.x); __builtin_amdgcn_sched_barrier(0);
        PV4_ACC4(r0[4], r0[5], r0[6], r0[7], wC.y);
        PX_LOAD_ROWS8(r0, eN[0], Vn);
        __builtin_amdgcn_sched_barrier(0);
        PV4_ACC4(r1[0], r1[1], r1[2], r1[3], wC.z); __builtin_amdgcn_sched_barrier(0);
        PV4_ACC4(r1[4], r1[5], r1[6], r1[7], wC.w);
#pragma unroll
        for (int i_ = 0; i_ < 16; ++i_) { const u32x2_t r_ = __builtin_amdgcn_permlane32_swap((unsigned)acc[i_], (unsigned)acc[i_ + 16], false, false); acc[i_] = (int)(r_.x + r_.y); }
#pragma unroll
        for (int i_ = 0; i_ < 8; ++i_) { const u32x2_t r_ = __builtin_amdgcn_permlane16_swap((unsigned)acc[i_], (unsigned)acc[i_ + 8], false, false); acc[i_] = (int)(r_.x + r_.y); }
#pragma unroll
        for (int i_ = 0; i_ < 4; ++i_) { const int a_ = acc[i_] + QDPP_(acc[i_], 0x128), b_ = acc[i_ + 4] + QDPP_(acc[i_ + 4], 0x128); acc[i_] = (lane & 8) ? b_ : a_; }
        const f32x4 po = (f32x4){(float)(acc[0] - acc[1]) * sC + oC, (float)acc[1] * (16.f * sC) - pC + oC, (float)(acc[2] - acc[3]) * sC + oC, (float)acc[3] * (16.f * sC) - pC + oC};
        const f32x4 x2 = (f32x4){bflo(xw.x), bfhi(xw.x), bflo(xw.y), bfhi(xw.y)} + gg * po;
        *(LAS v2u*)(xb + ((j & 7) * 1024 + col) * 2) = (v2u){pk2(x2.x, x2.y), pk2(x2.z, x2.w)};
        const float q2 = wave_sum((x2.x * x2.x + x2.y * x2.y) + (x2.z * x2.z + x2.w * x2.w));
        if (lane == 0) ssq[j & 7] += q2;
        eC[0] = eN[0]; eC[1] = eN[1]; wC = wN; sC = sN; oC = oN; pC = pN;
    }
#undef PVF_VS
#undef PVF_TOK
    asm volatile("s_waitcnt vmcnt(0) lgkmcnt(0)" ::: "memory");
#pragma unroll 2
    for (int i = 0; i < 8; ++i) { const int t = tw + 2048 * i;
        const float rstd = 1.f / sqrtf(ssq[i] * (1.f / D) + EPS); GAS f32x4* orow = (GAS f32x4*)(F.out + (size_t)t * D) + lane;
#pragma unroll
        for (int jj = 0; jj < 4; ++jj) { const f32x4 fg = ((const GAS f32x4*)F.final_g)[lane + 64 * jj]; const v2u xw = *(const LAS v2u*)(xb + (i * 1024 + 4 * (lane + 64 * jj)) * 2);
            __builtin_nontemporal_store((f32x4){bflo(xw.x), bfhi(xw.x), bflo(xw.y), bfhi(xw.y)} * rstd * fg, &orow[64 * jj]); } }
}
__device__ __forceinline__ void final_norm(Frame& F) {
    const bf16* po = (const bf16*)(F.ws + WS_PO); const float* mod = (const float*)(F.ws + WS_MOD); const int lane = F.lane, gw = F.bid * NWAVES + F.wave, NGW = F.G * NWAVES;
    for (int t0 = gw; t0 < ML; t0 += 2 * NGW) {
        f32x4 xv[2][4]; float s2[2] = {0.f, 0.f};
#pragma unroll
        for (int r = 0; r < 2; ++r) { const int t = (t0 + r * NGW < ML) ? t0 + r * NGW : t0;
            const GAS v2u* orow0 = (const GAS v2u*)((const bf16*)(F.ws + WS_YHG) + (size_t)t * 512) + lane; const GAS v2u* orow1 = (const GAS v2u*)((const bf16*)(F.ws + WS_YPOOL) + (size_t)t * 512) + lane; const GAS v2u* prow = (const GAS v2u*)(po + (size_t)t * D) + lane;
            const GAS f32x4* g2 = (const GAS f32x4*)(mod + (size_t)(t >> 12) * 6144 + 5 * 1024) + lane;
#pragma unroll
            for (int j = 0; j < 4; ++j) { const v2u xw = (j < 2) ? orow0[64 * j] : orow1[64 * (j - 2)]; const f32x4 x1 = (f32x4){bflo(xw.x), bfhi(xw.x), bflo(xw.y), bfhi(xw.y)}, gg = g2[64 * j]; const v2u pv = prow[64 * j];
                xv[r][j] = x1 + gg * (f32x4){bflo(pv.x), bfhi(pv.x), bflo(pv.y), bfhi(pv.y)};
                s2[r] += (xv[r][j].x * xv[r][j].x + xv[r][j].y * xv[r][j].y) + (xv[r][j].z * xv[r][j].z + xv[r][j].w * xv[r][j].w); } }
#pragma unroll
        for (int r = 0; r < 2; ++r) { const int t = t0 + r * NGW; if (t < ML) {
            const float rstd = 1.f / sqrtf(wave_sum(s2[r]) * (1.f / D) + EPS); GAS f32x4* orow = (GAS f32x4*)(F.out + (size_t)t * D) + lane;
#pragma unroll
            for (int j = 0; j < 4; ++j) { const f32x4 fg = ((const GAS f32x4*)F.final_g)[lane + 64 * j]; f32x4 ov = xv[r][j] * rstd * fg;
                orow[64 * j] = ov; } } }
    }
}

constexpr int N_PHASES = 15;
__global__ void __launch_bounds__(NTHREADS, 2) fwd_kernel(Args args) {
    extern __shared__ __attribute__((aligned(16))) unsigned char lds[];
    Frame F;
    F.lds = (LAS unsigned char*)lds;
    F.tid = threadIdx.x; F.lane = F.tid & 63; F.wave = __builtin_amdgcn_readfirstlane(F.tid >> 6); F.G = gridDim.x; F.bid = blockIdx.x;
    F.x = args.in[0]; F.c = args.in[1]; F.ctx = args.in[2]; F.c_ctx = args.in[3]; F.w_mod = args.in[4]; F.b_mod = args.in[5]; F.n1g = args.in[6]; F.n2g = args.in[7];
    F.w_in = args.in[8]; F.pool_w = args.in[9]; F.pool_scale = args.in[10]; F.lb_logits = args.in[11]; F.hg_norm_g = args.in[12]; F.w_a = args.in[13]; F.w_b = args.in[14];
    F.w_o = args.in[15]; F.wq = args.in[16]; F.keys = args.in[17]; F.pu = args.in[18]; F.pv = args.in[19]; F.final_g = args.in[20];
    F.out = args.out; F.ws = args.ws;
    volatile LAS unsigned* MISC = (volatile LAS unsigned*)(F.lds + MISC_OFF);
    if (F.tid < 64) MISC[F.tid] = 0u;
    __syncthreads();
    unsigned* barw = (unsigned*)(F.ws + WS_CTL) + CW_BAR;
    XcdBarrier bar; bar.bar = barw; bar.x = 0; bar.st = nullptr;
    if (ONE_LAUNCH) bar = xcd_barrier_post(barw, MISC + 8);
    const int lo = args.ph_lo, hi = args.ph_hi;
#ifndef PH_MASK
#define PH_MASK 0x7fff
#endif
#define IN(k) (((PH_MASK >> (k)) & 1) && lo <= (k) && (k) < hi)
#define SEAM(k) do { if (IN(k) && IN((k) + 1)) xcd_barrier(bar); } while (0)

#ifndef REPP
#define REPP (-1)
#endif
#define RUNP(k, ...) do { if (IN(k)) { __VA_ARGS__ if (REPP == (k)) { __syncthreads(); __VA_ARGS__ } } } while (0)
    RUNP(0, p0_prologue(F););
    { p1_win8_poll(F);
      __syncthreads(); if (F.tid == 0) { unsigned* c_ = (unsigned*)(F.ws + WS_CTL) + CW_MODCNT; XB_SPIN(xb_ld(c_) < 192u, barw); __builtin_amdgcn_fence(__ATOMIC_ACQUIRE, "agent"); asm volatile("s_waitcnt vmcnt(0)" ::: "memory"); } __syncthreads(); }
    RUNP(1, p1_win8_convert(F); p1_modulate(F);); SEAM(1);
    RUNP(2, {
        SchedIn S{(const char*)(F.ws + WS_H), (const char*)(F.ws + WS_WIN8), F.G, F.bid};
        EpiZ E{(bf16*)(F.ws + WS_Z), F.ws + WS_G8, (bf16*)(F.ws + WS_ZC), (bf16*)(F.ws + WS_ZC2), (const float*)(F.ws + WS_SA1), (const float*)(F.ws + WS_SBW)};
        pg8::gemm_phase<EpiZ, SchedIn, true, true, true>(F.lds, D / 2, S, E);
    }); SEAM(2);
    RUNP(3, {
        if (F.bid >= 128 && F.bid < 176) {
            SchedCtx S{(const char*)(F.ws + WS_HC), (const char*)(F.ws + WS_WIN8), F.bid - 128};
            EpiZ E{(bf16*)(F.ws + WS_Z), F.ws + WS_G8, (bf16*)(F.ws + WS_ZC), (bf16*)(F.ws + WS_ZC2), (const float*)(F.ws + WS_SA1), (const float*)(F.ws + WS_SBW)};
            pg8::gemm_phase<EpiZ, SchedCtx, true, true, true>(F.lds, D / 2, S, E);
            asm volatile("s_waitcnt vmcnt(0)" ::: "memory"); __syncthreads();
            if (F.tid == 0) xb_add((unsigned*)(F.ws + WS_CTL) + CW_CTXCNT, 1u);
        }
        scan_unit(F, F.bid);
        if (F.bid < NSCAN - NSCAN_L) {
            __syncthreads(); if (F.tid == 0) { unsigned* c_ = (unsigned*)(F.ws + WS_CTL) + CW_CTXCNT; XB_SPIN(xb_ld(c_) < 48u, barw); __builtin_amdgcn_fence(__ATOMIC_ACQUIRE, "agent"); asm volatile("s_waitcnt vmcnt(0)" ::: "memory"); } __syncthreads();
            scan_unit(F, NSCAN_L + F.bid);
        }
        for (int u = F.bid; u < NB * 64; u += F.G) pool_unit(F, u);
        if (F.bid >= 176) rows_bf16_to_i8((const bf16*)(F.ws + WS_WQ), F.ws + WS_WC8, (float*)(F.ws + WS_SB), 2048, (F.bid - 176) * NWAVES + F.wave, (F.G - 176) * NWAVES, F.lane);
    }); if (IN(3) && IN(14)) xcd_barrier(bar);
    RUNP(14, { for (int u = F.bid; u < 256; u += F.G) prefix_unit(F, u);
               }); if (IN(14) && IN(4)) xcd_barrier(bar);
    int pm = 0, pn = 0; pg8::tile_of(F.bid, 64, 4, pm, pn);
    unsigned* pcnt = (unsigned*)(F.ws + WS_CTL) + CW_PANEL + pm * 16;
#define PANEL_SYNC(seam) do { asm volatile("s_waitcnt vmcnt(0)" ::: "memory"); __syncthreads(); \
        if (F.tid == 0) { unsigned* c_ = pcnt + (seam) * 1024; xb_add(c_, 1u); XB_SPIN(xb_ld(c_) < 4u, barw); __builtin_amdgcn_fence(__ATOMIC_ACQUIRE, "agent"); asm volatile("s_waitcnt vmcnt(0)" ::: "memory"); } \
        __syncthreads(); } while (0)
    RUNP(4, { fix_unit(F, pm >> 4, pn, (pm >> 1) & 7, pm & 1); });
    PANEL_SYNC(0);
    RUNP(5, {
        SchedMerge S{(const char*)(F.ws + WS_YPOOL), (const char*)(F.ws + WS_YHG), (const char*)(F.ws + WS_WPA), (const char*)(F.ws + WS_WB), F.G, F.bid};
        EpiMerge E{F.ws + WS_G8, (bf16*)(F.ws + WS_M)};
        pg8::gemm_phase<EpiMerge, SchedMerge, true, true>(F.lds, 512, S, E);
    });
    PANEL_SYNC(1);
    RUNP(6, {
        SchedTile S{(const char*)(F.ws + WS_M), (const char*)(F.ws + WS_WO), D, pm, pn};
        EpiRes E{F.x, (const float*)(F.ws + WS_MOD), (bf16*)(F.ws + WS_YHG), (bf16*)(F.ws + WS_YPOOL)};
        pg8::gemm_phase<EpiRes, SchedTile, true, true>(F.lds, D, S, E);
    });
    PANEL_SYNC(2);
    RUNP(7, {
        const float* mod = (const float*)(F.ws + WS_MOD) + (pm >> 4) * 6144; unsigned char* H2 = F.ws + WS_M;
        const bf16* X0 = (const bf16*)(F.ws + WS_YHG); const bf16* X1 = (const bf16*)(F.ws + WS_YPOOL); unsigned char* H8 = F.ws + WS_H8P;
        const size_t m0 = (size_t)pm * 256 + pn * 64 + F.wave * 8;
        f32x4 gm[4]; f32x4 shv[4];
        _Pragma("unroll") for (int j = 0; j < 4; ++j) { const f32x4 gg = ((const GAS f32x4*)F.n2g)[F.lane + 64 * j], sc = ((const GAS f32x4*)(mod + 4 * 1024))[F.lane + 64 * j]; gm[j] = gg * (sc + 1.0f); shv[j] = ((const GAS f32x4*)(mod + 3 * 1024))[F.lane + 64 * j]; }
        v2u xc[4]; mrq_load(X0 + m0 * 512, X1 + m0 * 512, F.lane, xc);
        _Pragma("unroll 1") for (int i = 0; i < 8; ++i) { const size_t m = m0 + i, mn = m0 + (i < 7 ? i + 1 : i);
            v2u xn[4]; mrq_load(X0 + mn * 512, X1 + mn * 512, F.lane, xn);
            mrq_finish(xc, H2 + m * D, H8 + m * D, (float*)(F.ws + WS_SH) + m, (float*)(F.ws + WS_SH) + ML + m, gm, shv, F.lane);
            xc[0] = xn[0]; xc[1] = xn[1]; xc[2] = xn[2]; xc[3] = xn[3]; }
    }); xcd_barrier(bar);
    RUNP(8, {
#define P7B_TABLES() do { const int gw = F.bid * NWAVES + F.wave, NGW = F.G * NWAVES; \
          i4_rows(F.pu, F.ws + WS_U8, (float*)(F.ws + WS_SU), gw, NGW, F.lane, false); \
          i4_rows(F.pv, F.ws + WS_V8, (float*)(F.ws + WS_SV), gw, NGW, F.lane, true); } while (0)
        if (F.bid & 1) { P7B_TABLES(); __syncthreads(); }
        EpiTopk8 E{(unsigned short*)(F.ws + WS_EIDX), (float*)(F.ws + WS_GATE), (const float*)(F.ws + WS_SH) + 2 * ML, (const float*)(F.ws + WS_SB)};
        { SchedTile S{(const char*)(F.ws + WS_M), (const char*)(F.ws + WS_WC8), D / 2, pm, pn};
          pg8::gemm_phase<EpiTopk8, SchedTile, true, true, true>(F.lds, D / 2, S, E); }
        __syncthreads();
        { SchedTile S{(const char*)(F.ws + WS_M), (const char*)(F.ws + WS_WC8), D / 2, pm, pn + 4};
          pg8::gemm_phase<EpiTopk8, SchedTile, true, true, true>(F.lds, D / 2, S, E); }
        if (!(F.bid & 1)) { __syncthreads(); P7B_TABLES(); }
    }); xcd_barrier(bar);
    int pslice = F.bid & 7, prank = F.bid >> 3; const int pnrank = F.G >> 3;
    if (ONE_LAUNCH && (IN(10) || IN(12))) {
        bool okc = (F.G == 256) && (bar.x < 8u);
#pragma unroll
        for (int j = 0; j < 8; ++j) okc = okc && (xb_ld(&barw[XB_XCNT(j)]) == 32u);
        if (okc) { pslice = (int)bar.x; prank = (int)MISC[10]; }
    }
    RUNP(10, peer_u_reduce(F, (pslice * pnrank + prank)););
    { asm volatile("s_waitcnt vmcnt(0)" ::: "memory"); __syncthreads(); }
    RUNP(12, peer_v_final(F, (pslice * pnrank + prank)););
#undef RUNP
#undef IN
#undef SEAM
}

extern "C" void kernel_launch(void* const* d_in, const int* in_sizes, int n_in, void* d_out, int out_size, void* d_ws, size_t ws_size, hipStream_t stream) {
    static int grid = 0;
    if (grid == 0) {
        if (n_in != 21 || out_size != ML * D || ws_size < WS_END) { fprintf(stderr, "kernel_launch: unexpected problem (n_in %d, out %d, ws %zu)\n", n_in, out_size, ws_size); grid = -1; return; }
        int dev = 0, cus = 0;
        if (hipGetDevice(&dev) != hipSuccess || hipDeviceGetAttribute(&cus, hipDeviceAttributeMultiprocessorCount, dev) != hipSuccess) { grid = -1; return; }
        if (hipFuncSetAttribute((const void*)fwd_kernel, hipFuncAttributeMaxDynamicSharedMemorySize, LDS_BYTES) != hipSuccess) { fprintf(stderr, "kernel_launch: hipFuncSetAttribute failed\n"); grid = -1; return; }
        int per_cu = 0;
        if (hipOccupancyMaxActiveBlocksPerMultiprocessor(&per_cu, (const void*)fwd_kernel, NTHREADS, LDS_BYTES) != hipSuccess || per_cu < 1) fprintf(stderr, "kernel_launch: occupancy query says %d\n", per_cu);
        (void)hipGetLastError();
        if (cus != 256) { fprintf(stderr, "kernel_launch: the row-panel chain is laid out for 256 workgroups (one per CU), found %d CUs\n", cus); grid = -1; return; }
        grid = cus;
    }
    if (grid < 0) return;
    (void)hipMemsetAsync((char*)d_ws + WS_CTL, 0, CTL_ZERO_BYTES, stream);
    Args a{};
    for (int i = 0; i < 21; ++i) a.in[i] = (const float*)d_in[i];
    a.out = (float*)d_out; a.ws = (unsigned char*)d_ws;
#if ONE_LAUNCH
    a.ph_lo = 0; a.ph_hi = N_PHASES;
    hipLaunchKernelGGL(fwd_kernel, dim3(grid), dim3(NTHREADS), LDS_BYTES, stream, a);
#else
    static const int order[N_PHASES - 1] = {0, 1, 2, 3, 14, 4, 5, 6, 7, 8, 10, 11, 12, 13};
    for (int pi = 0; pi < N_PHASES - 1; ++pi) { const int p = order[pi]; a.ph_lo = p; a.ph_hi = p + 1; hipLaunchKernelGGL(fwd_kernel, dim3(grid), dim3(NTHREADS), LDS_BYTES, stream, a); }
#endif
}
```
